# Optimizing an MI355X kernel written in HIP

```python
import jax, jax.numpy as jnp
from jax import lax
import numpy as np

D_MODEL = 1024
BATCH = 4
SEQ = 4096
DEPTH = 2

CHUNK = 64
N_META = 16
Q_BLOCK = 128
D_MIX = D_MODEL
FOX_HEADS = 8
FOX_HEAD_DIM = 64
FOX_WIDTH = FOX_HEADS * FOX_HEAD_DIM
HG_HEADS = 4
HG_EXPAND = 128
HG_HEAD_V = (D_MIX - FOX_WIDTH) // HG_HEADS
HG_K = HG_HEADS * HG_EXPAND
HG_V = HG_HEADS * HG_HEAD_V
D_FF = -(-8 * D_MODEL // (3 * 256)) * 256
EPS = 1e-6
MASK_VALUE = -1e30
LOG_F_MIN = -30.0
IN_SIZES = (FOX_WIDTH, FOX_WIDTH, FOX_WIDTH, FOX_HEADS, HG_K, HG_K, HG_V, HG_V)
IN_COLS = sum(IN_SIZES)

kernel_name = "hymba_fox_hgrn2_hybrid_trunk"


def rms_norm(x, w):
    xf = x.astype(jnp.float32)
    y = xf * lax.rsqrt(jnp.mean(xf * xf, axis=-1, keepdims=True) + EPS)
    return (y * w.astype(jnp.float32)).astype(x.dtype)


def forgetting_attention(q, k, v, log_f):
    B, L, H, Dh = q.shape
    n_blk = -(-L // Q_BLOCK)
    Lp = n_blk * Q_BLOCK
    pad = Lp - L
    padf = lambda a: jnp.pad(a, [(0, 0), (0, pad)] + [(0, 0)] * (a.ndim - 2))
    q, k, v, log_f = padf(q), padf(k), padf(v), padf(log_f)
    c = jnp.cumsum(log_f, axis=1)
    cT = c.transpose(0, 2, 1)
    scale = Dh ** -0.5
    key_pos = jnp.arange(Lp)
    qb = q.reshape(B, n_blk, Q_BLOCK, H, Dh).transpose(1, 0, 2, 3, 4)
    cb = c.reshape(B, n_blk, Q_BLOCK, H).transpose(1, 0, 3, 2)

    def block(args):
        i, q_i, c_i = args
        s = jnp.einsum('bqhd,bkhd->bhqk', q_i, k, preferred_element_type=jnp.float32) * scale
        s = s + (c_i[..., :, None] - cT[:, :, None, :])
        q_pos = i * Q_BLOCK + jnp.arange(Q_BLOCK)
        s = jnp.where(key_pos[None, :] <= q_pos[:, None], s, MASK_VALUE)
        p = jax.nn.softmax(s, axis=-1)
        return jnp.einsum('bhqk,bkhd->bqhd', p.astype(v.dtype), v)

    o = lax.map(block, (jnp.arange(n_blk), qb, cb))
    return o.transpose(1, 0, 2, 3, 4).reshape(B, Lp, H, Dh)[:, :L]


def hgrn2_recurrence(q, k, v, log_f):
    B, L, H, K = q.shape
    V = v.shape[-1]
    pad = (-L) % CHUNK
    padf = lambda a: jnp.pad(a, ((0, 0), (pad, 0), (0, 0), (0, 0)))
    q, k, v, log_f = padf(q), padf(k), padf(v), padf(log_f)
    Lp = L + pad
    n = Lp // CHUNK
    to_chunks = lambda a: a.reshape(B, n, CHUNK, H, a.shape[-1]).transpose(1, 0, 3, 2, 4)
    causal = jnp.tril(jnp.ones((CHUNK, CHUNK), dtype=bool))[:, :, None]

    def step(S, inp):
        q_c, k_c, v_c, g_c = inp
        b = jnp.cumsum(g_c, axis=2)
        o_inter = jnp.einsum('bhtk,bhkv->bhtv', q_c * jnp.exp(b), S)
        rel = b[:, :, :, None, :] - b[:, :, None, :, :]
        decay = jnp.where(causal, jnp.exp(jnp.where(causal, rel, 0.0)), 0.0)
        A = jnp.einsum('bhtk,bhsk,bhtsk->bhts', q_c, k_c, decay)
        o_intra = jnp.einsum('bhts,bhsv->bhtv', A, v_c)
        b_last = b[:, :, -1]
        k_dec = k_c * jnp.exp(b_last[:, :, None, :] - b)
        S = jnp.exp(b_last)[..., None] * S + jnp.einsum('bhsk,bhsv->bhkv', k_dec, v_c)
        return S, o_inter + o_intra

    S0 = jnp.zeros((B, H, K, V), jnp.float32)
    _, o = lax.scan(step, S0, (to_chunks(q), to_chunks(k), to_chunks(v), to_chunks(log_f)))
    o = o.transpose(1, 0, 3, 2, 4).reshape(B, Lp, H, V)
    return o[:, pad:]


def setup_inputs(seed: int = 0) -> dict:
    key = jax.random.key(seed)
    ks = jax.random.split(key, 14)
    nrm = lambda k, shape, s: jax.random.normal(k, shape, jnp.float32) * s
    return {
        "x": nrm(ks[0], (BATCH, SEQ, D_MODEL), 1.0),
        "meta": nrm(ks[1], (N_META, D_MODEL), 1.0),
        "norm_mix_w": 1.0 + nrm(ks[2], (DEPTH, D_MODEL), 0.02),
        "w_in": nrm(ks[3], (DEPTH, D_MODEL, IN_COLS), D_MODEL ** -0.5),
        "fox_f_bias": 2.0 + nrm(ks[4], (DEPTH, FOX_HEADS), 0.5),
        "hgrn_lb_raw": nrm(ks[5], (DEPTH, HG_K), 1.0),
        "hgrn_norm_w": 1.0 + nrm(ks[6], (DEPTH, HG_HEAD_V), 0.02),
        "w_out": nrm(ks[7], (DEPTH, D_MIX, D_MODEL), D_MIX ** -0.5),
        "norm_ffn_w": 1.0 + nrm(ks[8], (DEPTH, D_MODEL), 0.02),
        "w_ffn_gate": nrm(ks[9], (DEPTH, D_MODEL, D_FF), D_MODEL ** -0.5),
        "w_ffn_up": nrm(ks[10], (DEPTH, D_MODEL, D_FF), D_MODEL ** -0.5),
        "w_ffn_down": nrm(ks[11], (DEPTH, D_FF, D_MODEL), D_FF ** -0.5),
        "norm_final_w": 1.0 + nrm(ks[12], (D_MODEL,), 0.02),
    }


def reference(x, meta, norm_mix_w, w_in, fox_f_bias, hgrn_lb_raw, hgrn_norm_w, w_out,
              norm_ffn_w, w_ffn_gate, w_ffn_up, w_ffn_down, norm_final_w):
    B = x.shape[0]
    h = jnp.concatenate([jnp.broadcast_to(meta[None].astype(x.dtype), (B, N_META, D_MODEL)), x], axis=1)
    L = h.shape[1]
    s_lb = jax.nn.softmax(hgrn_lb_raw.astype(jnp.float32), axis=0)
    lower_bounds = jnp.cumsum(s_lb, axis=0) - s_lb[0]
    split_at = tuple(int(v) for v in np.cumsum(IN_SIZES)[:-1])

    for l in range(DEPTH):
        u = rms_norm(h, norm_mix_w[l])
        proj = u @ w_in[l]
        fq, fk, fv, ff, hq, hf, hi, hg = jnp.split(proj, split_at, axis=-1)

        fox_log_f = jax.nn.log_sigmoid(ff.astype(jnp.float32) + fox_f_bias[l].astype(jnp.float32))
        hs = (B, L, FOX_HEADS, FOX_HEAD_DIM)
        fox_out = forgetting_attention(fq.reshape(hs), fk.reshape(hs), fv.reshape(hs), fox_log_f)
        fox_out = fox_out.reshape(B, L, FOX_WIDTH).astype(h.dtype)

        lb = lower_bounds[l]
        one_minus_f = (1.0 - lb) * jax.nn.sigmoid(-hf.astype(jnp.float32))
        log_f = jnp.maximum(jnp.log1p(-one_minus_f), LOG_F_MIN)
        k_in = -jnp.expm1(log_f)
        q_h = jax.nn.silu(hq.astype(jnp.float32)) * (HG_EXPAND ** -0.5)
        ks_ = (B, L, HG_HEADS, HG_EXPAND)
        o_h = hgrn2_recurrence(q_h.reshape(ks_), k_in.reshape(ks_),
                               hi.astype(jnp.float32).reshape(B, L, HG_HEADS, HG_HEAD_V),
                               log_f.reshape(ks_))
        o_h = rms_norm(o_h, hgrn_norm_w[l])
        hgrn_out = (o_h.reshape(B, L, HG_V) * jax.nn.silu(hg.astype(jnp.float32))).astype(h.dtype)

        mixed = jnp.concatenate([fox_out, hgrn_out], axis=-1) @ w_out[l]
        h = h + mixed

        u = rms_norm(h, norm_ffn_w[l])
        h = h + (jax.nn.silu(u @ w_ffn_gate[l]) * (u @ w_ffn_up[l])) @ w_ffn_down[l]

    return rms_norm(h, norm_final_w)[:, N_META:]
```

```cpp
#include <hip/hip_runtime.h>
#include <hip/hip_cooperative_groups.h>
#include <cstdint>
#include <cstdio>
namespace cg = cooperative_groups;

typedef unsigned short bf16_t;
typedef short bf16x8 __attribute__((ext_vector_type(8)));
typedef float f32x4 __attribute__((ext_vector_type(4)));
typedef unsigned u32x4 __attribute__((ext_vector_type(4)));
#define LAS __attribute__((address_space(3)))

constexpr int DM = 1024, NB = 4, SEQ = 4096, NMETA = 16, PADF = 48, LV = 4160, MROWS = NB * LV, MALLOC = MROWS + 256;
constexpr int FOXH = 8, FOXD = 64, FOXW = 512, HGH = 4, HGK = 128, HGV = 128, HGW = 512, DFF = 2816, INCOLS = 3592, NIN = 3584;
constexpr int KBL = 4352;
constexpr float EPS = 1e-6f, LOG2E = 1.4426950408889634f, C2 = 0.125f * LOG2E, HGQS = 0.08838834764831845f;
constexpr int NTHREADS = 512, NWAVES = 8;
constexpr int LDS_BYTES = 147456;

constexpr size_t MiB = 1u << 20;
constexpr size_t WS_CTL = 0;
constexpr size_t WS_SUMSQ = 64 * 1024;
constexpr size_t SUMSQ_STRIDE = (size_t)MALLOC * 4;
constexpr size_t WS_LBV = WS_SUMSQ + 4 * SUMSQ_STRIDE;
constexpr size_t WS_LOGF8 = WS_LBV + 4096;
constexpr size_t WS_KBIAS = WS_LOGF8 + (size_t)MALLOC * 32;
constexpr size_t WS_HS = 2 * MiB;
constexpr size_t WS_W = 3 * MiB;
constexpr size_t W_IN = 0, W_OUT = W_IN + (size_t)NIN * DM * 2, W_GU = W_OUT + (size_t)DM * DM * 2, W_DN = W_GU + (size_t)2 * DFF * DM * 2, W_LAYER = W_DN + (size_t)DM * DFF * 2;
constexpr size_t WS_HB = WS_W + 2 * W_LAYER + 65536;
constexpr size_t WS_MIX = WS_HB + (size_t)MALLOC * DM * 2;
constexpr size_t WS_QB = WS_MIX + (size_t)MALLOC * DM * 2;
constexpr size_t WS_KB = WS_QB + (size_t)MALLOC * 512 * 2, WS_VB = WS_KB + (size_t)MALLOC * 512 * 2;
constexpr size_t WS_HXQ = WS_VB + (size_t)MALLOC * 512 * 2;
constexpr size_t WS_LOGF = WS_HXQ + (size_t)MALLOC * 512 * 2;
constexpr size_t WS_HV = WS_LOGF + (size_t)MALLOC * 512 * 4, WS_HG = WS_HV + (size_t)MALLOC * 512 * 2;
constexpr size_t WS_END = WS_HG + (size_t)MALLOC * 512 * 2;
constexpr size_t WS_ACT = WS_QB;
static_assert(WS_KBIAS + 32 * KBL * 4 <= WS_HS && WS_HS + 4 * 64 * 1024 * 4 <= WS_W, "small map");
static_assert(WS_ACT + (size_t)MALLOC * DFF * 2 <= WS_END, "ACT overlay");
static_assert(WS_END <= 256 * MiB, "d_ws");

struct Args { const float* in[13]; float* out; unsigned char* ws; };

struct Ctx {
    const float *x, *meta, *nmw, *win, *fbias, *lbraw, *hnw, *wout, *nfw, *wg, *wu, *wd, *nfinal;
    float* out; unsigned char* ws;
    unsigned* ctl; float* sumsq; float* lbv; float* logf8; float* kbias; float* hs;
    bf16_t *HB, *MIX, *QB, *KB, *VB, *HXQ, *HV, *HG, *ACT; float* LOGF;
    int tid, lane, wave, gw, NGW;
};

__device__ __forceinline__ unsigned f2bf(float f) { unsigned u = __builtin_bit_cast(unsigned, f); return (u + 0x7fffu + ((u >> 16) & 1u)) >> 16; }
__device__ __forceinline__ unsigned pk2(float lo, float hi) { return f2bf(lo) | (f2bf(hi) << 16); }
__device__ __forceinline__ float bf2f(unsigned short b) { return __builtin_bit_cast(float, (unsigned)b << 16); }
__device__ __forceinline__ float wave_sum(float v) {
#pragma unroll
    for (int o = 1; o < 64; o <<= 1) v += __shfl_xor(v, o);
    return v;
}
__device__ __forceinline__ float wave_max(float v) {
#pragma unroll
    for (int o = 1; o < 64; o <<= 1) v = fmaxf(v, __shfl_xor(v, o));
    return v;
}
__device__ __forceinline__ float siluf(float x) { return x / (1.f + __expf(-x)); }
__device__ __forceinline__ float* hrow(const Ctx& c, int r) {
    const int b = r / LV, vp = r - b * LV;
    return vp >= 64 ? c.out + (size_t)(b * SEQ + vp - 64) * DM : c.hs + (size_t)(b * 64 + vp) * DM;
}
__device__ __forceinline__ bf16_t* wptr(const Ctx& c, int layer, size_t off) { return (bf16_t*)(c.ws + WS_W + (size_t)layer * W_LAYER + off); }

__device__ __forceinline__ void tr_item(const float* W, int K, int N, int k0, int nsrc0, bf16_t* WT, int dst_row0, const float* kscale, LAS float* scr, int lane) {
#pragma unroll 8
    for (int i = 0; i < 32; ++i) { const int kk = 2 * i + (lane >> 5); float s = kscale ? kscale[k0 + kk] : 1.f; scr[kk * 33 + (lane & 31)] = W[(size_t)(k0 + kk) * N + nsrc0 + (lane & 31)] * s; }
    asm volatile("s_waitcnt lgkmcnt(0)" ::: "memory");
    const int ch = lane & 7;
#pragma unroll
    for (int j = 0; j < 4; ++j) { const int n = (lane >> 3) + 8 * j; const LAS float* s = scr + (8 * ch) * 33 + n;
        u32x4 o; o.x = pk2(s[0 * 33], s[1 * 33]); o.y = pk2(s[2 * 33], s[3 * 33]); o.z = pk2(s[4 * 33], s[5 * 33]); o.w = pk2(s[6 * 33], s[7 * 33]);
        *(u32x4*)(WT + (size_t)(dst_row0 + n) * K + k0 + 8 * ch) = o; }
    asm volatile("s_waitcnt lgkmcnt(0)" ::: "memory");
}

__device__ __forceinline__ void p0_weights(const Ctx& c, LAS unsigned char* lds) {
    LAS float* scr = (LAS float*)(lds + c.wave * 16384);
    constexpr int I_IN = 16 * (NIN / 32), I_OUT = 16 * 32, I_G = 16 * (DFF / 32), I_D = (DFF / 64) * 32, I_L = I_IN + I_OUT + 2 * I_G + I_D;
    for (int it = c.gw; it < 2 * I_L; it += c.NGW) {
        const int l = it / I_L; int r = it - l * I_L;
        if (r < I_IN) { const int kb = r / (NIN / 32), nb = r % (NIN / 32), n0 = nb * 32;
            tr_item(c.win + (size_t)l * DM * INCOLS, DM, INCOLS, kb * 64, n0 + (n0 >= 1536 ? 8 : 0), wptr(c, l, W_IN), n0, c.nmw + l * DM, scr, c.lane); continue; }
        r -= I_IN;
        if (r < I_OUT) { const int kb = r / 32, nb = r % 32; tr_item(c.wout + (size_t)l * DM * DM, DM, DM, kb * 64, nb * 32, wptr(c, l, W_OUT), nb * 32, nullptr, scr, c.lane); continue; }
        r -= I_OUT;
        if (r < 2 * I_G) { const int up = r >= I_G; if (up) r -= I_G; const int kb = r / (DFF / 32), nb = r % (DFF / 32), f0 = nb * 32;
            tr_item((up ? c.wu : c.wg) + (size_t)l * DM * DFF, DM, DFF, kb * 64, f0, wptr(c, l, W_GU), 256 * (f0 >> 7) + (f0 & 127) + (up ? 128 : 0), c.nfw + l * DM, scr, c.lane); continue; }
        r -= 2 * I_G;
        { const int kb = r / 32, nb = r % 32; tr_item(c.wd + (size_t)l * DFF * DM, DFF, DM, kb * 64, nb * 32, wptr(c, l, W_DN), nb * 32, nullptr, scr, c.lane); }
    }
}

__device__ __forceinline__ void ff_rows(const Ctx& c, LAS unsigned char* lds, int layer) {
    LAS float* wff = (LAS float*)lds;
    for (int i = c.tid; i < 8 * DM; i += NTHREADS) { const int cc = i >> 10, k = i & 1023; wff[i] = c.win[(size_t)layer * DM * INCOLS + (size_t)k * INCOLS + 1536 + cc] * c.nmw[layer * DM + k]; }
    __syncthreads();
    float* ssq = c.sumsq + (size_t)layer * MALLOC;
    for (int r = c.gw; r < MROWS; r += c.NGW) {
        const int b = r / LV, vp = r - b * LV;
        f32x4 v[4];
        float* hp = hrow(c, r);
        if (layer == 0) {
            const float* src = vp >= 64 ? c.x + (size_t)(b * SEQ + vp - 64) * DM : (vp >= PADF ? c.meta + (size_t)(vp - PADF) * DM : nullptr);
#pragma unroll
            for (int j = 0; j < 4; ++j) { v[j] = src ? *(const f32x4*)(src + 4 * c.lane + 256 * j) : (f32x4){0.f, 0.f, 0.f, 0.f}; *(f32x4*)(hp + 4 * c.lane + 256 * j) = v[j];
                unsigned long long w = (unsigned long long)pk2(v[j].x, v[j].y) | ((unsigned long long)pk2(v[j].z, v[j].w) << 32);
                *(unsigned long long*)(c.HB + (size_t)r * DM + 4 * c.lane + 256 * j) = w; }
        } else {
#pragma unroll
            for (int j = 0; j < 4; ++j) v[j] = *(const f32x4*)(hp + 4 * c.lane + 256 * j);
        }
        float s = 0.f;
#pragma unroll
        for (int j = 0; j < 4; ++j) s += (v[j].x * v[j].x + v[j].y * v[j].y) + (v[j].z * v[j].z + v[j].w * v[j].w);
        s = wave_sum(s);
        const float rstd = 1.f / sqrtf(s * (1.f / DM) + EPS);
        float myv = 0.f;
#pragma unroll
        for (int cc = 0; cc < 8; ++cc) {
            float d = 0.f;
#pragma unroll
            for (int j = 0; j < 4; ++j) { const f32x4 w = *(const LAS f32x4*)(wff + cc * DM + 4 * c.lane + 256 * j); d += (v[j].x * w.x + v[j].y * w.y) + (v[j].z * w.z + v[j].w * w.w); }
            d = wave_sum(d);
            if (c.lane == cc) myv = d;
        }
        if (c.lane == 0) ssq[r] = s;
        if (c.lane < 8) { const float z = myv * rstd + c.fbias[layer * 8 + c.lane];
            c.logf8[(size_t)r * 8 + c.lane] = fminf(z, 0.f) - log1pf(__expf(-fabsf(z))); }
    }
    __syncthreads();
}

__device__ __forceinline__ void kbias_build(const Ctx& c) {
    for (int job = c.gw; job < NB * FOXH; job += c.NGW) {
        const int b = job >> 3, h = job & 7;
        float s = 0.f;
        const int v0 = 65 * c.lane;
        for (int i = 0; i < 65; ++i) { const int vp = v0 + i; const float g = vp >= PADF ? c.logf8[(size_t)(b * LV + vp) * 8 + h] : 0.f; s += g; }
        float inc = s;
#pragma unroll
        for (int o = 1; o < 64; o <<= 1) { const float t = __shfl_up(inc, o); if (c.lane >= o) inc += t; }
        float run = inc - s;
        float* kb = c.kbias + (size_t)job * KBL;
        for (int i = 0; i < 65; ++i) { const int vp = v0 + i; const float g = vp >= PADF ? c.logf8[(size_t)(b * LV + vp) * 8 + h] : 0.f; run += g; kb[vp] = vp >= PADF ? -run * LOG2E : -1e30f; }
        for (int i = LV + c.lane; i < KBL; i += 64) kb[i] = 0.f;
    }
}

template <int MODE>
__device__ __forceinline__ void gemm_simple(const Ctx& c, int layer) {
    const int fr = c.lane & 15, g = c.lane >> 4;
    const bf16_t* A = MODE == 0 ? c.HB : MODE == 1 ? c.MIX : MODE == 2 ? c.HB : c.ACT;
    const bf16_t* Bt = wptr(c, layer, MODE == 0 ? W_IN : MODE == 1 ? W_OUT : MODE == 2 ? W_GU : W_DN);
    constexpr int K = MODE == 3 ? DFF : DM;
    constexpr int NCOL = MODE == 0 ? NIN : MODE == 2 ? DFF : DM;
    constexpr int ntn = NCOL / 64, ntm = MROWS / 16;
    for (int t = c.gw; t < ntm * ntn; t += c.NGW) {
        const int tm = t / ntn, tn = t - tm * ntn, row0 = tm * 16, col0 = tn * 64;
        f32x4 acc[4], acc2[4];
#pragma unroll
        for (int n = 0; n < 4; ++n) { acc[n] = (f32x4){0.f, 0.f, 0.f, 0.f}; acc2[n] = (f32x4){0.f, 0.f, 0.f, 0.f}; }
        const bf16_t* ap = A + (size_t)(row0 + fr) * K + 8 * g;
        const bf16_t* bp[4];
#pragma unroll
        for (int n = 0; n < 4; ++n) { const int cn = col0 + 16 * n + fr; const int br = MODE == 2 ? 256 * (cn >> 7) + (cn & 127) : cn; bp[n] = Bt + (size_t)br * K + 8 * g; }
        for (int k0 = 0; k0 < K; k0 += 32) {
            const bf16x8 a = *(const bf16x8*)(ap + k0);
#pragma unroll
            for (int n = 0; n < 4; ++n) { const bf16x8 b = *(const bf16x8*)(bp[n] + k0); acc[n] = __builtin_amdgcn_mfma_f32_16x16x32_bf16(a, b, acc[n], 0, 0, 0);
                if (MODE == 2) { const bf16x8 b2 = *(const bf16x8*)(bp[n] + (size_t)128 * K + k0); acc2[n] = __builtin_amdgcn_mfma_f32_16x16x32_bf16(a, b2, acc2[n], 0, 0, 0); } }
        }
        if (MODE == 0) {
            const float* ssq = c.sumsq + (size_t)layer * MALLOC;
#pragma unroll
            for (int j = 0; j < 4; ++j) { const int r = row0 + 4 * g + j; const float rstd = 1.f / sqrtf(ssq[r] * (1.f / DM) + EPS);
#pragma unroll
                for (int n = 0; n < 4; ++n) { const int cn = col0 + 16 * n + fr; const float xv = acc[n][j] * rstd; const int part = cn >> 9, cc = cn & 511; const size_t o = (size_t)r * 512 + cc;
                    if (part == 0) c.QB[o] = (bf16_t)f2bf(xv * C2);
                    else if (part == 1) c.KB[o] = (bf16_t)f2bf(xv);
                    else if (part == 2) c.VB[o] = (bf16_t)f2bf(xv);
                    else if (part == 3) c.HXQ[o] = (bf16_t)f2bf(siluf(xv) * HGQS);
                    else if (part == 4) { const float lb = layer ? c.lbv[cc] : 0.f; const float omf = (1.f - lb) / (1.f + __expf(xv)); c.LOGF[o] = fmaxf(log1pf(-omf), -30.f); }
                    else if (part == 5) c.HV[o] = (bf16_t)f2bf(xv);
                    else c.HG[o] = (bf16_t)f2bf(siluf(xv)); } }
        } else if (MODE == 1 || MODE == 3) {
            float* ssq = c.sumsq + (size_t)(2 + layer) * MALLOC;
#pragma unroll
            for (int j = 0; j < 4; ++j) { const int r = row0 + 4 * g + j; float* hp = hrow(c, r); float q = 0.f;
#pragma unroll
                for (int n = 0; n < 4; ++n) { const int cn = col0 + 16 * n + fr; const float hn = hp[cn] + acc[n][j]; hp[cn] = hn; c.HB[(size_t)r * DM + cn] = (bf16_t)f2bf(hn); q += hn * hn; }
                if (MODE == 1) { q += __shfl_xor(q, 1); q += __shfl_xor(q, 2); q += __shfl_xor(q, 4); q += __shfl_xor(q, 8); if (fr == 0) atomicAdd(ssq + r, q); } }
        } else {
            const float* ssq = c.sumsq + (size_t)(2 + layer) * MALLOC;
#pragma unroll
            for (int j = 0; j < 4; ++j) { const int r = row0 + 4 * g + j; const float rstd = 1.f / sqrtf(ssq[r] * (1.f / DM) + EPS);
#pragma unroll
                for (int n = 0; n < 4; ++n) { const int cn = col0 + 16 * n + fr; const float gv = acc[n][j] * rstd, uv = acc2[n][j] * rstd; c.ACT[(size_t)r * DFF + cn] = (bf16_t)f2bf(siluf(gv) * uv); } }
        }
    }
}

__device__ __forceinline__ void fox_simple(const Ctx& c, LAS unsigned char* lds, int first_block) {
    LAS float* sc = (LAS float*)(lds + c.wave * 16896);
    LAS float* qs = sc; LAS float* ps = sc + 64;
    const int nblk = gridDim.x - first_block; if ((int)blockIdx.x < first_block) return;
    const int gw = ((int)blockIdx.x - first_block) * NWAVES + c.wave, NGW = nblk * NWAVES;
    for (int it = gw; it < MROWS * FOXH; it += NGW) {
        const int r = it >> 3, h = it & 7, b = r / LV, vp = r - b * LV;
        bf16_t* op = c.MIX + (size_t)r * DM + h * 64;
        if (vp < PADF) { op[c.lane] = 0; continue; }
        qs[c.lane] = bf2f(c.QB[(size_t)r * 512 + h * 64 + c.lane]);
        asm volatile("s_waitcnt lgkmcnt(0)" ::: "memory");
        const float* kb = c.kbias + (size_t)(b * 8 + h) * KBL;
        float mx = -3.0e38f;
        for (int j = PADF + c.lane; j <= vp; j += 64) {
            const bf16_t* kr = c.KB + (size_t)(b * LV + j) * 512 + h * 64; float s = 0.f;
#pragma unroll
            for (int d8 = 0; d8 < 8; ++d8) { const bf16x8 kv = *(const bf16x8*)(kr + d8 * 8);
#pragma unroll
                for (int e = 0; e < 8; ++e) s += qs[d8 * 8 + e] * bf2f((unsigned short)kv[e]); }
            s += kb[j]; ps[j] = s; mx = fmaxf(mx, s);
        }
        mx = wave_max(mx);
        float l = 0.f;
        for (int j = PADF + c.lane; j <= vp; j += 64) { const float p = exp2f(ps[j] - mx); ps[j] = p; l += p; }
        l = wave_sum(l);
        asm volatile("s_waitcnt lgkmcnt(0)" ::: "memory");
        float o = 0.f;
        const bf16_t* vr = c.VB + (size_t)(b * LV) * 512 + h * 64 + c.lane;
        for (int j = PADF; j <= vp; ++j) o += ps[j] * bf2f(vr[(size_t)j * 512]);
        op[c.lane] = (bf16_t)f2bf(o / l);
        asm volatile("s_waitcnt lgkmcnt(0)" ::: "memory");
    }
}

__device__ __forceinline__ void hgrn_simple(const Ctx& c, LAS unsigned char* lds, int layer) {
    if (blockIdx.x >= NB * HGH) return;
    const int b = blockIdx.x >> 2, hh = blockIdx.x & 3;
    LAS float* fL = (LAS float*)lds;
    LAS float* kL = fL + 2048; LAS float* qL = kL + 2048; LAS float* vL = qL + 2048; LAS float* oP = vL + 2048;
    const int v = c.tid & 127, kg = c.tid >> 7;
    float S[32];
#pragma unroll
    for (int i = 0; i < 32; ++i) S[i] = 0.f;
    for (int i = c.tid; i < PADF * 128; i += NTHREADS) { const int vp = i >> 7; c.MIX[(size_t)(b * LV + vp) * DM + 512 + hh * 128 + (i & 127)] = 0; }
    for (int t0 = PADF; t0 < LV; t0 += 16) {
        for (int i = c.tid; i < 2048; i += NTHREADS) { const int t = i >> 7, k = i & 127; const size_t o = (size_t)(b * LV + t0 + t) * 512 + hh * 128 + k;
            const float f = __expf(c.LOGF[o]); fL[i] = f; kL[i] = 1.f - f; qL[i] = bf2f(c.HXQ[o]); vL[i] = bf2f(c.HV[o]); }
        __syncthreads();
        for (int t = 0; t < 16; ++t) { const float vv = vL[t * 128 + v]; float part = 0.f;
#pragma unroll
            for (int i = 0; i < 32; ++i) { const int k = kg * 32 + i; S[i] = fL[t * 128 + k] * S[i] + kL[t * 128 + k] * vv; part += S[i] * qL[t * 128 + k]; }
            oP[(kg * 16 + t) * 128 + v] = part; }
        __syncthreads();
        for (int tt = 0; tt < 2; ++tt) { const int t = c.wave * 2 + tt; float o0, o1;
            { const int v0 = c.lane, v1 = c.lane + 64; o0 = oP[t * 128 + v0] + oP[(16 + t) * 128 + v0] + oP[(32 + t) * 128 + v0] + oP[(48 + t) * 128 + v0];
              o1 = oP[t * 128 + v1] + oP[(16 + t) * 128 + v1] + oP[(32 + t) * 128 + v1] + oP[(48 + t) * 128 + v1]; }
            const float ss = wave_sum(o0 * o0 + o1 * o1); const float rstd = 1.f / sqrtf(ss * (1.f / 128.f) + EPS);
            const size_t ro = (size_t)(b * LV + t0 + t);
            const float g0 = bf2f(c.HG[ro * 512 + hh * 128 + c.lane]), g1 = bf2f(c.HG[ro * 512 + hh * 128 + c.lane + 64]);
            c.MIX[ro * DM + 512 + hh * 128 + c.lane] = (bf16_t)f2bf(o0 * rstd * c.hnw[layer * 128 + c.lane] * g0);
            c.MIX[ro * DM + 512 + hh * 128 + c.lane + 64] = (bf16_t)f2bf(o1 * rstd * c.hnw[layer * 128 + c.lane + 64] * g1); }
        __syncthreads();
    }
}

__device__ __forceinline__ void final_norm(const Ctx& c) {
    for (int r = c.gw; r < NB * SEQ; r += c.NGW) {
        float* hp = c.out + (size_t)r * DM; f32x4 v[4]; float s = 0.f;
#pragma unroll
        for (int j = 0; j < 4; ++j) { v[j] = *(const f32x4*)(hp + 4 * c.lane + 256 * j); s += (v[j].x * v[j].x + v[j].y * v[j].y) + (v[j].z * v[j].z + v[j].w * v[j].w); }
        s = wave_sum(s); const float rstd = 1.f / sqrtf(s * (1.f / DM) + EPS);
#pragma unroll
        for (int j = 0; j < 4; ++j) { const f32x4 w = *(const f32x4*)(c.nfinal + 4 * c.lane + 256 * j); *(f32x4*)(hp + 4 * c.lane + 256 * j) = v[j] * rstd * w; }
    }
}

__global__ void __launch_bounds__(NTHREADS, 2) fwd_kernel(Args a) {
    extern __shared__ __attribute__((aligned(16))) unsigned char lds_raw[];
    LAS unsigned char* lds = (LAS unsigned char*)lds_raw;
    cg::grid_group grid = cg::this_grid();
    Ctx c;
    c.x = a.in[0]; c.meta = a.in[1]; c.nmw = a.in[2]; c.win = a.in[3]; c.fbias = a.in[4]; c.lbraw = a.in[5]; c.hnw = a.in[6]; c.wout = a.in[7];
    c.nfw = a.in[8]; c.wg = a.in[9]; c.wu = a.in[10]; c.wd = a.in[11]; c.nfinal = a.in[12];
    c.out = a.out; c.ws = a.ws;
    c.ctl = (unsigned*)(a.ws + WS_CTL); c.sumsq = (float*)(a.ws + WS_SUMSQ); c.lbv = (float*)(a.ws + WS_LBV); c.logf8 = (float*)(a.ws + WS_LOGF8);
    c.kbias = (float*)(a.ws + WS_KBIAS); c.hs = (float*)(a.ws + WS_HS);
    c.HB = (bf16_t*)(a.ws + WS_HB); c.MIX = (bf16_t*)(a.ws + WS_MIX); c.QB = (bf16_t*)(a.ws + WS_QB); c.KB = (bf16_t*)(a.ws + WS_KB); c.VB = (bf16_t*)(a.ws + WS_VB);
    c.HXQ = (bf16_t*)(a.ws + WS_HXQ); c.LOGF = (float*)(a.ws + WS_LOGF); c.HV = (bf16_t*)(a.ws + WS_HV); c.HG = (bf16_t*)(a.ws + WS_HG); c.ACT = (bf16_t*)(a.ws + WS_ACT);
    c.tid = threadIdx.x; c.lane = c.tid & 63; c.wave = __builtin_amdgcn_readfirstlane(c.tid >> 6);
    c.gw = blockIdx.x * NWAVES + c.wave; c.NGW = gridDim.x * NWAVES;

    { const int gt = blockIdx.x * NTHREADS + c.tid, NGT = gridDim.x * NTHREADS;
      for (int i = gt; i < 16384; i += NGT) c.ctl[i] = 0u;
      for (int i = gt; i < 2 * MALLOC; i += NGT) c.sumsq[2 * MALLOC + i] = 0.f;
      for (int i = gt; i < HGW; i += NGT) c.lbv[i] = 1.f / (1.f + __expf(c.lbraw[i] - c.lbraw[HGW + i])); }
    p0_weights(c, lds);
    __syncthreads();
    ff_rows(c, lds, 0);
    grid.sync();
    for (int layer = 0; layer < 2; ++layer) {
        if (layer) { ff_rows(c, lds, 1); grid.sync(); }
        kbias_build(c);
        gemm_simple<0>(c, layer);
        grid.sync();
        hgrn_simple(c, lds, layer);
        fox_simple(c, lds, NB * HGH);
        grid.sync();
        gemm_simple<1>(c, layer);
        grid.sync();
        gemm_simple<2>(c, layer);
        grid.sync();
        gemm_simple<3>(c, layer);
        grid.sync();
    }
    final_norm(c);
}

extern "C" void kernel_launch(void* const* d_in, const int* in_sizes, int n_in, void* d_out, int out_size, void* d_ws, size_t ws_size, hipStream_t stream) {
    static int grid = 0;
    if (grid == 0) {
        if (n_in != 13 || out_size != NB * SEQ * DM || ws_size < WS_END) { fprintf(stderr, "kernel_launch: unexpected shapes n_in %d out %d ws %zu\n", n_in, out_size, ws_size); grid = -1; return; }
        int dev = 0, cus = 0, per_cu = 0;
        (void)hipGetDevice(&dev); (void)hipDeviceGetAttribute(&cus, hipDeviceAttributeMultiprocessorCount, dev);
        (void)hipFuncSetAttribute((const void*)fwd_kernel, hipFuncAttributeMaxDynamicSharedMemorySize, LDS_BYTES);
        (void)hipOccupancyMaxActiveBlocksPerMultiprocessor(&per_cu, (const void*)fwd_kernel, NTHREADS, LDS_BYTES);
        if (per_cu < 1) per_cu = 1;
        grid = cus * per_cu;
        (void)hipGetLastError();
    }
    if (grid < 0) return;
    Args a{};
    for (int i = 0; i < 13; ++i) a.in[i] = (const float*)d_in[i];
    a.out = (float*)d_out; a.ws = (unsigned char*)d_ws;
    void* args[] = {&a};
    hipError_t e = hipLaunchCooperativeKernel((const void*)fwd_kernel, dim3(grid), dim3(NTHREADS), args, LDS_BYTES, stream);
    if (e != hipSuccess) fprintf(stderr, "cooperative launch failed: %s (grid %d)\n", hipGetErrorString(e), grid);
}
```

```cpp
#include <hip/hip_runtime.h>
#include <hip/hip_cooperative_groups.h>
#include <cstdint>
#include <cstdio>
namespace cg = cooperative_groups;

typedef unsigned short bf16_t;
typedef short bf16x8 __attribute__((ext_vector_type(8)));
typedef float f32x4 __attribute__((ext_vector_type(4)));
typedef unsigned u32x4 __attribute__((ext_vector_type(4)));
#define LAS __attribute__((address_space(3)))

constexpr int DM = 1024, NB = 4, SEQ = 4096, NMETA = 16, PADF = 48, LV = 4160, MROWS = NB * LV, MALLOC = MROWS + 256;
constexpr int FOXH = 8, FOXD = 64, FOXW = 512, HGH = 4, HGK = 128, HGV = 128, HGW = 512, DFF = 2816, INCOLS = 3592, NIN = 3584;
constexpr int KBL = 4352;
constexpr float EPS = 1e-6f, LOG2E = 1.4426950408889634f, C2 = 0.125f * LOG2E, HGQS = 0.08838834764831845f;
constexpr int NTHREADS = 512, NWAVES = 8;
constexpr int LDS_BYTES = 147456;
#ifndef FASTMASK
#define FASTMASK 15
#endif

constexpr size_t MiB = 1u << 20;
constexpr size_t WS_CTL = 0;
constexpr size_t WS_SUMSQ = 64 * 1024;
constexpr size_t SUMSQ_STRIDE = (size_t)MALLOC * 4;
constexpr size_t WS_LBV = WS_SUMSQ + 4 * SUMSQ_STRIDE;
constexpr size_t WS_LOGF8 = WS_LBV + 4096;
constexpr size_t WS_KBIAS = WS_LOGF8 + (size_t)MALLOC * 32;
constexpr size_t WS_HS = 2 * MiB;
constexpr size_t WS_W = 3 * MiB;
constexpr size_t W_IN = 0, W_OUT = W_IN + (size_t)NIN * DM * 2, W_GU = W_OUT + (size_t)DM * DM * 2, W_DN = W_GU + (size_t)2 * DFF * DM * 2, W_LAYER = W_DN + (size_t)DM * DFF * 2;
constexpr size_t WS_HB = WS_W + 2 * W_LAYER + 65536;
constexpr size_t WS_MIX = WS_HB + (size_t)MALLOC * DM * 2;
constexpr size_t WS_QB = WS_MIX + (size_t)MALLOC * DM * 2;
constexpr size_t WS_KB = WS_QB + (size_t)MALLOC * 512 * 2, WS_VB = WS_KB + (size_t)MALLOC * 512 * 2;
constexpr size_t WS_HXQ = WS_VB + (size_t)MALLOC * 512 * 2;
constexpr size_t WS_LOGF = WS_HXQ + (size_t)MALLOC * 512 * 2;
constexpr size_t WS_HV = WS_LOGF + (size_t)MALLOC * 512 * 4, WS_HG = WS_HV + (size_t)MALLOC * 512 * 2;
constexpr size_t WS_END = WS_HG + (size_t)MALLOC * 512 * 2;
constexpr size_t WS_ACT = WS_QB;
static_assert(WS_KBIAS + 32 * KBL * 4 <= WS_HS && WS_HS + 4 * 64 * 1024 * 4 <= WS_W, "small map");
static_assert(WS_ACT + (size_t)MALLOC * DFF * 2 <= WS_END, "ACT overlay");
static_assert(WS_END <= 256 * MiB, "d_ws");

struct Args { const float* in[13]; float* out; unsigned char* ws; };

struct Ctx {
    const float *x, *meta, *nmw, *win, *fbias, *lbraw, *hnw, *wout, *nfw, *wg, *wu, *wd, *nfinal;
    float* out; unsigned char* ws;
    unsigned* ctl; float* sumsq; float* lbv; float* logf8; float* kbias; float* hs;
    bf16_t *HB, *MIX, *QB, *KB, *VB, *HXQ, *HV, *HG, *ACT; float* LOGF;
    int tid, lane, wave, gw, NGW;
};

__device__ __forceinline__ unsigned f2bf(float f) { unsigned u = __builtin_bit_cast(unsigned, f); return (u + 0x7fffu + ((u >> 16) & 1u)) >> 16; }
__device__ __forceinline__ unsigned pk2(float lo, float hi) { return f2bf(lo) | (f2bf(hi) << 16); }
__device__ __forceinline__ float bf2f(unsigned short b) { return __builtin_bit_cast(float, (unsigned)b << 16); }
__device__ __forceinline__ float wave_sum(float v) {
#pragma unroll
    for (int o = 1; o < 64; o <<= 1) v += __shfl_xor(v, o);
    return v;
}
__device__ __forceinline__ float wave_max(float v) {
#pragma unroll
    for (int o = 1; o < 64; o <<= 1) v = fmaxf(v, __shfl_xor(v, o));
    return v;
}
__device__ __forceinline__ float siluf(float x) { return x / (1.f + __expf(-x)); }
__device__ __forceinline__ float* hrow(const Ctx& c, int r) {
    const int b = r / LV, vp = r - b * LV;
    return vp >= 64 ? c.out + (size_t)(b * SEQ + vp - 64) * DM : c.hs + (size_t)(b * 64 + vp) * DM;
}
__device__ __forceinline__ bf16_t* wptr(const Ctx& c, int layer, size_t off) { return (bf16_t*)(c.ws + WS_W + (size_t)layer * W_LAYER + off); }

namespace pg8 {
#define PG8_LAS __attribute__((address_space(3)))
typedef unsigned short bf16_t;
typedef short bf16x8 __attribute__((ext_vector_type(8)));
typedef float f32x4 __attribute__((ext_vector_type(4)));
typedef unsigned u32x4 __attribute__((ext_vector_type(4)));
constexpr int BM = 256, BK = 64, HALF = 128, HTB = HALF * BK * 2  , STAGE_BYTES = 8 * HTB, NXCD = 8, WGM = 8;

__host__ __device__ __forceinline__ int lds_byte(int r, int c) { const int st = (r >> 4) * 2 + (c >> 5), rr = r & 15, cc = c & 31, ob = rr * 64 + cc * 2; return st * 1024 + (ob ^ (((ob >> 9) & 1) << 5)); }
__host__ __device__ __forceinline__ void stage_rc(int b, int& R, int& C) { const int st = b / 1024, sb = b % 1024, swz = sb ^ (((sb >> 9) & 1) << 5); R = (st >> 1) * 16 + swz / 64; C = (st & 1) * 32 + (swz % 64) / 2; }
__host__ __device__ __forceinline__ int perm32(int rho) { const int n = rho >> 4, i = rho & 15; return 8 * (i >> 2) + 4 * n + (i & 3); }

struct Unit { int pm, pn; };
struct Gemm { const bf16_t* A; const bf16_t* Bt; int M, N, K; };

struct StaticOrder {
    int nM, nN, nwg, G, c;
    __host__ __device__ void init(int M, int N, int G_, int c_) { nM = M / BM; nN = N / BM; nwg = nM * nN; G = G_; c = c_; }
    __host__ __device__ bool next(int i, Unit& u) const {
        const long L = (long)i * G + c; if (L >= nwg) return false;
        int wgid = (int)L; { const int q = nwg / NXCD, r = nwg % NXCD, xcd = wgid % NXCD, off = wgid / NXCD; wgid = (xcd < r ? xcd * (q + 1) : r * (q + 1) + (xcd - r) * q) + off; }
        const int nig = WGM * nN, gid = wgid / nig, fm = gid * WGM, gsz = (nM - fm) < WGM ? (nM - fm) : WGM;
        u.pm = fm + ((wgid % nig) % gsz); u.pn = (wgid % nig) / gsz; return true;
    }
    __device__ __forceinline__ void a_ready(const Unit&) const {}
    __device__ __forceinline__ void done(const Unit&) const {}
};

__device__ __forceinline__ unsigned cvt_pk_bf16(float lo, float hi) { unsigned r; asm volatile("v_cvt_pk_bf16_f32 %0, %1, %2" : "=v"(r) : "v"(lo), "v"(hi)); return r; }
typedef float f32x2 __attribute__((ext_vector_type(2)));
template <class Epi, class Sched, bool ALIGN_EPI = false, bool SP2 = false>
__device__ __forceinline__ void gemm_phase(PG8_LAS unsigned char* lds, const Gemm g, const Sched& S, const Epi& E) {
    int tid_ = threadIdx.x; asm volatile("" : "+v"(tid_));
    const int tid = tid_, wid = __builtin_amdgcn_readfirstlane(tid >> 6), lane = tid & 63, wr = wid >> 2, wc = wid & 3, fr = lane & 15, fq = lane >> 4;
    const int K = g.K, nt = K / BK;
    unsigned voffA[2], voffB[2];
#pragma unroll
    for (int i = 0; i < 2; ++i) { int R, C; stage_rc(tid * 16 + i * 8192, R, C); const int Rb = Epi::PERM ? ((R & ~31) + perm32(R & 31)) : R;
        voffA[i] = (unsigned)(R * K + C) * 2u; voffB[i] = (unsigned)(Rb * K + C) * 2u; }
    const size_t kstep = (size_t)(BK * 2);
    const size_t hstep = (size_t)HALF * K * 2;
    const size_t tstep = 2 * hstep;
    const unsigned ldsw = (unsigned)wid * 1024u;
    const int aoff = lds_byte(wr * 64 + fr, fq * 8), boff = lds_byte(wc * 32 + fr, fq * 8);
#define PG8_SA(b, h) (((b) * 2 + (h)) * HTB)
#define PG8_SB(b, h) ((4 + (b) * 2 + (h)) * HTB)
#define PG8_STAGE(bufoff, gbase, voff) do { _Pragma("unroll") for (int _i = 0; _i < 2; ++_i) \
        __builtin_amdgcn_global_load_lds((const unsigned*)((const char*)(gbase) + (voff)[_i]), (PG8_LAS unsigned*)(lds + (bufoff) + ldsw + _i * 8192), 16, 0, 0); } while (0)
#define PG8_LDA(dst, b, h) do { _Pragma("unroll") for (int m = 0; m < 4; ++m) _Pragma("unroll") for (int k = 0; k < 2; ++k) dst[m][k] = *(const PG8_LAS bf16x8*)(lds + PG8_SA(b, h) + aoff + m * 2048 + k * 1024); } while (0)
#define PG8_LDB(dst, b, h) do { _Pragma("unroll") for (int n = 0; n < 2; ++n) _Pragma("unroll") for (int k = 0; k < 2; ++k) dst[n][k] = *(const PG8_LAS bf16x8*)(lds + PG8_SB(b, h) + boff + n * 2048 + k * 1024); } while (0)
#define PG8_MMA(ai, bj, At, Bt) do { __builtin_amdgcn_s_setprio(1); _Pragma("unroll") for (int m = 0; m < 4; ++m) _Pragma("unroll") for (int n = 0; n < 2; ++n) _Pragma("unroll") for (int k = 0; k < 2; ++k) \
        acc[ai][bj][m][n] = __builtin_amdgcn_mfma_f32_16x16x32_bf16(Bt[n][k], At[m][k], acc[ai][bj][m][n], 0, 0, 0); __builtin_amdgcn_s_setprio(0); } while (0)
#define PG8_WAIT_V(n) asm volatile("s_waitcnt vmcnt(" #n ")" ::: "memory")
#define PG8_WAIT_L(n) asm volatile("s_waitcnt lgkmcnt(" #n ")" ::: "memory")
#define PG8_BAR __builtin_amdgcn_s_barrier()
#define PG8_SCHED __builtin_amdgcn_sched_barrier(0)
    Unit cur, nxt; int ui = 0;
    if (!S.next(0, cur)) return;
    f32x4 acc[2][2][4][2];
#pragma unroll
    for (int a = 0; a < 2; ++a)
#pragma unroll
        for (int b = 0; b < 2; ++b)
#pragma unroll
            for (int m = 0; m < 4; ++m)
#pragma unroll
                for (int n = 0; n < 2; ++n) acc[a][b][m][n] = (f32x4){0.f, 0.f, 0.f, 0.f};
    bf16x8 At[4][2], B0[2][2], B1[2][2];
    const char* cA = (const char*)g.A + (size_t)cur.pm * tstep; const char* cB = (const char*)g.Bt + (size_t)cur.pn * tstep;
    S.a_ready(cur);
    if constexpr (SP2) {
        PG8_STAGE(PG8_SB(0, 0), cB, voffB); PG8_STAGE(PG8_SB(0, 1), cB + hstep, voffB); PG8_STAGE(PG8_SA(0, 0), cA, voffA); PG8_STAGE(PG8_SA(0, 1), cA + hstep, voffA);
        if (wr == 1) PG8_BAR;
        PG8_WAIT_V(2); PG8_BAR;
        PG8_STAGE(PG8_SB(1, 0), cB + kstep, voffB); PG8_STAGE(PG8_SA(1, 0), cA + kstep, voffA); PG8_STAGE(PG8_SB(1, 1), cB + hstep + kstep, voffB);
        PG8_WAIT_V(6); PG8_BAR;
    } else {
        PG8_STAGE(PG8_SB(0, 0), cB, voffB); PG8_STAGE(PG8_SA(0, 0), cA, voffA); PG8_STAGE(PG8_SB(0, 1), cB + hstep, voffB); PG8_STAGE(PG8_SA(0, 1), cA + hstep, voffA);
        if (wr == 1) PG8_BAR;
        PG8_WAIT_V(4); PG8_BAR;
        PG8_STAGE(PG8_SB(1, 0), cB + kstep, voffB); PG8_STAGE(PG8_SA(1, 0), cA + kstep, voffA); PG8_STAGE(PG8_SB(1, 1), cB + hstep + kstep, voffB);
        PG8_WAIT_V(6); PG8_BAR;
    }
    for (;;) {
        const bool has_next = S.next(ui + 1, nxt);
        const char* nA = has_next ? (const char*)g.A + (size_t)nxt.pm * tstep : cA; const char* nB = has_next ? (const char*)g.Bt + (size_t)nxt.pn * tstep : cB;
        for (int t = 0; t < nt; t += 2) {
            const bool last = (t == nt - 2);
            const char* a1 = cA + (size_t)(t + 1) * kstep;
            const char* a2 = last ? nA : cA + (size_t)(t + 2) * kstep; const char* b2 = last ? nB : cB + (size_t)(t + 2) * kstep;
            const char* a3 = a2 + kstep; const char* b3 = b2 + kstep;
            if (last && has_next) S.a_ready(nxt);
            if constexpr (SP2) {
            PG8_LDB(B0, 0, 0); PG8_LDB(B1, 0, 1); PG8_SCHED; PG8_LDA(At, 0, 0); PG8_STAGE(PG8_SA(1, 1), a1 + hstep, voffA);
            PG8_WAIT_V(8); PG8_WAIT_L(0); PG8_BAR; PG8_MMA(0, 0, At, B0); PG8_MMA(0, 1, At, B1); PG8_BAR; PG8_SCHED;
            PG8_LDA(At, 0, 1); PG8_STAGE(PG8_SB(0, 0), b2, voffB); PG8_STAGE(PG8_SB(0, 1), b2 + hstep, voffB); PG8_STAGE(PG8_SA(0, 0), a2, voffA);
            PG8_WAIT_V(8); PG8_WAIT_L(0); PG8_BAR; PG8_MMA(1, 0, At, B0); PG8_MMA(1, 1, At, B1); PG8_BAR; PG8_SCHED;
            PG8_LDB(B0, 1, 0); PG8_LDB(B1, 1, 1); PG8_SCHED; PG8_LDA(At, 1, 0); PG8_STAGE(PG8_SA(0, 1), a2 + hstep, voffA);
            PG8_WAIT_V(8); PG8_WAIT_L(0); PG8_BAR; PG8_MMA(0, 0, At, B0); PG8_MMA(0, 1, At, B1); PG8_BAR; PG8_SCHED;
            PG8_LDA(At, 1, 1); PG8_STAGE(PG8_SB(1, 0), b3, voffB); PG8_STAGE(PG8_SB(1, 1), b3 + hstep, voffB); PG8_STAGE(PG8_SA(1, 0), a3, voffA);
            PG8_WAIT_V(8); PG8_WAIT_L(0); PG8_BAR; PG8_MMA(1, 0, At, B0); PG8_MMA(1, 1, At, B1); PG8_BAR; PG8_SCHED;
            } else {
            PG8_LDB(B0, 0, 0); PG8_SCHED; PG8_LDA(At, 0, 0); PG8_STAGE(PG8_SA(1, 1), a1 + hstep, voffA);
            PG8_WAIT_L(8); PG8_BAR; PG8_WAIT_L(0); PG8_MMA(0, 0, At, B0); PG8_BAR; PG8_SCHED;
            PG8_LDB(B1, 0, 1); PG8_STAGE(PG8_SB(0, 0), b2, voffB);
            PG8_BAR; PG8_WAIT_L(0); PG8_MMA(0, 1, At, B1); PG8_BAR;
            PG8_LDA(At, 0, 1); PG8_STAGE(PG8_SA(0, 0), a2, voffA);
            PG8_BAR; PG8_WAIT_L(0); PG8_MMA(1, 0, At, B0); PG8_BAR; PG8_SCHED;
            PG8_STAGE(PG8_SB(0, 1), b2 + hstep, voffB);
            PG8_WAIT_V(6); PG8_BAR; PG8_MMA(1, 1, At, B1); PG8_BAR;
            PG8_LDB(B0, 1, 0); PG8_SCHED; PG8_LDA(At, 1, 0); PG8_STAGE(PG8_SA(0, 1), a2 + hstep, voffA);
            PG8_WAIT_L(8); PG8_BAR; PG8_WAIT_L(0); PG8_MMA(0, 0, At, B0); PG8_BAR; PG8_SCHED;
            PG8_LDB(B1, 1, 1); PG8_STAGE(PG8_SB(1, 0), b3, voffB);
            PG8_BAR; PG8_WAIT_L(0); PG8_MMA(0, 1, At, B1); PG8_BAR;
            PG8_LDA(At, 1, 1); PG8_STAGE(PG8_SA(1, 0), a3, voffA);
            PG8_BAR; PG8_WAIT_L(0); PG8_MMA(1, 0, At, B0); PG8_BAR; PG8_SCHED;
            PG8_STAGE(PG8_SB(1, 1), b3 + hstep, voffB);
            PG8_WAIT_V(6); PG8_BAR; PG8_MMA(1, 1, At, B1); PG8_BAR;
            }
        }
        if constexpr (ALIGN_EPI) { if (wr == 0) PG8_BAR; }
        if constexpr (!Epi::AFTER_DRAIN) { E(acc, cur, wr, wc, fr, fq); S.done(cur); }
        if (!has_next) break;
#pragma unroll
        for (int a = 0; a < 2; ++a)
#pragma unroll
            for (int b = 0; b < 2; ++b)
#pragma unroll
                for (int m = 0; m < 4; ++m)
#pragma unroll
                    for (int n = 0; n < 2; ++n) acc[a][b][m][n] = (f32x4){0.f, 0.f, 0.f, 0.f};
        cur = nxt; cA = nA; cB = nB; ++ui;
        if constexpr (ALIGN_EPI) { if (wr == 1) PG8_BAR; }
    }
    PG8_WAIT_V(0);
    if constexpr (!ALIGN_EPI) { if (wr == 0) PG8_BAR; }
    PG8_BAR;
    if constexpr (Epi::AFTER_DRAIN) { E.fused(acc, cur, wr, wc, fr, fq, lds, wid, lane); S.done(cur); }
#undef PG8_SA
#undef PG8_SB
#undef PG8_STAGE
#undef PG8_LDA
#undef PG8_LDB
#undef PG8_MMA
#undef PG8_WAIT_V
#undef PG8_WAIT_L
#undef PG8_BAR
#undef PG8_SCHED
}
}

namespace pg8 {
__device__ __forceinline__ float silu_f(float x) { return x * __builtin_amdgcn_rcpf(1.f + __expf(-x)); }
struct EpiInProj {
    static constexpr bool PERM = true, AFTER_DRAIN = false;
    const float* ssq; const float* lbv; bf16_t *QB, *KB, *VB, *HXQ, *HV, *HG; float* LOGF;
    __device__ __forceinline__ void operator()(const f32x4 (&acc)[2][2][4][2], const Unit& u, int wr, int wc, int fr, int fq) const {
        const int part = u.pn >> 1;
        const int cbase = (u.pn & 1) * 256 + wc * 32 + 8 * fq;
        if (part == 4) {
#pragma unroll
            for (int bj = 0; bj < 2; ++bj)
#pragma unroll
                for (int n = 0; n < 2; ++n) {
                    const int cc = cbase + bj * HALF + 4 * n;
                    f32x4 lb1 = (f32x4){1.f, 1.f, 1.f, 1.f};
                    if (lbv) lb1 = lb1 - *(const f32x4*)(lbv + cc);
#pragma unroll
                    for (int ai = 0; ai < 2; ++ai)
#pragma unroll
                        for (int m = 0; m < 4; ++m) {
                            const int r = u.pm * BM + ai * HALF + wr * 64 + m * 16 + fr;
                            const float rstd = 1.f / sqrtf(ssq[r] * (1.f / 1024.f) + 1e-6f);
                            f32x4 a;
#pragma unroll
                            for (int e = 0; e < 4; ++e) { const float xv = acc[ai][bj][m][n][e] * rstd; const float omf = lb1[e] * __builtin_amdgcn_rcpf(1.f + __expf(xv)); a[e] = fmaxf(__logf(1.f - omf), -30.f); }
                            *(f32x4*)(LOGF + (size_t)r * 512 + cc) = a;
                        }
                }
        } else {
            bf16_t* dst = part == 0 ? QB : part == 1 ? KB : part == 2 ? VB : part == 3 ? HXQ : part == 5 ? HV : HG;
            const float sc = part == 0 ? 0.125f * 1.4426950408889634f : part == 3 ? 0.08838834764831845f : 1.f;
            const bool dosilu = (part == 3) || (part == 6);
#pragma unroll
            for (int ai = 0; ai < 2; ++ai)
#pragma unroll
                for (int m = 0; m < 4; ++m) {
                    const int r = u.pm * BM + ai * HALF + wr * 64 + m * 16 + fr;
                    const float rstd = sc / sqrtf(ssq[r] * (1.f / 1024.f) + 1e-6f);
#pragma unroll
                    for (int bj = 0; bj < 2; ++bj) {
                        f32x4 v0 = acc[ai][bj][m][0], v1 = acc[ai][bj][m][1];
                        if (dosilu) {
#pragma unroll
                            for (int e = 0; e < 4; ++e) { const float a0 = v0[e] * (rstd / sc), a1 = v1[e] * (rstd / sc); v0[e] = silu_f(a0) * sc; v1[e] = silu_f(a1) * sc; }
                        } else { v0 = v0 * rstd; v1 = v1 * rstd; }
                        u32x4 w; w.x = cvt_pk_bf16(v0[0], v0[1]); w.y = cvt_pk_bf16(v0[2], v0[3]); w.z = cvt_pk_bf16(v1[0], v1[1]); w.w = cvt_pk_bf16(v1[2], v1[3]);
                        *(u32x4*)(dst + (size_t)r * 512 + cbase + bj * HALF) = w;
                    }
                }
        }
    }
};
struct EpiResid {
    static constexpr bool PERM = false, AFTER_DRAIN = false;
    float* out; float* hs; bf16_t* HB; float* ssq;
    __device__ __forceinline__ void operator()(const f32x4 (&acc)[2][2][4][2], const Unit& u, int wr, int wc, int fr, int fq) const {
        const int col0 = u.pn * BM + wc * 32 + 4 * fq;
#pragma unroll
        for (int ai = 0; ai < 2; ++ai)
#pragma unroll
            for (int m = 0; m < 4; ++m) {
                const int r = u.pm * BM + ai * HALF + wr * 64 + m * 16 + fr;
                const int b = r / 4160, vp = r - b * 4160;
                float* hp = vp >= 64 ? out + (size_t)(b * 4096 + vp - 64) * 1024 : hs + (size_t)(b * 64 + vp) * 1024;
                float q = 0.f;
#pragma unroll
                for (int bj = 0; bj < 2; ++bj)
#pragma unroll
                    for (int n = 0; n < 2; ++n) { const int c = col0 + bj * HALF + n * 16; const f32x4 h = *(const f32x4*)(hp + c) + acc[ai][bj][m][n]; *(f32x4*)(hp + c) = h;
                        unsigned long long w = (unsigned long long)cvt_pk_bf16(h[0], h[1]) | ((unsigned long long)cvt_pk_bf16(h[2], h[3]) << 32);
                        *(unsigned long long*)(HB + (size_t)r * 1024 + c) = w; q += (h[0] * h[0] + h[1] * h[1]) + (h[2] * h[2] + h[3] * h[3]); }
                if (ssq) { q += __shfl_xor(q, 16); q += __shfl_xor(q, 32); if (fq == 0) atomicAdd(ssq + r, q); }
            }
    }
};
struct EpiSwiGLU {
    static constexpr bool PERM = true, AFTER_DRAIN = false;
    const float* ssq; bf16_t* ACT;
    __device__ __forceinline__ void operator()(const f32x4 (&acc)[2][2][4][2], const Unit& u, int wr, int wc, int fr, int fq) const {
        const int f0 = u.pn * HALF + wc * 32 + 8 * fq;
#pragma unroll
        for (int ai = 0; ai < 2; ++ai)
#pragma unroll
            for (int m = 0; m < 4; ++m) {
                const int r = u.pm * BM + ai * HALF + wr * 64 + m * 16 + fr;
                const float rstd = 1.f / sqrtf(ssq[r] * (1.f / 1024.f) + 1e-6f);
                float y[8];
#pragma unroll
                for (int n = 0; n < 2; ++n)
#pragma unroll
                    for (int e = 0; e < 4; ++e) { const float g = acc[ai][0][m][n][e] * rstd, uu = acc[ai][1][m][n][e] * rstd; y[4 * n + e] = silu_f(g) * uu; }
                u32x4 w; w.x = cvt_pk_bf16(y[0], y[1]); w.y = cvt_pk_bf16(y[2], y[3]); w.z = cvt_pk_bf16(y[4], y[5]); w.w = cvt_pk_bf16(y[6], y[7]);
                *(u32x4*)(ACT + (size_t)r * 2816 + f0) = w;
            }
    }
};
}

__device__ __forceinline__ void tr_item(const float* W, int K, int N, int k0, int nsrc0, bf16_t* WT, int dst_row0, const float* kscale, LAS float* scr, int lane) {
#pragma unroll 8
    for (int i = 0; i < 32; ++i) { const int kk = 2 * i + (lane >> 5); float s = kscale ? kscale[k0 + kk] : 1.f; scr[kk * 33 + (lane & 31)] = W[(size_t)(k0 + kk) * N + nsrc0 + (lane & 31)] * s; }
    asm volatile("s_waitcnt lgkmcnt(0)" ::: "memory");
    const int ch = lane & 7;
#pragma unroll
    for (int j = 0; j < 4; ++j) { const int n = (lane >> 3) + 8 * j; const LAS float* s = scr + (8 * ch) * 33 + n;
        u32x4 o; o.x = pk2(s[0 * 33], s[1 * 33]); o.y = pk2(s[2 * 33], s[3 * 33]); o.z = pk2(s[4 * 33], s[5 * 33]); o.w = pk2(s[6 * 33], s[7 * 33]);
        *(u32x4*)(WT + (size_t)(dst_row0 + n) * K + k0 + 8 * ch) = o; }
    asm volatile("s_waitcnt lgkmcnt(0)" ::: "memory");
}

__device__ __forceinline__ void p0_weights(const Ctx& c, LAS unsigned char* lds) {
    LAS float* scr = (LAS float*)(lds + c.wave * 16384);
    constexpr int I_IN = 16 * (NIN / 32), I_OUT = 16 * 32, I_G = 16 * (DFF / 32), I_D = (DFF / 64) * 32, I_L = I_IN + I_OUT + 2 * I_G + I_D;
    for (int it = c.gw; it < 2 * I_L; it += c.NGW) {
        const int l = it / I_L; int r = it - l * I_L;
        if (r < I_IN) { const int kb = r / (NIN / 32), nb = r % (NIN / 32), n0 = nb * 32;
            tr_item(c.win + (size_t)l * DM * INCOLS, DM, INCOLS, kb * 64, n0 + (n0 >= 1536 ? 8 : 0), wptr(c, l, W_IN), n0, c.nmw + l * DM, scr, c.lane); continue; }
        r -= I_IN;
        if (r < I_OUT) { const int kb = r / 32, nb = r % 32; tr_item(c.wout + (size_t)l * DM * DM, DM, DM, kb * 64, nb * 32, wptr(c, l, W_OUT), nb * 32, nullptr, scr, c.lane); continue; }
        r -= I_OUT;
        if (r < 2 * I_G) { const int up = r >= I_G; if (up) r -= I_G; const int kb = r / (DFF / 32), nb = r % (DFF / 32), f0 = nb * 32;
            tr_item((up ? c.wu : c.wg) + (size_t)l * DM * DFF, DM, DFF, kb * 64, f0, wptr(c, l, W_GU), 256 * (f0 >> 7) + (f0 & 127) + (up ? 128 : 0), c.nfw + l * DM, scr, c.lane); continue; }
        r -= 2 * I_G;
        { const int kb = r / 32, nb = r % 32; tr_item(c.wd + (size_t)l * DFF * DM, DFF, DM, kb * 64, nb * 32, wptr(c, l, W_DN), nb * 32, nullptr, scr, c.lane); }
    }
}

__device__ __forceinline__ void ff_rows(const Ctx& c, LAS unsigned char* lds, int layer) {
    LAS float* wff = (LAS float*)lds;
    for (int i = c.tid; i < 8 * DM; i += NTHREADS) { const int cc = i >> 10, k = i & 1023; wff[i] = c.win[(size_t)layer * DM * INCOLS + (size_t)k * INCOLS + 1536 + cc] * c.nmw[layer * DM + k]; }
    __syncthreads();
    float* ssq = c.sumsq + (size_t)layer * MALLOC;
    for (int r = c.gw; r < MROWS; r += c.NGW) {
        const int b = r / LV, vp = r - b * LV;
        f32x4 v[4];
        float* hp = hrow(c, r);
        if (layer == 0) {
            const float* src = vp >= 64 ? c.x + (size_t)(b * SEQ + vp - 64) * DM : (vp >= PADF ? c.meta + (size_t)(vp - PADF) * DM : nullptr);
#pragma unroll
            for (int j = 0; j < 4; ++j) { v[j] = src ? *(const f32x4*)(src + 4 * c.lane + 256 * j) : (f32x4){0.f, 0.f, 0.f, 0.f}; *(f32x4*)(hp + 4 * c.lane + 256 * j) = v[j];
                unsigned long long w = (unsigned long long)pk2(v[j].x, v[j].y) | ((unsigned long long)pk2(v[j].z, v[j].w) << 32);
                *(unsigned long long*)(c.HB + (size_t)r * DM + 4 * c.lane + 256 * j) = w; }
        } else {
#pragma unroll
            for (int j = 0; j < 4; ++j) v[j] = *(const f32x4*)(hp + 4 * c.lane + 256 * j);
        }
        float s = 0.f;
#pragma unroll
        for (int j = 0; j < 4; ++j) s += (v[j].x * v[j].x + v[j].y * v[j].y) + (v[j].z * v[j].z + v[j].w * v[j].w);
        s = wave_sum(s);
        const float rstd = 1.f / sqrtf(s * (1.f / DM) + EPS);
        float myv = 0.f;
#pragma unroll
        for (int cc = 0; cc < 8; ++cc) {
            float d = 0.f;
#pragma unroll
            for (int j = 0; j < 4; ++j) { const f32x4 w = *(const LAS f32x4*)(wff + cc * DM + 4 * c.lane + 256 * j); d += (v[j].x * w.x + v[j].y * w.y) + (v[j].z * w.z + v[j].w * w.w); }
            d = wave_sum(d);
            if (c.lane == cc) myv = d;
        }
        if (c.lane == 0) ssq[r] = s;
        if (c.lane < 8) { const float z = myv * rstd + c.fbias[layer * 8 + c.lane];
            c.logf8[(size_t)r * 8 + c.lane] = fminf(z, 0.f) - log1pf(__expf(-fabsf(z))); }
    }
    __syncthreads();
}

__device__ __forceinline__ void kbias_build(const Ctx& c) {
    for (int job = c.gw; job < NB * FOXH; job += c.NGW) {
        const int b = job >> 3, h = job & 7;
        float s = 0.f;
        const int v0 = 65 * c.lane;
        for (int i = 0; i < 65; ++i) { const int vp = v0 + i; const float g = vp >= PADF ? c.logf8[(size_t)(b * LV + vp) * 8 + h] : 0.f; s += g; }
        float inc = s;
#pragma unroll
        for (int o = 1; o < 64; o <<= 1) { const float t = __shfl_up(inc, o); if (c.lane >= o) inc += t; }
        float run = inc - s;
        float* kb = c.kbias + (size_t)job * KBL;
        for (int i = 0; i < 65; ++i) { const int vp = v0 + i; const float g = vp >= PADF ? c.logf8[(size_t)(b * LV + vp) * 8 + h] : 0.f; run += g; kb[vp] = vp >= PADF ? -run * LOG2E : -1e30f; }
        for (int i = LV + c.lane; i < KBL; i += 64) kb[i] = 0.f;
    }
}

template <int MODE>
__device__ __forceinline__ void gemm_simple(const Ctx& c, int layer) {
    const int fr = c.lane & 15, g = c.lane >> 4;
    const bf16_t* A = MODE == 0 ? c.HB : MODE == 1 ? c.MIX : MODE == 2 ? c.HB : c.ACT;
    const bf16_t* Bt = wptr(c, layer, MODE == 0 ? W_IN : MODE == 1 ? W_OUT : MODE == 2 ? W_GU : W_DN);
    constexpr int K = MODE == 3 ? DFF : DM;
    constexpr int NCOL = MODE == 0 ? NIN : MODE == 2 ? DFF : DM;
    constexpr int ntn = NCOL / 64, ntm = MROWS / 16;
    for (int t = c.gw; t < ntm * ntn; t += c.NGW) {
        const int tm = t / ntn, tn = t - tm * ntn, row0 = tm * 16, col0 = tn * 64;
        f32x4 acc[4], acc2[4];
#pragma unroll
        for (int n = 0; n < 4; ++n) { acc[n] = (f32x4){0.f, 0.f, 0.f, 0.f}; acc2[n] = (f32x4){0.f, 0.f, 0.f, 0.f}; }
        const bf16_t* ap = A + (size_t)(row0 + fr) * K + 8 * g;
        const bf16_t* bp[4];
#pragma unroll
        for (int n = 0; n < 4; ++n) { const int cn = col0 + 16 * n + fr; const int br = MODE == 2 ? 256 * (cn >> 7) + (cn & 127) : cn; bp[n] = Bt + (size_t)br * K + 8 * g; }
        for (int k0 = 0; k0 < K; k0 += 32) {
            const bf16x8 a = *(const bf16x8*)(ap + k0);
#pragma unroll
            for (int n = 0; n < 4; ++n) { const bf16x8 b = *(const bf16x8*)(bp[n] + k0); acc[n] = __builtin_amdgcn_mfma_f32_16x16x32_bf16(a, b, acc[n], 0, 0, 0);
                if (MODE == 2) { const bf16x8 b2 = *(const bf16x8*)(bp[n] + (size_t)128 * K + k0); acc2[n] = __builtin_amdgcn_mfma_f32_16x16x32_bf16(a, b2, acc2[n], 0, 0, 0); } }
        }
        if (MODE == 0) {
            const float* ssq = c.sumsq + (size_t)layer * MALLOC;
#pragma unroll
            for (int j = 0; j < 4; ++j) { const int r = row0 + 4 * g + j; const float rstd = 1.f / sqrtf(ssq[r] * (1.f / DM) + EPS);
#pragma unroll
                for (int n = 0; n < 4; ++n) { const int cn = col0 + 16 * n + fr; const float xv = acc[n][j] * rstd; const int part = cn >> 9, cc = cn & 511; const size_t o = (size_t)r * 512 + cc;
                    if (part == 0) c.QB[o] = (bf16_t)f2bf(xv * C2);
                    else if (part == 1) c.KB[o] = (bf16_t)f2bf(xv);
                    else if (part == 2) c.VB[o] = (bf16_t)f2bf(xv);
                    else if (part == 3) c.HXQ[o] = (bf16_t)f2bf(siluf(xv) * HGQS);
                    else if (part == 4) { const float lb = layer ? c.lbv[cc] : 0.f; const float omf = (1.f - lb) / (1.f + __expf(xv)); c.LOGF[o] = fmaxf(log1pf(-omf), -30.f); }
                    else if (part == 5) c.HV[o] = (bf16_t)f2bf(xv);
                    else c.HG[o] = (bf16_t)f2bf(siluf(xv)); } }
        } else if (MODE == 1 || MODE == 3) {
            float* ssq = c.sumsq + (size_t)(2 + layer) * MALLOC;
#pragma unroll
            for (int j = 0; j < 4; ++j) { const int r = row0 + 4 * g + j; float* hp = hrow(c, r); float q = 0.f;
#pragma unroll
                for (int n = 0; n < 4; ++n) { const int cn = col0 + 16 * n + fr; const float hn = hp[cn] + acc[n][j]; hp[cn] = hn; c.HB[(size_t)r * DM + cn] = (bf16_t)f2bf(hn); q += hn * hn; }
                if (MODE == 1) { q += __shfl_xor(q, 1); q += __shfl_xor(q, 2); q += __shfl_xor(q, 4); q += __shfl_xor(q, 8); if (fr == 0) atomicAdd(ssq + r, q); } }
        } else {
            const float* ssq = c.sumsq + (size_t)(2 + layer) * MALLOC;
#pragma unroll
            for (int j = 0; j < 4; ++j) { const int r = row0 + 4 * g + j; const float rstd = 1.f / sqrtf(ssq[r] * (1.f / DM) + EPS);
#pragma unroll
                for (int n = 0; n < 4; ++n) { const int cn = col0 + 16 * n + fr; const float gv = acc[n][j] * rstd, uv = acc2[n][j] * rstd; c.ACT[(size_t)r * DFF + cn] = (bf16_t)f2bf(siluf(gv) * uv); } }
        }
    }
}

template <int MODE>
__device__ __forceinline__ void gemm_fast(const Ctx& c, LAS unsigned char* lds, int layer) {
    const bf16_t* A = MODE == 0 ? c.HB : MODE == 1 ? c.MIX : MODE == 2 ? c.HB : c.ACT;
    const bf16_t* Bt = wptr(c, layer, MODE == 0 ? W_IN : MODE == 1 ? W_OUT : MODE == 2 ? W_GU : W_DN);
    constexpr int K = MODE == 3 ? DFF : DM;
    constexpr int N = MODE == 0 ? NIN : MODE == 2 ? 2 * DFF : DM;
    pg8::Gemm g{A, Bt, MROWS, N, K}; pg8::StaticOrder S; S.init(MROWS, N, (int)gridDim.x, (int)blockIdx.x);
    if constexpr (MODE == 0) {
        pg8::EpiInProj E{c.sumsq + (size_t)layer * MALLOC, layer ? c.lbv : nullptr, c.QB, c.KB, c.VB, c.HXQ, c.HV, c.HG, c.LOGF};
        pg8::gemm_phase<pg8::EpiInProj, pg8::StaticOrder, true, true>(lds, g, S, E);
    } else if constexpr (MODE == 2) {
        pg8::EpiSwiGLU E{c.sumsq + (size_t)(2 + layer) * MALLOC, c.ACT};
        pg8::gemm_phase<pg8::EpiSwiGLU, pg8::StaticOrder, true, true>(lds, g, S, E);
    } else {
        pg8::EpiResid E{c.out, c.hs, c.HB, MODE == 1 ? c.sumsq + (size_t)(2 + layer) * MALLOC : nullptr};
        pg8::gemm_phase<pg8::EpiResid, pg8::StaticOrder, true, true>(lds, g, S, E);
    }
}

#include <hip/hip_bf16.h>
#include <cmath>
namespace attn_body {
using bf16=__hip_bfloat16;
using bf16x8=__attribute__((ext_vector_type(8)))short;
using s16x4=__attribute__((ext_vector_type(4)))short;
using f32x16=__attribute__((ext_vector_type(16)))float;
using u32x4=__attribute__((ext_vector_type(4)))unsigned;
constexpr int BATCH=4,NHEAD=8,SEQ=4160,D=64,DM=NHEAD*D,OP=1024;
constexpr int NW=8,QBLK=32,QB=QBLK*NW,KVBLK=64,NQB=17;
constexpr int ATTN_PITCH=DM, ATTN_UNIT_ROWS=QB;
__device__ __forceinline__ int crow(int r,int hi){return (r&3)+8*(r>>2)+4*hi;}
#define SBAR() __builtin_amdgcn_sched_barrier(0)
__device__ __forceinline__ void cmask(f32x16&p0,f32x16&p1,int jb,int qrel,int hi){
  const float NEG=-INFINITY; int kb=64*jb+4*hi;
  #pragma unroll
  for(int r=0;r<16;++r){int kv=kb+(r&3)+8*(r>>2); if(kv>qrel)p0[r]=NEG; if(kv+32>qrel)p1[r]=NEG;}
}

constexpr int NSLOT=3, SLOTB=8192;
constexpr int LDS_K=0, LDS_V=NSLOT*SLOTB, LDS_WS=2*NSLOT*SLOTB, LDS_OST=LDS_WS+NW*64*4, LDS_KB=LDS_OST+NW*4096, LDS_BYTES=LDS_KB+4352*4+256;
constexpr float C2=0.125f*1.4426950408889634f;
__device__ __forceinline__ void glds16(const void*gsrc,unsigned lds_dst){unsigned keep;
  asm volatile("s_mov_b32 %0, m0\n\ts_mov_b32 m0, %2\n\ts_nop 0\n\tglobal_load_lds_dwordx4 %1, off\n\ts_mov_b32 m0, %0":"=&s"(keep):"v"(gsrc),"s"(lds_dst):"memory");}
__device__ __forceinline__ float max3f(float a,float b,float c){float r;asm("v_max3_f32 %0, %1, %2, %3":"=v"(r):"v"(a),"v"(b),"v"(c));return r;}
__device__ __forceinline__ float max2f(float a,float b){float r;asm("v_max_f32_e32 %0, %1, %2":"=v"(r):"v"(a),"v"(b));return r;}
__device__ __forceinline__ float fadd_s(float a,float b){float r;asm("v_add_f32_e32 %0, %1, %2":"=v"(r):"v"(a),"v"(b));return r;}
__device__ __forceinline__ float fsub_s(float a,float b){float r;asm("v_sub_f32_e32 %0, %1, %2":"=v"(r):"v"(a),"v"(b));return r;}
typedef float f32x2_t __attribute__((ext_vector_type(2))); typedef __bf16 bf16x2_t __attribute__((ext_vector_type(2)));
__device__ __forceinline__ unsigned cvtpk_s(float lo,float hi){f32x2_t v={lo,hi};bf16x2_t b=__builtin_convertvector(v,bf16x2_t);return __builtin_bit_cast(unsigned,b);}
#define WAIT_BAR(N) asm volatile("s_waitcnt vmcnt(" #N ") lgkmcnt(0)\n\ts_barrier":::"memory")

__device__ __forceinline__ void qkt(f32x16&p0,f32x16&p1,const char*Kslot,const bf16x8*qr,int r32,int hi){
  const char*kb=Kslot+hi*1024+r32*16;
  #pragma unroll
  for(int d0=0;d0<4;++d0){
    const bf16x8 b0=*reinterpret_cast<const bf16x8*>(kb+d0*2048);
    const bf16x8 b1=*reinterpret_cast<const bf16x8*>(kb+d0*2048+512);
    p0=__builtin_amdgcn_mfma_f32_32x32x16_bf16(b0,qr[d0],p0,0,0,0);p1=__builtin_amdgcn_mfma_f32_32x32x16_bf16(b1,qr[d0],p1,0,0,0);}
}
typedef __attribute__((address_space(3))) const char* lds_cptr;
typedef short v4i16_t __attribute__((ext_vector_type(4)));
__device__ __forceinline__ void kload8(bf16x8*kf,lds_cptr kp){
  kf[0]=*(const __attribute__((address_space(3))) bf16x8*)(kp);      kf[1]=*(const __attribute__((address_space(3))) bf16x8*)(kp+512);
  kf[2]=*(const __attribute__((address_space(3))) bf16x8*)(kp+2048); kf[3]=*(const __attribute__((address_space(3))) bf16x8*)(kp+2560);
  kf[4]=*(const __attribute__((address_space(3))) bf16x8*)(kp+4096); kf[5]=*(const __attribute__((address_space(3))) bf16x8*)(kp+4608);
  kf[6]=*(const __attribute__((address_space(3))) bf16x8*)(kp+6144); kf[7]=*(const __attribute__((address_space(3))) bf16x8*)(kp+6656);
}
__device__ __forceinline__ void kload2(bf16x8*kf,lds_cptr kp,int j){ kf[2*j]=*(const __attribute__((address_space(3))) bf16x8*)(kp+j*2048); kf[2*j+1]=*(const __attribute__((address_space(3))) bf16x8*)(kp+j*2048+512); }
__device__ __forceinline__ s16x4 vtr(lds_cptr p){ return __builtin_bit_cast(s16x4,__builtin_amdgcn_ds_read_tr16_b64_v4i16((__attribute__((address_space(3))) v4i16_t*)p)); }
__device__ __forceinline__ float rowmax(const f32x16&p0,const f32x16&p1){
  float a=max3f(p0[0],p0[1],p1[0]),b=max3f(p0[2],p0[3],p1[1]);a=max3f(a,p1[2],p1[3]);
  #pragma unroll
  for(int r=4;r<16;r+=4){a=max3f(a,p0[r],p0[r+1]);b=max3f(b,p0[r+2],p0[r+3]);a=max3f(a,p1[r],p1[r+1]);b=max3f(b,p1[r+2],p1[r+3]);}
  const float m=max2f(a,b);
  auto rr=__builtin_amdgcn_permlane32_swap(__float_as_uint(m),__float_as_uint(m),false,false);
  return max2f(__uint_as_float(rr[0]),__uint_as_float(rr[1]));
}
__device__ __forceinline__ void pv(f32x16*o,int vb,bf16x8 pa0,bf16x8 pa1,bf16x8 pa2,bf16x8 pa3){
  #pragma unroll
  for(int d0=0;d0<2;++d0){s16x4 lo[4],hi[4];
    #pragma unroll
    for(int ks=0;ks<4;++ks){
      asm volatile("ds_read_b64_tr_b16 %0,%1 offset:%c2":"=&v"(lo[ks]):"v"(vb),"i"(d0*4096+ks*1024):"memory");
      asm volatile("ds_read_b64_tr_b16 %0,%1 offset:%c2":"=&v"(hi[ks]):"v"(vb),"i"(d0*4096+ks*1024+512):"memory");}
    asm volatile("s_waitcnt lgkmcnt(0)":::"memory");SBAR();
    #define PK(k) (bf16x8){lo[k][0],lo[k][1],lo[k][2],lo[k][3],hi[k][0],hi[k][1],hi[k][2],hi[k][3]}
    o[d0]=__builtin_amdgcn_mfma_f32_32x32x16_bf16(pa0,PK(0),o[d0],0,0,0);
    o[d0]=__builtin_amdgcn_mfma_f32_32x32x16_bf16(pa1,PK(1),o[d0],0,0,0);
    o[d0]=__builtin_amdgcn_mfma_f32_32x32x16_bf16(pa2,PK(2),o[d0],0,0,0);
    o[d0]=__builtin_amdgcn_mfma_f32_32x32x16_bf16(pa3,PK(3),o[d0],0,0,0);
    #undef PK
  }
}

#ifndef ATTN_STORE16
#define ATTN_STORE16(p,v) (*(u32x4*)(p)=(v))
#endif
template<int THRL> __device__ __forceinline__ void attn_unit(int b,int h,int qb,const bf16*Q,const bf16*__restrict__ K,const bf16*__restrict__ V,bf16*O,const float*__restrict__ kbg,char*shm){
  int tid_=threadIdx.x; asm volatile("":"+v"(tid_)); const int tid=tid_,lane=tid&63,r32=lane&31,hi=lane>>5; const int wid=__builtin_amdgcn_readfirstlane(tid>>6);
  const long rowbase=(long)b*SEQ; const int q0=qb*QB;
  const bf16*Qw=Q+(rowbase+q0+wid*QBLK)*DM+h*D;
  const bf16*Kh=K+rowbase*DM+h*D,*Vh=V+rowbase*DM+h*D;
  const unsigned lds0=(unsigned)(uintptr_t)shm;
  float*wsf=(float*)(shm+LDS_WS)+wid*64;
  const bf16*ksrc=Kh+(long)lane*DM+wid*8;
  const bf16*vsrc=Vh+(long)(16*(wid&3)+(lane>>2))*DM+(wid>>2)*32+(lane&3)*8;
  const unsigned kdst=lds0+LDS_K+wid*1024, vdst=lds0+LDS_V+wid*1024;
  #define DMA_K(t,slot) glds16(ksrc+(long)(t)*KVBLK*DM,(unsigned)__builtin_amdgcn_readfirstlane(kdst+(slot)))
  #define DMA_V(t,slot) glds16(vsrc+(long)(t)*KVBLK*DM,(unsigned)__builtin_amdgcn_readfirstlane(vdst+(slot)))
  const int vb0=(int)(lds0+LDS_V)+((lane>>4)&1)*32+(lane&3)*8+(4*hi+((lane&15)>>2))*64;
  const char*Kbase=shm+LDS_K; bf16x8 kf[8];
  const lds_cptr shm3=(lds_cptr)shm; const lds_cptr kp0=shm3+LDS_K+hi*1024+r32*16; const lds_cptr vp0=shm3+LDS_V+((lane>>4)&1)*32+(lane&3)*8+(4*hi+((lane&15)>>2))*64;
  const int NT=(q0+QB)/KVBLK;
  typedef __attribute__((address_space(3))) float lds_f32; typedef float kb4_t __attribute__((ext_vector_type(4)));
  { lds_f32*kw=(lds_f32*)(shm3+LDS_KB); for(int i=tid;i<NT*KVBLK;i+=NW*64)kw[i]=kbg[i]; }
  const __attribute__((address_space(3))) kb4_t*kbl=(const __attribute__((address_space(3))) kb4_t*)(shm3+LDS_KB)+hi;
  #define KBLOAD(P0,P1,t) do{ const __attribute__((address_space(3))) kb4_t*kb_=kbl+16*(t); \
    _Pragma("unroll") for(int g_=0;g_<4;++g_){ const kb4_t a_=kb_[2*g_], b_=kb_[2*g_+8]; \
      P0[4*g_]=a_[0];P0[4*g_+1]=a_[1];P0[4*g_+2]=a_[2];P0[4*g_+3]=a_[3]; P1[4*g_]=b_[0];P1[4*g_+1]=b_[1];P1[4*g_+2]=b_[2];P1[4*g_+3]=b_[3]; } }while(0)
  DMA_K(0,0);DMA_V(0,0);DMA_K(1,SLOTB);
  bf16x8 qr[4];
  #pragma unroll
  for(int d0=0;d0<4;++d0)qr[d0]=*reinterpret_cast<const bf16x8*>(&Qw[(long)r32*DM+d0*16+hi*8]);
  float mhat=0.f,l_reg=0.f;f32x16 o[2];o[0]=f32x16{};o[1]=f32x16{};
  const int qrel=wid*QBLK+r32;
  #define CMASK(P0,P1,t) do{int jb_=(t)-(NT-4); if(jb_>=0)cmask(P0,P1,jb_,qrel,hi);}while(0)
  bool resc=false;
  #define START(P0,P1) do{ const float rm=rowmax(P0,P1); resc=false; \
    { const float dl=rm; mhat=fadd_s(mhat,dl); \
      _Pragma("unroll") for(int r=0;r<16;++r){P0[r]=fsub_s(P0[r],dl);P1[r]=fsub_s(P1[r],dl);} } \
    _Pragma("unroll") for(int r=0;r<16;++r)P0[r]=__builtin_amdgcn_exp2f(P0[r]); }while(0)
  #define RESC() do{ if(resc){ asm volatile("s_waitcnt lgkmcnt(0)":::"memory"); \
      _Pragma("unroll") for(int d_=0;d_<2;++d_) _Pragma("unroll") for(int r=0;r<16;++r)o[d_][r]*=wsf[crow(r,hi)]; } }while(0)
  f32x16 pA0,pA1,pB0,pB1;
  int sl_prev=0,sl_cur=0,sl_next=SLOTB;
  #define ROT() do{sl_prev=sl_cur;sl_cur=sl_next;sl_next=(sl_next==(NSLOT-1)*SLOTB)?0:sl_next+SLOTB;}while(0)
  DMA_K(2,2*SLOTB);
  WAIT_BAR(3);
  KBLOAD(pA0,pA1,0);
  qkt(pA0,pA1,Kbase,qr,r32,hi);asm volatile("s_nop 15\n\ts_nop 7":"+v"(pA0),"+v"(pA1));CMASK(pA0,pA1,0);
  START(pA0,pA1);
  _Pragma("unroll") for(int r=0;r<16;++r)pA1[r]=__builtin_amdgcn_exp2f(pA1[r]);
  KBLOAD(pB0,pB1,1);
  WAIT_BAR(0);
  DMA_K(3,0);DMA_V(1,SLOTB);
  ROT();
  kload8(kf,kp0+sl_cur);
  WAIT_BAR(2);
  s16x4 vlo[8],vhi[8]; u32x4 pw0,pw1,pw2,pw3;
  #define PKW(P,B) cvtpk_s(P[B],P[B+1])
  #define PAF(k) __builtin_bit_cast(bf16x8,pw##k)
  #define VFR(i) (bf16x8){vlo[i][0],vlo[i][1],vlo[i][2],vlo[i][3],vhi[i][0],vhi[i][1],vhi[i][2],vhi[i][3]}
  #define PIN(x) asm volatile("":"+v"(x))
  #define MX3(a,b,c) __builtin_fmaxf(__builtin_fmaxf((a),(b)),(c))
  #define GAPA(MF,A0,A1,A2,A3,W0,W1,PW) do{ MF; sacc+=A0; sacc+=A1; sacc+=A2; sacc+=A3; PIN(sacc); W0; W1; PIN(PW); SBAR(); }while(0)
  #define EX(v) __builtin_amdgcn_exp2f(v)
  #define GAPB(MF,X,B) do{ MF; X[B]=EX(X[B]); X[B+1]=EX(X[B+1]); X[B+2]=EX(X[B+2]); X[B+3]=EX(X[B+3]); PIN(X); SBAR(); }while(0)
  #define VRD(i) do{ vlo[i]=vtr(vp_+(((i)>>2)*4096+((i)&3)*1024)); vhi[i]=vtr(vp_+(((i)>>2)*4096+((i)&3)*1024+512)); }while(0)
  #define KRD(G,j) do{ if(G){ kload2(kf,kp0+sl_next,j); SBAR(); } }while(0)
  #define STEP(C0,C1,P0,P1,t,GK,GV,GL) do{ SBAR(); \
    const lds_cptr vp_=vp0+sl_prev; \
    VRD(0); SBAR(); float sacc=(P0[0]+P0[1]); \
    GAPA(C0=__builtin_amdgcn_mfma_f32_32x32x16_bf16(kf[0],qr[0],C0,0,0,0), P0[2],P0[3],P0[4],P0[5],     pw0[0]=PKW(P0,0), pw0[1]=PKW(P0,2), pw0); \
    VRD(4); SBAR(); GAPA(C1=__builtin_amdgcn_mfma_f32_32x32x16_bf16(kf[1],qr[0],C1,0,0,0), P0[6],P0[7],P0[8],P0[9],     pw0[2]=PKW(P0,4), pw0[3]=PKW(P0,6), pw0); \
    VRD(1); SBAR(); GAPA(C0=__builtin_amdgcn_mfma_f32_32x32x16_bf16(kf[2],qr[1],C0,0,0,0),   P0[10],P0[11],P0[12],P0[13], pw1[0]=PKW(P0,8), pw1[1]=PKW(P0,10), pw1); \
    VRD(5); SBAR(); GAPA(C1=__builtin_amdgcn_mfma_f32_32x32x16_bf16(kf[3],qr[1],C1,0,0,0),   P0[14],P0[15],P1[0],P1[1],   pw1[2]=PKW(P0,12),pw1[3]=PKW(P0,14), pw1); \
    VRD(2); SBAR(); GAPA(C0=__builtin_amdgcn_mfma_f32_32x32x16_bf16(kf[4],qr[2],C0,0,0,0),   P1[2],P1[3],P1[4],P1[5],     pw2[0]=PKW(P1,0), pw2[1]=PKW(P1,2), pw2); \
    VRD(6); SBAR(); GAPA(C1=__builtin_amdgcn_mfma_f32_32x32x16_bf16(kf[5],qr[2],C1,0,0,0),   P1[6],P1[7],P1[8],P1[9],     pw2[2]=PKW(P1,4), pw2[3]=PKW(P1,6), pw2); \
    VRD(3); SBAR(); GAPA(C0=__builtin_amdgcn_mfma_f32_32x32x16_bf16(kf[6],qr[3],C0,0,0,0),   P1[10],P1[11],P1[12],P1[13], pw3[0]=PKW(P1,8), pw3[1]=PKW(P1,10), pw3); \
    VRD(7); SBAR(); GAPA(C1=__builtin_amdgcn_mfma_f32_32x32x16_bf16(kf[7],qr[3],C1,0,0,0),   P1[14],P1[15],0.f,0.f,       pw3[2]=PKW(P1,12),pw3[3]=PKW(P1,14), pw3); \
    l_reg+=sacc; \
    if(GK){DMA_K((t)+3,sl_cur);} if(GV){DMA_V((t)+1,sl_next);} \
    _Pragma("unroll") for(int r=0;r<16;++r){C0[r]-=mhat;C1[r]-=mhat;} \
    CMASK(C0,C1,t); \
    { float a=MX3(C0[0],C0[1],C1[0]),b=MX3(C0[2],C0[3],C1[1]); a=MX3(a,C1[2],C1[3]); \
      _Pragma("unroll") for(int r=4;r<16;r+=4){a=MX3(a,C0[r],C0[r+1]);b=MX3(b,C0[r+2],C0[r+3]);a=MX3(a,C1[r],C1[r+1]);b=MX3(b,C1[r+2],C1[r+3]);} \
      float rm=__builtin_fmaxf(a,b); { auto rr=__builtin_amdgcn_permlane32_swap(__float_as_uint(rm),__float_as_uint(rm),false,false); rm=__builtin_fmaxf(__uint_as_float(rr[0]),__uint_as_float(rr[1])); } \
      resc=false; \
      if(__builtin_expect(__any(rm>(float)THRL),0)){ const float dl=__builtin_fmaxf(rm,0.f); mhat+=dl; \
        _Pragma("unroll") for(int r=0;r<16;++r){C0[r]-=dl;C1[r]-=dl;} \
        const float f=__builtin_amdgcn_exp2f(-dl); l_reg*=f; if(hi==0)wsf[r32]=f; resc=true; } } \
    SBAR(); \
    KBLOAD(P0,P1,(t)+1); SBAR(); \
    GAPB(o[0]=__builtin_amdgcn_mfma_f32_32x32x16_bf16(PAF(0),VFR(0),o[0],0,0,0), C0,0); \
    GAPB(o[1]=__builtin_amdgcn_mfma_f32_32x32x16_bf16(PAF(0),VFR(4),o[1],0,0,0), C0,4); \
    KRD(GL,0); GAPB(o[0]=__builtin_amdgcn_mfma_f32_32x32x16_bf16(PAF(1),VFR(1),o[0],0,0,0), C0,8); \
    KRD(GL,1); GAPB(o[1]=__builtin_amdgcn_mfma_f32_32x32x16_bf16(PAF(1),VFR(5),o[1],0,0,0), C0,12); \
    KRD(GL,2); GAPB(o[0]=__builtin_amdgcn_mfma_f32_32x32x16_bf16(PAF(2),VFR(2),o[0],0,0,0), C1,0); \
    KRD(GL,3); GAPB(o[1]=__builtin_amdgcn_mfma_f32_32x32x16_bf16(PAF(2),VFR(6),o[1],0,0,0), C1,4); \
    GAPB(o[0]=__builtin_amdgcn_mfma_f32_32x32x16_bf16(PAF(3),VFR(3),o[0],0,0,0), C1,8); \
    GAPB(o[1]=__builtin_amdgcn_mfma_f32_32x32x16_bf16(PAF(3),VFR(7),o[1],0,0,0), C1,12); \
    }while(0)
  int t=1;
  #undef CMASK
  #define CMASK(P0,P1,t) do{}while(0)
  for(;t+5<NT;t+=2){
    STEP(pB0,pB1,pA0,pA1,t,true,true,true);     WAIT_BAR(2); RESC(); ROT();
    STEP(pA0,pA1,pB0,pB1,t+1,true,true,true);   WAIT_BAR(2); RESC(); ROT();
  }
  #undef CMASK
  #define CMASK(P0,P1,t) do{int jb_=(t)-(NT-4); if(jb_>=0)cmask(P0,P1,jb_,qrel,hi);}while(0)
  #define ENDW(tt) do{ if((tt)+3<NT){WAIT_BAR(2);} else if((tt)+2<NT){WAIT_BAR(1);} else {WAIT_BAR(0);} }while(0)
  for(;t+1<NT;t+=2){
    STEP(pB0,pB1,pA0,pA1,t,(t+3<NT),(t+1<NT),(t+1<NT));       ENDW(t);   RESC(); ROT();
    STEP(pA0,pA1,pB0,pB1,t+1,(t+4<NT),(t+2<NT),(t+2<NT));     ENDW(t+1); RESC(); ROT();
  }
  STEP(pB0,pB1,pA0,pA1,NT-1,false,false,false); RESC();
  { float sacc=pB0[0]+pB0[1]; _Pragma("unroll") for(int r=2;r<16;++r)sacc+=pB0[r]; _Pragma("unroll") for(int r=0;r<16;++r)sacc+=pB1[r]; l_reg+=sacc;
    pw0=(u32x4){PKW(pB0,0),PKW(pB0,2),PKW(pB0,4),PKW(pB0,6)};pw1=(u32x4){PKW(pB0,8),PKW(pB0,10),PKW(pB0,12),PKW(pB0,14)};pw2=(u32x4){PKW(pB1,0),PKW(pB1,2),PKW(pB1,4),PKW(pB1,6)};pw3=(u32x4){PKW(pB1,8),PKW(pB1,10),PKW(pB1,12),PKW(pB1,14)};
    SBAR(); pv(o,vb0+sl_cur,PAF(0),PAF(1),PAF(2),PAF(3)); }
  #undef PKW
  #undef PAF
  #undef VFR
  #undef PIN
  #undef MX3
  #undef GAPA
  #undef GAPB
  #undef EX
  #undef VRD
  #undef KRD
  #undef STEP
  #undef ENDW
  {auto rr=__builtin_amdgcn_permlane32_swap(__float_as_uint(l_reg),__float_as_uint(l_reg),false,false);l_reg=__uint_as_float(rr[0])+__uint_as_float(rr[1]);}
  if(hi==0)wsf[32+r32]=l_reg;asm volatile("s_waitcnt lgkmcnt(0)":::"memory");
  float rli[16];
  #pragma unroll
  for(int r=0;r<16;++r)rli[r]=__builtin_amdgcn_rcpf(wsf[32+crow(r,hi)]);
  bf16*Ow=O+(rowbase+q0+wid*QBLK)*OP+h*D;
  { bf16*stg=(bf16*)(shm+LDS_OST)+wid*2048;
    #pragma unroll
    for(int r=0;r<16;++r){const int orow=crow(r,hi);
      #pragma unroll
      for(int d0=0;d0<2;++d0)stg[orow*64+d0*32+r32]=__float2bfloat16(o[d0][r]*rli[r]);}
    asm volatile("s_waitcnt lgkmcnt(0)":::"memory");
    #pragma unroll
    for(int i=0;i<4;++i){const int row=i*8+(lane>>3),ch=lane&7; const u32x4 v=*(const u32x4*)(stg+row*64+ch*8); if(q0+wid*QBLK+row<SEQ)ATTN_STORE16(Ow+(long)row*OP+ch*8,v);} }
  asm volatile("s_waitcnt lgkmcnt(0)\n\ts_barrier":::"memory");
  #undef KBLOAD
  #undef DMA_K
  #undef DMA_V
  #undef CMASK
  #undef START
  #undef RESC
  #undef ROT
}
constexpr int ATTN_LDS_BYTES=LDS_BYTES;
#undef SBAR
#undef WAIT_BAR
}

__device__ __forceinline__ void fox_fast(const Ctx& c, unsigned char* lds_generic, int layer, int first_block) {
    if ((int)blockIdx.x < first_block) return;
    LAS volatile int* slot = (LAS volatile int*)((LAS unsigned char*)lds_generic + 131072);
    for (;;) {
        if (c.tid == 0) slot[0] = (int)atomicAdd(c.ctl + 64 * (1 + layer), 1u);
        __syncthreads();
        const int n = slot[0];
        if (n >= 17 * 32) break;
        const int qb = 16 - (n >> 5), bh = n & 31;
        attn_body::attn_unit<8>(bh >> 3, bh & 7, qb, (const attn_body::bf16*)c.QB, (const attn_body::bf16*)c.KB, (const attn_body::bf16*)c.VB, (attn_body::bf16*)c.MIX,
                                c.kbias + (size_t)bh * KBL, (char*)lds_generic);
    }
}

__device__ __forceinline__ void fox_simple(const Ctx& c, LAS unsigned char* lds, int first_block) {
    LAS float* sc = (LAS float*)(lds + c.wave * 16896);
    LAS float* qs = sc; LAS float* ps = sc + 64;
    const int nblk = gridDim.x - first_block; if ((int)blockIdx.x < first_block) return;
    const int gw = ((int)blockIdx.x - first_block) * NWAVES + c.wave, NGW = nblk * NWAVES;
    for (int it = gw; it < MROWS * FOXH; it += NGW) {
        const int r = it >> 3, h = it & 7, b = r / LV, vp = r - b * LV;
        bf16_t* op = c.MIX + (size_t)r * DM + h * 64;
        if (vp < PADF) { op[c.lane] = 0; continue; }
        qs[c.lane] = bf2f(c.QB[(size_t)r * 512 + h * 64 + c.lane]);
        asm volatile("s_waitcnt lgkmcnt(0)" ::: "memory");
        const float* kb = c.kbias + (size_t)(b * 8 + h) * KBL;
        float mx = -3.0e38f;
        for (int j = PADF + c.lane; j <= vp; j += 64) {
            const bf16_t* kr = c.KB + (size_t)(b * LV + j) * 512 + h * 64; float s = 0.f;
#pragma unroll
            for (int d8 = 0; d8 < 8; ++d8) { const bf16x8 kv = *(const bf16x8*)(kr + d8 * 8);
#pragma unroll
                for (int e = 0; e < 8; ++e) s += qs[d8 * 8 + e] * bf2f((unsigned short)kv[e]); }
            s += kb[j]; ps[j] = s; mx = fmaxf(mx, s);
        }
        mx = wave_max(mx);
        float l = 0.f;
        for (int j = PADF + c.lane; j <= vp; j += 64) { const float p = exp2f(ps[j] - mx); ps[j] = p; l += p; }
        l = wave_sum(l);
        asm volatile("s_waitcnt lgkmcnt(0)" ::: "memory");
        float o = 0.f;
        const bf16_t* vr = c.VB + (size_t)(b * LV) * 512 + h * 64 + c.lane;
        for (int j = PADF; j <= vp; ++j) o += ps[j] * bf2f(vr[(size_t)j * 512]);
        op[c.lane] = (bf16_t)f2bf(o / l);
        asm volatile("s_waitcnt lgkmcnt(0)" ::: "memory");
    }
}

__device__ __forceinline__ void hgrn_simple(const Ctx& c, LAS unsigned char* lds, int layer) {
    if (blockIdx.x >= NB * HGH) return;
    const int b = blockIdx.x >> 2, hh = blockIdx.x & 3;
    LAS float* fL = (LAS float*)lds;
    LAS float* kL = fL + 2048; LAS float* qL = kL + 2048; LAS float* vL = qL + 2048; LAS float* oP = vL + 2048;
    const int v = c.tid & 127, kg = c.tid >> 7;
    float S[32];
#pragma unroll
    for (int i = 0; i < 32; ++i) S[i] = 0.f;
    for (int i = c.tid; i < PADF * 128; i += NTHREADS) { const int vp = i >> 7; c.MIX[(size_t)(b * LV + vp) * DM + 512 + hh * 128 + (i & 127)] = 0; }
    for (int t0 = PADF; t0 < LV; t0 += 16) {
        for (int i = c.tid; i < 2048; i += NTHREADS) { const int t = i >> 7, k = i & 127; const size_t o = (size_t)(b * LV + t0 + t) * 512 + hh * 128 + k;
            const float f = __expf(c.LOGF[o]); fL[i] = f; kL[i] = 1.f - f; qL[i] = bf2f(c.HXQ[o]); vL[i] = bf2f(c.HV[o]); }
        __syncthreads();
        for (int t = 0; t < 16; ++t) { const float vv = vL[t * 128 + v]; float part = 0.f;
#pragma unroll
            for (int i = 0; i < 32; ++i) { const int k = kg * 32 + i; S[i] = fL[t * 128 + k] * S[i] + kL[t * 128 + k] * vv; part += S[i] * qL[t * 128 + k]; }
            oP[(kg * 16 + t) * 128 + v] = part; }
        __syncthreads();
        for (int tt = 0; tt < 2; ++tt) { const int t = c.wave * 2 + tt; float o0, o1;
            { const int v0 = c.lane, v1 = c.lane + 64; o0 = oP[t * 128 + v0] + oP[(16 + t) * 128 + v0] + oP[(32 + t) * 128 + v0] + oP[(48 + t) * 128 + v0];
              o1 = oP[t * 128 + v1] + oP[(16 + t) * 128 + v1] + oP[(32 + t) * 128 + v1] + oP[(48 + t) * 128 + v1]; }
            const float ss = wave_sum(o0 * o0 + o1 * o1); const float rstd = 1.f / sqrtf(ss * (1.f / 128.f) + EPS);
            const size_t ro = (size_t)(b * LV + t0 + t);
            const float g0 = bf2f(c.HG[ro * 512 + hh * 128 + c.lane]), g1 = bf2f(c.HG[ro * 512 + hh * 128 + c.lane + 64]);
            c.MIX[ro * DM + 512 + hh * 128 + c.lane] = (bf16_t)f2bf(o0 * rstd * c.hnw[layer * 128 + c.lane] * g0);
            c.MIX[ro * DM + 512 + hh * 128 + c.lane + 64] = (bf16_t)f2bf(o1 * rstd * c.hnw[layer * 128 + c.lane + 64] * g1); }
        __syncthreads();
    }
}

__device__ __forceinline__ void final_norm(const Ctx& c) {
    for (int r = c.gw; r < NB * SEQ; r += c.NGW) {
        float* hp = c.out + (size_t)r * DM; f32x4 v[4]; float s = 0.f;
#pragma unroll
        for (int j = 0; j < 4; ++j) { v[j] = *(const f32x4*)(hp + 4 * c.lane + 256 * j); s += (v[j].x * v[j].x + v[j].y * v[j].y) + (v[j].z * v[j].z + v[j].w * v[j].w); }
        s = wave_sum(s); const float rstd = 1.f / sqrtf(s * (1.f / DM) + EPS);
#pragma unroll
        for (int j = 0; j < 4; ++j) { const f32x4 w = *(const f32x4*)(c.nfinal + 4 * c.lane + 256 * j); *(f32x4*)(hp + 4 * c.lane + 256 * j) = v[j] * rstd * w; }
    }
}

__global__ void __launch_bounds__(NTHREADS, 2) fwd_kernel(Args a) {
    extern __shared__ __attribute__((aligned(16))) unsigned char lds_raw[];
    LAS unsigned char* lds = (LAS unsigned char*)lds_raw;
    cg::grid_group grid = cg::this_grid();
    Ctx c;
    c.x = a.in[0]; c.meta = a.in[1]; c.nmw = a.in[2]; c.win = a.in[3]; c.fbias = a.in[4]; c.lbraw = a.in[5]; c.hnw = a.in[6]; c.wout = a.in[7];
    c.nfw = a.in[8]; c.wg = a.in[9]; c.wu = a.in[10]; c.wd = a.in[11]; c.nfinal = a.in[12];
    c.out = a.out; c.ws = a.ws;
    c.ctl = (unsigned*)(a.ws + WS_CTL); c.sumsq = (float*)(a.ws + WS_SUMSQ); c.lbv = (float*)(a.ws + WS_LBV); c.logf8 = (float*)(a.ws + WS_LOGF8);
    c.kbias = (float*)(a.ws + WS_KBIAS); c.hs = (float*)(a.ws + WS_HS);
    c.HB = (bf16_t*)(a.ws + WS_HB); c.MIX = (bf16_t*)(a.ws + WS_MIX); c.QB = (bf16_t*)(a.ws + WS_QB); c.KB = (bf16_t*)(a.ws + WS_KB); c.VB = (bf16_t*)(a.ws + WS_VB);
    c.HXQ = (bf16_t*)(a.ws + WS_HXQ); c.LOGF = (float*)(a.ws + WS_LOGF); c.HV = (bf16_t*)(a.ws + WS_HV); c.HG = (bf16_t*)(a.ws + WS_HG); c.ACT = (bf16_t*)(a.ws + WS_ACT);
    c.tid = threadIdx.x; c.lane = c.tid & 63; c.wave = __builtin_amdgcn_readfirstlane(c.tid >> 6);
    c.gw = blockIdx.x * NWAVES + c.wave; c.NGW = gridDim.x * NWAVES;

    { const int gt = blockIdx.x * NTHREADS + c.tid, NGT = gridDim.x * NTHREADS;
      for (int i = gt; i < 16384; i += NGT) c.ctl[i] = 0u;
      for (int i = gt; i < 2 * MALLOC; i += NGT) c.sumsq[2 * MALLOC + i] = 0.f;
      for (int i = gt; i < HGW; i += NGT) c.lbv[i] = 1.f / (1.f + __expf(c.lbraw[i] - c.lbraw[HGW + i])); }
    p0_weights(c, lds);
    __syncthreads();
    ff_rows(c, lds, 0);
    grid.sync();
#define LAUNDER() asm volatile("" : "+v"(c.tid), "+v"(c.lane))
    for (int layer = 0; layer < 2; ++layer) {
        LAUNDER();
        if (layer) { ff_rows(c, lds, 1); grid.sync(); }
        LAUNDER();
        kbias_build(c);
        LAUNDER();
        if constexpr (FASTMASK & 1) gemm_fast<0>(c, lds, layer); else gemm_simple<0>(c, layer);
        grid.sync();
        LAUNDER();
        hgrn_simple(c, lds, layer);
        LAUNDER();
        fox_fast(c, lds_raw, layer, NB * HGH);
        grid.sync();
        LAUNDER();
        if constexpr (FASTMASK & 2) gemm_fast<1>(c, lds, layer); else gemm_simple<1>(c, layer);
        grid.sync();
        if constexpr (FASTMASK & 4) gemm_fast<2>(c, lds, layer); else gemm_simple<2>(c, layer);
        grid.sync();
        if constexpr (FASTMASK & 8) gemm_fast<3>(c, lds, layer); else gemm_simple<3>(c, layer);
        grid.sync();
    }
    LAUNDER();
    final_norm(c);
}

extern "C" void kernel_launch(void* const* d_in, const int* in_sizes, int n_in, void* d_out, int out_size, void* d_ws, size_t ws_size, hipStream_t stream) {
    static int grid = 0;
    if (grid == 0) {
        if (n_in != 13 || out_size != NB * SEQ * DM || ws_size < WS_END) { fprintf(stderr, "kernel_launch: unexpected shapes n_in %d out %d ws %zu\n", n_in, out_size, ws_size); grid = -1; return; }
        int dev = 0, cus = 0, per_cu = 0;
        (void)hipGetDevice(&dev); (void)hipDeviceGetAttribute(&cus, hipDeviceAttributeMultiprocessorCount, dev);
        (void)hipFuncSetAttribute((const void*)fwd_kernel, hipFuncAttributeMaxDynamicSharedMemorySize, LDS_BYTES);
        (void)hipOccupancyMaxActiveBlocksPerMultiprocessor(&per_cu, (const void*)fwd_kernel, NTHREADS, LDS_BYTES);
        if (per_cu < 1) per_cu = 1;
        grid = cus * per_cu;
        (void)hipGetLastError();
    }
    if (grid < 0) return;
    Args a{};
    for (int i = 0; i < 13; ++i) a.in[i] = (const float*)d_in[i];
    a.out = (float*)d_out; a.ws = (unsigned char*)d_ws;
    void* args[] = {&a};
    hipError_t e = hipLaunchCooperativeKernel((const void*)fwd_kernel, dim3(grid), dim3(NTHREADS), args, LDS_BYTES, stream);
    if (e != hipSuccess) fprintf(stderr, "cooperative launch failed: %s (grid %d)\n", hipGetErrorString(e), grid);
}
```

```cpp
#include <hip/hip_runtime.h>
#include <hip/hip_cooperative_groups.h>
#include <cstdint>
#include <cstdio>
namespace cg = cooperative_groups;

typedef unsigned short bf16_t;
typedef short bf16x8 __attribute__((ext_vector_type(8)));
typedef float f32x4 __attribute__((ext_vector_type(4)));
typedef unsigned u32x4 __attribute__((ext_vector_type(4)));
#define LAS __attribute__((address_space(3)))

constexpr int DM = 1024, NB = 4, SEQ = 4096, NMETA = 16, PADF = 48, LV = 4160, MROWS = NB * LV, MALLOC = MROWS + 256;
constexpr int FOXH = 8, FOXD = 64, FOXW = 512, HGH = 4, HGK = 128, HGV = 128, HGW = 512, DFF = 2816, INCOLS = 3592, NIN = 3584;
constexpr int KBL = 4352;
constexpr float EPS = 1e-6f, LOG2E = 1.4426950408889634f, C2 = 0.125f * LOG2E, HGQS = 0.08838834764831845f;
constexpr int NTHREADS = 512, NWAVES = 8;
constexpr int LDS_BYTES = 147456;
#ifndef FASTMASK
#define FASTMASK 15
#endif

constexpr size_t MiB = 1u << 20;
constexpr size_t WS_CTL = 0;
constexpr size_t WS_SUMSQ = 64 * 1024;
constexpr size_t SUMSQ_STRIDE = (size_t)MALLOC * 4;
constexpr size_t WS_LBV = WS_SUMSQ + 4 * SUMSQ_STRIDE;
constexpr size_t WS_LOGF8 = WS_LBV + 4096;
constexpr size_t WS_KBIAS = WS_LOGF8 + (size_t)MALLOC * 32;
constexpr size_t WS_DV = WS_KBIAS + 32 * KBL * 4;
constexpr size_t WS_HS = 2 * MiB;
constexpr size_t WS_W = 3 * MiB;
constexpr size_t W_IN = 0, W_OUT = W_IN + (size_t)NIN * DM * 2, W_GU = W_OUT + (size_t)DM * DM * 2, W_DN = W_GU + (size_t)2 * DFF * DM * 2, W_LAYER = W_DN + (size_t)DM * DFF * 2;
constexpr size_t WS_HB = WS_W + 2 * W_LAYER + 65536;
constexpr size_t WS_MIX = WS_HB + (size_t)MALLOC * DM * 2;
constexpr size_t WS_QB = WS_MIX + (size_t)MALLOC * DM * 2;
constexpr size_t WS_KB = WS_QB + (size_t)MALLOC * 512 * 2, WS_VB = WS_KB + (size_t)MALLOC * 512 * 2;
constexpr size_t WS_HXQ = WS_VB + (size_t)MALLOC * 512 * 2;
constexpr size_t WS_LOGF = WS_HXQ + (size_t)MALLOC * 512 * 2;
constexpr size_t WS_HV = WS_LOGF + (size_t)MALLOC * 512 * 4, WS_HG = WS_HV + (size_t)MALLOC * 512 * 2;
constexpr size_t WS_END = WS_HG + (size_t)MALLOC * 512 * 2;
constexpr size_t WS_ACT = WS_QB;
static_assert(WS_DV + 16 * 64 * 128 * 4 <= WS_HS && (size_t)16 * 64 * 16384 * 2 <= (size_t)MALLOC * DM * 2 && WS_HS + 4 * 64 * 1024 * 4 <= WS_W, "small map");
static_assert(WS_ACT + (size_t)MALLOC * DFF * 2 <= WS_END, "ACT overlay");
static_assert(WS_END <= 256 * MiB, "d_ws");

struct Args { const float* in[13]; float* out; unsigned char* ws; };

struct Ctx {
    const float *x, *meta, *nmw, *win, *fbias, *lbraw, *hnw, *wout, *nfw, *wg, *wu, *wd, *nfinal;
    float* out; unsigned char* ws;
    unsigned* ctl; float* sumsq; float* lbv; float* logf8; float* kbias; float* hs;
    bf16_t *HB, *MIX, *QB, *KB, *VB, *HXQ, *HV, *HG, *ACT; float* LOGF;
    int tid, lane, wave, gw, NGW;
};

__device__ __forceinline__ unsigned f2bf(float f) { unsigned u = __builtin_bit_cast(unsigned, f); return (u + 0x7fffu + ((u >> 16) & 1u)) >> 16; }
__device__ __forceinline__ unsigned pk2(float lo, float hi) { return f2bf(lo) | (f2bf(hi) << 16); }
__device__ __forceinline__ float bf2f(unsigned short b) { return __builtin_bit_cast(float, (unsigned)b << 16); }
__device__ __forceinline__ float wave_sum(float v) {
#pragma unroll
    for (int o = 1; o < 64; o <<= 1) v += __shfl_xor(v, o);
    return v;
}
__device__ __forceinline__ float wave_max(float v) {
#pragma unroll
    for (int o = 1; o < 64; o <<= 1) v = fmaxf(v, __shfl_xor(v, o));
    return v;
}
__device__ __forceinline__ float siluf(float x) { return x / (1.f + __expf(-x)); }
__device__ __forceinline__ float* hrow(const Ctx& c, int r) {
    const int b = r / LV, vp = r - b * LV;
    return vp >= 64 ? c.out + (size_t)(b * SEQ + vp - 64) * DM : c.hs + (size_t)(b * 64 + vp) * DM;
}
__device__ __forceinline__ bf16_t* wptr(const Ctx& c, int layer, size_t off) { return (bf16_t*)(c.ws + WS_W + (size_t)layer * W_LAYER + off); }

namespace pg8 {
#define PG8_LAS __attribute__((address_space(3)))
typedef unsigned short bf16_t;
typedef short bf16x8 __attribute__((ext_vector_type(8)));
typedef float f32x4 __attribute__((ext_vector_type(4)));
typedef unsigned u32x4 __attribute__((ext_vector_type(4)));
constexpr int BM = 256, BK = 64, HALF = 128, HTB = HALF * BK * 2  , STAGE_BYTES = 8 * HTB, NXCD = 8, WGM = 8;

__host__ __device__ __forceinline__ int lds_byte(int r, int c) { const int st = (r >> 4) * 2 + (c >> 5), rr = r & 15, cc = c & 31, ob = rr * 64 + cc * 2; return st * 1024 + (ob ^ (((ob >> 9) & 1) << 5)); }
__host__ __device__ __forceinline__ void stage_rc(int b, int& R, int& C) { const int st = b / 1024, sb = b % 1024, swz = sb ^ (((sb >> 9) & 1) << 5); R = (st >> 1) * 16 + swz / 64; C = (st & 1) * 32 + (swz % 64) / 2; }
__host__ __device__ __forceinline__ int perm32(int rho) { const int n = rho >> 4, i = rho & 15; return 8 * (i >> 2) + 4 * n + (i & 3); }

struct Unit { int pm, pn; };
struct Gemm { const bf16_t* A; const bf16_t* Bt; int M, N, K; };

struct StaticOrder {
    int nM, nN, nwg, G, c;
    __host__ __device__ void init(int M, int N, int G_, int c_) { nM = M / BM; nN = N / BM; nwg = nM * nN; G = G_; c = c_; }
    __host__ __device__ bool next(int i, Unit& u) const {
        const long L = (long)i * G + c; if (L >= nwg) return false;
        int wgid = (int)L; { const int q = nwg / NXCD, r = nwg % NXCD, xcd = wgid % NXCD, off = wgid / NXCD; wgid = (xcd < r ? xcd * (q + 1) : r * (q + 1) + (xcd - r) * q) + off; }
        const int nig = WGM * nN, gid = wgid / nig, fm = gid * WGM, gsz = (nM - fm) < WGM ? (nM - fm) : WGM;
        u.pm = fm + ((wgid % nig) % gsz); u.pn = (wgid % nig) / gsz; return true;
    }
    __device__ __forceinline__ void a_ready(const Unit&) const {}
    __device__ __forceinline__ void done(const Unit&) const {}
};

__device__ __forceinline__ unsigned cvt_pk_bf16(float lo, float hi) { unsigned r; asm volatile("v_cvt_pk_bf16_f32 %0, %1, %2" : "=v"(r) : "v"(lo), "v"(hi)); return r; }
typedef float f32x2 __attribute__((ext_vector_type(2)));
template <class Epi, class Sched, bool ALIGN_EPI = false, bool SP2 = false>
__device__ __forceinline__ void gemm_phase(PG8_LAS unsigned char* lds, const Gemm g, const Sched& S, const Epi& E) {
    int tid_ = threadIdx.x; asm volatile("" : "+v"(tid_));
    const int tid = tid_, wid = __builtin_amdgcn_readfirstlane(tid >> 6), lane = tid & 63, wr = wid >> 2, wc = wid & 3, fr = lane & 15, fq = lane >> 4;
    const int K = g.K, nt = K / BK;
    unsigned voffA[2], voffB[2];
#pragma unroll
    for (int i = 0; i < 2; ++i) { int R, C; stage_rc(tid * 16 + i * 8192, R, C); const int Rb = Epi::PERM ? ((R & ~31) + perm32(R & 31)) : R;
        voffA[i] = (unsigned)(R * K + C) * 2u; voffB[i] = (unsigned)(Rb * K + C) * 2u; }
    const size_t kstep = (size_t)(BK * 2);
    const size_t hstep = (size_t)HALF * K * 2;
    const size_t tstep = 2 * hstep;
    const unsigned ldsw = (unsigned)wid * 1024u;
    const int aoff = lds_byte(wr * 64 + fr, fq * 8), boff = lds_byte(wc * 32 + fr, fq * 8);
#define PG8_SA(b, h) (((b) * 2 + (h)) * HTB)
#define PG8_SB(b, h) ((4 + (b) * 2 + (h)) * HTB)
#define PG8_STAGE(bufoff, gbase, voff) do { _Pragma("unroll") for (int _i = 0; _i < 2; ++_i) \
        __builtin_amdgcn_global_load_lds((const unsigned*)((const char*)(gbase) + (voff)[_i]), (PG8_LAS unsigned*)(lds + (bufoff) + ldsw + _i * 8192), 16, 0, 0); } while (0)
#define PG8_LDA(dst, b, h) do { _Pragma("unroll") for (int m = 0; m < 4; ++m) _Pragma("unroll") for (int k = 0; k < 2; ++k) dst[m][k] = *(const PG8_LAS bf16x8*)(lds + PG8_SA(b, h) + aoff + m * 2048 + k * 1024); } while (0)
#define PG8_LDB(dst, b, h) do { _Pragma("unroll") for (int n = 0; n < 2; ++n) _Pragma("unroll") for (int k = 0; k < 2; ++k) dst[n][k] = *(const PG8_LAS bf16x8*)(lds + PG8_SB(b, h) + boff + n * 2048 + k * 1024); } while (0)
#define PG8_MMA(ai, bj, At, Bt) do { __builtin_amdgcn_s_setprio(1); _Pragma("unroll") for (int m = 0; m < 4; ++m) _Pragma("unroll") for (int n = 0; n < 2; ++n) _Pragma("unroll") for (int k = 0; k < 2; ++k) \
        acc[ai][bj][m][n] = __builtin_amdgcn_mfma_f32_16x16x32_bf16(Bt[n][k], At[m][k], acc[ai][bj][m][n], 0, 0, 0); __builtin_amdgcn_s_setprio(0); } while (0)
#define PG8_WAIT_V(n) asm volatile("s_waitcnt vmcnt(" #n ")" ::: "memory")
#define PG8_WAIT_L(n) asm volatile("s_waitcnt lgkmcnt(" #n ")" ::: "memory")
#define PG8_BAR __builtin_amdgcn_s_barrier()
#define PG8_SCHED __builtin_amdgcn_sched_barrier(0)
    Unit cur, nxt; int ui = 0;
    if (!S.next(0, cur)) return;
    f32x4 acc[2][2][4][2];
#pragma unroll
    for (int a = 0; a < 2; ++a)
#pragma unroll
        for (int b = 0; b < 2; ++b)
#pragma unroll
            for (int m = 0; m < 4; ++m)
#pragma unroll
                for (int n = 0; n < 2; ++n) acc[a][b][m][n] = (f32x4){0.f, 0.f, 0.f, 0.f};
    bf16x8 At[4][2], B0[2][2], B1[2][2];
    const char* cA = (const char*)g.A + (size_t)cur.pm * tstep; const char* cB = (const char*)g.Bt + (size_t)cur.pn * tstep;
    S.a_ready(cur);
    if constexpr (SP2) {
        PG8_STAGE(PG8_SB(0, 0), cB, voffB); PG8_STAGE(PG8_SB(0, 1), cB + hstep, voffB); PG8_STAGE(PG8_SA(0, 0), cA, voffA); PG8_STAGE(PG8_SA(0, 1), cA + hstep, voffA);
        if (wr == 1) PG8_BAR;
        PG8_WAIT_V(2); PG8_BAR;
        PG8_STAGE(PG8_SB(1, 0), cB + kstep, voffB); PG8_STAGE(PG8_SA(1, 0), cA + kstep, voffA); PG8_STAGE(PG8_SB(1, 1), cB + hstep + kstep, voffB);
        PG8_WAIT_V(6); PG8_BAR;
    } else {
        PG8_STAGE(PG8_SB(0, 0), cB, voffB); PG8_STAGE(PG8_SA(0, 0), cA, voffA); PG8_STAGE(PG8_SB(0, 1), cB + hstep, voffB); PG8_STAGE(PG8_SA(0, 1), cA + hstep, voffA);
        if (wr == 1) PG8_BAR;
        PG8_WAIT_V(4); PG8_BAR;
        PG8_STAGE(PG8_SB(1, 0), cB + kstep, voffB); PG8_STAGE(PG8_SA(1, 0), cA + kstep, voffA); PG8_STAGE(PG8_SB(1, 1), cB + hstep + kstep, voffB);
        PG8_WAIT_V(6); PG8_BAR;
    }
    for (;;) {
        const bool has_next = S.next(ui + 1, nxt);
        const char* nA = has_next ? (const char*)g.A + (size_t)nxt.pm * tstep : cA; const char* nB = has_next ? (const char*)g.Bt + (size_t)nxt.pn * tstep : cB;
        for (int t = 0; t < nt; t += 2) {
            const bool last = (t == nt - 2);
            const char* a1 = cA + (size_t)(t + 1) * kstep;
            const char* a2 = last ? nA : cA + (size_t)(t + 2) * kstep; const char* b2 = last ? nB : cB + (size_t)(t + 2) * kstep;
            const char* a3 = a2 + kstep; const char* b3 = b2 + kstep;
            if (last && has_next) S.a_ready(nxt);
            if constexpr (SP2) {
            PG8_LDB(B0, 0, 0); PG8_LDB(B1, 0, 1); PG8_SCHED; PG8_LDA(At, 0, 0); PG8_STAGE(PG8_SA(1, 1), a1 + hstep, voffA);
            PG8_WAIT_V(8); PG8_WAIT_L(0); PG8_BAR; PG8_MMA(0, 0, At, B0); PG8_MMA(0, 1, At, B1); PG8_BAR; PG8_SCHED;
            PG8_LDA(At, 0, 1); PG8_STAGE(PG8_SB(0, 0), b2, voffB); PG8_STAGE(PG8_SB(0, 1), b2 + hstep, voffB); PG8_STAGE(PG8_SA(0, 0), a2, voffA);
            PG8_WAIT_V(8); PG8_WAIT_L(0); PG8_BAR; PG8_MMA(1, 0, At, B0); PG8_MMA(1, 1, At, B1); PG8_BAR; PG8_SCHED;
            PG8_LDB(B0, 1, 0); PG8_LDB(B1, 1, 1); PG8_SCHED; PG8_LDA(At, 1, 0); PG8_STAGE(PG8_SA(0, 1), a2 + hstep, voffA);
            PG8_WAIT_V(8); PG8_WAIT_L(0); PG8_BAR; PG8_MMA(0, 0, At, B0); PG8_MMA(0, 1, At, B1); PG8_BAR; PG8_SCHED;
            PG8_LDA(At, 1, 1); PG8_STAGE(PG8_SB(1, 0), b3, voffB); PG8_STAGE(PG8_SB(1, 1), b3 + hstep, voffB); PG8_STAGE(PG8_SA(1, 0), a3, voffA);
            PG8_WAIT_V(8); PG8_WAIT_L(0); PG8_BAR; PG8_MMA(1, 0, At, B0); PG8_MMA(1, 1, At, B1); PG8_BAR; PG8_SCHED;
            } else {
            PG8_LDB(B0, 0, 0); PG8_SCHED; PG8_LDA(At, 0, 0); PG8_STAGE(PG8_SA(1, 1), a1 + hstep, voffA);
            PG8_WAIT_L(8); PG8_BAR; PG8_WAIT_L(0); PG8_MMA(0, 0, At, B0); PG8_BAR; PG8_SCHED;
            PG8_LDB(B1, 0, 1); PG8_STAGE(PG8_SB(0, 0), b2, voffB);
            PG8_BAR; PG8_WAIT_L(0); PG8_MMA(0, 1, At, B1); PG8_BAR;
            PG8_LDA(At, 0, 1); PG8_STAGE(PG8_SA(0, 0), a2, voffA);
            PG8_BAR; PG8_WAIT_L(0); PG8_MMA(1, 0, At, B0); PG8_BAR; PG8_SCHED;
            PG8_STAGE(PG8_SB(0, 1), b2 + hstep, voffB);
            PG8_WAIT_V(6); PG8_BAR; PG8_MMA(1, 1, At, B1); PG8_BAR;
            PG8_LDB(B0, 1, 0); PG8_SCHED; PG8_LDA(At, 1, 0); PG8_STAGE(PG8_SA(0, 1), a2 + hstep, voffA);
            PG8_WAIT_L(8); PG8_BAR; PG8_WAIT_L(0); PG8_MMA(0, 0, At, B0); PG8_BAR; PG8_SCHED;
            PG8_LDB(B1, 1, 1); PG8_STAGE(PG8_SB(1, 0), b3, voffB);
            PG8_BAR; PG8_WAIT_L(0); PG8_MMA(0, 1, At, B1); PG8_BAR;
            PG8_LDA(At, 1, 1); PG8_STAGE(PG8_SA(1, 0), a3, voffA);
            PG8_BAR; PG8_WAIT_L(0); PG8_MMA(1, 0, At, B0); PG8_BAR; PG8_SCHED;
            PG8_STAGE(PG8_SB(1, 1), b3 + hstep, voffB);
            PG8_WAIT_V(6); PG8_BAR; PG8_MMA(1, 1, At, B1); PG8_BAR;
            }
        }
        if constexpr (ALIGN_EPI) { if (wr == 0) PG8_BAR; }
        if constexpr (!Epi::AFTER_DRAIN) { E(acc, cur, wr, wc, fr, fq); S.done(cur); }
        if (!has_next) break;
#pragma unroll
        for (int a = 0; a < 2; ++a)
#pragma unroll
            for (int b = 0; b < 2; ++b)
#pragma unroll
                for (int m = 0; m < 4; ++m)
#pragma unroll
                    for (int n = 0; n < 2; ++n) acc[a][b][m][n] = (f32x4){0.f, 0.f, 0.f, 0.f};
        cur = nxt; cA = nA; cB = nB; ++ui;
        if constexpr (ALIGN_EPI) { if (wr == 1) PG8_BAR; }
    }
    PG8_WAIT_V(0);
    if constexpr (!ALIGN_EPI) { if (wr == 0) PG8_BAR; }
    PG8_BAR;
    if constexpr (Epi::AFTER_DRAIN) { E.fused(acc, cur, wr, wc, fr, fq, lds, wid, lane); S.done(cur); }
#undef PG8_SA
#undef PG8_SB
#undef PG8_STAGE
#undef PG8_LDA
#undef PG8_LDB
#undef PG8_MMA
#undef PG8_WAIT_V
#undef PG8_WAIT_L
#undef PG8_BAR
#undef PG8_SCHED
}
}

namespace pg8 {
__device__ __forceinline__ float silu_f(float x) { return x * __builtin_amdgcn_rcpf(1.f + __expf(-x)); }
struct EpiInProj {
    static constexpr bool PERM = true, AFTER_DRAIN = false;
    const float* ssq; const float* lbv; bf16_t *QB, *KB, *VB, *HXQ, *HV, *HG; float* LOGF;
    __device__ __forceinline__ void operator()(const f32x4 (&acc)[2][2][4][2], const Unit& u, int wr, int wc, int fr, int fq) const {
        const int part = u.pn >> 1;
        const int cbase = (u.pn & 1) * 256 + wc * 32 + 8 * fq;
        if (part == 4) {
#pragma unroll
            for (int bj = 0; bj < 2; ++bj)
#pragma unroll
                for (int n = 0; n < 2; ++n) {
                    const int cc = cbase + bj * HALF + 4 * n;
                    f32x4 lb1 = (f32x4){1.f, 1.f, 1.f, 1.f};
                    if (lbv) lb1 = lb1 - *(const f32x4*)(lbv + cc);
#pragma unroll
                    for (int ai = 0; ai < 2; ++ai)
#pragma unroll
                        for (int m = 0; m < 4; ++m) {
                            const int r = u.pm * BM + ai * HALF + wr * 64 + m * 16 + fr;
                            const float rstd = 1.f / sqrtf(ssq[r] * (1.f / 1024.f) + 1e-6f);
                            f32x4 a;
#pragma unroll
                            for (int e = 0; e < 4; ++e) { const float xv = acc[ai][bj][m][n][e] * rstd; const float omf = lb1[e] * __builtin_amdgcn_rcpf(1.f + __expf(xv)); a[e] = fmaxf(__logf(1.f - omf), -30.f); }
                            *(f32x4*)(LOGF + (size_t)r * 512 + cc) = a;
                        }
                }
        } else {
            bf16_t* dst = part == 0 ? QB : part == 1 ? KB : part == 2 ? VB : part == 3 ? HXQ : part == 5 ? HV : HG;
            const float sc = part == 0 ? 0.125f * 1.4426950408889634f : part == 3 ? 0.08838834764831845f : 1.f;
            const bool dosilu = (part == 3) || (part == 6);
#pragma unroll
            for (int ai = 0; ai < 2; ++ai)
#pragma unroll
                for (int m = 0; m < 4; ++m) {
                    const int r = u.pm * BM + ai * HALF + wr * 64 + m * 16 + fr;
                    const float rstd = sc / sqrtf(ssq[r] * (1.f / 1024.f) + 1e-6f);
#pragma unroll
                    for (int bj = 0; bj < 2; ++bj) {
                        f32x4 v0 = acc[ai][bj][m][0], v1 = acc[ai][bj][m][1];
                        if (dosilu) {
#pragma unroll
                            for (int e = 0; e < 4; ++e) { const float a0 = v0[e] * (rstd / sc), a1 = v1[e] * (rstd / sc); v0[e] = silu_f(a0) * sc; v1[e] = silu_f(a1) * sc; }
                        } else { v0 = v0 * rstd; v1 = v1 * rstd; }
                        u32x4 w; w.x = cvt_pk_bf16(v0[0], v0[1]); w.y = cvt_pk_bf16(v0[2], v0[3]); w.z = cvt_pk_bf16(v1[0], v1[1]); w.w = cvt_pk_bf16(v1[2], v1[3]);
                        *(u32x4*)(dst + (size_t)r * 512 + cbase + bj * HALF) = w;
                    }
                }
        }
    }
};
struct EpiResid {
    static constexpr bool PERM = false, AFTER_DRAIN = false;
    float* out; float* hs; bf16_t* HB; float* ssq;
    __device__ __forceinline__ void operator()(const f32x4 (&acc)[2][2][4][2], const Unit& u, int wr, int wc, int fr, int fq) const {
        const int col0 = u.pn * BM + wc * 32 + 4 * fq;
#pragma unroll
        for (int ai = 0; ai < 2; ++ai)
#pragma unroll
            for (int m = 0; m < 4; ++m) {
                const int r = u.pm * BM + ai * HALF + wr * 64 + m * 16 + fr;
                const int b = r / 4160, vp = r - b * 4160;
                float* hp = vp >= 64 ? out + (size_t)(b * 4096 + vp - 64) * 1024 : hs + (size_t)(b * 64 + vp) * 1024;
                float q = 0.f;
#pragma unroll
                for (int bj = 0; bj < 2; ++bj)
#pragma unroll
                    for (int n = 0; n < 2; ++n) { const int c = col0 + bj * HALF + n * 16; const f32x4 h = *(const f32x4*)(hp + c) + acc[ai][bj][m][n]; *(f32x4*)(hp + c) = h;
                        unsigned long long w = (unsigned long long)cvt_pk_bf16(h[0], h[1]) | ((unsigned long long)cvt_pk_bf16(h[2], h[3]) << 32);
                        *(unsigned long long*)(HB + (size_t)r * 1024 + c) = w; q += (h[0] * h[0] + h[1] * h[1]) + (h[2] * h[2] + h[3] * h[3]); }
                if (ssq) { q += __shfl_xor(q, 16); q += __shfl_xor(q, 32); if (fq == 0) atomicAdd(ssq + r, q); }
            }
    }
};
struct EpiSwiGLU {
    static constexpr bool PERM = true, AFTER_DRAIN = false;
    const float* ssq; bf16_t* ACT;
    __device__ __forceinline__ void operator()(const f32x4 (&acc)[2][2][4][2], const Unit& u, int wr, int wc, int fr, int fq) const {
        const int f0 = u.pn * HALF + wc * 32 + 8 * fq;
#pragma unroll
        for (int ai = 0; ai < 2; ++ai)
#pragma unroll
            for (int m = 0; m < 4; ++m) {
                const int r = u.pm * BM + ai * HALF + wr * 64 + m * 16 + fr;
                const float rstd = 1.f / sqrtf(ssq[r] * (1.f / 1024.f) + 1e-6f);
                float y[8];
#pragma unroll
                for (int n = 0; n < 2; ++n)
#pragma unroll
                    for (int e = 0; e < 4; ++e) { const float g = acc[ai][0][m][n][e] * rstd, uu = acc[ai][1][m][n][e] * rstd; y[4 * n + e] = silu_f(g) * uu; }
                u32x4 w; w.x = cvt_pk_bf16(y[0], y[1]); w.y = cvt_pk_bf16(y[2], y[3]); w.z = cvt_pk_bf16(y[4], y[5]); w.w = cvt_pk_bf16(y[6], y[7]);
                *(u32x4*)(ACT + (size_t)r * 2816 + f0) = w;
            }
    }
};
}

__device__ __forceinline__ void tr_item(const float* W, int K, int N, int k0, int nsrc0, bf16_t* WT, int dst_row0, const float* kscale, LAS float* scr, int lane) {
#pragma unroll 8
    for (int i = 0; i < 32; ++i) { const int kk = 2 * i + (lane >> 5); float s = kscale ? kscale[k0 + kk] : 1.f; scr[kk * 33 + (lane & 31)] = W[(size_t)(k0 + kk) * N + nsrc0 + (lane & 31)] * s; }
    asm volatile("s_waitcnt lgkmcnt(0)" ::: "memory");
    const int ch = lane & 7;
#pragma unroll
    for (int j = 0; j < 4; ++j) { const int n = (lane >> 3) + 8 * j; const LAS float* s = scr + (8 * ch) * 33 + n;
        u32x4 o; o.x = pk2(s[0 * 33], s[1 * 33]); o.y = pk2(s[2 * 33], s[3 * 33]); o.z = pk2(s[4 * 33], s[5 * 33]); o.w = pk2(s[6 * 33], s[7 * 33]);
        *(u32x4*)(WT + (size_t)(dst_row0 + n) * K + k0 + 8 * ch) = o; }
    asm volatile("s_waitcnt lgkmcnt(0)" ::: "memory");
}

__device__ __forceinline__ void p0_weights(const Ctx& c, LAS unsigned char* lds) {
    LAS float* scr = (LAS float*)(lds + c.wave * 16384);
    constexpr int I_IN = 16 * (NIN / 32), I_OUT = 16 * 32, I_G = 16 * (DFF / 32), I_D = (DFF / 64) * 32, I_L = I_IN + I_OUT + 2 * I_G + I_D;
    for (int it = c.gw; it < 2 * I_L; it += c.NGW) {
        const int l = it / I_L; int r = it - l * I_L;
        if (r < I_IN) { const int kb = r / (NIN / 32), nb = r % (NIN / 32), n0 = nb * 32;
            tr_item(c.win + (size_t)l * DM * INCOLS, DM, INCOLS, kb * 64, n0 + (n0 >= 1536 ? 8 : 0), wptr(c, l, W_IN), n0, c.nmw + l * DM, scr, c.lane); continue; }
        r -= I_IN;
        if (r < I_OUT) { const int kb = r / 32, nb = r % 32; tr_item(c.wout + (size_t)l * DM * DM, DM, DM, kb * 64, nb * 32, wptr(c, l, W_OUT), nb * 32, nullptr, scr, c.lane); continue; }
        r -= I_OUT;
        if (r < 2 * I_G) { const int up = r >= I_G; if (up) r -= I_G; const int kb = r / (DFF / 32), nb = r % (DFF / 32), f0 = nb * 32;
            tr_item((up ? c.wu : c.wg) + (size_t)l * DM * DFF, DM, DFF, kb * 64, f0, wptr(c, l, W_GU), 256 * (f0 >> 7) + (f0 & 127) + (up ? 128 : 0), c.nfw + l * DM, scr, c.lane); continue; }
        r -= 2 * I_G;
        { const int kb = r / 32, nb = r % 32; tr_item(c.wd + (size_t)l * DFF * DM, DFF, DM, kb * 64, nb * 32, wptr(c, l, W_DN), nb * 32, nullptr, scr, c.lane); }
    }
}

__device__ __forceinline__ void ff_rows(const Ctx& c, LAS unsigned char* lds, int layer) {
    LAS float* wff = (LAS float*)lds;
    for (int i = c.tid; i < 8 * DM; i += NTHREADS) { const int cc = i >> 10, k = i & 1023; wff[i] = c.win[(size_t)layer * DM * INCOLS + (size_t)k * INCOLS + 1536 + cc] * c.nmw[layer * DM + k]; }
    __syncthreads();
    float* ssq = c.sumsq + (size_t)layer * MALLOC;
    for (int r = c.gw; r < MROWS; r += c.NGW) {
        const int b = r / LV, vp = r - b * LV;
        f32x4 v[4];
        float* hp = hrow(c, r);
        if (layer == 0) {
            const float* src = vp >= 64 ? c.x + (size_t)(b * SEQ + vp - 64) * DM : (vp >= PADF ? c.meta + (size_t)(vp - PADF) * DM : nullptr);
#pragma unroll
            for (int j = 0; j < 4; ++j) { v[j] = src ? *(const f32x4*)(src + 4 * c.lane + 256 * j) : (f32x4){0.f, 0.f, 0.f, 0.f}; *(f32x4*)(hp + 4 * c.lane + 256 * j) = v[j];
                unsigned long long w = (unsigned long long)pk2(v[j].x, v[j].y) | ((unsigned long long)pk2(v[j].z, v[j].w) << 32);
                *(unsigned long long*)(c.HB + (size_t)r * DM + 4 * c.lane + 256 * j) = w; }
        } else {
#pragma unroll
            for (int j = 0; j < 4; ++j) v[j] = *(const f32x4*)(hp + 4 * c.lane + 256 * j);
        }
        float s = 0.f;
#pragma unroll
        for (int j = 0; j < 4; ++j) s += (v[j].x * v[j].x + v[j].y * v[j].y) + (v[j].z * v[j].z + v[j].w * v[j].w);
        s = wave_sum(s);
        const float rstd = 1.f / sqrtf(s * (1.f / DM) + EPS);
        float myv = 0.f;
#pragma unroll
        for (int cc = 0; cc < 8; ++cc) {
            float d = 0.f;
#pragma unroll
            for (int j = 0; j < 4; ++j) { const f32x4 w = *(const LAS f32x4*)(wff + cc * DM + 4 * c.lane + 256 * j); d += (v[j].x * w.x + v[j].y * w.y) + (v[j].z * w.z + v[j].w * w.w); }
            d = wave_sum(d);
            if (c.lane == cc) myv = d;
        }
        if (c.lane == 0) ssq[r] = s;
        if (c.lane < 8) { const float z = myv * rstd + c.fbias[layer * 8 + c.lane];
            c.logf8[(size_t)r * 8 + c.lane] = fminf(z, 0.f) - log1pf(__expf(-fabsf(z))); }
    }
    __syncthreads();
}

__device__ __forceinline__ void kbias_build(const Ctx& c) {
    for (int job = c.gw; job < NB * FOXH; job += c.NGW) {
        const int b = job >> 3, h = job & 7;
        float s = 0.f;
        const int v0 = 65 * c.lane;
        for (int i = 0; i < 65; ++i) { const int vp = v0 + i; const float g = vp >= PADF ? c.logf8[(size_t)(b * LV + vp) * 8 + h] : 0.f; s += g; }
        float inc = s;
#pragma unroll
        for (int o = 1; o < 64; o <<= 1) { const float t = __shfl_up(inc, o); if (c.lane >= o) inc += t; }
        float run = inc - s;
        float* kb = c.kbias + (size_t)job * KBL;
        for (int i = 0; i < 65; ++i) { const int vp = v0 + i; const float g = vp >= PADF ? c.logf8[(size_t)(b * LV + vp) * 8 + h] : 0.f; run += g; kb[vp] = vp >= PADF ? -run * LOG2E : -1e30f; }
        for (int i = LV + c.lane; i < KBL; i += 64) kb[i] = 0.f;
    }
}

template <int MODE>
__device__ __forceinline__ void gemm_simple(const Ctx& c, int layer) {
    const int fr = c.lane & 15, g = c.lane >> 4;
    const bf16_t* A = MODE == 0 ? c.HB : MODE == 1 ? c.MIX : MODE == 2 ? c.HB : c.ACT;
    const bf16_t* Bt = wptr(c, layer, MODE == 0 ? W_IN : MODE == 1 ? W_OUT : MODE == 2 ? W_GU : W_DN);
    constexpr int K = MODE == 3 ? DFF : DM;
    constexpr int NCOL = MODE == 0 ? NIN : MODE == 2 ? DFF : DM;
    constexpr int ntn = NCOL / 64, ntm = MROWS / 16;
    for (int t = c.gw; t < ntm * ntn; t += c.NGW) {
        const int tm = t / ntn, tn = t - tm * ntn, row0 = tm * 16, col0 = tn * 64;
        f32x4 acc[4], acc2[4];
#pragma unroll
        for (int n = 0; n < 4; ++n) { acc[n] = (f32x4){0.f, 0.f, 0.f, 0.f}; acc2[n] = (f32x4){0.f, 0.f, 0.f, 0.f}; }
        const bf16_t* ap = A + (size_t)(row0 + fr) * K + 8 * g;
        const bf16_t* bp[4];
#pragma unroll
        for (int n = 0; n < 4; ++n) { const int cn = col0 + 16 * n + fr; const int br = MODE == 2 ? 256 * (cn >> 7) + (cn & 127) : cn; bp[n] = Bt + (size_t)br * K + 8 * g; }
        for (int k0 = 0; k0 < K; k0 += 32) {
            const bf16x8 a = *(const bf16x8*)(ap + k0);
#pragma unroll
            for (int n = 0; n < 4; ++n) { const bf16x8 b = *(const bf16x8*)(bp[n] + k0); acc[n] = __builtin_amdgcn_mfma_f32_16x16x32_bf16(a, b, acc[n], 0, 0, 0);
                if (MODE == 2) { const bf16x8 b2 = *(const bf16x8*)(bp[n] + (size_t)128 * K + k0); acc2[n] = __builtin_amdgcn_mfma_f32_16x16x32_bf16(a, b2, acc2[n], 0, 0, 0); } }
        }
        if (MODE == 0) {
            const float* ssq = c.sumsq + (size_t)layer * MALLOC;
#pragma unroll
            for (int j = 0; j < 4; ++j) { const int r = row0 + 4 * g + j; const float rstd = 1.f / sqrtf(ssq[r] * (1.f / DM) + EPS);
#pragma unroll
                for (int n = 0; n < 4; ++n) { const int cn = col0 + 16 * n + fr; const float xv = acc[n][j] * rstd; const int part = cn >> 9, cc = cn & 511; const size_t o = (size_t)r * 512 + cc;
                    if (part == 0) c.QB[o] = (bf16_t)f2bf(xv * C2);
                    else if (part == 1) c.KB[o] = (bf16_t)f2bf(xv);
                    else if (part == 2) c.VB[o] = (bf16_t)f2bf(xv);
                    else if (part == 3) c.HXQ[o] = (bf16_t)f2bf(siluf(xv) * HGQS);
                    else if (part == 4) { const float lb = layer ? c.lbv[cc] : 0.f; const float omf = (1.f - lb) / (1.f + __expf(xv)); c.LOGF[o] = fmaxf(log1pf(-omf), -30.f); }
                    else if (part == 5) c.HV[o] = (bf16_t)f2bf(xv);
                    else c.HG[o] = (bf16_t)f2bf(siluf(xv)); } }
        } else if (MODE == 1 || MODE == 3) {
            float* ssq = c.sumsq + (size_t)(2 + layer) * MALLOC;
#pragma unroll
            for (int j = 0; j < 4; ++j) { const int r = row0 + 4 * g + j; float* hp = hrow(c, r); float q = 0.f;
#pragma unroll
                for (int n = 0; n < 4; ++n) { const int cn = col0 + 16 * n + fr; const float hn = hp[cn] + acc[n][j]; hp[cn] = hn; c.HB[(size_t)r * DM + cn] = (bf16_t)f2bf(hn); q += hn * hn; }
                if (MODE == 1) { q += __shfl_xor(q, 1); q += __shfl_xor(q, 2); q += __shfl_xor(q, 4); q += __shfl_xor(q, 8); if (fr == 0) atomicAdd(ssq + r, q); } }
        } else {
            const float* ssq = c.sumsq + (size_t)(2 + layer) * MALLOC;
#pragma unroll
            for (int j = 0; j < 4; ++j) { const int r = row0 + 4 * g + j; const float rstd = 1.f / sqrtf(ssq[r] * (1.f / DM) + EPS);
#pragma unroll
                for (int n = 0; n < 4; ++n) { const int cn = col0 + 16 * n + fr; const float gv = acc[n][j] * rstd, uv = acc2[n][j] * rstd; c.ACT[(size_t)r * DFF + cn] = (bf16_t)f2bf(siluf(gv) * uv); } }
        }
    }
}

template <int MODE>
__device__ __forceinline__ void gemm_fast(const Ctx& c, LAS unsigned char* lds, int layer) {
    const bf16_t* A = MODE == 0 ? c.HB : MODE == 1 ? c.MIX : MODE == 2 ? c.HB : c.ACT;
    const bf16_t* Bt = wptr(c, layer, MODE == 0 ? W_IN : MODE == 1 ? W_OUT : MODE == 2 ? W_GU : W_DN);
    constexpr int K = MODE == 3 ? DFF : DM;
    constexpr int N = MODE == 0 ? NIN : MODE == 2 ? 2 * DFF : DM;
    pg8::Gemm g{A, Bt, MROWS, N, K}; pg8::StaticOrder S; S.init(MROWS, N, (int)gridDim.x, (int)blockIdx.x);
    if constexpr (MODE == 0) {
        pg8::EpiInProj E{c.sumsq + (size_t)layer * MALLOC, layer ? c.lbv : nullptr, c.QB, c.KB, c.VB, c.HXQ, c.HV, c.HG, c.LOGF};
        pg8::gemm_phase<pg8::EpiInProj, pg8::StaticOrder, true, true>(lds, g, S, E);
    } else if constexpr (MODE == 2) {
        pg8::EpiSwiGLU E{c.sumsq + (size_t)(2 + layer) * MALLOC, c.ACT};
        pg8::gemm_phase<pg8::EpiSwiGLU, pg8::StaticOrder, true, true>(lds, g, S, E);
    } else {
        pg8::EpiResid E{c.out, c.hs, c.HB, MODE == 1 ? c.sumsq + (size_t)(2 + layer) * MALLOC : nullptr};
        pg8::gemm_phase<pg8::EpiResid, pg8::StaticOrder, true, true>(lds, g, S, E);
    }
}

#include <hip/hip_bf16.h>
#include <cmath>
namespace attn_body {
using bf16=__hip_bfloat16;
using bf16x8=__attribute__((ext_vector_type(8)))short;
using s16x4=__attribute__((ext_vector_type(4)))short;
using f32x16=__attribute__((ext_vector_type(16)))float;
using u32x4=__attribute__((ext_vector_type(4)))unsigned;
constexpr int BATCH=4,NHEAD=8,SEQ=4160,D=64,DM=NHEAD*D,OP=1024;
constexpr int NW=8,QBLK=32,QB=QBLK*NW,KVBLK=64,NQB=17;
constexpr int ATTN_PITCH=DM, ATTN_UNIT_ROWS=QB;
__device__ __forceinline__ int crow(int r,int hi){return (r&3)+8*(r>>2)+4*hi;}
#define SBAR() __builtin_amdgcn_sched_barrier(0)
__device__ __forceinline__ void cmask(f32x16&p0,f32x16&p1,int jb,int qrel,int hi){
  const float NEG=-INFINITY; int kb=64*jb+4*hi;
  #pragma unroll
  for(int r=0;r<16;++r){int kv=kb+(r&3)+8*(r>>2); if(kv>qrel)p0[r]=NEG; if(kv+32>qrel)p1[r]=NEG;}
}

constexpr int NSLOT=3, SLOTB=8192;
constexpr int LDS_K=0, LDS_V=NSLOT*SLOTB, LDS_WS=2*NSLOT*SLOTB, LDS_OST=LDS_WS+NW*64*4, LDS_KB=LDS_OST+NW*4096, LDS_BYTES=LDS_KB+4352*4+256;
constexpr float C2=0.125f*1.4426950408889634f;
__device__ __forceinline__ void glds16(const void*gsrc,unsigned lds_dst){unsigned keep;
  asm volatile("s_mov_b32 %0, m0\n\ts_mov_b32 m0, %2\n\ts_nop 0\n\tglobal_load_lds_dwordx4 %1, off\n\ts_mov_b32 m0, %0":"=&s"(keep):"v"(gsrc),"s"(lds_dst):"memory");}
__device__ __forceinline__ float max3f(float a,float b,float c){float r;asm("v_max3_f32 %0, %1, %2, %3":"=v"(r):"v"(a),"v"(b),"v"(c));return r;}
__device__ __forceinline__ float max2f(float a,float b){float r;asm("v_max_f32_e32 %0, %1, %2":"=v"(r):"v"(a),"v"(b));return r;}
__device__ __forceinline__ float fadd_s(float a,float b){float r;asm("v_add_f32_e32 %0, %1, %2":"=v"(r):"v"(a),"v"(b));return r;}
__device__ __forceinline__ float fsub_s(float a,float b){float r;asm("v_sub_f32_e32 %0, %1, %2":"=v"(r):"v"(a),"v"(b));return r;}
typedef float f32x2_t __attribute__((ext_vector_type(2))); typedef __bf16 bf16x2_t __attribute__((ext_vector_type(2)));
__device__ __forceinline__ unsigned cvtpk_s(float lo,float hi){f32x2_t v={lo,hi};bf16x2_t b=__builtin_convertvector(v,bf16x2_t);return __builtin_bit_cast(unsigned,b);}
#define WAIT_BAR(N) asm volatile("s_waitcnt vmcnt(" #N ") lgkmcnt(0)\n\ts_barrier":::"memory")

__device__ __forceinline__ void qkt(f32x16&p0,f32x16&p1,const char*Kslot,const bf16x8*qr,int r32,int hi){
  const char*kb=Kslot+hi*1024+r32*16;
  #pragma unroll
  for(int d0=0;d0<4;++d0){
    const bf16x8 b0=*reinterpret_cast<const bf16x8*>(kb+d0*2048);
    const bf16x8 b1=*reinterpret_cast<const bf16x8*>(kb+d0*2048+512);
    p0=__builtin_amdgcn_mfma_f32_32x32x16_bf16(b0,qr[d0],p0,0,0,0);p1=__builtin_amdgcn_mfma_f32_32x32x16_bf16(b1,qr[d0],p1,0,0,0);}
}
typedef __attribute__((address_space(3))) const char* lds_cptr;
typedef short v4i16_t __attribute__((ext_vector_type(4)));
__device__ __forceinline__ void kload8(bf16x8*kf,lds_cptr kp){
  kf[0]=*(const __attribute__((address_space(3))) bf16x8*)(kp);      kf[1]=*(const __attribute__((address_space(3))) bf16x8*)(kp+512);
  kf[2]=*(const __attribute__((address_space(3))) bf16x8*)(kp+2048); kf[3]=*(const __attribute__((address_space(3))) bf16x8*)(kp+2560);
  kf[4]=*(const __attribute__((address_space(3))) bf16x8*)(kp+4096); kf[5]=*(const __attribute__((address_space(3))) bf16x8*)(kp+4608);
  kf[6]=*(const __attribute__((address_space(3))) bf16x8*)(kp+6144); kf[7]=*(const __attribute__((address_space(3))) bf16x8*)(kp+6656);
}
__device__ __forceinline__ void kload2(bf16x8*kf,lds_cptr kp,int j){ kf[2*j]=*(const __attribute__((address_space(3))) bf16x8*)(kp+j*2048); kf[2*j+1]=*(const __attribute__((address_space(3))) bf16x8*)(kp+j*2048+512); }
__device__ __forceinline__ s16x4 vtr(lds_cptr p){ return __builtin_bit_cast(s16x4,__builtin_amdgcn_ds_read_tr16_b64_v4i16((__attribute__((address_space(3))) v4i16_t*)p)); }
__device__ __forceinline__ float rowmax(const f32x16&p0,const f32x16&p1){
  float a=max3f(p0[0],p0[1],p1[0]),b=max3f(p0[2],p0[3],p1[1]);a=max3f(a,p1[2],p1[3]);
  #pragma unroll
  for(int r=4;r<16;r+=4){a=max3f(a,p0[r],p0[r+1]);b=max3f(b,p0[r+2],p0[r+3]);a=max3f(a,p1[r],p1[r+1]);b=max3f(b,p1[r+2],p1[r+3]);}
  const float m=max2f(a,b);
  auto rr=__builtin_amdgcn_permlane32_swap(__float_as_uint(m),__float_as_uint(m),false,false);
  return max2f(__uint_as_float(rr[0]),__uint_as_float(rr[1]));
}
__device__ __forceinline__ void pv(f32x16*o,int vb,bf16x8 pa0,bf16x8 pa1,bf16x8 pa2,bf16x8 pa3){
  #pragma unroll
  for(int d0=0;d0<2;++d0){s16x4 lo[4],hi[4];
    #pragma unroll
    for(int ks=0;ks<4;++ks){
      asm volatile("ds_read_b64_tr_b16 %0,%1 offset:%c2":"=&v"(lo[ks]):"v"(vb),"i"(d0*4096+ks*1024):"memory");
      asm volatile("ds_read_b64_tr_b16 %0,%1 offset:%c2":"=&v"(hi[ks]):"v"(vb),"i"(d0*4096+ks*1024+512):"memory");}
    asm volatile("s_waitcnt lgkmcnt(0)":::"memory");SBAR();
    #define PK(k) (bf16x8){lo[k][0],lo[k][1],lo[k][2],lo[k][3],hi[k][0],hi[k][1],hi[k][2],hi[k][3]}
    o[d0]=__builtin_amdgcn_mfma_f32_32x32x16_bf16(pa0,PK(0),o[d0],0,0,0);
    o[d0]=__builtin_amdgcn_mfma_f32_32x32x16_bf16(pa1,PK(1),o[d0],0,0,0);
    o[d0]=__builtin_amdgcn_mfma_f32_32x32x16_bf16(pa2,PK(2),o[d0],0,0,0);
    o[d0]=__builtin_amdgcn_mfma_f32_32x32x16_bf16(pa3,PK(3),o[d0],0,0,0);
    #undef PK
  }
}

#ifndef ATTN_STORE16
#define ATTN_STORE16(p,v) (*(u32x4*)(p)=(v))
#endif
template<int THRL> __device__ __forceinline__ void attn_unit(int b,int h,int qb,const bf16*Q,const bf16*__restrict__ K,const bf16*__restrict__ V,bf16*O,const float*__restrict__ kbg,char*shm){
  int tid_=threadIdx.x; asm volatile("":"+v"(tid_)); const int tid=tid_,lane=tid&63,r32=lane&31,hi=lane>>5; const int wid=__builtin_amdgcn_readfirstlane(tid>>6);
  const long rowbase=(long)b*SEQ; const int q0=qb*QB;
  const bf16*Qw=Q+(rowbase+q0+wid*QBLK)*DM+h*D;
  const bf16*Kh=K+rowbase*DM+h*D,*Vh=V+rowbase*DM+h*D;
  const unsigned lds0=(unsigned)(uintptr_t)shm;
  float*wsf=(float*)(shm+LDS_WS)+wid*64;
  const bf16*ksrc=Kh+(long)lane*DM+wid*8;
  const bf16*vsrc=Vh+(long)(16*(wid&3)+(lane>>2))*DM+(wid>>2)*32+(lane&3)*8;
  const unsigned kdst=lds0+LDS_K+wid*1024, vdst=lds0+LDS_V+wid*1024;
  #define DMA_K(t,slot) glds16(ksrc+(long)(t)*KVBLK*DM,(unsigned)__builtin_amdgcn_readfirstlane(kdst+(slot)))
  #define DMA_V(t,slot) glds16(vsrc+(long)(t)*KVBLK*DM,(unsigned)__builtin_amdgcn_readfirstlane(vdst+(slot)))
  const int vb0=(int)(lds0+LDS_V)+((lane>>4)&1)*32+(lane&3)*8+(4*hi+((lane&15)>>2))*64;
  const char*Kbase=shm+LDS_K; bf16x8 kf[8];
  const lds_cptr shm3=(lds_cptr)shm; const lds_cptr kp0=shm3+LDS_K+hi*1024+r32*16; const lds_cptr vp0=shm3+LDS_V+((lane>>4)&1)*32+(lane&3)*8+(4*hi+((lane&15)>>2))*64;
  const int NT=(q0+QB)/KVBLK;
  typedef __attribute__((address_space(3))) float lds_f32; typedef float kb4_t __attribute__((ext_vector_type(4)));
  { lds_f32*kw=(lds_f32*)(shm3+LDS_KB); for(int i=tid;i<NT*KVBLK;i+=NW*64)kw[i]=kbg[i]; }
  const __attribute__((address_space(3))) kb4_t*kbl=(const __attribute__((address_space(3))) kb4_t*)(shm3+LDS_KB)+hi;
  #define KBLOAD(P0,P1,t) do{ const __attribute__((address_space(3))) kb4_t*kb_=kbl+16*(t); \
    _Pragma("unroll") for(int g_=0;g_<4;++g_){ const kb4_t a_=kb_[2*g_], b_=kb_[2*g_+8]; \
      P0[4*g_]=a_[0];P0[4*g_+1]=a_[1];P0[4*g_+2]=a_[2];P0[4*g_+3]=a_[3]; P1[4*g_]=b_[0];P1[4*g_+1]=b_[1];P1[4*g_+2]=b_[2];P1[4*g_+3]=b_[3]; } }while(0)
  DMA_K(0,0);DMA_V(0,0);DMA_K(1,SLOTB);
  bf16x8 qr[4];
  #pragma unroll
  for(int d0=0;d0<4;++d0)qr[d0]=*reinterpret_cast<const bf16x8*>(&Qw[(long)r32*DM+d0*16+hi*8]);
  float mhat=0.f,l_reg=0.f;f32x16 o[2];o[0]=f32x16{};o[1]=f32x16{};
  const int qrel=wid*QBLK+r32;
  #define CMASK(P0,P1,t) do{int jb_=(t)-(NT-4); if(jb_>=0)cmask(P0,P1,jb_,qrel,hi);}while(0)
  bool resc=false;
  #define START(P0,P1) do{ const float rm=rowmax(P0,P1); resc=false; \
    { const float dl=rm; mhat=fadd_s(mhat,dl); \
      _Pragma("unroll") for(int r=0;r<16;++r){P0[r]=fsub_s(P0[r],dl);P1[r]=fsub_s(P1[r],dl);} } \
    _Pragma("unroll") for(int r=0;r<16;++r)P0[r]=__builtin_amdgcn_exp2f(P0[r]); }while(0)
  #define RESC() do{ if(resc){ asm volatile("s_waitcnt lgkmcnt(0)":::"memory"); \
      _Pragma("unroll") for(int d_=0;d_<2;++d_) _Pragma("unroll") for(int r=0;r<16;++r)o[d_][r]*=wsf[crow(r,hi)]; } }while(0)
  f32x16 pA0,pA1,pB0,pB1;
  int sl_prev=0,sl_cur=0,sl_next=SLOTB;
  #define ROT() do{sl_prev=sl_cur;sl_cur=sl_next;sl_next=(sl_next==(NSLOT-1)*SLOTB)?0:sl_next+SLOTB;}while(0)
  DMA_K(2,2*SLOTB);
  WAIT_BAR(3);
  KBLOAD(pA0,pA1,0);
  qkt(pA0,pA1,Kbase,qr,r32,hi);asm volatile("s_nop 15\n\ts_nop 7":"+v"(pA0),"+v"(pA1));CMASK(pA0,pA1,0);
  START(pA0,pA1);
  _Pragma("unroll") for(int r=0;r<16;++r)pA1[r]=__builtin_amdgcn_exp2f(pA1[r]);
  KBLOAD(pB0,pB1,1);
  WAIT_BAR(0);
  DMA_K(3,0);DMA_V(1,SLOTB);
  ROT();
  kload8(kf,kp0+sl_cur);
  WAIT_BAR(2);
  s16x4 vlo[8],vhi[8]; u32x4 pw0,pw1,pw2,pw3;
  #define PKW(P,B) cvtpk_s(P[B],P[B+1])
  #define PAF(k) __builtin_bit_cast(bf16x8,pw##k)
  #define VFR(i) (bf16x8){vlo[i][0],vlo[i][1],vlo[i][2],vlo[i][3],vhi[i][0],vhi[i][1],vhi[i][2],vhi[i][3]}
  #define PIN(x) asm volatile("":"+v"(x))
  #define MX3(a,b,c) __builtin_fmaxf(__builtin_fmaxf((a),(b)),(c))
  #define GAPA(MF,A0,A1,A2,A3,W0,W1,PW) do{ MF; sacc+=A0; sacc+=A1; sacc+=A2; sacc+=A3; PIN(sacc); W0; W1; PIN(PW); SBAR(); }while(0)
  #define EX(v) __builtin_amdgcn_exp2f(v)
  #define GAPB(MF,X,B) do{ MF; X[B]=EX(X[B]); X[B+1]=EX(X[B+1]); X[B+2]=EX(X[B+2]); X[B+3]=EX(X[B+3]); PIN(X); SBAR(); }while(0)
  #define VRD(i) do{ vlo[i]=vtr(vp_+(((i)>>2)*4096+((i)&3)*1024)); vhi[i]=vtr(vp_+(((i)>>2)*4096+((i)&3)*1024+512)); }while(0)
  #define KRD(G,j) do{ if(G){ kload2(kf,kp0+sl_next,j); SBAR(); } }while(0)
  #define STEP(C0,C1,P0,P1,t,GK,GV,GL) do{ SBAR(); \
    const lds_cptr vp_=vp0+sl_prev; \
    VRD(0); SBAR(); float sacc=(P0[0]+P0[1]); \
    GAPA(C0=__builtin_amdgcn_mfma_f32_32x32x16_bf16(kf[0],qr[0],C0,0,0,0), P0[2],P0[3],P0[4],P0[5],     pw0[0]=PKW(P0,0), pw0[1]=PKW(P0,2), pw0); \
    VRD(4); SBAR(); GAPA(C1=__builtin_amdgcn_mfma_f32_32x32x16_bf16(kf[1],qr[0],C1,0,0,0), P0[6],P0[7],P0[8],P0[9],     pw0[2]=PKW(P0,4), pw0[3]=PKW(P0,6), pw0); \
    VRD(1); SBAR(); GAPA(C0=__builtin_amdgcn_mfma_f32_32x32x16_bf16(kf[2],qr[1],C0,0,0,0),   P0[10],P0[11],P0[12],P0[13], pw1[0]=PKW(P0,8), pw1[1]=PKW(P0,10), pw1); \
    VRD(5); SBAR(); GAPA(C1=__builtin_amdgcn_mfma_f32_32x32x16_bf16(kf[3],qr[1],C1,0,0,0),   P0[14],P0[15],P1[0],P1[1],   pw1[2]=PKW(P0,12),pw1[3]=PKW(P0,14), pw1); \
    VRD(2); SBAR(); GAPA(C0=__builtin_amdgcn_mfma_f32_32x32x16_bf16(kf[4],qr[2],C0,0,0,0),   P1[2],P1[3],P1[4],P1[5],     pw2[0]=PKW(P1,0), pw2[1]=PKW(P1,2), pw2); \
    VRD(6); SBAR(); GAPA(C1=__builtin_amdgcn_mfma_f32_32x32x16_bf16(kf[5],qr[2],C1,0,0,0),   P1[6],P1[7],P1[8],P1[9],     pw2[2]=PKW(P1,4), pw2[3]=PKW(P1,6), pw2); \
    VRD(3); SBAR(); GAPA(C0=__builtin_amdgcn_mfma_f32_32x32x16_bf16(kf[6],qr[3],C0,0,0,0),   P1[10],P1[11],P1[12],P1[13], pw3[0]=PKW(P1,8), pw3[1]=PKW(P1,10), pw3); \
    VRD(7); SBAR(); GAPA(C1=__builtin_amdgcn_mfma_f32_32x32x16_bf16(kf[7],qr[3],C1,0,0,0),   P1[14],P1[15],0.f,0.f,       pw3[2]=PKW(P1,12),pw3[3]=PKW(P1,14), pw3); \
    l_reg+=sacc; \
    if(GK){DMA_K((t)+3,sl_cur);} if(GV){DMA_V((t)+1,sl_next);} \
    _Pragma("unroll") for(int r=0;r<16;++r){C0[r]-=mhat;C1[r]-=mhat;} \
    CMASK(C0,C1,t); \
    { float a=MX3(C0[0],C0[1],C1[0]),b=MX3(C0[2],C0[3],C1[1]); a=MX3(a,C1[2],C1[3]); \
      _Pragma("unroll") for(int r=4;r<16;r+=4){a=MX3(a,C0[r],C0[r+1]);b=MX3(b,C0[r+2],C0[r+3]);a=MX3(a,C1[r],C1[r+1]);b=MX3(b,C1[r+2],C1[r+3]);} \
      float rm=__builtin_fmaxf(a,b); { auto rr=__builtin_amdgcn_permlane32_swap(__float_as_uint(rm),__float_as_uint(rm),false,false); rm=__builtin_fmaxf(__uint_as_float(rr[0]),__uint_as_float(rr[1])); } \
      resc=false; \
      if(__builtin_expect(__any(rm>(float)THRL),0)){ const float dl=__builtin_fmaxf(rm,0.f); mhat+=dl; \
        _Pragma("unroll") for(int r=0;r<16;++r){C0[r]-=dl;C1[r]-=dl;} \
        const float f=__builtin_amdgcn_exp2f(-dl); l_reg*=f; if(hi==0)wsf[r32]=f; resc=true; } } \
    SBAR(); \
    KBLOAD(P0,P1,(t)+1); SBAR(); \
    GAPB(o[0]=__builtin_amdgcn_mfma_f32_32x32x16_bf16(PAF(0),VFR(0),o[0],0,0,0), C0,0); \
    GAPB(o[1]=__builtin_amdgcn_mfma_f32_32x32x16_bf16(PAF(0),VFR(4),o[1],0,0,0), C0,4); \
    KRD(GL,0); GAPB(o[0]=__builtin_amdgcn_mfma_f32_32x32x16_bf16(PAF(1),VFR(1),o[0],0,0,0), C0,8); \
    KRD(GL,1); GAPB(o[1]=__builtin_amdgcn_mfma_f32_32x32x16_bf16(PAF(1),VFR(5),o[1],0,0,0), C0,12); \
    KRD(GL,2); GAPB(o[0]=__builtin_amdgcn_mfma_f32_32x32x16_bf16(PAF(2),VFR(2),o[0],0,0,0), C1,0); \
    KRD(GL,3); GAPB(o[1]=__builtin_amdgcn_mfma_f32_32x32x16_bf16(PAF(2),VFR(6),o[1],0,0,0), C1,4); \
    GAPB(o[0]=__builtin_amdgcn_mfma_f32_32x32x16_bf16(PAF(3),VFR(3),o[0],0,0,0), C1,8); \
    GAPB(o[1]=__builtin_amdgcn_mfma_f32_32x32x16_bf16(PAF(3),VFR(7),o[1],0,0,0), C1,12); \
    }while(0)
  int t=1;
  #undef CMASK
  #define CMASK(P0,P1,t) do{}while(0)
  for(;t+5<NT;t+=2){
    STEP(pB0,pB1,pA0,pA1,t,true,true,true);     WAIT_BAR(2); RESC(); ROT();
    STEP(pA0,pA1,pB0,pB1,t+1,true,true,true);   WAIT_BAR(2); RESC(); ROT();
  }
  #undef CMASK
  #define CMASK(P0,P1,t) do{int jb_=(t)-(NT-4); if(jb_>=0)cmask(P0,P1,jb_,qrel,hi);}while(0)
  #define ENDW(tt) do{ if((tt)+3<NT){WAIT_BAR(2);} else if((tt)+2<NT){WAIT_BAR(1);} else {WAIT_BAR(0);} }while(0)
  for(;t+1<NT;t+=2){
    STEP(pB0,pB1,pA0,pA1,t,(t+3<NT),(t+1<NT),(t+1<NT));       ENDW(t);   RESC(); ROT();
    STEP(pA0,pA1,pB0,pB1,t+1,(t+4<NT),(t+2<NT),(t+2<NT));     ENDW(t+1); RESC(); ROT();
  }
  STEP(pB0,pB1,pA0,pA1,NT-1,false,false,false); RESC();
  { float sacc=pB0[0]+pB0[1]; _Pragma("unroll") for(int r=2;r<16;++r)sacc+=pB0[r]; _Pragma("unroll") for(int r=0;r<16;++r)sacc+=pB1[r]; l_reg+=sacc;
    pw0=(u32x4){PKW(pB0,0),PKW(pB0,2),PKW(pB0,4),PKW(pB0,6)};pw1=(u32x4){PKW(pB0,8),PKW(pB0,10),PKW(pB0,12),PKW(pB0,14)};pw2=(u32x4){PKW(pB1,0),PKW(pB1,2),PKW(pB1,4),PKW(pB1,6)};pw3=(u32x4){PKW(pB1,8),PKW(pB1,10),PKW(pB1,12),PKW(pB1,14)};
    SBAR(); pv(o,vb0+sl_cur,PAF(0),PAF(1),PAF(2),PAF(3)); }
  #undef PKW
  #undef PAF
  #undef VFR
  #undef PIN
  #undef MX3
  #undef GAPA
  #undef GAPB
  #undef EX
  #undef VRD
  #undef KRD
  #undef STEP
  #undef ENDW
  {auto rr=__builtin_amdgcn_permlane32_swap(__float_as_uint(l_reg),__float_as_uint(l_reg),false,false);l_reg=__uint_as_float(rr[0])+__uint_as_float(rr[1]);}
  if(hi==0)wsf[32+r32]=l_reg;asm volatile("s_waitcnt lgkmcnt(0)":::"memory");
  float rli[16];
  #pragma unroll
  for(int r=0;r<16;++r)rli[r]=__builtin_amdgcn_rcpf(wsf[32+crow(r,hi)]);
  bf16*Ow=O+(rowbase+q0+wid*QBLK)*OP+h*D;
  { bf16*stg=(bf16*)(shm+LDS_OST)+wid*2048;
    #pragma unroll
    for(int r=0;r<16;++r){const int orow=crow(r,hi);
      #pragma unroll
      for(int d0=0;d0<2;++d0)stg[orow*64+d0*32+r32]=__float2bfloat16(o[d0][r]*rli[r]);}
    asm volatile("s_waitcnt lgkmcnt(0)":::"memory");
    #pragma unroll
    for(int i=0;i<4;++i){const int row=i*8+(lane>>3),ch=lane&7; const u32x4 v=*(const u32x4*)(stg+row*64+ch*8); if(q0+wid*QBLK+row<SEQ)ATTN_STORE16(Ow+(long)row*OP+ch*8,v);} }
  asm volatile("s_waitcnt lgkmcnt(0)\n\ts_barrier":::"memory");
  #undef KBLOAD
  #undef DMA_K
  #undef DMA_V
  #undef CMASK
  #undef START
  #undef RESC
  #undef ROT
}
constexpr int ATTN_LDS_BYTES=LDS_BYTES;
#undef SBAR
#undef WAIT_BAR
}

__device__ __forceinline__ void mix_queue(const Ctx& c, unsigned char* lds_generic, int layer, const bf16_t* SD);

namespace hg {
constexpr int P = 272, PA = 144;
constexpr int O_QE = 0, O_QS = 17408, O_KS = 34816, O_VT = 52224, O_ST = 69632, O_AM = 104448, O_QT = 113664, O_RS = 115712, O_END = 117760;
typedef short v4i16_t __attribute__((ext_vector_type(4)));
__device__ __forceinline__ f32x4 mfma16(bf16x8 a, bf16x8 b, f32x4 c) { return __builtin_amdgcn_mfma_f32_16x16x32_bf16(a, b, c, 0, 0, 0); }
__device__ __forceinline__ bf16x8 tr_frag(const LAS unsigned char* p, int pitch) {
    const v4i16_t lo = __builtin_amdgcn_ds_read_tr16_b64_v4i16((LAS v4i16_t*)p);
    const v4i16_t hi = __builtin_amdgcn_ds_read_tr16_b64_v4i16((LAS v4i16_t*)(p + 4 * pitch));
    return (bf16x8){lo[0], lo[1], lo[2], lo[3], hi[0], hi[1], hi[2], hi[3]};
}
}

__device__ __forceinline__ void hgrn_A_unit(const Ctx& c, LAS unsigned char* lds, int bh, int ch, bf16_t* SD, float* DV) {
    using namespace hg;
    int tid_ = threadIdx.x; asm volatile("" : "+v"(tid_)); const int tid = tid_, lane = tid & 63, w = __builtin_amdgcn_readfirstlane(tid >> 6);
    const int b = bh >> 2, hh = bh & 3; const size_t r0 = (size_t)b * LV + 64 * ch;
    const int k = tid & 127, sq = tid >> 7;
    float g[16], bl[16];
    { const float* gp = c.LOGF + (r0 + 16 * sq) * 512 + hh * 128 + k; float s = 0.f;
#pragma unroll
      for (int i = 0; i < 16; ++i) { g[i] = gp[(size_t)i * 512]; s += g[i]; bl[i] = s; }
      ((LAS float*)(lds + O_QT))[sq * 128 + k] = s; }
#pragma unroll
    for (int i = 0; i < 2; ++i) { const int id = tid + 512 * i, row = id >> 4, cc = id & 15;
        const u32x4 v = *(const u32x4*)(c.HV + (r0 + row) * 512 + hh * 128 + cc * 8); *(LAS u32x4*)(lds + O_VT + row * P + cc * 16) = v; }
    __syncthreads();
    { const LAS float* qt = (const LAS float*)(lds + O_QT); float pre = 0.f, tot = 0.f;
#pragma unroll
      for (int q = 0; q < 4; ++q) { const float t = qt[q * 128 + k]; tot += t; if (q < sq) pre += t; }
#pragma unroll
      for (int i = 0; i < 16; ++i) { const float kd = (1.f - __expf(g[i])) * __expf(tot - (pre + bl[i])); *(LAS bf16_t*)(lds + O_KS + (16 * sq + i) * P + 2 * k) = (bf16_t)f2bf(kd); }
      if (sq == 0) DV[((size_t)bh * 64 + ch) * 128 + k] = __expf(tot); }
    __syncthreads();
    const int fr = lane & 15, g4 = lane >> 4, q = fr >> 2, p = lane & 3;
    const LAS unsigned char* abase = lds + O_VT + (8 * g4 + q) * P + w * 32 + p * 8;
    const LAS unsigned char* bbase = lds + O_KS + (8 * g4 + q) * P + p * 8;
    bf16x8 a[2]; a[0] = tr_frag(abase, P); a[1] = tr_frag(abase + 32 * P, P);
    bf16_t* od = SD + ((size_t)bh * 64 + ch) * 16384 + (size_t)(16 * w + 4 * g4) * 128 + fr;
#pragma unroll
    for (int ct = 0; ct < 8; ++ct) { f32x4 acc = (f32x4){0.f, 0.f, 0.f, 0.f};
        acc = mfma16(a[0], tr_frag(bbase + ct * 32, P), acc); acc = mfma16(a[1], tr_frag(bbase + 32 * P + ct * 32, P), acc);
#pragma unroll
        for (int j = 0; j < 4; ++j) od[j * 128 + 16 * ct] = (bf16_t)f2bf(acc[j]); }
    __syncthreads();
}

__device__ __forceinline__ void hgrn_B_scan(const Ctx& c, bf16_t* SD, const float* DV) {
    const int gt = blockIdx.x * NTHREADS + c.tid, NGT = gridDim.x * NTHREADS;
    for (int pidx = gt; pidx < 16 * 8192; pidx += NGT) {
        const int bh = pidx >> 13, e2 = pidx & 8191, k = (e2 & 63) * 2;
        unsigned* sp = (unsigned*)(SD + (size_t)bh * 64 * 16384 + 2 * e2);
        const float* dp = DV + (size_t)bh * 64 * 128 + k;
        float s0 = 0.f, s1 = 0.f;
#pragma unroll 8
        for (int ch = 0; ch < 64; ++ch) { const unsigned d = sp[(size_t)ch * 8192]; const float d0 = dp[ch * 128], d1 = dp[ch * 128 + 1];
            s0 = d0 * s0 + __builtin_bit_cast(float, d << 16); s1 = d1 * s1 + __builtin_bit_cast(float, d & 0xffff0000u);
            sp[(size_t)ch * 8192] = pk2(s0, s1); }
    }
}

__device__ __forceinline__ void hgrn_C_unit(const Ctx& c, LAS unsigned char* lds, int layer, int bh, int ch, const bf16_t* SD) {
    using namespace hg;
    int tid_ = threadIdx.x; asm volatile("" : "+v"(tid_)); const int tid = tid_, lane = tid & 63, w = __builtin_amdgcn_readfirstlane(tid >> 6);
    const int b = bh >> 2, hh = bh & 3; const size_t r0 = (size_t)b * LV + 64 * ch;
    const int k = tid & 127, sq = tid >> 7;
    float g[16], bl[16], qv[16];
    { const float* gp = c.LOGF + (r0 + 16 * sq) * 512 + hh * 128 + k; const bf16_t* qp = c.HXQ + (r0 + 16 * sq) * 512 + hh * 128 + k; float s = 0.f;
#pragma unroll
      for (int i = 0; i < 16; ++i) { g[i] = gp[(size_t)i * 512]; qv[i] = bf2f(qp[(size_t)i * 512]); s += g[i]; bl[i] = s; }
      ((LAS float*)(lds + O_QT))[sq * 128 + k] = s; }
#pragma unroll
    for (int i = 0; i < 2; ++i) { const int id = tid + 512 * i, row = id >> 4, cc = id & 15;
        const u32x4 v = *(const u32x4*)(c.HV + (r0 + row) * 512 + hh * 128 + cc * 8); *(LAS u32x4*)(lds + O_VT + row * P + cc * 16) = v; }
    if (ch > 0) {
        const bf16_t* sp = SD + ((size_t)bh * 64 + ch - 1) * 16384;
#pragma unroll
        for (int i = 0; i < 4; ++i) { const int id = tid + 512 * i, row = id >> 4, cc = id & 15; const u32x4 v = *(const u32x4*)(sp + row * 128 + cc * 8); *(LAS u32x4*)(lds + O_ST + row * P + cc * 16) = v; }
    }
    __syncthreads();
    { const LAS float* qt = (const LAS float*)(lds + O_QT); float pre = 0.f;
#pragma unroll
      for (int q = 0; q < 4; ++q) { const float t = qt[q * 128 + k]; if (q < sq) pre += t; }
      const float rr = qt[k] + qt[128 + k];
#pragma unroll
      for (int i = 0; i < 16; ++i) { const float bb = pre + bl[i]; const int off = (16 * sq + i) * P + 2 * k;
          *(LAS bf16_t*)(lds + O_QE + off) = (bf16_t)f2bf(qv[i] * __expf(bb));
          *(LAS bf16_t*)(lds + O_QS + off) = (bf16_t)f2bf(qv[i] * __expf(fminf(bb - rr, 80.f)));
          *(LAS bf16_t*)(lds + O_KS + off) = (bf16_t)f2bf((1.f - __expf(g[i])) * __expf(fminf(rr - bb, 80.f))); } }
    __syncthreads();
    const int fr = lane & 15, g4 = lane >> 4, q = fr >> 2, p = lane & 3;
#pragma unroll
    for (int tl = 0; tl < 2; ++tl) { const int tile = 2 * w + tl, ti = tile >> 2, sj = tile & 3;
        f32x4 acc = (f32x4){0.f, 0.f, 0.f, 0.f};
        if (sj <= ti) {
#pragma unroll
            for (int ks = 0; ks < 4; ++ks) { const bf16x8 a = *(const LAS bf16x8*)(lds + O_QS + (16 * ti + fr) * P + (32 * ks + 8 * g4) * 2);
                const bf16x8 bb = *(const LAS bf16x8*)(lds + O_KS + (16 * sj + fr) * P + (32 * ks + 8 * g4) * 2); acc = mfma16(a, bb, acc); } }
#pragma unroll
        for (int j = 0; j < 4; ++j) { const int t = 16 * ti + 4 * g4 + j, s = 16 * sj + fr; const float v = (s <= t) ? acc[j] : 0.f; *(LAS bf16_t*)(lds + O_AM + t * PA + 2 * s) = (bf16_t)f2bf(v); } }
    __syncthreads();
    f32x4 acc[4];
#pragma unroll
    for (int tt = 0; tt < 4; ++tt) acc[tt] = (f32x4){0.f, 0.f, 0.f, 0.f};
    if (ch > 0) {
#pragma unroll
        for (int ks = 0; ks < 4; ++ks) { const bf16x8 bfr = *(const LAS bf16x8*)(lds + O_ST + (16 * w + fr) * P + (32 * ks + 8 * g4) * 2);
#pragma unroll
            for (int tt = 0; tt < 4; ++tt) { const bf16x8 a = *(const LAS bf16x8*)(lds + O_QE + (16 * tt + fr) * P + (32 * ks + 8 * g4) * 2); acc[tt] = mfma16(a, bfr, acc[tt]); } }
    }
#pragma unroll
    for (int ks = 0; ks < 2; ++ks) { const bf16x8 bfr = tr_frag(lds + O_VT + (32 * ks + 8 * g4 + q) * P + w * 32 + p * 8, P);
#pragma unroll
        for (int tt = 0; tt < 4; ++tt) { const bf16x8 a = *(const LAS bf16x8*)(lds + O_AM + (16 * tt + fr) * PA + (32 * ks + 8 * g4) * 2); acc[tt] = mfma16(a, bfr, acc[tt]); } }
    LAS float* rs = (LAS float*)(lds + O_RS);
#pragma unroll
    for (int tt = 0; tt < 4; ++tt)
#pragma unroll
        for (int j = 0; j < 4; ++j) { float s2 = acc[tt][j] * acc[tt][j]; s2 += __shfl_xor(s2, 1); s2 += __shfl_xor(s2, 2); s2 += __shfl_xor(s2, 4); s2 += __shfl_xor(s2, 8);
            if (fr == 0) rs[(16 * tt + 4 * g4 + j) * 8 + w] = s2; }
    __syncthreads();
    { const int v = 16 * w + fr; const float nw = c.hnw[layer * 128 + v];
#pragma unroll
      for (int tt = 0; tt < 4; ++tt)
#pragma unroll
        for (int j = 0; j < 4; ++j) { const int t = 16 * tt + 4 * g4 + j; const f32x4 s0 = *(const LAS f32x4*)(rs + t * 8), s1 = *(const LAS f32x4*)(rs + t * 8 + 4);
            const float ss = ((s0[0] + s0[1]) + (s0[2] + s0[3])) + ((s1[0] + s1[1]) + (s1[2] + s1[3])); const float rstd = 1.f / sqrtf(ss * (1.f / 128.f) + EPS);
            const float gate = bf2f(c.HG[(r0 + t) * 512 + hh * 128 + v]);
            c.MIX[(r0 + t) * DM + 512 + hh * 128 + v] = (bf16_t)f2bf(acc[tt][j] * rstd * nw * gate); } }
    __syncthreads();
}

__device__ __forceinline__ void mix_queue(const Ctx& c, unsigned char* lds_generic, int layer, const bf16_t* SD) {
    LAS volatile int* slot = (LAS volatile int*)((LAS unsigned char*)lds_generic + 131072);
    for (;;) {
        if (c.tid == 0) slot[0] = (int)atomicAdd(c.ctl + 64 * (1 + layer), 1u);
        __syncthreads();
        const int n = slot[0];
        if (n >= 17 * 32 + 16 * 65) break;
        if (n < 17 * 32) {
            const int qb = 16 - (n >> 5), bh = n & 31;
            attn_body::attn_unit<8>(bh >> 3, bh & 7, qb, (const attn_body::bf16*)c.QB, (const attn_body::bf16*)c.KB, (const attn_body::bf16*)c.VB, (attn_body::bf16*)c.MIX,
                                    c.kbias + (size_t)bh * KBL, (char*)lds_generic);
        } else {
            const int u = n - 17 * 32, bh = u / 65, ch = u - bh * 65;
            hgrn_C_unit(c, (LAS unsigned char*)lds_generic, layer, bh, ch, SD);
        }
    }
}

__device__ __forceinline__ void fox_simple(const Ctx& c, LAS unsigned char* lds, int first_block) {
    LAS float* sc = (LAS float*)(lds + c.wave * 16896);
    LAS float* qs = sc; LAS float* ps = sc + 64;
    const int nblk = gridDim.x - first_block; if ((int)blockIdx.x < first_block) return;
    const int gw = ((int)blockIdx.x - first_block) * NWAVES + c.wave, NGW = nblk * NWAVES;
    for (int it = gw; it < MROWS * FOXH; it += NGW) {
        const int r = it >> 3, h = it & 7, b = r / LV, vp = r - b * LV;
        bf16_t* op = c.MIX + (size_t)r * DM + h * 64;
        if (vp < PADF) { op[c.lane] = 0; continue; }
        qs[c.lane] = bf2f(c.QB[(size_t)r * 512 + h * 64 + c.lane]);
        asm volatile("s_waitcnt lgkmcnt(0)" ::: "memory");
        const float* kb = c.kbias + (size_t)(b * 8 + h) * KBL;
        float mx = -3.0e38f;
        for (int j = PADF + c.lane; j <= vp; j += 64) {
            const bf16_t* kr = c.KB + (size_t)(b * LV + j) * 512 + h * 64; float s = 0.f;
#pragma unroll
            for (int d8 = 0; d8 < 8; ++d8) { const bf16x8 kv = *(const bf16x8*)(kr + d8 * 8);
#pragma unroll
                for (int e = 0; e < 8; ++e) s += qs[d8 * 8 + e] * bf2f((unsigned short)kv[e]); }
            s += kb[j]; ps[j] = s; mx = fmaxf(mx, s);
        }
        mx = wave_max(mx);
        float l = 0.f;
        for (int j = PADF + c.lane; j <= vp; j += 64) { const float p = exp2f(ps[j] - mx); ps[j] = p; l += p; }
        l = wave_sum(l);
        asm volatile("s_waitcnt lgkmcnt(0)" ::: "memory");
        float o = 0.f;
        const bf16_t* vr = c.VB + (size_t)(b * LV) * 512 + h * 64 + c.lane;
        for (int j = PADF; j <= vp; ++j) o += ps[j] * bf2f(vr[(size_t)j * 512]);
        op[c.lane] = (bf16_t)f2bf(o / l);
        asm volatile("s_waitcnt lgkmcnt(0)" ::: "memory");
    }
}

__device__ __forceinline__ void hgrn_simple(const Ctx& c, LAS unsigned char* lds, int layer) {
    if (blockIdx.x >= NB * HGH) return;
    const int b = blockIdx.x >> 2, hh = blockIdx.x & 3;
    LAS float* fL = (LAS float*)lds;
    LAS float* kL = fL + 2048; LAS float* qL = kL + 2048; LAS float* vL = qL + 2048; LAS float* oP = vL + 2048;
    const int v = c.tid & 127, kg = c.tid >> 7;
    float S[32];
#pragma unroll
    for (int i = 0; i < 32; ++i) S[i] = 0.f;
    for (int i = c.tid; i < PADF * 128; i += NTHREADS) { const int vp = i >> 7; c.MIX[(size_t)(b * LV + vp) * DM + 512 + hh * 128 + (i & 127)] = 0; }
    for (int t0 = PADF; t0 < LV; t0 += 16) {
        for (int i = c.tid; i < 2048; i += NTHREADS) { const int t = i >> 7, k = i & 127; const size_t o = (size_t)(b * LV + t0 + t) * 512 + hh * 128 + k;
            const float f = __expf(c.LOGF[o]); fL[i] = f; kL[i] = 1.f - f; qL[i] = bf2f(c.HXQ[o]); vL[i] = bf2f(c.HV[o]); }
        __syncthreads();
        for (int t = 0; t < 16; ++t) { const float vv = vL[t * 128 + v]; float part = 0.f;
#pragma unroll
            for (int i = 0; i < 32; ++i) { const int k = kg * 32 + i; S[i] = fL[t * 128 + k] * S[i] + kL[t * 128 + k] * vv; part += S[i] * qL[t * 128 + k]; }
            oP[(kg * 16 + t) * 128 + v] = part; }
        __syncthreads();
        for (int tt = 0; tt < 2; ++tt) { const int t = c.wave * 2 + tt; float o0, o1;
            { const int v0 = c.lane, v1 = c.lane + 64; o0 = oP[t * 128 + v0] + oP[(16 + t) * 128 + v0] + oP[(32 + t) * 128 + v0] + oP[(48 + t) * 128 + v0];
              o1 = oP[t * 128 + v1] + oP[(16 + t) * 128 + v1] + oP[(32 + t) * 128 + v1] + oP[(48 + t) * 128 + v1]; }
            const float ss = wave_sum(o0 * o0 + o1 * o1); const float rstd = 1.f / sqrtf(ss * (1.f / 128.f) + EPS);
            const size_t ro = (size_t)(b * LV + t0 + t);
            const float g0 = bf2f(c.HG[ro * 512 + hh * 128 + c.lane]), g1 = bf2f(c.HG[ro * 512 + hh * 128 + c.lane + 64]);
            c.MIX[ro * DM + 512 + hh * 128 + c.lane] = (bf16_t)f2bf(o0 * rstd * c.hnw[layer * 128 + c.lane] * g0);
            c.MIX[ro * DM + 512 + hh * 128 + c.lane + 64] = (bf16_t)f2bf(o1 * rstd * c.hnw[layer * 128 + c.lane + 64] * g1); }
        __syncthreads();
    }
}

__device__ __forceinline__ void final_norm(const Ctx& c) {
    for (int r = c.gw; r < NB * SEQ; r += c.NGW) {
        float* hp = c.out + (size_t)r * DM; f32x4 v[4]; float s = 0.f;
#pragma unroll
        for (int j = 0; j < 4; ++j) { v[j] = *(const f32x4*)(hp + 4 * c.lane + 256 * j); s += (v[j].x * v[j].x + v[j].y * v[j].y) + (v[j].z * v[j].z + v[j].w * v[j].w); }
        s = wave_sum(s); const float rstd = 1.f / sqrtf(s * (1.f / DM) + EPS);
#pragma unroll
        for (int j = 0; j < 4; ++j) { const f32x4 w = *(const f32x4*)(c.nfinal + 4 * c.lane + 256 * j); *(f32x4*)(hp + 4 * c.lane + 256 * j) = v[j] * rstd * w; }
    }
}

__global__ void __launch_bounds__(NTHREADS, 2) fwd_kernel(Args a) {
    extern __shared__ __attribute__((aligned(16))) unsigned char lds_raw[];
    LAS unsigned char* lds = (LAS unsigned char*)lds_raw;
    cg::grid_group grid = cg::this_grid();
    Ctx c;
    c.x = a.in[0]; c.meta = a.in[1]; c.nmw = a.in[2]; c.win = a.in[3]; c.fbias = a.in[4]; c.lbraw = a.in[5]; c.hnw = a.in[6]; c.wout = a.in[7];
    c.nfw = a.in[8]; c.wg = a.in[9]; c.wu = a.in[10]; c.wd = a.in[11]; c.nfinal = a.in[12];
    c.out = a.out; c.ws = a.ws;
    c.ctl = (unsigned*)(a.ws + WS_CTL); c.sumsq = (float*)(a.ws + WS_SUMSQ); c.lbv = (float*)(a.ws + WS_LBV); c.logf8 = (float*)(a.ws + WS_LOGF8);
    c.kbias = (float*)(a.ws + WS_KBIAS); c.hs = (float*)(a.ws + WS_HS);
    c.HB = (bf16_t*)(a.ws + WS_HB); c.MIX = (bf16_t*)(a.ws + WS_MIX); c.QB = (bf16_t*)(a.ws + WS_QB); c.KB = (bf16_t*)(a.ws + WS_KB); c.VB = (bf16_t*)(a.ws + WS_VB);
    c.HXQ = (bf16_t*)(a.ws + WS_HXQ); c.LOGF = (float*)(a.ws + WS_LOGF); c.HV = (bf16_t*)(a.ws + WS_HV); c.HG = (bf16_t*)(a.ws + WS_HG); c.ACT = (bf16_t*)(a.ws + WS_ACT);
    c.tid = threadIdx.x; c.lane = c.tid & 63; c.wave = __builtin_amdgcn_readfirstlane(c.tid >> 6);
    c.gw = blockIdx.x * NWAVES + c.wave; c.NGW = gridDim.x * NWAVES;
    bf16_t* SD = (bf16_t*)(a.ws + WS_HB);
    float* DV = (float*)(a.ws + WS_DV);

    { const int gt = blockIdx.x * NTHREADS + c.tid, NGT = gridDim.x * NTHREADS;
      for (int i = gt; i < 16384; i += NGT) c.ctl[i] = 0u;
      for (int i = gt; i < 2 * MALLOC; i += NGT) c.sumsq[2 * MALLOC + i] = 0.f;
      for (int i = gt; i < HGW; i += NGT) c.lbv[i] = 1.f / (1.f + __expf(c.lbraw[i] - c.lbraw[HGW + i])); }
    p0_weights(c, lds);
    __syncthreads();
    ff_rows(c, lds, 0);
    grid.sync();
#define LAUNDER() asm volatile("" : "+v"(c.tid), "+v"(c.lane))
    for (int layer = 0; layer < 2; ++layer) {
        LAUNDER();
        if (layer) { ff_rows(c, lds, 1); grid.sync(); }
        LAUNDER();
        kbias_build(c);
        LAUNDER();
        if constexpr (FASTMASK & 1) gemm_fast<0>(c, lds, layer); else gemm_simple<0>(c, layer);
        grid.sync();
        LAUNDER();
        for (int u = blockIdx.x; u < 16 * 64; u += gridDim.x) hgrn_A_unit(c, lds, u >> 6, u & 63, SD, DV);
        grid.sync();
        LAUNDER();
        hgrn_B_scan(c, SD, DV);
        grid.sync();
        LAUNDER();
        mix_queue(c, lds_raw, layer, SD);
        grid.sync();
        LAUNDER();
        if constexpr (FASTMASK & 2) gemm_fast<1>(c, lds, layer); else gemm_simple<1>(c, layer);
        grid.sync();
        if constexpr (FASTMASK & 4) gemm_fast<2>(c, lds, layer); else gemm_simple<2>(c, layer);
        grid.sync();
        if constexpr (FASTMASK & 8) gemm_fast<3>(c, lds, layer); else gemm_simple<3>(c, layer);
        grid.sync();
    }
    LAUNDER();
    final_norm(c);
}

extern "C" void kernel_launch(void* const* d_in, const int* in_sizes, int n_in, void* d_out, int out_size, void* d_ws, size_t ws_size, hipStream_t stream) {
    static int grid = 0;
    if (grid == 0) {
        if (n_in != 13 || out_size != NB * SEQ * DM || ws_size < WS_END) { fprintf(stderr, "kernel_launch: unexpected shapes n_in %d out %d ws %zu\n", n_in, out_size, ws_size); grid = -1; return; }
        int dev = 0, cus = 0, per_cu = 0;
        (void)hipGetDevice(&dev); (void)hipDeviceGetAttribute(&cus, hipDeviceAttributeMultiprocessorCount, dev);
        (void)hipFuncSetAttribute((const void*)fwd_kernel, hipFuncAttributeMaxDynamicSharedMemorySize, LDS_BYTES);
        (void)hipOccupancyMaxActiveBlocksPerMultiprocessor(&per_cu, (const void*)fwd_kernel, NTHREADS, LDS_BYTES);
        if (per_cu < 1) per_cu = 1;
        grid = cus * per_cu;
        (void)hipGetLastError();
    }
    if (grid < 0) return;
    Args a{};
    for (int i = 0; i < 13; ++i) a.in[i] = (const float*)d_in[i];
    a.out = (float*)d_out; a.ws = (unsigned char*)d_ws;
    void* args[] = {&a};
    hipError_t e = hipLaunchCooperativeKernel((const void*)fwd_kernel, dim3(grid), dim3(NTHREADS), args, LDS_BYTES, stream);
    if (e != hipSuccess) fprintf(stderr, "cooperative launch failed: %s (grid %d)\n", hipGetErrorString(e), grid);
}
```

```cpp
#include <hip/hip_runtime.h>
#include <hip/hip_cooperative_groups.h>
#include <cstdint>
#include <cstdio>
namespace cg = cooperative_groups;

typedef unsigned short bf16_t;
typedef short bf16x8 __attribute__((ext_vector_type(8)));
typedef float f32x4 __attribute__((ext_vector_type(4)));
typedef unsigned u32x4 __attribute__((ext_vector_type(4)));
#define LAS __attribute__((address_space(3)))

constexpr int DM = 1024, NB = 4, SEQ = 4096, NMETA = 16, PADF = 48, LV = 4160, MROWS = NB * LV, MALLOC = MROWS + 256;
constexpr int FOXH = 8, FOXD = 64, FOXW = 512, HGH = 4, HGK = 128, HGV = 128, HGW = 512, DFF = 2816, INCOLS = 3592, NIN = 3584;
constexpr int KBL = 4352;
constexpr float EPS = 1e-6f, LOG2E = 1.4426950408889634f, C2 = 0.125f * LOG2E, HGQS = 0.08838834764831845f;
constexpr int NTHREADS = 512, NWAVES = 8;
constexpr int LDS_BYTES = 147456;
#ifndef FASTMASK
#define FASTMASK 15
#endif
#ifndef DUPMASK
#define DUPMASK 0
#endif

constexpr size_t MiB = 1u << 20;
constexpr size_t WS_CTL = 0;
constexpr size_t WS_SUMSQ = 64 * 1024;
constexpr size_t SUMSQ_STRIDE = (size_t)MALLOC * 4;
constexpr size_t WS_LBV = WS_SUMSQ + 4 * SUMSQ_STRIDE;
constexpr size_t WS_LOGF8 = WS_LBV + 4096;
constexpr size_t WS_KBIAS = WS_LOGF8 + (size_t)MALLOC * 32;
constexpr size_t WS_DV = WS_KBIAS + 32 * KBL * 4;
constexpr size_t WS_BAR = WS_DV + 16 * 64 * 128 * 4;
constexpr size_t WS_HS = 2 * MiB;
constexpr size_t WS_W = 3 * MiB;
constexpr size_t W_IN = 0, W_OUT = W_IN + (size_t)NIN * DM * 2, W_GU = W_OUT + (size_t)DM * DM * 2, W_DN = W_GU + (size_t)2 * DFF * DM * 2, W_LAYER = W_DN + (size_t)DM * DFF * 2;
constexpr size_t WS_HB = WS_W + 2 * W_LAYER + 65536;
constexpr size_t WS_MIX = WS_HB + (size_t)MALLOC * DM * 2;
constexpr size_t WS_QB = WS_MIX + (size_t)MALLOC * DM * 2;
constexpr size_t WS_KB = WS_QB + (size_t)MALLOC * 512 * 2, WS_VB = WS_KB + (size_t)MALLOC * 512 * 2;
constexpr size_t WS_HXQ = WS_VB + (size_t)MALLOC * 512 * 2;
constexpr size_t WS_LOGF = WS_HXQ + (size_t)MALLOC * 512 * 2;
constexpr size_t WS_HV = WS_LOGF + (size_t)MALLOC * 512 * 4, WS_HG = WS_HV + (size_t)MALLOC * 512 * 2;
constexpr size_t WS_END = WS_HG + (size_t)MALLOC * 512 * 2;
constexpr size_t WS_ACT = WS_QB;
static_assert(WS_BAR + 16384 <= WS_HS && 3456 * 4 <= 16384 && (size_t)16 * 64 * 16384 * 2 <= (size_t)MALLOC * DM * 2 && WS_HS + 4 * 64 * 1024 * 4 <= WS_W, "small map");
static_assert(WS_ACT + (size_t)MALLOC * DFF * 2 <= WS_END, "ACT overlay");
static_assert(WS_END <= 256 * MiB, "d_ws");

#define LAUNDER0() asm volatile("" : "+v"(c.tid), "+v"(c.lane))
struct Args { const float* in[13]; float* out; unsigned char* ws; };

struct Ctx {
    const float *x, *meta, *nmw, *win, *fbias, *lbraw, *hnw, *wout, *nfw, *wg, *wu, *wd, *nfinal;
    float* out; unsigned char* ws;
    unsigned* ctl; float* sumsq; float* lbv; float* logf8; float* kbias; float* hs;
    bf16_t *HB, *MIX, *QB, *KB, *VB, *HXQ, *HV, *HG, *ACT; float* LOGF;
    int tid, lane, wave, gw, NGW;
};

__device__ __forceinline__ unsigned f2bf(float f) { unsigned u = __builtin_bit_cast(unsigned, f); return (u + 0x7fffu + ((u >> 16) & 1u)) >> 16; }
__device__ __forceinline__ unsigned pk2(float lo, float hi) { return f2bf(lo) | (f2bf(hi) << 16); }
__device__ __forceinline__ float bf2f(unsigned short b) { return __builtin_bit_cast(float, (unsigned)b << 16); }
__device__ __forceinline__ float wave_sum(float v) {
#pragma unroll
    for (int o = 1; o < 64; o <<= 1) v += __shfl_xor(v, o);
    return v;
}
__device__ __forceinline__ float wave_max(float v) {
#pragma unroll
    for (int o = 1; o < 64; o <<= 1) v = fmaxf(v, __shfl_xor(v, o));
    return v;
}
__device__ __forceinline__ float siluf(float x) { return x / (1.f + __expf(-x)); }
__device__ __forceinline__ float* hrow(const Ctx& c, int r) {
    const int b = r / LV, vp = r - b * LV;
    return vp >= 64 ? c.out + (size_t)(b * SEQ + vp - 64) * DM : c.hs + (size_t)(b * 64 + vp) * DM;
}
__device__ __forceinline__ bf16_t* wptr(const Ctx& c, int layer, size_t off) { return (bf16_t*)(c.ws + WS_W + (size_t)layer * W_LAYER + off); }

namespace pg8 {
#define PG8_LAS __attribute__((address_space(3)))
typedef unsigned short bf16_t;
typedef short bf16x8 __attribute__((ext_vector_type(8)));
typedef float f32x4 __attribute__((ext_vector_type(4)));
typedef unsigned u32x4 __attribute__((ext_vector_type(4)));
constexpr int BM = 256, BK = 64, HALF = 128, HTB = HALF * BK * 2  , STAGE_BYTES = 8 * HTB, NXCD = 8, WGM = 8;

__host__ __device__ __forceinline__ int lds_byte(int r, int c) { const int st = (r >> 4) * 2 + (c >> 5), rr = r & 15, cc = c & 31, ob = rr * 64 + cc * 2; return st * 1024 + (ob ^ (((ob >> 9) & 1) << 5)); }
__host__ __device__ __forceinline__ void stage_rc(int b, int& R, int& C) { const int st = b / 1024, sb = b % 1024, swz = sb ^ (((sb >> 9) & 1) << 5); R = (st >> 1) * 16 + swz / 64; C = (st & 1) * 32 + (swz % 64) / 2; }
__host__ __device__ __forceinline__ int perm32(int rho) { const int n = rho >> 4, i = rho & 15; return 8 * (i >> 2) + 4 * n + (i & 3); }

struct Unit { int pm, pn; };
struct Gemm { const bf16_t* A; const bf16_t* Bt; int M, N, K; };

struct StaticOrder {
    int nM, nN, nwg, G, c;
    __host__ __device__ void init(int M, int N, int G_, int c_) { nM = M / BM; nN = N / BM; nwg = nM * nN; G = G_; c = c_; }
    __host__ __device__ bool next(int i, Unit& u) const {
        const long L = (long)i * G + c; if (L >= nwg) return false;
        int wgid = (int)L; { const int q = nwg / NXCD, r = nwg % NXCD, xcd = wgid % NXCD, off = wgid / NXCD; wgid = (xcd < r ? xcd * (q + 1) : r * (q + 1) + (xcd - r) * q) + off; }
        const int nig = WGM * nN, gid = wgid / nig, fm = gid * WGM, gsz = (nM - fm) < WGM ? (nM - fm) : WGM;
        u.pm = fm + ((wgid % nig) % gsz); u.pn = (wgid % nig) / gsz; return true;
    }
    __device__ __forceinline__ void a_ready(const Unit&) const {}
    __device__ __forceinline__ void done(const Unit&) const {}
};

__device__ __forceinline__ unsigned cvt_pk_bf16(float lo, float hi) { unsigned r; asm volatile("v_cvt_pk_bf16_f32 %0, %1, %2" : "=v"(r) : "v"(lo), "v"(hi)); return r; }
typedef float f32x2 __attribute__((ext_vector_type(2)));
template <class Epi, class Sched, bool ALIGN_EPI = false, bool SP2 = false>
__device__ __forceinline__ void gemm_phase(PG8_LAS unsigned char* lds, const Gemm g, const Sched& S, const Epi& E) {
    int tid_ = threadIdx.x; asm volatile("" : "+v"(tid_));
    const int tid = tid_, wid = __builtin_amdgcn_readfirstlane(tid >> 6), lane = tid & 63, wr = wid >> 2, wc = wid & 3, fr = lane & 15, fq = lane >> 4;
    const int K = g.K, nt = K / BK;
    unsigned voffA[2], voffB[2];
#pragma unroll
    for (int i = 0; i < 2; ++i) { int R, C; stage_rc(tid * 16 + i * 8192, R, C); const int Rb = Epi::PERM ? ((R & ~31) + perm32(R & 31)) : R;
        voffA[i] = (unsigned)(R * K + C) * 2u; voffB[i] = (unsigned)(Rb * K + C) * 2u; }
    const size_t kstep = (size_t)(BK * 2);
    const size_t hstep = (size_t)HALF * K * 2;
    const size_t tstep = 2 * hstep;
    const unsigned ldsw = (unsigned)wid * 1024u;
    const int aoff = lds_byte(wr * 64 + fr, fq * 8), boff = lds_byte(wc * 32 + fr, fq * 8);
#define PG8_SA(b, h) (((b) * 2 + (h)) * HTB)
#define PG8_SB(b, h) ((4 + (b) * 2 + (h)) * HTB)
#define PG8_STAGE(bufoff, gbase, voff) do { _Pragma("unroll") for (int _i = 0; _i < 2; ++_i) \
        __builtin_amdgcn_global_load_lds((const unsigned*)((const char*)(gbase) + (voff)[_i]), (PG8_LAS unsigned*)(lds + (bufoff) + ldsw + _i * 8192), 16, 0, 0); } while (0)
#define PG8_LDA(dst, b, h) do { _Pragma("unroll") for (int m = 0; m < 4; ++m) _Pragma("unroll") for (int k = 0; k < 2; ++k) dst[m][k] = *(const PG8_LAS bf16x8*)(lds + PG8_SA(b, h) + aoff + m * 2048 + k * 1024); } while (0)
#define PG8_LDB(dst, b, h) do { _Pragma("unroll") for (int n = 0; n < 2; ++n) _Pragma("unroll") for (int k = 0; k < 2; ++k) dst[n][k] = *(const PG8_LAS bf16x8*)(lds + PG8_SB(b, h) + boff + n * 2048 + k * 1024); } while (0)
#define PG8_MMA(ai, bj, At, Bt) do { __builtin_amdgcn_s_setprio(1); _Pragma("unroll") for (int m = 0; m < 4; ++m) _Pragma("unroll") for (int n = 0; n < 2; ++n) _Pragma("unroll") for (int k = 0; k < 2; ++k) \
        acc[ai][bj][m][n] = __builtin_amdgcn_mfma_f32_16x16x32_bf16(Bt[n][k], At[m][k], acc[ai][bj][m][n], 0, 0, 0); __builtin_amdgcn_s_setprio(0); } while (0)
#define PG8_WAIT_V(n) asm volatile("s_waitcnt vmcnt(" #n ")" ::: "memory")
#define PG8_WAIT_L(n) asm volatile("s_waitcnt lgkmcnt(" #n ")" ::: "memory")
#define PG8_BAR __builtin_amdgcn_s_barrier()
#define PG8_SCHED __builtin_amdgcn_sched_barrier(0)
    Unit cur, nxt; int ui = 0;
    if (!S.next(0, cur)) return;
    f32x4 acc[2][2][4][2];
#pragma unroll
    for (int a = 0; a < 2; ++a)
#pragma unroll
        for (int b = 0; b < 2; ++b)
#pragma unroll
            for (int m = 0; m < 4; ++m)
#pragma unroll
                for (int n = 0; n < 2; ++n) acc[a][b][m][n] = (f32x4){0.f, 0.f, 0.f, 0.f};
    bf16x8 At[4][2], B0[2][2], B1[2][2];
    const char* cA = (const char*)g.A + (size_t)cur.pm * tstep; const char* cB = (const char*)g.Bt + (size_t)cur.pn * tstep;
    S.a_ready(cur);
    if constexpr (SP2) {
        PG8_STAGE(PG8_SB(0, 0), cB, voffB); PG8_STAGE(PG8_SB(0, 1), cB + hstep, voffB); PG8_STAGE(PG8_SA(0, 0), cA, voffA); PG8_STAGE(PG8_SA(0, 1), cA + hstep, voffA);
        if (wr == 1) PG8_BAR;
        PG8_WAIT_V(2); PG8_BAR;
        PG8_STAGE(PG8_SB(1, 0), cB + kstep, voffB); PG8_STAGE(PG8_SA(1, 0), cA + kstep, voffA); PG8_STAGE(PG8_SB(1, 1), cB + hstep + kstep, voffB);
        PG8_WAIT_V(6); PG8_BAR;
    } else {
        PG8_STAGE(PG8_SB(0, 0), cB, voffB); PG8_STAGE(PG8_SA(0, 0), cA, voffA); PG8_STAGE(PG8_SB(0, 1), cB + hstep, voffB); PG8_STAGE(PG8_SA(0, 1), cA + hstep, voffA);
        if (wr == 1) PG8_BAR;
        PG8_WAIT_V(4); PG8_BAR;
        PG8_STAGE(PG8_SB(1, 0), cB + kstep, voffB); PG8_STAGE(PG8_SA(1, 0), cA + kstep, voffA); PG8_STAGE(PG8_SB(1, 1), cB + hstep + kstep, voffB);
        PG8_WAIT_V(6); PG8_BAR;
    }
    for (;;) {
        const bool has_next = S.next(ui + 1, nxt);
        const char* nA = has_next ? (const char*)g.A + (size_t)nxt.pm * tstep : cA; const char* nB = has_next ? (const char*)g.Bt + (size_t)nxt.pn * tstep : cB;
        for (int t = 0; t < nt; t += 2) {
            const bool last = (t == nt - 2);
            const char* a1 = cA + (size_t)(t + 1) * kstep;
            const char* a2 = last ? nA : cA + (size_t)(t + 2) * kstep; const char* b2 = last ? nB : cB + (size_t)(t + 2) * kstep;
            const char* a3 = a2 + kstep; const char* b3 = b2 + kstep;
            if (last && has_next) S.a_ready(nxt);
            if constexpr (SP2) {
            PG8_LDB(B0, 0, 0); PG8_LDB(B1, 0, 1); PG8_SCHED; PG8_LDA(At, 0, 0); PG8_STAGE(PG8_SA(1, 1), a1 + hstep, voffA);
            PG8_WAIT_V(8); PG8_WAIT_L(0); PG8_BAR; PG8_MMA(0, 0, At, B0); PG8_MMA(0, 1, At, B1); PG8_BAR; PG8_SCHED;
            PG8_LDA(At, 0, 1); PG8_STAGE(PG8_SB(0, 0), b2, voffB); PG8_STAGE(PG8_SB(0, 1), b2 + hstep, voffB); PG8_STAGE(PG8_SA(0, 0), a2, voffA);
            PG8_WAIT_V(8); PG8_WAIT_L(0); PG8_BAR; PG8_MMA(1, 0, At, B0); PG8_MMA(1, 1, At, B1); PG8_BAR; PG8_SCHED;
            PG8_LDB(B0, 1, 0); PG8_LDB(B1, 1, 1); PG8_SCHED; PG8_LDA(At, 1, 0); PG8_STAGE(PG8_SA(0, 1), a2 + hstep, voffA);
            PG8_WAIT_V(8); PG8_WAIT_L(0); PG8_BAR; PG8_MMA(0, 0, At, B0); PG8_MMA(0, 1, At, B1); PG8_BAR; PG8_SCHED;
            PG8_LDA(At, 1, 1); PG8_STAGE(PG8_SB(1, 0), b3, voffB); PG8_STAGE(PG8_SB(1, 1), b3 + hstep, voffB); PG8_STAGE(PG8_SA(1, 0), a3, voffA);
            PG8_WAIT_V(8); PG8_WAIT_L(0); PG8_BAR; PG8_MMA(1, 0, At, B0); PG8_MMA(1, 1, At, B1); PG8_BAR; PG8_SCHED;
            } else {
            PG8_LDB(B0, 0, 0); PG8_SCHED; PG8_LDA(At, 0, 0); PG8_STAGE(PG8_SA(1, 1), a1 + hstep, voffA);
            PG8_WAIT_L(8); PG8_BAR; PG8_WAIT_L(0); PG8_MMA(0, 0, At, B0); PG8_BAR; PG8_SCHED;
            PG8_LDB(B1, 0, 1); PG8_STAGE(PG8_SB(0, 0), b2, voffB);
            PG8_BAR; PG8_WAIT_L(0); PG8_MMA(0, 1, At, B1); PG8_BAR;
            PG8_LDA(At, 0, 1); PG8_STAGE(PG8_SA(0, 0), a2, voffA);
            PG8_BAR; PG8_WAIT_L(0); PG8_MMA(1, 0, At, B0); PG8_BAR; PG8_SCHED;
            PG8_STAGE(PG8_SB(0, 1), b2 + hstep, voffB);
            PG8_WAIT_V(6); PG8_BAR; PG8_MMA(1, 1, At, B1); PG8_BAR;
            PG8_LDB(B0, 1, 0); PG8_SCHED; PG8_LDA(At, 1, 0); PG8_STAGE(PG8_SA(0, 1), a2 + hstep, voffA);
            PG8_WAIT_L(8); PG8_BAR; PG8_WAIT_L(0); PG8_MMA(0, 0, At, B0); PG8_BAR; PG8_SCHED;
            PG8_LDB(B1, 1, 1); PG8_STAGE(PG8_SB(1, 0), b3, voffB);
            PG8_BAR; PG8_WAIT_L(0); PG8_MMA(0, 1, At, B1); PG8_BAR;
            PG8_LDA(At, 1, 1); PG8_STAGE(PG8_SA(1, 0), a3, voffA);
            PG8_BAR; PG8_WAIT_L(0); PG8_MMA(1, 0, At, B0); PG8_BAR; PG8_SCHED;
            PG8_STAGE(PG8_SB(1, 1), b3 + hstep, voffB);
            PG8_WAIT_V(6); PG8_BAR; PG8_MMA(1, 1, At, B1); PG8_BAR;
            }
        }
        if constexpr (ALIGN_EPI) { if (wr == 0) PG8_BAR; }
        if constexpr (!Epi::AFTER_DRAIN) { E(acc, cur, wr, wc, fr, fq); S.done(cur); }
        if (!has_next) break;
#pragma unroll
        for (int a = 0; a < 2; ++a)
#pragma unroll
            for (int b = 0; b < 2; ++b)
#pragma unroll
                for (int m = 0; m < 4; ++m)
#pragma unroll
                    for (int n = 0; n < 2; ++n) acc[a][b][m][n] = (f32x4){0.f, 0.f, 0.f, 0.f};
        cur = nxt; cA = nA; cB = nB; ++ui;
        if constexpr (ALIGN_EPI) { if (wr == 1) PG8_BAR; }
    }
    PG8_WAIT_V(0);
    if constexpr (!ALIGN_EPI) { if (wr == 0) PG8_BAR; }
    PG8_BAR;
    if constexpr (Epi::AFTER_DRAIN) { E.fused(acc, cur, wr, wc, fr, fq, lds, wid, lane); S.done(cur); }
#undef PG8_SA
#undef PG8_SB
#undef PG8_STAGE
#undef PG8_LDA
#undef PG8_LDB
#undef PG8_MMA
#undef PG8_WAIT_V
#undef PG8_WAIT_L
#undef PG8_BAR
#undef PG8_SCHED
}
}

namespace pg8 {
__device__ __forceinline__ float silu_f(float x) { return x * __builtin_amdgcn_rcpf(1.f + __expf(-x)); }
struct EpiInProj {
    static constexpr bool PERM = true, AFTER_DRAIN = false;
    const float* ssq; const float* lbv; bf16_t *QB, *KB, *VB, *HXQ, *HV, *HG; float* LOGF;
    __device__ __forceinline__ void operator()(const f32x4 (&acc)[2][2][4][2], const Unit& u, int wr, int wc, int fr, int fq) const {
        const int part = u.pn >> 1;
        const int cbase = (u.pn & 1) * 256 + wc * 32 + 8 * fq;
        if (part == 4) {
#pragma unroll
            for (int bj = 0; bj < 2; ++bj)
#pragma unroll
                for (int n = 0; n < 2; ++n) {
                    const int cc = cbase + bj * HALF + 4 * n;
                    f32x4 lb1 = (f32x4){1.f, 1.f, 1.f, 1.f};
                    if (lbv) lb1 = lb1 - *(const f32x4*)(lbv + cc);
#pragma unroll
                    for (int ai = 0; ai < 2; ++ai)
#pragma unroll
                        for (int m = 0; m < 4; ++m) {
                            const int r = u.pm * BM + ai * HALF + wr * 64 + m * 16 + fr;
                            const float rstd = 1.f / sqrtf(ssq[r] * (1.f / 1024.f) + 1e-6f);
                            f32x4 a;
#pragma unroll
                            for (int e = 0; e < 4; ++e) { const float xv = acc[ai][bj][m][n][e] * rstd; const float omf = lb1[e] * __builtin_amdgcn_rcpf(1.f + __expf(xv)); a[e] = fmaxf(__logf(1.f - omf), -30.f); }
                            *(f32x4*)(LOGF + (size_t)r * 512 + cc) = a;
                        }
                }
        } else {
            bf16_t* dst = part == 0 ? QB : part == 1 ? KB : part == 2 ? VB : part == 3 ? HXQ : part == 5 ? HV : HG;
            const float sc = part == 0 ? 0.125f * 1.4426950408889634f : part == 3 ? 0.08838834764831845f : 1.f;
            const bool dosilu = (part == 3) || (part == 6);
#pragma unroll
            for (int ai = 0; ai < 2; ++ai)
#pragma unroll
                for (int m = 0; m < 4; ++m) {
                    const int r = u.pm * BM + ai * HALF + wr * 64 + m * 16 + fr;
                    const float rstd = sc / sqrtf(ssq[r] * (1.f / 1024.f) + 1e-6f);
#pragma unroll
                    for (int bj = 0; bj < 2; ++bj) {
                        f32x4 v0 = acc[ai][bj][m][0], v1 = acc[ai][bj][m][1];
                        if (dosilu) {
#pragma unroll
                            for (int e = 0; e < 4; ++e) { const float a0 = v0[e] * (rstd / sc), a1 = v1[e] * (rstd / sc); v0[e] = silu_f(a0) * sc; v1[e] = silu_f(a1) * sc; }
                        } else { v0 = v0 * rstd; v1 = v1 * rstd; }
                        u32x4 w; w.x = cvt_pk_bf16(v0[0], v0[1]); w.y = cvt_pk_bf16(v0[2], v0[3]); w.z = cvt_pk_bf16(v1[0], v1[1]); w.w = cvt_pk_bf16(v1[2], v1[3]);
                        *(u32x4*)(dst + (size_t)r * 512 + cbase + bj * HALF) = w;
                    }
                }
        }
    }
};
struct EpiResid {
    static constexpr bool PERM = false, AFTER_DRAIN = false;
    float* out; float* hs; bf16_t* HB; float* ssq; unsigned skip;
    __device__ __forceinline__ void operator()(const f32x4 (&acc)[2][2][4][2], const Unit& u, int wr, int wc, int fr, int fq) const {
        if (skip) return;
        const int col0 = u.pn * BM + wc * 32 + 4 * fq;
#pragma unroll
        for (int ai = 0; ai < 2; ++ai)
#pragma unroll
            for (int m = 0; m < 4; ++m) {
                const int r = u.pm * BM + ai * HALF + wr * 64 + m * 16 + fr;
                const int b = r / 4160, vp = r - b * 4160;
                float* hp = vp >= 64 ? out + (size_t)(b * 4096 + vp - 64) * 1024 : hs + (size_t)(b * 64 + vp) * 1024;
                float q = 0.f;
#pragma unroll
                for (int bj = 0; bj < 2; ++bj)
#pragma unroll
                    for (int n = 0; n < 2; ++n) { const int c = col0 + bj * HALF + n * 16; const f32x4 h = *(const f32x4*)(hp + c) + acc[ai][bj][m][n]; *(f32x4*)(hp + c) = h;
                        unsigned long long w = (unsigned long long)cvt_pk_bf16(h[0], h[1]) | ((unsigned long long)cvt_pk_bf16(h[2], h[3]) << 32);
                        *(unsigned long long*)(HB + (size_t)r * 1024 + c) = w; q += (h[0] * h[0] + h[1] * h[1]) + (h[2] * h[2] + h[3] * h[3]); }
                if (ssq) { q += __shfl_xor(q, 16); q += __shfl_xor(q, 32); if (fq == 0) atomicAdd(ssq + r, q); }
            }
    }
};
struct EpiSwiGLU {
    static constexpr bool PERM = true, AFTER_DRAIN = false;
    const float* ssq; bf16_t* ACT;
    __device__ __forceinline__ void operator()(const f32x4 (&acc)[2][2][4][2], const Unit& u, int wr, int wc, int fr, int fq) const {
        const int f0 = u.pn * HALF + wc * 32 + 8 * fq;
#pragma unroll
        for (int ai = 0; ai < 2; ++ai)
#pragma unroll
            for (int m = 0; m < 4; ++m) {
                const int r = u.pm * BM + ai * HALF + wr * 64 + m * 16 + fr;
                const float rstd = 1.f / sqrtf(ssq[r] * (1.f / 1024.f) + 1e-6f);
                float y[8];
#pragma unroll
                for (int n = 0; n < 2; ++n)
#pragma unroll
                    for (int e = 0; e < 4; ++e) { const float g = acc[ai][0][m][n][e] * rstd, uu = acc[ai][1][m][n][e] * rstd; y[4 * n + e] = silu_f(g) * uu; }
                u32x4 w; w.x = cvt_pk_bf16(y[0], y[1]); w.y = cvt_pk_bf16(y[2], y[3]); w.z = cvt_pk_bf16(y[4], y[5]); w.w = cvt_pk_bf16(y[6], y[7]);
                *(u32x4*)(ACT + (size_t)r * 2816 + f0) = w;
            }
    }
};
}

#define GAS __attribute__((address_space(1)))
typedef unsigned v4u __attribute__((ext_vector_type(4)));
typedef GAS unsigned gu32;
typedef GAS unsigned long long gu64;
#define RLX_AGENT __ATOMIC_RELAXED, __HIP_MEMORY_SCOPE_AGENT
#define LDS_WAIT() asm volatile("s_waitcnt lgkmcnt(0)" ::: "memory")
#define VM_WAIT() asm volatile("s_waitcnt vmcnt(0)" ::: "memory")
__device__ __forceinline__ unsigned long long rt() { return __builtin_amdgcn_s_memrealtime(); }
#define XB_TMO      128
#define XB_XCNT(j)  (256  + 64 * (j))
#define XB_XSUB(j)  (1280 + 64 * (j))
#define XB_XGEN(j)  (2304 + 64 * (j))
#define XB_TOP      3328
#define XB_TOPGEN   3392
#define XCD_BAR_WORDS 3456
#define XB_SPIN_CAP (1u << 18)

__device__ __forceinline__ unsigned xb_ld(unsigned* p)              { return __hip_atomic_load(p, __ATOMIC_RELAXED, __HIP_MEMORY_SCOPE_AGENT); }
__device__ __forceinline__ unsigned xb_add(unsigned* p, unsigned v) { return __hip_atomic_fetch_add(p, v, __ATOMIC_RELAXED, __HIP_MEMORY_SCOPE_AGENT); }
__device__ __forceinline__ unsigned xb_xcc_id() { return (unsigned)__builtin_amdgcn_s_getreg((3 << 11) | 20) & 0xFu; }
#define XB_SPIN(cond, bar) do { unsigned _sp = 0; while (cond) { __builtin_amdgcn_s_sleep(1); \
    if ((++_sp & 255u) == 0u) { if (xb_ld(&(bar)[XB_TMO])) break; if (_sp > XB_SPIN_CAP) { atomicAdd(&(bar)[XB_TMO], 1u); break; } } } } while (0)

struct XcdBarrier {
    unsigned* bar; unsigned x;
    volatile LAS unsigned* st;
};

__device__ __forceinline__ XcdBarrier xcd_barrier_post(unsigned* bar, volatile LAS unsigned* st) {
    XcdBarrier b; b.bar = bar; b.x = xb_xcc_id(); b.st = st;
    if (threadIdx.x == 0) (void)xb_add(&bar[XB_XCNT(b.x)], 1u);
    return b;
}
__device__ __forceinline__ void xcd_barrier_complete(unsigned* bar, unsigned x, unsigned& nloc, unsigned& nx) {
    const unsigned G = gridDim.x * gridDim.y * gridDim.z;
    unsigned sum, cnt, mine, sp = 0u;
    for (;;) {
        sum = 0u; cnt = 0u; mine = 0u;
#pragma unroll
        for (unsigned j = 0; j < 16; ++j) { const unsigned c = xb_ld(&bar[XB_XCNT(j)]); sum += c; cnt += (c > 0u) ? 1u : 0u; mine = (j == x) ? c : mine; }
        if (sum == G) break;
        __builtin_amdgcn_s_sleep(1);
        if ((++sp & 255u) == 0u) { if (xb_ld(&bar[XB_TMO])) break; if (sp > XB_SPIN_CAP) { atomicAdd(&bar[XB_TMO], 1u); break; } }
    }
    nloc = mine > 0u ? mine : 1u; nx = cnt > 0u ? cnt : 1u;
}

__device__ __forceinline__ void xcd_barrier(const XcdBarrier& b) {
    asm volatile("s_waitcnt vmcnt(0)" ::: "memory");
    __syncthreads();
    if (threadIdx.x == 0) {
        unsigned* bar = b.bar;
        __builtin_amdgcn_s_waitcnt(0);
        unsigned nloc = b.st[0], nx = b.st[1];
        if (nloc == 0u) { xcd_barrier_complete(bar, b.x, nloc, nx); b.st[0] = nloc; b.st[1] = nx; }
        const unsigned old = xb_add(&bar[XB_XSUB(b.x)], 1u);
        const unsigned gen = old / nloc;
        if (old + 1u == (gen + 1u) * nloc) {
            __builtin_amdgcn_fence(__ATOMIC_RELEASE, "agent");
            asm volatile("s_waitcnt vmcnt(0)" ::: "memory");
            const unsigned og = xb_add(&bar[XB_TOP], 1u);
            const unsigned tg = og / nx;
            if (og + 1u == (tg + 1u) * nx) xb_add(&bar[XB_TOPGEN], 1u);
            else XB_SPIN(xb_ld(&bar[XB_TOPGEN]) == tg, bar);
            __builtin_amdgcn_fence(__ATOMIC_ACQUIRE, "agent");
            xb_add(&bar[XB_XGEN(b.x)], 1u);
            asm volatile("s_waitcnt vmcnt(0)" ::: "memory");
        } else {
            XB_SPIN(xb_ld(&bar[XB_XGEN(b.x)]) == gen, bar);
            __builtin_amdgcn_fence(__ATOMIC_ACQUIRE, "agent");
            asm volatile("s_waitcnt vmcnt(0)" ::: "memory");
        }
    }
    __syncthreads();
}

__device__ __forceinline__ void tr_item(const float* W, int K, int N, int k0, int nsrc0, bf16_t* WT, int dst_row0, const float* kscale, LAS float* scr, int lane) {
#pragma unroll 8
    for (int i = 0; i < 32; ++i) { const int kk = 2 * i + (lane >> 5); float s = kscale ? kscale[k0 + kk] : 1.f; scr[kk * 33 + (lane & 31)] = W[(size_t)(k0 + kk) * N + nsrc0 + (lane & 31)] * s; }
    asm volatile("s_waitcnt lgkmcnt(0)" ::: "memory");
    const int ch = lane & 7;
#pragma unroll
    for (int j = 0; j < 4; ++j) { const int n = (lane >> 3) + 8 * j; const LAS float* s = scr + (8 * ch) * 33 + n;
        u32x4 o; o.x = pk2(s[0 * 33], s[1 * 33]); o.y = pk2(s[2 * 33], s[3 * 33]); o.z = pk2(s[4 * 33], s[5 * 33]); o.w = pk2(s[6 * 33], s[7 * 33]);
        *(u32x4*)(WT + (size_t)(dst_row0 + n) * K + k0 + 8 * ch) = o; }
    asm volatile("s_waitcnt lgkmcnt(0)" ::: "memory");
}

__device__ __forceinline__ void p0_weights(const Ctx& c, LAS unsigned char* lds) {
    LAS float* scr = (LAS float*)(lds + c.wave * 16384);
    constexpr int I_IN = 16 * (NIN / 32), I_OUT = 16 * 32, I_G = 16 * (DFF / 32), I_D = (DFF / 64) * 32, I_L = I_IN + I_OUT + 2 * I_G + I_D;
    for (int it = c.gw; it < 2 * I_L; it += c.NGW) {
        const int l = it / I_L; int r = it - l * I_L;
        if (r < I_IN) { const int kb = r / (NIN / 32), nb = r % (NIN / 32), n0 = nb * 32;
            tr_item(c.win + (size_t)l * DM * INCOLS, DM, INCOLS, kb * 64, n0 + (n0 >= 1536 ? 8 : 0), wptr(c, l, W_IN), n0, c.nmw + l * DM, scr, c.lane); continue; }
        r -= I_IN;
        if (r < I_OUT) { const int kb = r / 32, nb = r % 32; tr_item(c.wout + (size_t)l * DM * DM, DM, DM, kb * 64, nb * 32, wptr(c, l, W_OUT), nb * 32, nullptr, scr, c.lane); continue; }
        r -= I_OUT;
        if (r < 2 * I_G) { const int up = r >= I_G; if (up) r -= I_G; const int kb = r / (DFF / 32), nb = r % (DFF / 32), f0 = nb * 32;
            tr_item((up ? c.wu : c.wg) + (size_t)l * DM * DFF, DM, DFF, kb * 64, f0, wptr(c, l, W_GU), 256 * (f0 >> 7) + (f0 & 127) + (up ? 128 : 0), c.nfw + l * DM, scr, c.lane); continue; }
        r -= 2 * I_G;
        { const int kb = r / 32, nb = r % 32; tr_item(c.wd + (size_t)l * DFF * DM, DFF, DM, kb * 64, nb * 32, wptr(c, l, W_DN), nb * 32, nullptr, scr, c.lane); }
    }
}

__device__ __forceinline__ void ff_rows(const Ctx& c, LAS unsigned char* lds, int layer) {
    LAS float* wff = (LAS float*)lds;
    for (int i = c.tid; i < 8 * DM; i += NTHREADS) { const int cc = i >> 10, k = i & 1023; wff[i] = c.win[(size_t)layer * DM * INCOLS + (size_t)k * INCOLS + 1536 + cc] * c.nmw[layer * DM + k]; }
    __syncthreads();
    float* ssq = c.sumsq + (size_t)layer * MALLOC;
    for (int r = c.gw; r < MROWS; r += c.NGW) {
        const int b = r / LV, vp = r - b * LV;
        f32x4 v[4];
        float* hp = hrow(c, r);
        if (layer == 0) {
            const float* src = vp >= 64 ? c.x + (size_t)(b * SEQ + vp - 64) * DM : (vp >= PADF ? c.meta + (size_t)(vp - PADF) * DM : nullptr);
#pragma unroll
            for (int j = 0; j < 4; ++j) { v[j] = src ? *(const f32x4*)(src + 4 * c.lane + 256 * j) : (f32x4){0.f, 0.f, 0.f, 0.f}; *(f32x4*)(hp + 4 * c.lane + 256 * j) = v[j];
                unsigned long long w = (unsigned long long)pk2(v[j].x, v[j].y) | ((unsigned long long)pk2(v[j].z, v[j].w) << 32);
                *(unsigned long long*)(c.HB + (size_t)r * DM + 4 * c.lane + 256 * j) = w; }
        } else {
#pragma unroll
            for (int j = 0; j < 4; ++j) v[j] = *(const f32x4*)(hp + 4 * c.lane + 256 * j);
        }
        float s = 0.f;
#pragma unroll
        for (int j = 0; j < 4; ++j) s += (v[j].x * v[j].x + v[j].y * v[j].y) + (v[j].z * v[j].z + v[j].w * v[j].w);
        s = wave_sum(s);
        const float rstd = 1.f / sqrtf(s * (1.f / DM) + EPS);
        float myv = 0.f;
#pragma unroll
        for (int cc = 0; cc < 8; ++cc) {
            float d = 0.f;
#pragma unroll
            for (int j = 0; j < 4; ++j) { const f32x4 w = *(const LAS f32x4*)(wff + cc * DM + 4 * c.lane + 256 * j); d += (v[j].x * w.x + v[j].y * w.y) + (v[j].z * w.z + v[j].w * w.w); }
            d = wave_sum(d);
            if (c.lane == cc) myv = d;
        }
        if (c.lane == 0) ssq[r] = s;
        if (c.lane < 8) { const float z = myv * rstd + c.fbias[layer * 8 + c.lane];
            c.logf8[(size_t)r * 8 + c.lane] = fminf(z, 0.f) - log1pf(__expf(-fabsf(z))); }
    }
    __syncthreads();
}

__device__ __forceinline__ void kbias_build(const Ctx& c) {
    for (int job = c.gw; job < NB * FOXH; job += c.NGW) {
        const int b = job >> 3, h = job & 7;
        float s = 0.f;
        const int v0 = 65 * c.lane;
        for (int i = 0; i < 65; ++i) { const int vp = v0 + i; const float g = vp >= PADF ? c.logf8[(size_t)(b * LV + vp) * 8 + h] : 0.f; s += g; }
        float inc = s;
#pragma unroll
        for (int o = 1; o < 64; o <<= 1) { const float t = __shfl_up(inc, o); if (c.lane >= o) inc += t; }
        float run = inc - s;
        float* kb = c.kbias + (size_t)job * KBL;
        for (int i = 0; i < 65; ++i) { const int vp = v0 + i; const float g = vp >= PADF ? c.logf8[(size_t)(b * LV + vp) * 8 + h] : 0.f; run += g; kb[vp] = vp >= PADF ? -run * LOG2E : -1e30f; }
        for (int i = LV + c.lane; i < KBL; i += 64) kb[i] = 0.f;
    }
}

template <int MODE>
__device__ __forceinline__ void gemm_simple(const Ctx& c, int layer) {
    const int fr = c.lane & 15, g = c.lane >> 4;
    const bf16_t* A = MODE == 0 ? c.HB : MODE == 1 ? c.MIX : MODE == 2 ? c.HB : c.ACT;
    const bf16_t* Bt = wptr(c, layer, MODE == 0 ? W_IN : MODE == 1 ? W_OUT : MODE == 2 ? W_GU : W_DN);
    constexpr int K = MODE == 3 ? DFF : DM;
    constexpr int NCOL = MODE == 0 ? NIN : MODE == 2 ? DFF : DM;
    constexpr int ntn = NCOL / 64, ntm = MROWS / 16;
    for (int t = c.gw; t < ntm * ntn; t += c.NGW) {
        const int tm = t / ntn, tn = t - tm * ntn, row0 = tm * 16, col0 = tn * 64;
        f32x4 acc[4], acc2[4];
#pragma unroll
        for (int n = 0; n < 4; ++n) { acc[n] = (f32x4){0.f, 0.f, 0.f, 0.f}; acc2[n] = (f32x4){0.f, 0.f, 0.f, 0.f}; }
        const bf16_t* ap = A + (size_t)(row0 + fr) * K + 8 * g;
        const bf16_t* bp[4];
#pragma unroll
        for (int n = 0; n < 4; ++n) { const int cn = col0 + 16 * n + fr; const int br = MODE == 2 ? 256 * (cn >> 7) + (cn & 127) : cn; bp[n] = Bt + (size_t)br * K + 8 * g; }
        for (int k0 = 0; k0 < K; k0 += 32) {
            const bf16x8 a = *(const bf16x8*)(ap + k0);
#pragma unroll
            for (int n = 0; n < 4; ++n) { const bf16x8 b = *(const bf16x8*)(bp[n] + k0); acc[n] = __builtin_amdgcn_mfma_f32_16x16x32_bf16(a, b, acc[n], 0, 0, 0);
                if (MODE == 2) { const bf16x8 b2 = *(const bf16x8*)(bp[n] + (size_t)128 * K + k0); acc2[n] = __builtin_amdgcn_mfma_f32_16x16x32_bf16(a, b2, acc2[n], 0, 0, 0); } }
        }
        if (MODE == 0) {
            const float* ssq = c.sumsq + (size_t)layer * MALLOC;
#pragma unroll
            for (int j = 0; j < 4; ++j) { const int r = row0 + 4 * g + j; const float rstd = 1.f / sqrtf(ssq[r] * (1.f / DM) + EPS);
#pragma unroll
                for (int n = 0; n < 4; ++n) { const int cn = col0 + 16 * n + fr; const float xv = acc[n][j] * rstd; const int part = cn >> 9, cc = cn & 511; const size_t o = (size_t)r * 512 + cc;
                    if (part == 0) c.QB[o] = (bf16_t)f2bf(xv * C2);
                    else if (part == 1) c.KB[o] = (bf16_t)f2bf(xv);
                    else if (part == 2) c.VB[o] = (bf16_t)f2bf(xv);
                    else if (part == 3) c.HXQ[o] = (bf16_t)f2bf(siluf(xv) * HGQS);
                    else if (part == 4) { const float lb = layer ? c.lbv[cc] : 0.f; const float omf = (1.f - lb) / (1.f + __expf(xv)); c.LOGF[o] = fmaxf(log1pf(-omf), -30.f); }
                    else if (part == 5) c.HV[o] = (bf16_t)f2bf(xv);
                    else c.HG[o] = (bf16_t)f2bf(siluf(xv)); } }
        } else if (MODE == 1 || MODE == 3) {
            float* ssq = c.sumsq + (size_t)(2 + layer) * MALLOC;
#pragma unroll
            for (int j = 0; j < 4; ++j) { const int r = row0 + 4 * g + j; float* hp = hrow(c, r); float q = 0.f;
#pragma unroll
                for (int n = 0; n < 4; ++n) { const int cn = col0 + 16 * n + fr; const float hn = hp[cn] + acc[n][j]; hp[cn] = hn; c.HB[(size_t)r * DM + cn] = (bf16_t)f2bf(hn); q += hn * hn; }
                if (MODE == 1) { q += __shfl_xor(q, 1); q += __shfl_xor(q, 2); q += __shfl_xor(q, 4); q += __shfl_xor(q, 8); if (fr == 0) atomicAdd(ssq + r, q); } }
        } else {
            const float* ssq = c.sumsq + (size_t)(2 + layer) * MALLOC;
#pragma unroll
            for (int j = 0; j < 4; ++j) { const int r = row0 + 4 * g + j; const float rstd = 1.f / sqrtf(ssq[r] * (1.f / DM) + EPS);
#pragma unroll
                for (int n = 0; n < 4; ++n) { const int cn = col0 + 16 * n + fr; const float gv = acc[n][j] * rstd, uv = acc2[n][j] * rstd; c.ACT[(size_t)r * DFF + cn] = (bf16_t)f2bf(siluf(gv) * uv); } }
        }
    }
}

template <int MODE>
__device__ __forceinline__ void gemm_fast(const Ctx& c, LAS unsigned char* lds, int layer, unsigned skip = 0u) {
    const bf16_t* A = MODE == 0 ? c.HB : MODE == 1 ? c.MIX : MODE == 2 ? c.HB : c.ACT;
    const bf16_t* Bt = wptr(c, layer, MODE == 0 ? W_IN : MODE == 1 ? W_OUT : MODE == 2 ? W_GU : W_DN);
    constexpr int K = MODE == 3 ? DFF : DM;
    constexpr int N = MODE == 0 ? NIN : MODE == 2 ? 2 * DFF : DM;
    pg8::Gemm g{A, Bt, MROWS, N, K}; pg8::StaticOrder S; S.init(MROWS, N, (int)gridDim.x, (int)blockIdx.x);
    if constexpr (MODE == 0) {
        pg8::EpiInProj E{c.sumsq + (size_t)layer * MALLOC, layer ? c.lbv : nullptr, c.QB, c.KB, c.VB, c.HXQ, c.HV, c.HG, c.LOGF};
        pg8::gemm_phase<pg8::EpiInProj, pg8::StaticOrder, true, true>(lds, g, S, E);
    } else if constexpr (MODE == 2) {
        pg8::EpiSwiGLU E{c.sumsq + (size_t)(2 + layer) * MALLOC, c.ACT};
        pg8::gemm_phase<pg8::EpiSwiGLU, pg8::StaticOrder, true, true>(lds, g, S, E);
    } else {
        pg8::EpiResid E{c.out, c.hs, c.HB, MODE == 1 ? c.sumsq + (size_t)(2 + layer) * MALLOC : nullptr, skip};
        pg8::gemm_phase<pg8::EpiResid, pg8::StaticOrder, true, true>(lds, g, S, E);
    }
}

#include <hip/hip_bf16.h>
#include <cmath>
namespace attn_body {
using bf16=__hip_bfloat16;
using bf16x8=__attribute__((ext_vector_type(8)))short;
using s16x4=__attribute__((ext_vector_type(4)))short;
using f32x16=__attribute__((ext_vector_type(16)))float;
using u32x4=__attribute__((ext_vector_type(4)))unsigned;
constexpr int BATCH=4,NHEAD=8,SEQ=4160,D=64,DM=NHEAD*D,OP=1024;
constexpr int NW=8,QBLK=32,QB=QBLK*NW,KVBLK=64,NQB=17;
constexpr int ATTN_PITCH=DM, ATTN_UNIT_ROWS=QB;
__device__ __forceinline__ int crow(int r,int hi){return (r&3)+8*(r>>2)+4*hi;}
#define SBAR() __builtin_amdgcn_sched_barrier(0)
__device__ __forceinline__ void cmask(f32x16&p0,f32x16&p1,int jb,int qrel,int hi){
  const float NEG=-INFINITY; int kb=64*jb+4*hi;
  #pragma unroll
  for(int r=0;r<16;++r){int kv=kb+(r&3)+8*(r>>2); if(kv>qrel)p0[r]=NEG; if(kv+32>qrel)p1[r]=NEG;}
}

constexpr int NSLOT=3, SLOTB=8192;
constexpr int LDS_K=0, LDS_V=NSLOT*SLOTB, LDS_WS=2*NSLOT*SLOTB, LDS_OST=LDS_WS+NW*64*4, LDS_KB=LDS_OST+NW*4096, LDS_BYTES=LDS_KB+4352*4+256;
constexpr float C2=0.125f*1.4426950408889634f;
__device__ __forceinline__ void glds16(const void*gsrc,unsigned lds_dst){unsigned keep;
  asm volatile("s_mov_b32 %0, m0\n\ts_mov_b32 m0, %2\n\ts_nop 0\n\tglobal_load_lds_dwordx4 %1, off\n\ts_mov_b32 m0, %0":"=&s"(keep):"v"(gsrc),"s"(lds_dst):"memory");}
__device__ __forceinline__ float max3f(float a,float b,float c){float r;asm("v_max3_f32 %0, %1, %2, %3":"=v"(r):"v"(a),"v"(b),"v"(c));return r;}
__device__ __forceinline__ float max2f(float a,float b){float r;asm("v_max_f32_e32 %0, %1, %2":"=v"(r):"v"(a),"v"(b));return r;}
__device__ __forceinline__ float fadd_s(float a,float b){float r;asm("v_add_f32_e32 %0, %1, %2":"=v"(r):"v"(a),"v"(b));return r;}
__device__ __forceinline__ float fsub_s(float a,float b){float r;asm("v_sub_f32_e32 %0, %1, %2":"=v"(r):"v"(a),"v"(b));return r;}
typedef float f32x2_t __attribute__((ext_vector_type(2))); typedef __bf16 bf16x2_t __attribute__((ext_vector_type(2)));
__device__ __forceinline__ unsigned cvtpk_s(float lo,float hi){f32x2_t v={lo,hi};bf16x2_t b=__builtin_convertvector(v,bf16x2_t);return __builtin_bit_cast(unsigned,b);}
#define WAIT_BAR(N) asm volatile("s_waitcnt vmcnt(" #N ") lgkmcnt(0)\n\ts_barrier":::"memory")

__device__ __forceinline__ void qkt(f32x16&p0,f32x16&p1,const char*Kslot,const bf16x8*qr,int r32,int hi){
  const char*kb=Kslot+hi*1024+r32*16;
  #pragma unroll
  for(int d0=0;d0<4;++d0){
    const bf16x8 b0=*reinterpret_cast<const bf16x8*>(kb+d0*2048);
    const bf16x8 b1=*reinterpret_cast<const bf16x8*>(kb+d0*2048+512);
    p0=__builtin_amdgcn_mfma_f32_32x32x16_bf16(b0,qr[d0],p0,0,0,0);p1=__builtin_amdgcn_mfma_f32_32x32x16_bf16(b1,qr[d0],p1,0,0,0);}
}
typedef __attribute__((address_space(3))) const char* lds_cptr;
typedef short v4i16_t __attribute__((ext_vector_type(4)));
__device__ __forceinline__ void kload8(bf16x8*kf,lds_cptr kp){
  kf[0]=*(const __attribute__((address_space(3))) bf16x8*)(kp);      kf[1]=*(const __attribute__((address_space(3))) bf16x8*)(kp+512);
  kf[2]=*(const __attribute__((address_space(3))) bf16x8*)(kp+2048); kf[3]=*(const __attribute__((address_space(3))) bf16x8*)(kp+2560);
  kf[4]=*(const __attribute__((address_space(3))) bf16x8*)(kp+4096); kf[5]=*(const __attribute__((address_space(3))) bf16x8*)(kp+4608);
  kf[6]=*(const __attribute__((address_space(3))) bf16x8*)(kp+6144); kf[7]=*(const __attribute__((address_space(3))) bf16x8*)(kp+6656);
}
__device__ __forceinline__ void kload2(bf16x8*kf,lds_cptr kp,int j){ kf[2*j]=*(const __attribute__((address_space(3))) bf16x8*)(kp+j*2048); kf[2*j+1]=*(const __attribute__((address_space(3))) bf16x8*)(kp+j*2048+512); }
__device__ __forceinline__ s16x4 vtr(lds_cptr p){ return __builtin_bit_cast(s16x4,__builtin_amdgcn_ds_read_tr16_b64_v4i16((__attribute__((address_space(3))) v4i16_t*)p)); }
__device__ __forceinline__ float rowmax(const f32x16&p0,const f32x16&p1){
  float a=max3f(p0[0],p0[1],p1[0]),b=max3f(p0[2],p0[3],p1[1]);a=max3f(a,p1[2],p1[3]);
  #pragma unroll
  for(int r=4;r<16;r+=4){a=max3f(a,p0[r],p0[r+1]);b=max3f(b,p0[r+2],p0[r+3]);a=max3f(a,p1[r],p1[r+1]);b=max3f(b,p1[r+2],p1[r+3]);}
  const float m=max2f(a,b);
  auto rr=__builtin_amdgcn_permlane32_swap(__float_as_uint(m),__float_as_uint(m),false,false);
  return max2f(__uint_as_float(rr[0]),__uint_as_float(rr[1]));
}
__device__ __forceinline__ void pv(f32x16*o,int vb,bf16x8 pa0,bf16x8 pa1,bf16x8 pa2,bf16x8 pa3){
  #pragma unroll
  for(int d0=0;d0<2;++d0){s16x4 lo[4],hi[4];
    #pragma unroll
    for(int ks=0;ks<4;++ks){
      asm volatile("ds_read_b64_tr_b16 %0,%1 offset:%c2":"=&v"(lo[ks]):"v"(vb),"i"(d0*4096+ks*1024):"memory");
      asm volatile("ds_read_b64_tr_b16 %0,%1 offset:%c2":"=&v"(hi[ks]):"v"(vb),"i"(d0*4096+ks*1024+512):"memory");}
    asm volatile("s_waitcnt lgkmcnt(0)":::"memory");SBAR();
    #define PK(k) (bf16x8){lo[k][0],lo[k][1],lo[k][2],lo[k][3],hi[k][0],hi[k][1],hi[k][2],hi[k][3]}
    o[d0]=__builtin_amdgcn_mfma_f32_32x32x16_bf16(pa0,PK(0),o[d0],0,0,0);
    o[d0]=__builtin_amdgcn_mfma_f32_32x32x16_bf16(pa1,PK(1),o[d0],0,0,0);
    o[d0]=__builtin_amdgcn_mfma_f32_32x32x16_bf16(pa2,PK(2),o[d0],0,0,0);
    o[d0]=__builtin_amdgcn_mfma_f32_32x32x16_bf16(pa3,PK(3),o[d0],0,0,0);
    #undef PK
  }
}

#ifndef ATTN_STORE16
#define ATTN_STORE16(p,v) (*(u32x4*)(p)=(v))
#endif
template<int THRL> __device__ __forceinline__ void attn_unit(int b,int h,int qb,const bf16*Q,const bf16*__restrict__ K,const bf16*__restrict__ V,bf16*O,const float*__restrict__ kbg,char*shm){
  int tid_=threadIdx.x; asm volatile("":"+v"(tid_)); const int tid=tid_,lane=tid&63,r32=lane&31,hi=lane>>5; const int wid=__builtin_amdgcn_readfirstlane(tid>>6);
  const long rowbase=(long)b*SEQ; const int q0=qb*QB;
  const bf16*Qw=Q+(rowbase+q0+wid*QBLK)*DM+h*D;
  const bf16*Kh=K+rowbase*DM+h*D,*Vh=V+rowbase*DM+h*D;
  const unsigned lds0=(unsigned)(uintptr_t)shm;
  float*wsf=(float*)(shm+LDS_WS)+wid*64;
  const bf16*ksrc=Kh+(long)lane*DM+wid*8;
  const bf16*vsrc=Vh+(long)(16*(wid&3)+(lane>>2))*DM+(wid>>2)*32+(lane&3)*8;
  const unsigned kdst=lds0+LDS_K+wid*1024, vdst=lds0+LDS_V+wid*1024;
  #define DMA_K(t,slot) glds16(ksrc+(long)(t)*KVBLK*DM,(unsigned)__builtin_amdgcn_readfirstlane(kdst+(slot)))
  #define DMA_V(t,slot) glds16(vsrc+(long)(t)*KVBLK*DM,(unsigned)__builtin_amdgcn_readfirstlane(vdst+(slot)))
  const int vb0=(int)(lds0+LDS_V)+((lane>>4)&1)*32+(lane&3)*8+(4*hi+((lane&15)>>2))*64;
  const char*Kbase=shm+LDS_K; bf16x8 kf[8];
  const lds_cptr shm3=(lds_cptr)shm; const lds_cptr kp0=shm3+LDS_K+hi*1024+r32*16; const lds_cptr vp0=shm3+LDS_V+((lane>>4)&1)*32+(lane&3)*8+(4*hi+((lane&15)>>2))*64;
  const int NT=(q0+QB)/KVBLK;
  typedef __attribute__((address_space(3))) float lds_f32; typedef float kb4_t __attribute__((ext_vector_type(4)));
  { lds_f32*kw=(lds_f32*)(shm3+LDS_KB); for(int i=tid;i<NT*KVBLK;i+=NW*64)kw[i]=kbg[i]; }
  const __attribute__((address_space(3))) kb4_t*kbl=(const __attribute__((address_space(3))) kb4_t*)(shm3+LDS_KB)+hi;
  #define KBLOAD(P0,P1,t) do{ const __attribute__((address_space(3))) kb4_t*kb_=kbl+16*(t); \
    _Pragma("unroll") for(int g_=0;g_<4;++g_){ const kb4_t a_=kb_[2*g_], b_=kb_[2*g_+8]; \
      P0[4*g_]=a_[0];P0[4*g_+1]=a_[1];P0[4*g_+2]=a_[2];P0[4*g_+3]=a_[3]; P1[4*g_]=b_[0];P1[4*g_+1]=b_[1];P1[4*g_+2]=b_[2];P1[4*g_+3]=b_[3]; } }while(0)
  DMA_K(0,0);DMA_V(0,0);DMA_K(1,SLOTB);
  bf16x8 qr[4];
  #pragma unroll
  for(int d0=0;d0<4;++d0)qr[d0]=*reinterpret_cast<const bf16x8*>(&Qw[(long)r32*DM+d0*16+hi*8]);
  float mhat=0.f,l_reg=0.f;f32x16 o[2];o[0]=f32x16{};o[1]=f32x16{};
  const int qrel=wid*QBLK+r32;
  #define CMASK(P0,P1,t) do{int jb_=(t)-(NT-4); if(jb_>=0)cmask(P0,P1,jb_,qrel,hi);}while(0)
  bool resc=false;
  #define START(P0,P1) do{ const float rm=rowmax(P0,P1); resc=false; \
    { const float dl=rm; mhat=fadd_s(mhat,dl); \
      _Pragma("unroll") for(int r=0;r<16;++r){P0[r]=fsub_s(P0[r],dl);P1[r]=fsub_s(P1[r],dl);} } \
    _Pragma("unroll") for(int r=0;r<16;++r)P0[r]=__builtin_amdgcn_exp2f(P0[r]); }while(0)
  #define RESC() do{ if(resc){ asm volatile("s_waitcnt lgkmcnt(0)":::"memory"); \
      _Pragma("unroll") for(int d_=0;d_<2;++d_) _Pragma("unroll") for(int r=0;r<16;++r)o[d_][r]*=wsf[crow(r,hi)]; } }while(0)
  f32x16 pA0,pA1,pB0,pB1;
  int sl_prev=0,sl_cur=0,sl_next=SLOTB;
  #define ROT() do{sl_prev=sl_cur;sl_cur=sl_next;sl_next=(sl_next==(NSLOT-1)*SLOTB)?0:sl_next+SLOTB;}while(0)
  DMA_K(2,2*SLOTB);
  WAIT_BAR(3);
  KBLOAD(pA0,pA1,0);
  qkt(pA0,pA1,Kbase,qr,r32,hi);asm volatile("s_nop 15\n\ts_nop 7":"+v"(pA0),"+v"(pA1));CMASK(pA0,pA1,0);
  START(pA0,pA1);
  _Pragma("unroll") for(int r=0;r<16;++r)pA1[r]=__builtin_amdgcn_exp2f(pA1[r]);
  KBLOAD(pB0,pB1,1);
  WAIT_BAR(0);
  DMA_K(3,0);DMA_V(1,SLOTB);
  ROT();
  kload8(kf,kp0+sl_cur);
  WAIT_BAR(2);
  s16x4 vlo[8],vhi[8]; u32x4 pw0,pw1,pw2,pw3;
  #define PKW(P,B) cvtpk_s(P[B],P[B+1])
  #define PAF(k) __builtin_bit_cast(bf16x8,pw##k)
  #define VFR(i) (bf16x8){vlo[i][0],vlo[i][1],vlo[i][2],vlo[i][3],vhi[i][0],vhi[i][1],vhi[i][2],vhi[i][3]}
  #define PIN(x) asm volatile("":"+v"(x))
  #define MX3(a,b,c) __builtin_fmaxf(__builtin_fmaxf((a),(b)),(c))
  #define GAPA(MF,A0,A1,A2,A3,W0,W1,PW) do{ MF; sacc+=A0; sacc+=A1; sacc+=A2; sacc+=A3; PIN(sacc); W0; W1; PIN(PW); SBAR(); }while(0)
  #define EX(v) __builtin_amdgcn_exp2f(v)
  #define GAPB(MF,X,B) do{ MF; X[B]=EX(X[B]); X[B+1]=EX(X[B+1]); X[B+2]=EX(X[B+2]); X[B+3]=EX(X[B+3]); PIN(X); SBAR(); }while(0)
  #define VRD(i) do{ vlo[i]=vtr(vp_+(((i)>>2)*4096+((i)&3)*1024)); vhi[i]=vtr(vp_+(((i)>>2)*4096+((i)&3)*1024+512)); }while(0)
  #define KRD(G,j) do{ if(G){ kload2(kf,kp0+sl_next,j); SBAR(); } }while(0)
  #define STEP(C0,C1,P0,P1,t,GK,GV,GL) do{ SBAR(); \
    const lds_cptr vp_=vp0+sl_prev; \
    VRD(0); SBAR(); float sacc=(P0[0]+P0[1]); \
    GAPA(C0=__builtin_amdgcn_mfma_f32_32x32x16_bf16(kf[0],qr[0],C0,0,0,0), P0[2],P0[3],P0[4],P0[5],     pw0[0]=PKW(P0,0), pw0[1]=PKW(P0,2), pw0); \
    VRD(4); SBAR(); GAPA(C1=__builtin_amdgcn_mfma_f32_32x32x16_bf16(kf[1],qr[0],C1,0,0,0), P0[6],P0[7],P0[8],P0[9],     pw0[2]=PKW(P0,4), pw0[3]=PKW(P0,6), pw0); \
    VRD(1); SBAR(); GAPA(C0=__builtin_amdgcn_mfma_f32_32x32x16_bf16(kf[2],qr[1],C0,0,0,0),   P0[10],P0[11],P0[12],P0[13], pw1[0]=PKW(P0,8), pw1[1]=PKW(P0,10), pw1); \
    VRD(5); SBAR(); GAPA(C1=__builtin_amdgcn_mfma_f32_32x32x16_bf16(kf[3],qr[1],C1,0,0,0),   P0[14],P0[15],P1[0],P1[1],   pw1[2]=PKW(P0,12),pw1[3]=PKW(P0,14), pw1); \
    VRD(2); SBAR(); GAPA(C0=__builtin_amdgcn_mfma_f32_32x32x16_bf16(kf[4],qr[2],C0,0,0,0),   P1[2],P1[3],P1[4],P1[5],     pw2[0]=PKW(P1,0), pw2[1]=PKW(P1,2), pw2); \
    VRD(6); SBAR(); GAPA(C1=__builtin_amdgcn_mfma_f32_32x32x16_bf16(kf[5],qr[2],C1,0,0,0),   P1[6],P1[7],P1[8],P1[9],     pw2[2]=PKW(P1,4), pw2[3]=PKW(P1,6), pw2); \
    VRD(3); SBAR(); GAPA(C0=__builtin_amdgcn_mfma_f32_32x32x16_bf16(kf[6],qr[3],C0,0,0,0),   P1[10],P1[11],P1[12],P1[13], pw3[0]=PKW(P1,8), pw3[1]=PKW(P1,10), pw3); \
    VRD(7); SBAR(); GAPA(C1=__builtin_amdgcn_mfma_f32_32x32x16_bf16(kf[7],qr[3],C1,0,0,0),   P1[14],P1[15],0.f,0.f,       pw3[2]=PKW(P1,12),pw3[3]=PKW(P1,14), pw3); \
    l_reg+=sacc; \
    if(GK){DMA_K((t)+3,sl_cur);} if(GV){DMA_V((t)+1,sl_next);} \
    _Pragma("unroll") for(int r=0;r<16;++r){C0[r]-=mhat;C1[r]-=mhat;} \
    CMASK(C0,C1,t); \
    { float a=MX3(C0[0],C0[1],C1[0]),b=MX3(C0[2],C0[3],C1[1]); a=MX3(a,C1[2],C1[3]); \
      _Pragma("unroll") for(int r=4;r<16;r+=4){a=MX3(a,C0[r],C0[r+1]);b=MX3(b,C0[r+2],C0[r+3]);a=MX3(a,C1[r],C1[r+1]);b=MX3(b,C1[r+2],C1[r+3]);} \
      float rm=__builtin_fmaxf(a,b); { auto rr=__builtin_amdgcn_permlane32_swap(__float_as_uint(rm),__float_as_uint(rm),false,false); rm=__builtin_fmaxf(__uint_as_float(rr[0]),__uint_as_float(rr[1])); } \
      resc=false; \
      if(__builtin_expect(__any(rm>(float)THRL),0)){ const float dl=__builtin_fmaxf(rm,0.f); mhat+=dl; \
        _Pragma("unroll") for(int r=0;r<16;++r){C0[r]-=dl;C1[r]-=dl;} \
        const float f=__builtin_amdgcn_exp2f(-dl); l_reg*=f; if(hi==0)wsf[r32]=f; resc=true; } } \
    SBAR(); \
    KBLOAD(P0,P1,(t)+1); SBAR(); \
    GAPB(o[0]=__builtin_amdgcn_mfma_f32_32x32x16_bf16(PAF(0),VFR(0),o[0],0,0,0), C0,0); \
    GAPB(o[1]=__builtin_amdgcn_mfma_f32_32x32x16_bf16(PAF(0),VFR(4),o[1],0,0,0), C0,4); \
    KRD(GL,0); GAPB(o[0]=__builtin_amdgcn_mfma_f32_32x32x16_bf16(PAF(1),VFR(1),o[0],0,0,0), C0,8); \
    KRD(GL,1); GAPB(o[1]=__builtin_amdgcn_mfma_f32_32x32x16_bf16(PAF(1),VFR(5),o[1],0,0,0), C0,12); \
    KRD(GL,2); GAPB(o[0]=__builtin_amdgcn_mfma_f32_32x32x16_bf16(PAF(2),VFR(2),o[0],0,0,0), C1,0); \
    KRD(GL,3); GAPB(o[1]=__builtin_amdgcn_mfma_f32_32x32x16_bf16(PAF(2),VFR(6),o[1],0,0,0), C1,4); \
    GAPB(o[0]=__builtin_amdgcn_mfma_f32_32x32x16_bf16(PAF(3),VFR(3),o[0],0,0,0), C1,8); \
    GAPB(o[1]=__builtin_amdgcn_mfma_f32_32x32x16_bf16(PAF(3),VFR(7),o[1],0,0,0), C1,12); \
    }while(0)
  int t=1;
  #undef CMASK
  #define CMASK(P0,P1,t) do{}while(0)
  for(;t+5<NT;t+=2){
    STEP(pB0,pB1,pA0,pA1,t,true,true,true);     WAIT_BAR(2); RESC(); ROT();
    STEP(pA0,pA1,pB0,pB1,t+1,true,true,true);   WAIT_BAR(2); RESC(); ROT();
  }
  #undef CMASK
  #define CMASK(P0,P1,t) do{int jb_=(t)-(NT-4); if(jb_>=0)cmask(P0,P1,jb_,qrel,hi);}while(0)
  #define ENDW(tt) do{ if((tt)+3<NT){WAIT_BAR(2);} else if((tt)+2<NT){WAIT_BAR(1);} else {WAIT_BAR(0);} }while(0)
  for(;t+1<NT;t+=2){
    STEP(pB0,pB1,pA0,pA1,t,(t+3<NT),(t+1<NT),(t+1<NT));       ENDW(t);   RESC(); ROT();
    STEP(pA0,pA1,pB0,pB1,t+1,(t+4<NT),(t+2<NT),(t+2<NT));     ENDW(t+1); RESC(); ROT();
  }
  STEP(pB0,pB1,pA0,pA1,NT-1,false,false,false); RESC();
  { float sacc=pB0[0]+pB0[1]; _Pragma("unroll") for(int r=2;r<16;++r)sacc+=pB0[r]; _Pragma("unroll") for(int r=0;r<16;++r)sacc+=pB1[r]; l_reg+=sacc;
    pw0=(u32x4){PKW(pB0,0),PKW(pB0,2),PKW(pB0,4),PKW(pB0,6)};pw1=(u32x4){PKW(pB0,8),PKW(pB0,10),PKW(pB0,12),PKW(pB0,14)};pw2=(u32x4){PKW(pB1,0),PKW(pB1,2),PKW(pB1,4),PKW(pB1,6)};pw3=(u32x4){PKW(pB1,8),PKW(pB1,10),PKW(pB1,12),PKW(pB1,14)};
    SBAR(); pv(o,vb0+sl_cur,PAF(0),PAF(1),PAF(2),PAF(3)); }
  #undef PKW
  #undef PAF
  #undef VFR
  #undef PIN
  #undef MX3
  #undef GAPA
  #undef GAPB
  #undef EX
  #undef VRD
  #undef KRD
  #undef STEP
  #undef ENDW
  {auto rr=__builtin_amdgcn_permlane32_swap(__float_as_uint(l_reg),__float_as_uint(l_reg),false,false);l_reg=__uint_as_float(rr[0])+__uint_as_float(rr[1]);}
  if(hi==0)wsf[32+r32]=l_reg;asm volatile("s_waitcnt lgkmcnt(0)":::"memory");
  float rli[16];
  #pragma unroll
  for(int r=0;r<16;++r)rli[r]=__builtin_amdgcn_rcpf(wsf[32+crow(r,hi)]);
  bf16*Ow=O+(rowbase+q0+wid*QBLK)*OP+h*D;
  { bf16*stg=(bf16*)(shm+LDS_OST)+wid*2048;
    #pragma unroll
    for(int r=0;r<16;++r){const int orow=crow(r,hi);
      #pragma unroll
      for(int d0=0;d0<2;++d0)stg[orow*64+d0*32+r32]=__float2bfloat16(o[d0][r]*rli[r]);}
    asm volatile("s_waitcnt lgkmcnt(0)":::"memory");
    #pragma unroll
    for(int i=0;i<4;++i){const int row=i*8+(lane>>3),ch=lane&7; const u32x4 v=*(const u32x4*)(stg+row*64+ch*8); if(q0+wid*QBLK+row<SEQ)ATTN_STORE16(Ow+(long)row*OP+ch*8,v);} }
  asm volatile("s_waitcnt lgkmcnt(0)\n\ts_barrier":::"memory");
  #undef KBLOAD
  #undef DMA_K
  #undef DMA_V
  #undef CMASK
  #undef START
  #undef RESC
  #undef ROT
}
constexpr int ATTN_LDS_BYTES=LDS_BYTES;
#undef SBAR
#undef WAIT_BAR
}

__device__ __forceinline__ void mix_queue(const Ctx& c, unsigned char* lds_generic, int layer, const bf16_t* SD, unsigned* qctr);

namespace hg {
constexpr int P = 272, PA = 144;
constexpr int O_QE = 0, O_QS = 17408, O_KS = 34816, O_VT = 52224, O_ST = 69632, O_AM = 104448, O_QT = 113664, O_RS = 115712, O_END = 117760;
typedef short v4i16_t __attribute__((ext_vector_type(4)));
__device__ __forceinline__ f32x4 mfma16(bf16x8 a, bf16x8 b, f32x4 c) { return __builtin_amdgcn_mfma_f32_16x16x32_bf16(a, b, c, 0, 0, 0); }
__device__ __forceinline__ bf16x8 tr_frag(const LAS unsigned char* p, int pitch) {
    const v4i16_t lo = __builtin_amdgcn_ds_read_tr16_b64_v4i16((LAS v4i16_t*)p);
    const v4i16_t hi = __builtin_amdgcn_ds_read_tr16_b64_v4i16((LAS v4i16_t*)(p + 4 * pitch));
    return (bf16x8){lo[0], lo[1], lo[2], lo[3], hi[0], hi[1], hi[2], hi[3]};
}
}

__device__ __forceinline__ void hgrn_A_unit(const Ctx& c, LAS unsigned char* lds, int bh, int ch, bf16_t* SD, float* DV) {
    using namespace hg;
    int tid_ = threadIdx.x; asm volatile("" : "+v"(tid_)); const int tid = tid_, lane = tid & 63, w = __builtin_amdgcn_readfirstlane(tid >> 6);
    const int b = bh >> 2, hh = bh & 3; const size_t r0 = (size_t)b * LV + 64 * ch;
    const int k = tid & 127, sq = tid >> 7;
    float g[16], bl[16];
    { const float* gp = c.LOGF + (r0 + 16 * sq) * 512 + hh * 128 + k; float s = 0.f;
#pragma unroll
      for (int i = 0; i < 16; ++i) { g[i] = gp[(size_t)i * 512]; s += g[i]; bl[i] = s; }
      ((LAS float*)(lds + O_QT))[sq * 128 + k] = s; }
#pragma unroll
    for (int i = 0; i < 2; ++i) { const int id = tid + 512 * i, row = id >> 4, cc = id & 15;
        const u32x4 v = *(const u32x4*)(c.HV + (r0 + row) * 512 + hh * 128 + cc * 8); *(LAS u32x4*)(lds + O_VT + row * P + cc * 16) = v; }
    __syncthreads();
    { const LAS float* qt = (const LAS float*)(lds + O_QT); float pre = 0.f, tot = 0.f;
#pragma unroll
      for (int q = 0; q < 4; ++q) { const float t = qt[q * 128 + k]; tot += t; if (q < sq) pre += t; }
#pragma unroll
      for (int i = 0; i < 16; ++i) { const float kd = (1.f - __expf(g[i])) * __expf(tot - (pre + bl[i])); *(LAS bf16_t*)(lds + O_KS + (16 * sq + i) * P + 2 * k) = (bf16_t)f2bf(kd); }
      if (sq == 0) DV[((size_t)bh * 64 + ch) * 128 + k] = __expf(tot); }
    __syncthreads();
    const int fr = lane & 15, g4 = lane >> 4, q = fr >> 2, p = lane & 3;
    const LAS unsigned char* abase = lds + O_VT + (8 * g4 + q) * P + w * 32 + p * 8;
    const LAS unsigned char* bbase = lds + O_KS + (8 * g4 + q) * P + p * 8;
    bf16x8 a[2]; a[0] = tr_frag(abase, P); a[1] = tr_frag(abase + 32 * P, P);
    bf16_t* od = SD + ((size_t)bh * 64 + ch) * 16384 + (size_t)(16 * w + 4 * g4) * 128 + fr;
#pragma unroll
    for (int ct = 0; ct < 8; ++ct) { f32x4 acc = (f32x4){0.f, 0.f, 0.f, 0.f};
        acc = mfma16(a[0], tr_frag(bbase + ct * 32, P), acc); acc = mfma16(a[1], tr_frag(bbase + 32 * P + ct * 32, P), acc);
#pragma unroll
        for (int j = 0; j < 4; ++j) od[j * 128 + 16 * ct] = (bf16_t)f2bf(acc[j]); }
    __syncthreads();
}

__device__ __forceinline__ void hgrn_B_scan(const Ctx& c, bf16_t* SD, const float* DV) {
    const int gt = blockIdx.x * NTHREADS + c.tid, NGT = gridDim.x * NTHREADS;
    for (int pidx = gt; pidx < 16 * 8192; pidx += NGT) {
        const int bh = pidx >> 13, e2 = pidx & 8191, k = (e2 & 63) * 2;
        unsigned* sp = (unsigned*)(SD + (size_t)bh * 64 * 16384 + 2 * e2);
        const float* dp = DV + (size_t)bh * 64 * 128 + k;
        float s0 = 0.f, s1 = 0.f;
#pragma unroll 8
        for (int ch = 0; ch < 64; ++ch) { const unsigned d = sp[(size_t)ch * 8192]; const float d0 = dp[ch * 128], d1 = dp[ch * 128 + 1];
            s0 = d0 * s0 + __builtin_bit_cast(float, d << 16); s1 = d1 * s1 + __builtin_bit_cast(float, d & 0xffff0000u);
            sp[(size_t)ch * 8192] = pk2(s0, s1); }
    }
}

__device__ __forceinline__ void hgrn_C_unit(const Ctx& c, LAS unsigned char* lds, int layer, int bh, int ch, const bf16_t* SD) {
    using namespace hg;
    int tid_ = threadIdx.x; asm volatile("" : "+v"(tid_)); const int tid = tid_, lane = tid & 63, w = __builtin_amdgcn_readfirstlane(tid >> 6);
    const int b = bh >> 2, hh = bh & 3; const size_t r0 = (size_t)b * LV + 64 * ch;
    const int k = tid & 127, sq = tid >> 7;
    float g[16], bl[16], qv[16];
    { const float* gp = c.LOGF + (r0 + 16 * sq) * 512 + hh * 128 + k; const bf16_t* qp = c.HXQ + (r0 + 16 * sq) * 512 + hh * 128 + k; float s = 0.f;
#pragma unroll
      for (int i = 0; i < 16; ++i) { g[i] = gp[(size_t)i * 512]; qv[i] = bf2f(qp[(size_t)i * 512]); s += g[i]; bl[i] = s; }
      ((LAS float*)(lds + O_QT))[sq * 128 + k] = s; }
#pragma unroll
    for (int i = 0; i < 2; ++i) { const int id = tid + 512 * i, row = id >> 4, cc = id & 15;
        const u32x4 v = *(const u32x4*)(c.HV + (r0 + row) * 512 + hh * 128 + cc * 8); *(LAS u32x4*)(lds + O_VT + row * P + cc * 16) = v; }
    if (ch > 0) {
        const bf16_t* sp = SD + ((size_t)bh * 64 + ch - 1) * 16384;
#pragma unroll
        for (int i = 0; i < 4; ++i) { const int id = tid + 512 * i, row = id >> 4, cc = id & 15; const u32x4 v = *(const u32x4*)(sp + row * 128 + cc * 8); *(LAS u32x4*)(lds + O_ST + row * P + cc * 16) = v; }
    }
    __syncthreads();
    { const LAS float* qt = (const LAS float*)(lds + O_QT); float pre = 0.f;
#pragma unroll
      for (int q = 0; q < 4; ++q) { const float t = qt[q * 128 + k]; if (q < sq) pre += t; }
      const float rr = qt[k] + qt[128 + k];
#pragma unroll
      for (int i = 0; i < 16; ++i) { const float bb = pre + bl[i]; const int off = (16 * sq + i) * P + 2 * k;
          *(LAS bf16_t*)(lds + O_QE + off) = (bf16_t)f2bf(qv[i] * __expf(bb));
          *(LAS bf16_t*)(lds + O_QS + off) = (bf16_t)f2bf(qv[i] * __expf(fminf(bb - rr, 80.f)));
          *(LAS bf16_t*)(lds + O_KS + off) = (bf16_t)f2bf((1.f - __expf(g[i])) * __expf(fminf(rr - bb, 80.f))); } }
    __syncthreads();
    const int fr = lane & 15, g4 = lane >> 4, q = fr >> 2, p = lane & 3;
#pragma unroll
    for (int tl = 0; tl < 2; ++tl) { const int tile = 2 * w + tl, ti = tile >> 2, sj = tile & 3;
        f32x4 acc = (f32x4){0.f, 0.f, 0.f, 0.f};
        if (sj <= ti) {
#pragma unroll
            for (int ks = 0; ks < 4; ++ks) { const bf16x8 a = *(const LAS bf16x8*)(lds + O_QS + (16 * ti + fr) * P + (32 * ks + 8 * g4) * 2);
                const bf16x8 bb = *(const LAS bf16x8*)(lds + O_KS + (16 * sj + fr) * P + (32 * ks + 8 * g4) * 2); acc = mfma16(a, bb, acc); } }
#pragma unroll
        for (int j = 0; j < 4; ++j) { const int t = 16 * ti + 4 * g4 + j, s = 16 * sj + fr; const float v = (s <= t) ? acc[j] : 0.f; *(LAS bf16_t*)(lds + O_AM + t * PA + 2 * s) = (bf16_t)f2bf(v); } }
    __syncthreads();
    f32x4 acc[4];
#pragma unroll
    for (int tt = 0; tt < 4; ++tt) acc[tt] = (f32x4){0.f, 0.f, 0.f, 0.f};
    if (ch > 0) {
#pragma unroll
        for (int ks = 0; ks < 4; ++ks) { const bf16x8 bfr = *(const LAS bf16x8*)(lds + O_ST + (16 * w + fr) * P + (32 * ks + 8 * g4) * 2);
#pragma unroll
            for (int tt = 0; tt < 4; ++tt) { const bf16x8 a = *(const LAS bf16x8*)(lds + O_QE + (16 * tt + fr) * P + (32 * ks + 8 * g4) * 2); acc[tt] = mfma16(a, bfr, acc[tt]); } }
    }
#pragma unroll
    for (int ks = 0; ks < 2; ++ks) { const bf16x8 bfr = tr_frag(lds + O_VT + (32 * ks + 8 * g4 + q) * P + w * 32 + p * 8, P);
#pragma unroll
        for (int tt = 0; tt < 4; ++tt) { const bf16x8 a = *(const LAS bf16x8*)(lds + O_AM + (16 * tt + fr) * PA + (32 * ks + 8 * g4) * 2); acc[tt] = mfma16(a, bfr, acc[tt]); } }
    LAS float* rs = (LAS float*)(lds + O_RS);
#pragma unroll
    for (int tt = 0; tt < 4; ++tt)
#pragma unroll
        for (int j = 0; j < 4; ++j) { float s2 = acc[tt][j] * acc[tt][j]; s2 += __shfl_xor(s2, 1); s2 += __shfl_xor(s2, 2); s2 += __shfl_xor(s2, 4); s2 += __shfl_xor(s2, 8);
            if (fr == 0) rs[(16 * tt + 4 * g4 + j) * 8 + w] = s2; }
    __syncthreads();
    { const int v = 16 * w + fr; const float nw = c.hnw[layer * 128 + v];
#pragma unroll
      for (int tt = 0; tt < 4; ++tt)
#pragma unroll
        for (int j = 0; j < 4; ++j) { const int t = 16 * tt + 4 * g4 + j; const f32x4 s0 = *(const LAS f32x4*)(rs + t * 8), s1 = *(const LAS f32x4*)(rs + t * 8 + 4);
            const float ss = ((s0[0] + s0[1]) + (s0[2] + s0[3])) + ((s1[0] + s1[1]) + (s1[2] + s1[3])); const float rstd = 1.f / sqrtf(ss * (1.f / 128.f) + EPS);
            const float gate = bf2f(c.HG[(r0 + t) * 512 + hh * 128 + v]);
            c.MIX[(r0 + t) * DM + 512 + hh * 128 + v] = (bf16_t)f2bf(acc[tt][j] * rstd * nw * gate); } }
    __syncthreads();
}

__device__ __forceinline__ void mix_queue(const Ctx& c, unsigned char* lds_generic, int layer, const bf16_t* SD, unsigned* qctr) {
    LAS volatile int* slot = (LAS volatile int*)((LAS unsigned char*)lds_generic + 131072);
    for (;;) {
        if (c.tid == 0) slot[0] = (int)atomicAdd(qctr, 1u);
        __syncthreads();
        const int n = slot[0];
        if (n >= 17 * 32 + 16 * 65) break;
        if (n < 17 * 32) {
            const int qb = 16 - (n >> 5), bh = n & 31;
            attn_body::attn_unit<8>(bh >> 3, bh & 7, qb, (const attn_body::bf16*)c.QB, (const attn_body::bf16*)c.KB, (const attn_body::bf16*)c.VB, (attn_body::bf16*)c.MIX,
                                    c.kbias + (size_t)bh * KBL, (char*)lds_generic);
        } else {
            const int u = n - 17 * 32, bh = u / 65, ch = u - bh * 65;
            hgrn_C_unit(c, (LAS unsigned char*)lds_generic, layer, bh, ch, SD);
        }
    }
}

__device__ __forceinline__ void fox_simple(const Ctx& c, LAS unsigned char* lds, int first_block) {
    LAS float* sc = (LAS float*)(lds + c.wave * 16896);
    LAS float* qs = sc; LAS float* ps = sc + 64;
    const int nblk = gridDim.x - first_block; if ((int)blockIdx.x < first_block) return;
    const int gw = ((int)blockIdx.x - first_block) * NWAVES + c.wave, NGW = nblk * NWAVES;
    for (int it = gw; it < MROWS * FOXH; it += NGW) {
        const int r = it >> 3, h = it & 7, b = r / LV, vp = r - b * LV;
        bf16_t* op = c.MIX + (size_t)r * DM + h * 64;
        if (vp < PADF) { op[c.lane] = 0; continue; }
        qs[c.lane] = bf2f(c.QB[(size_t)r * 512 + h * 64 + c.lane]);
        asm volatile("s_waitcnt lgkmcnt(0)" ::: "memory");
        const float* kb = c.kbias + (size_t)(b * 8 + h) * KBL;
        float mx = -3.0e38f;
        for (int j = PADF + c.lane; j <= vp; j += 64) {
            const bf16_t* kr = c.KB + (size_t)(b * LV + j) * 512 + h * 64; float s = 0.f;
#pragma unroll
            for (int d8 = 0; d8 < 8; ++d8) { const bf16x8 kv = *(const bf16x8*)(kr + d8 * 8);
#pragma unroll
                for (int e = 0; e < 8; ++e) s += qs[d8 * 8 + e] * bf2f((unsigned short)kv[e]); }
            s += kb[j]; ps[j] = s; mx = fmaxf(mx, s);
        }
        mx = wave_max(mx);
        float l = 0.f;
        for (int j = PADF + c.lane; j <= vp; j += 64) { const float p = exp2f(ps[j] - mx); ps[j] = p; l += p; }
        l = wave_sum(l);
        asm volatile("s_waitcnt lgkmcnt(0)" ::: "memory");
        float o = 0.f;
        const bf16_t* vr = c.VB + (size_t)(b * LV) * 512 + h * 64 + c.lane;
        for (int j = PADF; j <= vp; ++j) o += ps[j] * bf2f(vr[(size_t)j * 512]);
        op[c.lane] = (bf16_t)f2bf(o / l);
        asm volatile("s_waitcnt lgkmcnt(0)" ::: "memory");
    }
}

__device__ __forceinline__ void hgrn_simple(const Ctx& c, LAS unsigned char* lds, int layer) {
    if (blockIdx.x >= NB * HGH) return;
    const int b = blockIdx.x >> 2, hh = blockIdx.x & 3;
    LAS float* fL = (LAS float*)lds;
    LAS float* kL = fL + 2048; LAS float* qL = kL + 2048; LAS float* vL = qL + 2048; LAS float* oP = vL + 2048;
    const int v = c.tid & 127, kg = c.tid >> 7;
    float S[32];
#pragma unroll
    for (int i = 0; i < 32; ++i) S[i] = 0.f;
    for (int i = c.tid; i < PADF * 128; i += NTHREADS) { const int vp = i >> 7; c.MIX[(size_t)(b * LV + vp) * DM + 512 + hh * 128 + (i & 127)] = 0; }
    for (int t0 = PADF; t0 < LV; t0 += 16) {
        for (int i = c.tid; i < 2048; i += NTHREADS) { const int t = i >> 7, k = i & 127; const size_t o = (size_t)(b * LV + t0 + t) * 512 + hh * 128 + k;
            const float f = __expf(c.LOGF[o]); fL[i] = f; kL[i] = 1.f - f; qL[i] = bf2f(c.HXQ[o]); vL[i] = bf2f(c.HV[o]); }
        __syncthreads();
        for (int t = 0; t < 16; ++t) { const float vv = vL[t * 128 + v]; float part = 0.f;
#pragma unroll
            for (int i = 0; i < 32; ++i) { const int k = kg * 32 + i; S[i] = fL[t * 128 + k] * S[i] + kL[t * 128 + k] * vv; part += S[i] * qL[t * 128 + k]; }
            oP[(kg * 16 + t) * 128 + v] = part; }
        __syncthreads();
        for (int tt = 0; tt < 2; ++tt) { const int t = c.wave * 2 + tt; float o0, o1;
            { const int v0 = c.lane, v1 = c.lane + 64; o0 = oP[t * 128 + v0] + oP[(16 + t) * 128 + v0] + oP[(32 + t) * 128 + v0] + oP[(48 + t) * 128 + v0];
              o1 = oP[t * 128 + v1] + oP[(16 + t) * 128 + v1] + oP[(32 + t) * 128 + v1] + oP[(48 + t) * 128 + v1]; }
            const float ss = wave_sum(o0 * o0 + o1 * o1); const float rstd = 1.f / sqrtf(ss * (1.f / 128.f) + EPS);
            const size_t ro = (size_t)(b * LV + t0 + t);
            const float g0 = bf2f(c.HG[ro * 512 + hh * 128 + c.lane]), g1 = bf2f(c.HG[ro * 512 + hh * 128 + c.lane + 64]);
            c.MIX[ro * DM + 512 + hh * 128 + c.lane] = (bf16_t)f2bf(o0 * rstd * c.hnw[layer * 128 + c.lane] * g0);
            c.MIX[ro * DM + 512 + hh * 128 + c.lane + 64] = (bf16_t)f2bf(o1 * rstd * c.hnw[layer * 128 + c.lane + 64] * g1); }
        __syncthreads();
    }
}

__device__ __forceinline__ void final_norm(const Ctx& c) {
    for (int r = c.gw; r < NB * SEQ; r += c.NGW) {
        float* hp = c.out + (size_t)r * DM; f32x4 v[4]; float s = 0.f;
#pragma unroll
        for (int j = 0; j < 4; ++j) { v[j] = *(const f32x4*)(hp + 4 * c.lane + 256 * j); s += (v[j].x * v[j].x + v[j].y * v[j].y) + (v[j].z * v[j].z + v[j].w * v[j].w); }
        s = wave_sum(s); const float rstd = 1.f / sqrtf(s * (1.f / DM) + EPS);
#pragma unroll
        for (int j = 0; j < 4; ++j) { const f32x4 w = *(const f32x4*)(c.nfinal + 4 * c.lane + 256 * j); *(f32x4*)(hp + 4 * c.lane + 256 * j) = v[j] * rstd * w; }
    }
}

__global__ void __launch_bounds__(NTHREADS, 2) fwd_kernel(Args a) {
    extern __shared__ __attribute__((aligned(16))) unsigned char lds_raw[];
    LAS unsigned char* lds = (LAS unsigned char*)lds_raw;
    cg::grid_group grid = cg::this_grid();
    Ctx c;
    c.x = a.in[0]; c.meta = a.in[1]; c.nmw = a.in[2]; c.win = a.in[3]; c.fbias = a.in[4]; c.lbraw = a.in[5]; c.hnw = a.in[6]; c.wout = a.in[7];
    c.nfw = a.in[8]; c.wg = a.in[9]; c.wu = a.in[10]; c.wd = a.in[11]; c.nfinal = a.in[12];
    c.out = a.out; c.ws = a.ws;
    c.ctl = (unsigned*)(a.ws + WS_CTL); c.sumsq = (float*)(a.ws + WS_SUMSQ); c.lbv = (float*)(a.ws + WS_LBV); c.logf8 = (float*)(a.ws + WS_LOGF8);
    c.kbias = (float*)(a.ws + WS_KBIAS); c.hs = (float*)(a.ws + WS_HS);
    c.HB = (bf16_t*)(a.ws + WS_HB); c.MIX = (bf16_t*)(a.ws + WS_MIX); c.QB = (bf16_t*)(a.ws + WS_QB); c.KB = (bf16_t*)(a.ws + WS_KB); c.VB = (bf16_t*)(a.ws + WS_VB);
    c.HXQ = (bf16_t*)(a.ws + WS_HXQ); c.LOGF = (float*)(a.ws + WS_LOGF); c.HV = (bf16_t*)(a.ws + WS_HV); c.HG = (bf16_t*)(a.ws + WS_HG); c.ACT = (bf16_t*)(a.ws + WS_ACT);
    c.tid = threadIdx.x; c.lane = c.tid & 63; c.wave = __builtin_amdgcn_readfirstlane(c.tid >> 6);
    c.gw = blockIdx.x * NWAVES + c.wave; c.NGW = gridDim.x * NWAVES;
    volatile LAS unsigned* bst = (volatile LAS unsigned*)(lds + 131072 + 64);
    if (c.tid == 0) { bst[0] = 0u; bst[1] = 0u; }
    __syncthreads();
    const XcdBarrier bar = xcd_barrier_post((unsigned*)(a.ws + WS_BAR), bst);
#define GSYNC() xcd_barrier(bar)
    bf16_t* SD = (bf16_t*)(a.ws + WS_HB);
    float* DV = (float*)(a.ws + WS_DV);

    { const int gt = blockIdx.x * NTHREADS + c.tid, NGT = gridDim.x * NTHREADS;
      for (int i = gt; i < 16384; i += NGT) c.ctl[i] = (i == 8) ? 1u : 0u;
      for (int i = gt; i < 2 * MALLOC; i += NGT) c.sumsq[2 * MALLOC + i] = 0.f;
      for (int i = gt; i < HGW; i += NGT) c.lbv[i] = 1.f / (1.f + __expf(c.lbraw[i] - c.lbraw[HGW + i])); }
    p0_weights(c, lds);
    __syncthreads();
    if constexpr (DUPMASK & 1) { LAUNDER0(); p0_weights(c, lds); __syncthreads(); }
    ff_rows(c, lds, 0);
    grid.sync();
#define LAUNDER() asm volatile("" : "+v"(c.tid), "+v"(c.lane))
    for (int layer = 0; layer < 2; ++layer) {
        LAUNDER();
        if (layer) { ff_rows(c, lds, 1); GSYNC(); }
        LAUNDER();
        kbias_build(c);
        LAUNDER();
        if constexpr (FASTMASK & 1) gemm_fast<0>(c, lds, layer); else gemm_simple<0>(c, layer);
        if constexpr (DUPMASK & 2) { LAUNDER(); gemm_fast<0>(c, lds, layer); }
        GSYNC();
        LAUNDER();
        for (int u = blockIdx.x; u < 16 * 64; u += gridDim.x) hgrn_A_unit(c, lds, u >> 6, u & 63, SD, DV);
        if constexpr (DUPMASK & 4) { LAUNDER(); for (int u = blockIdx.x; u < 16 * 64; u += gridDim.x) hgrn_A_unit(c, lds, u >> 6, u & 63, SD, DV); }
        GSYNC();
        LAUNDER();
        hgrn_B_scan(c, SD, DV);
        GSYNC();
        LAUNDER();
        mix_queue(c, lds_raw, layer, SD, c.ctl + 64 * (1 + layer));
        if constexpr (DUPMASK & 8) { LAUNDER(); mix_queue(c, lds_raw, layer, SD, c.ctl + 64 * (3 + layer)); }
        if constexpr (DUPMASK & 128) { for (int i = 0; i < 8; ++i) GSYNC(); }
        GSYNC();
        LAUNDER();
        if constexpr (DUPMASK & 16) { gemm_fast<1>(c, lds, layer, c.ctl[8]); LAUNDER(); }
        if constexpr (FASTMASK & 2) gemm_fast<1>(c, lds, layer); else gemm_simple<1>(c, layer);
        GSYNC();
        if constexpr (FASTMASK & 4) gemm_fast<2>(c, lds, layer); else gemm_simple<2>(c, layer);
        if constexpr (DUPMASK & 32) { LAUNDER(); gemm_fast<2>(c, lds, layer); }
        GSYNC();
        if constexpr (DUPMASK & 64) { gemm_fast<3>(c, lds, layer, c.ctl[8]); LAUNDER(); }
        if constexpr (FASTMASK & 8) gemm_fast<3>(c, lds, layer); else gemm_simple<3>(c, layer);
        GSYNC();
    }
    LAUNDER();
    final_norm(c);
}

extern "C" void kernel_launch(void* const* d_in, const int* in_sizes, int n_in, void* d_out, int out_size, void* d_ws, size_t ws_size, hipStream_t stream) {
    static int grid = 0;
    if (grid == 0) {
        if (n_in != 13 || out_size != NB * SEQ * DM || ws_size < WS_END) { fprintf(stderr, "kernel_launch: unexpected shapes n_in %d out %d ws %zu\n", n_in, out_size, ws_size); grid = -1; return; }
        int dev = 0, cus = 0, per_cu = 0;
        (void)hipGetDevice(&dev); (void)hipDeviceGetAttribute(&cus, hipDeviceAttributeMultiprocessorCount, dev);
        (void)hipFuncSetAttribute((const void*)fwd_kernel, hipFuncAttributeMaxDynamicSharedMemorySize, LDS_BYTES);
        (void)hipOccupancyMaxActiveBlocksPerMultiprocessor(&per_cu, (const void*)fwd_kernel, NTHREADS, LDS_BYTES);
        if (per_cu < 1) per_cu = 1;
        grid = cus * per_cu;
        (void)hipGetLastError();
    }
    if (grid < 0) return;
    Args a{};
    for (int i = 0; i < 13; ++i) a.in[i] = (const float*)d_in[i];
    a.out = (float*)d_out; a.ws = (unsigned char*)d_ws;
    (void)hipMemsetAsync((unsigned char*)d_ws + WS_BAR, 0, 16384, stream);
    void* args[] = {&a};
    hipError_t e = hipLaunchCooperativeKernel((const void*)fwd_kernel, dim3(grid), dim3(NTHREADS), args, LDS_BYTES, stream);
    if (e != hipSuccess) fprintf(stderr, "cooperative launch failed: %s (grid %d)\n", hipGetErrorString(e), grid);
}
```

```cpp
#include <hip/hip_runtime.h>
#include <hip/hip_cooperative_groups.h>
#include <cstdint>
#include <cstdio>
namespace cg = cooperative_groups;

typedef unsigned short bf16_t;
typedef short bf16x8 __attribute__((ext_vector_type(8)));
typedef float f32x4 __attribute__((ext_vector_type(4)));
typedef unsigned u32x4 __attribute__((ext_vector_type(4)));
#define LAS __attribute__((address_space(3)))

constexpr int DM = 1024, NB = 4, SEQ = 4096, NMETA = 16, PADF = 48, LV = 4160, MROWS = NB * LV, MALLOC = MROWS + 256;
constexpr int FOXH = 8, FOXD = 64, FOXW = 512, HGH = 4, HGK = 128, HGV = 128, HGW = 512, DFF = 2816, INCOLS = 3592, NIN = 3584, NINP = 3840;
constexpr int KBL = 4352;
constexpr float EPS = 1e-6f, LOG2E = 1.4426950408889634f, C2 = 0.125f * LOG2E, HGQS = 0.08838834764831845f;
constexpr int NTHREADS = 512, NWAVES = 8;
constexpr int LDS_BYTES = 147456;
#ifndef FASTMASK
#define FASTMASK 15
#endif
#ifndef DUPMASK
#define DUPMASK 0
#endif

constexpr size_t MiB = 1u << 20;
constexpr size_t WS_CTL = 0;
constexpr size_t WS_SUMSQ = 64 * 1024;
constexpr size_t SUMSQ_STRIDE = (size_t)MALLOC * 4;
constexpr size_t WS_LBV = WS_SUMSQ + 4 * SUMSQ_STRIDE;
constexpr size_t WS_LOGF8 = WS_LBV + 4096;
constexpr size_t WS_KBIAS = WS_LOGF8 + (size_t)MALLOC * 32;
constexpr size_t WS_DV = WS_KBIAS + 32 * KBL * 4;
constexpr size_t WS_BAR = WS_DV + 16 * 64 * 128 * 4;
constexpr size_t WS_HS = 2 * MiB;
constexpr size_t WS_W = 3 * MiB;
constexpr size_t W_IN = 0, W_OUT = W_IN + (size_t)NINP * DM * 2, W_GU = W_OUT + (size_t)DM * DM * 2, W_DN = W_GU + (size_t)2 * DFF * DM * 2, W_LAYER = W_DN + (size_t)DM * DFF * 2;
constexpr size_t WS_HB = WS_W + 2 * W_LAYER + 65536;
constexpr size_t WS_MIX = WS_HB + (size_t)MALLOC * DM * 2;
constexpr size_t WS_QB = WS_MIX + (size_t)MALLOC * DM * 2;
constexpr size_t WS_KB = WS_QB + (size_t)MALLOC * 512 * 2, WS_VB = WS_KB + (size_t)MALLOC * 512 * 2;
constexpr size_t WS_HXQ = WS_VB + (size_t)MALLOC * 512 * 2;
constexpr size_t WS_LOGF = WS_HXQ + (size_t)MALLOC * 512 * 2;
constexpr size_t WS_HV = WS_LOGF + (size_t)MALLOC * 512 * 4, WS_HG = WS_HV + (size_t)MALLOC * 512 * 2;
constexpr size_t WS_END = WS_HG + (size_t)MALLOC * 512 * 2;
constexpr size_t WS_ACT = WS_QB;
static_assert(WS_BAR + 16384 <= WS_HS && 3456 * 4 <= 16384 && (size_t)16 * 64 * 16384 * 2 <= (size_t)MALLOC * DM * 2 && WS_HS + 4 * 64 * 1024 * 4 <= WS_W, "small map");
static_assert(WS_ACT + (size_t)MALLOC * DFF * 2 <= WS_END, "ACT overlay");
static_assert(WS_END <= 256 * MiB, "d_ws");

#define LAUNDER0() do { int t_ = threadIdx.x; asm volatile("" : "+v"(t_)); c.tid = t_; c.lane = t_ & 63; } while (0)
struct Args { const float* in[13]; float* out; unsigned char* ws; };

struct Ctx {
    const float *x, *meta, *nmw, *win, *fbias, *lbraw, *hnw, *wout, *nfw, *wg, *wu, *wd, *nfinal;
    float* out; unsigned char* ws;
    unsigned* ctl; float* sumsq; float* lbv; float* logf8; float* kbias; float* hs;
    bf16_t *HB, *MIX, *QB, *KB, *VB, *HXQ, *HV, *HG, *ACT; float* LOGF;
    int tid, lane, wave, gw, NGW;
};

__device__ __forceinline__ unsigned f2bf(float f) { unsigned u = __builtin_bit_cast(unsigned, f); return (u + 0x7fffu + ((u >> 16) & 1u)) >> 16; }
__device__ __forceinline__ unsigned pk2(float lo, float hi) { return f2bf(lo) | (f2bf(hi) << 16); }
__device__ __forceinline__ float bf2f(unsigned short b) { return __builtin_bit_cast(float, (unsigned)b << 16); }
__device__ __forceinline__ float wave_sum(float v) {
#pragma unroll
    for (int o = 1; o < 64; o <<= 1) v += __shfl_xor(v, o);
    return v;
}
__device__ __forceinline__ float wave_max(float v) {
#pragma unroll
    for (int o = 1; o < 64; o <<= 1) v = fmaxf(v, __shfl_xor(v, o));
    return v;
}
__device__ __forceinline__ float siluf(float x) { return x / (1.f + __expf(-x)); }
__device__ __forceinline__ float* hrow(const Ctx& c, int r) {
    const int b = r / LV, vp = r - b * LV;
    return vp >= 64 ? c.out + (size_t)(b * SEQ + vp - 64) * DM : c.hs + (size_t)(b * 64 + vp) * DM;
}
__device__ __forceinline__ bf16_t* wptr(const Ctx& c, int layer, size_t off) { return (bf16_t*)(c.ws + WS_W + (size_t)layer * W_LAYER + off); }

namespace pg8 {
#define PG8_LAS __attribute__((address_space(3)))
typedef unsigned short bf16_t;
typedef short bf16x8 __attribute__((ext_vector_type(8)));
typedef float f32x4 __attribute__((ext_vector_type(4)));
typedef unsigned u32x4 __attribute__((ext_vector_type(4)));
constexpr int BM = 256, BK = 64, HALF = 128, HTB = HALF * BK * 2  , STAGE_BYTES = 8 * HTB, NXCD = 8, WGM = 8;

__host__ __device__ __forceinline__ int lds_byte(int r, int c) { const int st = (r >> 4) * 2 + (c >> 5), rr = r & 15, cc = c & 31, ob = rr * 64 + cc * 2; return st * 1024 + (ob ^ (((ob >> 9) & 1) << 5)); }
__host__ __device__ __forceinline__ void stage_rc(int b, int& R, int& C) { const int st = b / 1024, sb = b % 1024, swz = sb ^ (((sb >> 9) & 1) << 5); R = (st >> 1) * 16 + swz / 64; C = (st & 1) * 32 + (swz % 64) / 2; }
__host__ __device__ __forceinline__ int perm32(int rho) { const int n = rho >> 4, i = rho & 15; return 8 * (i >> 2) + 4 * n + (i & 3); }

struct Unit { int pm, pn; };
struct Gemm { const bf16_t* A; const bf16_t* Bt; int M, N, K; };

struct StaticOrder {
    int nM, nN, nwg, G, c;
    __host__ __device__ void init(int M, int N, int G_, int c_) { nM = M / BM; nN = N / BM; nwg = nM * nN; G = G_; c = c_; }
    __host__ __device__ bool next(int i, Unit& u) const {
        const long L = (long)i * G + c; if (L >= nwg) return false;
        int wgid = (int)L; { const int q = nwg / NXCD, r = nwg % NXCD, xcd = wgid % NXCD, off = wgid / NXCD; wgid = (xcd < r ? xcd * (q + 1) : r * (q + 1) + (xcd - r) * q) + off; }
        const int nig = WGM * nN, gid = wgid / nig, fm = gid * WGM, gsz = (nM - fm) < WGM ? (nM - fm) : WGM;
        u.pm = fm + ((wgid % nig) % gsz); u.pn = (wgid % nig) / gsz; return true;
    }
    __device__ __forceinline__ void a_ready(const Unit&) const {}
    __device__ __forceinline__ void done(const Unit&) const {}
};

__device__ __forceinline__ unsigned cvt_pk_bf16(float lo, float hi) { unsigned r; asm volatile("v_cvt_pk_bf16_f32 %0, %1, %2" : "=v"(r) : "v"(lo), "v"(hi)); return r; }
typedef float f32x2 __attribute__((ext_vector_type(2)));
template <class Epi, class Sched, bool ALIGN_EPI = false, bool SP2 = false>
__device__ __forceinline__ void gemm_phase(PG8_LAS unsigned char* lds, const Gemm g, const Sched& S, const Epi& E) {
    int tid_ = threadIdx.x; asm volatile("" : "+v"(tid_));
    const int tid = tid_, wid = __builtin_amdgcn_readfirstlane(tid >> 6), lane = tid & 63, wr = wid >> 2, wc = wid & 3, fr = lane & 15, fq = lane >> 4;
    const int K = g.K, nt = K / BK;
    unsigned voffA[2], voffB[2];
#pragma unroll
    for (int i = 0; i < 2; ++i) { int R, C; stage_rc(tid * 16 + i * 8192, R, C); const int Rb = Epi::PERM ? ((R & ~31) + perm32(R & 31)) : R;
        voffA[i] = (unsigned)(R * K + C) * 2u; voffB[i] = (unsigned)(Rb * K + C) * 2u; }
    const size_t kstep = (size_t)(BK * 2);
    const size_t hstep = (size_t)HALF * K * 2;
    const size_t tstep = 2 * hstep;
    const unsigned ldsw = (unsigned)wid * 1024u;
    const int aoff = lds_byte(wr * 64 + fr, fq * 8), boff = lds_byte(wc * 32 + fr, fq * 8);
#define PG8_SA(b, h) (((b) * 2 + (h)) * HTB)
#define PG8_SB(b, h) ((4 + (b) * 2 + (h)) * HTB)
#define PG8_STAGE(bufoff, gbase, voff) do { _Pragma("unroll") for (int _i = 0; _i < 2; ++_i) \
        __builtin_amdgcn_global_load_lds((const unsigned*)((const char*)(gbase) + (voff)[_i]), (PG8_LAS unsigned*)(lds + (bufoff) + ldsw + _i * 8192), 16, 0, 0); } while (0)
#define PG8_LDA(dst, b, h) do { _Pragma("unroll") for (int m = 0; m < 4; ++m) _Pragma("unroll") for (int k = 0; k < 2; ++k) dst[m][k] = *(const PG8_LAS bf16x8*)(lds + PG8_SA(b, h) + aoff + m * 2048 + k * 1024); } while (0)
#define PG8_LDB(dst, b, h) do { _Pragma("unroll") for (int n = 0; n < 2; ++n) _Pragma("unroll") for (int k = 0; k < 2; ++k) dst[n][k] = *(const PG8_LAS bf16x8*)(lds + PG8_SB(b, h) + boff + n * 2048 + k * 1024); } while (0)
#define PG8_MMA(ai, bj, At, Bt) do { __builtin_amdgcn_s_setprio(1); _Pragma("unroll") for (int m = 0; m < 4; ++m) _Pragma("unroll") for (int n = 0; n < 2; ++n) _Pragma("unroll") for (int k = 0; k < 2; ++k) \
        acc[ai][bj][m][n] = __builtin_amdgcn_mfma_f32_16x16x32_bf16(Bt[n][k], At[m][k], acc[ai][bj][m][n], 0, 0, 0); __builtin_amdgcn_s_setprio(0); } while (0)
#define PG8_WAIT_V(n) asm volatile("s_waitcnt vmcnt(" #n ")" ::: "memory")
#define PG8_WAIT_L(n) asm volatile("s_waitcnt lgkmcnt(" #n ")" ::: "memory")
#define PG8_BAR __builtin_amdgcn_s_barrier()
#define PG8_SCHED __builtin_amdgcn_sched_barrier(0)
    Unit cur, nxt; int ui = 0;
    if (!S.next(0, cur)) return;
    f32x4 acc[2][2][4][2];
#pragma unroll
    for (int a = 0; a < 2; ++a)
#pragma unroll
        for (int b = 0; b < 2; ++b)
#pragma unroll
            for (int m = 0; m < 4; ++m)
#pragma unroll
                for (int n = 0; n < 2; ++n) acc[a][b][m][n] = (f32x4){0.f, 0.f, 0.f, 0.f};
    bf16x8 At[4][2], B0[2][2], B1[2][2];
    const char* cA = (const char*)g.A + (size_t)cur.pm * tstep; const char* cB = (const char*)g.Bt + (size_t)cur.pn * tstep;
    S.a_ready(cur);
    if constexpr (SP2) {
        PG8_STAGE(PG8_SB(0, 0), cB, voffB); PG8_STAGE(PG8_SB(0, 1), cB + hstep, voffB); PG8_STAGE(PG8_SA(0, 0), cA, voffA); PG8_STAGE(PG8_SA(0, 1), cA + hstep, voffA);
        if (wr == 1) PG8_BAR;
        PG8_WAIT_V(2); PG8_BAR;
        PG8_STAGE(PG8_SB(1, 0), cB + kstep, voffB); PG8_STAGE(PG8_SA(1, 0), cA + kstep, voffA); PG8_STAGE(PG8_SB(1, 1), cB + hstep + kstep, voffB);
        PG8_WAIT_V(6); PG8_BAR;
    } else {
        PG8_STAGE(PG8_SB(0, 0), cB, voffB); PG8_STAGE(PG8_SA(0, 0), cA, voffA); PG8_STAGE(PG8_SB(0, 1), cB + hstep, voffB); PG8_STAGE(PG8_SA(0, 1), cA + hstep, voffA);
        if (wr == 1) PG8_BAR;
        PG8_WAIT_V(4); PG8_BAR;
        PG8_STAGE(PG8_SB(1, 0), cB + kstep, voffB); PG8_STAGE(PG8_SA(1, 0), cA + kstep, voffA); PG8_STAGE(PG8_SB(1, 1), cB + hstep + kstep, voffB);
        PG8_WAIT_V(6); PG8_BAR;
    }
    for (;;) {
        const bool has_next = S.next(ui + 1, nxt);
        const char* nA = has_next ? (const char*)g.A + (size_t)nxt.pm * tstep : cA; const char* nB = has_next ? (const char*)g.Bt + (size_t)nxt.pn * tstep : cB;
        for (int t = 0; t < nt; t += 2) {
            const bool last = (t == nt - 2);
            const char* a1 = cA + (size_t)(t + 1) * kstep;
            const char* a2 = last ? nA : cA + (size_t)(t + 2) * kstep; const char* b2 = last ? nB : cB + (size_t)(t + 2) * kstep;
            const char* a3 = a2 + kstep; const char* b3 = b2 + kstep;
            if (last && has_next) S.a_ready(nxt);
            if constexpr (SP2) {
            PG8_LDB(B0, 0, 0); PG8_LDB(B1, 0, 1); PG8_SCHED; PG8_LDA(At, 0, 0); PG8_STAGE(PG8_SA(1, 1), a1 + hstep, voffA);
            PG8_WAIT_V(8); PG8_WAIT_L(0); PG8_BAR; PG8_MMA(0, 0, At, B0); PG8_MMA(0, 1, At, B1); PG8_BAR; PG8_SCHED;
            PG8_LDA(At, 0, 1); PG8_STAGE(PG8_SB(0, 0), b2, voffB); PG8_STAGE(PG8_SB(0, 1), b2 + hstep, voffB); PG8_STAGE(PG8_SA(0, 0), a2, voffA);
            PG8_WAIT_V(8); PG8_WAIT_L(0); PG8_BAR; PG8_MMA(1, 0, At, B0); PG8_MMA(1, 1, At, B1); PG8_BAR; PG8_SCHED;
            PG8_LDB(B0, 1, 0); PG8_LDB(B1, 1, 1); PG8_SCHED; PG8_LDA(At, 1, 0); PG8_STAGE(PG8_SA(0, 1), a2 + hstep, voffA);
            PG8_WAIT_V(8); PG8_WAIT_L(0); PG8_BAR; PG8_MMA(0, 0, At, B0); PG8_MMA(0, 1, At, B1); PG8_BAR; PG8_SCHED;
            PG8_LDA(At, 1, 1); PG8_STAGE(PG8_SB(1, 0), b3, voffB); PG8_STAGE(PG8_SB(1, 1), b3 + hstep, voffB); PG8_STAGE(PG8_SA(1, 0), a3, voffA);
            PG8_WAIT_V(8); PG8_WAIT_L(0); PG8_BAR; PG8_MMA(1, 0, At, B0); PG8_MMA(1, 1, At, B1); PG8_BAR; PG8_SCHED;
            } else {
            PG8_LDB(B0, 0, 0); PG8_SCHED; PG8_LDA(At, 0, 0); PG8_STAGE(PG8_SA(1, 1), a1 + hstep, voffA);
            PG8_WAIT_L(8); PG8_BAR; PG8_WAIT_L(0); PG8_MMA(0, 0, At, B0); PG8_BAR; PG8_SCHED;
            PG8_LDB(B1, 0, 1); PG8_STAGE(PG8_SB(0, 0), b2, voffB);
            PG8_BAR; PG8_WAIT_L(0); PG8_MMA(0, 1, At, B1); PG8_BAR;
            PG8_LDA(At, 0, 1); PG8_STAGE(PG8_SA(0, 0), a2, voffA);
            PG8_BAR; PG8_WAIT_L(0); PG8_MMA(1, 0, At, B0); PG8_BAR; PG8_SCHED;
            PG8_STAGE(PG8_SB(0, 1), b2 + hstep, voffB);
            PG8_WAIT_V(6); PG8_BAR; PG8_MMA(1, 1, At, B1); PG8_BAR;
            PG8_LDB(B0, 1, 0); PG8_SCHED; PG8_LDA(At, 1, 0); PG8_STAGE(PG8_SA(0, 1), a2 + hstep, voffA);
            PG8_WAIT_L(8); PG8_BAR; PG8_WAIT_L(0); PG8_MMA(0, 0, At, B0); PG8_BAR; PG8_SCHED;
            PG8_LDB(B1, 1, 1); PG8_STAGE(PG8_SB(1, 0), b3, voffB);
            PG8_BAR; PG8_WAIT_L(0); PG8_MMA(0, 1, At, B1); PG8_BAR;
            PG8_LDA(At, 1, 1); PG8_STAGE(PG8_SA(1, 0), a3, voffA);
            PG8_BAR; PG8_WAIT_L(0); PG8_MMA(1, 0, At, B0); PG8_BAR; PG8_SCHED;
            PG8_STAGE(PG8_SB(1, 1), b3 + hstep, voffB);
            PG8_WAIT_V(6); PG8_BAR; PG8_MMA(1, 1, At, B1); PG8_BAR;
            }
        }
        if constexpr (ALIGN_EPI) { if (wr == 0) PG8_BAR; }
        if constexpr (!Epi::AFTER_DRAIN) { E(acc, cur, wr, wc, fr, fq); S.done(cur); }
        if (!has_next) break;
#pragma unroll
        for (int a = 0; a < 2; ++a)
#pragma unroll
            for (int b = 0; b < 2; ++b)
#pragma unroll
                for (int m = 0; m < 4; ++m)
#pragma unroll
                    for (int n = 0; n < 2; ++n) acc[a][b][m][n] = (f32x4){0.f, 0.f, 0.f, 0.f};
        cur = nxt; cA = nA; cB = nB; ++ui;
        if constexpr (ALIGN_EPI) { if (wr == 1) PG8_BAR; }
    }
    PG8_WAIT_V(0);
    if constexpr (!ALIGN_EPI) { if (wr == 0) PG8_BAR; }
    PG8_BAR;
    if constexpr (Epi::AFTER_DRAIN) { E.fused(acc, cur, wr, wc, fr, fq, lds, wid, lane); S.done(cur); }
#undef PG8_SA
#undef PG8_SB
#undef PG8_STAGE
#undef PG8_LDA
#undef PG8_LDB
#undef PG8_MMA
#undef PG8_WAIT_V
#undef PG8_WAIT_L
#undef PG8_BAR
#undef PG8_SCHED
}
}

namespace pg8 {
__device__ __forceinline__ float silu_f(float x) { return x * __builtin_amdgcn_rcpf(1.f + __expf(-x)); }
struct EpiInProj {
    static constexpr bool PERM = true, AFTER_DRAIN = false;
    const float* ssq; const float* lbv; bf16_t *QB, *KB, *VB, *HXQ, *HV, *HG; float* LOGF; const float* fbias; float* logf8;
    __device__ __forceinline__ void operator()(const f32x4 (&acc)[2][2][4][2], const Unit& u, int wr, int wc, int fr, int fq) const {
        const int part = u.pn >> 1;
        const int cbase = (u.pn & 1) * 256 + wc * 32 + 8 * fq;
        if (part == 7) {
            if (wc == 0 && fq == 0) {
                const f32x4 b0 = *(const f32x4*)fbias, b1 = *(const f32x4*)(fbias + 4);
#pragma unroll
                for (int ai = 0; ai < 2; ++ai)
#pragma unroll
                    for (int m = 0; m < 4; ++m) {
                        const int r = u.pm * BM + ai * HALF + wr * 64 + m * 16 + fr;
                        const float rstd = 1.f / sqrtf(ssq[r] * (1.f / 1024.f) + 1e-6f);
                        f32x4 z0 = acc[ai][0][m][0] * rstd + b0, z1 = acc[ai][0][m][1] * rstd + b1;
#pragma unroll
                        for (int e = 0; e < 4; ++e) { z0[e] = fminf(z0[e], 0.f) - __logf(1.f + __expf(-fabsf(z0[e]))); z1[e] = fminf(z1[e], 0.f) - __logf(1.f + __expf(-fabsf(z1[e]))); }
                        *(f32x4*)(logf8 + (size_t)r * 8) = z0; *(f32x4*)(logf8 + (size_t)r * 8 + 4) = z1;
                    }
            }
        } else if (part == 4) {
#pragma unroll
            for (int bj = 0; bj < 2; ++bj)
#pragma unroll
                for (int n = 0; n < 2; ++n) {
                    const int cc = cbase + bj * HALF + 4 * n;
                    f32x4 lb1 = (f32x4){1.f, 1.f, 1.f, 1.f};
                    if (lbv) lb1 = lb1 - *(const f32x4*)(lbv + cc);
#pragma unroll
                    for (int ai = 0; ai < 2; ++ai)
#pragma unroll
                        for (int m = 0; m < 4; ++m) {
                            const int r = u.pm * BM + ai * HALF + wr * 64 + m * 16 + fr;
                            const float rstd = 1.f / sqrtf(ssq[r] * (1.f / 1024.f) + 1e-6f);
                            f32x4 a;
#pragma unroll
                            for (int e = 0; e < 4; ++e) { const float xv = acc[ai][bj][m][n][e] * rstd; const float omf = lb1[e] * __builtin_amdgcn_rcpf(1.f + __expf(xv)); a[e] = fmaxf(__logf(1.f - omf), -30.f); }
                            *(f32x4*)(LOGF + (size_t)r * 512 + cc) = a;
                        }
                }
        } else {
            bf16_t* dst = part == 0 ? QB : part == 1 ? KB : part == 2 ? VB : part == 3 ? HXQ : part == 5 ? HV : HG;
            const float sc = part == 0 ? 0.125f * 1.4426950408889634f : part == 3 ? 0.08838834764831845f : 1.f;
            const bool dosilu = (part == 3) || (part == 6);
#pragma unroll
            for (int ai = 0; ai < 2; ++ai)
#pragma unroll
                for (int m = 0; m < 4; ++m) {
                    const int r = u.pm * BM + ai * HALF + wr * 64 + m * 16 + fr;
                    const float rstd = sc / sqrtf(ssq[r] * (1.f / 1024.f) + 1e-6f);
#pragma unroll
                    for (int bj = 0; bj < 2; ++bj) {
                        f32x4 v0 = acc[ai][bj][m][0], v1 = acc[ai][bj][m][1];
                        if (dosilu) {
#pragma unroll
                            for (int e = 0; e < 4; ++e) { const float a0 = v0[e] * (rstd / sc), a1 = v1[e] * (rstd / sc); v0[e] = silu_f(a0) * sc; v1[e] = silu_f(a1) * sc; }
                        } else { v0 = v0 * rstd; v1 = v1 * rstd; }
                        u32x4 w; w.x = cvt_pk_bf16(v0[0], v0[1]); w.y = cvt_pk_bf16(v0[2], v0[3]); w.z = cvt_pk_bf16(v1[0], v1[1]); w.w = cvt_pk_bf16(v1[2], v1[3]);
                        *(u32x4*)(dst + (size_t)r * 512 + cbase + bj * HALF) = w;
                    }
                }
        }
    }
};
struct EpiResid {
    static constexpr bool PERM = false, AFTER_DRAIN = false;
    float* out; float* hs; bf16_t* HB; float* ssq; unsigned skip;
    __device__ __forceinline__ void operator()(const f32x4 (&acc)[2][2][4][2], const Unit& u, int wr, int wc, int fr, int fq) const {
        if (skip) return;
        const int col0 = u.pn * BM + wc * 32 + 4 * fq;
#pragma unroll
        for (int ai = 0; ai < 2; ++ai)
#pragma unroll
            for (int m = 0; m < 4; ++m) {
                const int r = u.pm * BM + ai * HALF + wr * 64 + m * 16 + fr;
                const int b = r / 4160, vp = r - b * 4160;
                float* hp = vp >= 64 ? out + (size_t)(b * 4096 + vp - 64) * 1024 : hs + (size_t)(b * 64 + vp) * 1024;
                float q = 0.f;
#pragma unroll
                for (int bj = 0; bj < 2; ++bj)
#pragma unroll
                    for (int n = 0; n < 2; ++n) { const int c = col0 + bj * HALF + n * 16; const f32x4 h = *(const f32x4*)(hp + c) + acc[ai][bj][m][n]; *(f32x4*)(hp + c) = h;
                        unsigned long long w = (unsigned long long)cvt_pk_bf16(h[0], h[1]) | ((unsigned long long)cvt_pk_bf16(h[2], h[3]) << 32);
                        *(unsigned long long*)(HB + (size_t)r * 1024 + c) = w; q += (h[0] * h[0] + h[1] * h[1]) + (h[2] * h[2] + h[3] * h[3]); }
                if (ssq) { q += __shfl_xor(q, 16); q += __shfl_xor(q, 32); if (fq == 0) atomicAdd(ssq + r, q); }
            }
    }
};
struct EpiSwiGLU {
    static constexpr bool PERM = true, AFTER_DRAIN = false;
    const float* ssq; bf16_t* ACT;
    __device__ __forceinline__ void operator()(const f32x4 (&acc)[2][2][4][2], const Unit& u, int wr, int wc, int fr, int fq) const {
        const int f0 = u.pn * HALF + wc * 32 + 8 * fq;
#pragma unroll
        for (int ai = 0; ai < 2; ++ai)
#pragma unroll
            for (int m = 0; m < 4; ++m) {
                const int r = u.pm * BM + ai * HALF + wr * 64 + m * 16 + fr;
                const float rstd = 1.f / sqrtf(ssq[r] * (1.f / 1024.f) + 1e-6f);
                float y[8];
#pragma unroll
                for (int n = 0; n < 2; ++n)
#pragma unroll
                    for (int e = 0; e < 4; ++e) { const float g = acc[ai][0][m][n][e] * rstd, uu = acc[ai][1][m][n][e] * rstd; y[4 * n + e] = silu_f(g) * uu; }
                u32x4 w; w.x = cvt_pk_bf16(y[0], y[1]); w.y = cvt_pk_bf16(y[2], y[3]); w.z = cvt_pk_bf16(y[4], y[5]); w.w = cvt_pk_bf16(y[6], y[7]);
                *(u32x4*)(ACT + (size_t)r * 2816 + f0) = w;
            }
    }
};
}

#define GAS __attribute__((address_space(1)))
typedef unsigned v4u __attribute__((ext_vector_type(4)));
typedef GAS unsigned gu32;
typedef GAS unsigned long long gu64;
#define RLX_AGENT __ATOMIC_RELAXED, __HIP_MEMORY_SCOPE_AGENT
#define LDS_WAIT() asm volatile("s_waitcnt lgkmcnt(0)" ::: "memory")
#define VM_WAIT() asm volatile("s_waitcnt vmcnt(0)" ::: "memory")
__device__ __forceinline__ unsigned long long rt() { return __builtin_amdgcn_s_memrealtime(); }
#define XB_TMO      128
#define XB_XCNT(j)  (256  + 64 * (j))
#define XB_XSUB(j)  (1280 + 64 * (j))
#define XB_XGEN(j)  (2304 + 64 * (j))
#define XB_TOP      3328
#define XB_TOPGEN   3392
#define XCD_BAR_WORDS 3456
#define XB_SPIN_CAP (1u << 18)

__device__ __forceinline__ unsigned xb_ld(unsigned* p)              { return __hip_atomic_load(p, __ATOMIC_RELAXED, __HIP_MEMORY_SCOPE_AGENT); }
__device__ __forceinline__ unsigned xb_add(unsigned* p, unsigned v) { return __hip_atomic_fetch_add(p, v, __ATOMIC_RELAXED, __HIP_MEMORY_SCOPE_AGENT); }
__device__ __forceinline__ unsigned xb_xcc_id() { return (unsigned)__builtin_amdgcn_s_getreg((3 << 11) | 20) & 0xFu; }
#define XB_SPIN(cond, bar) do { unsigned _sp = 0; while (cond) { __builtin_amdgcn_s_sleep(1); \
    if ((++_sp & 255u) == 0u) { if (xb_ld(&(bar)[XB_TMO])) break; if (_sp > XB_SPIN_CAP) { atomicAdd(&(bar)[XB_TMO], 1u); break; } } } } while (0)

struct XcdBarrier {
    unsigned* bar; unsigned x;
    volatile LAS unsigned* st;
};

__device__ __forceinline__ XcdBarrier xcd_barrier_post(unsigned* bar, volatile LAS unsigned* st) {
    XcdBarrier b; b.bar = bar; b.x = xb_xcc_id(); b.st = st;
    if (threadIdx.x == 0) (void)xb_add(&bar[XB_XCNT(b.x)], 1u);
    return b;
}
__device__ __forceinline__ void xcd_barrier_complete(unsigned* bar, unsigned x, unsigned& nloc, unsigned& nx) {
    const unsigned G = gridDim.x * gridDim.y * gridDim.z;
    unsigned sum, cnt, mine, sp = 0u;
    for (;;) {
        sum = 0u; cnt = 0u; mine = 0u;
#pragma unroll
        for (unsigned j = 0; j < 16; ++j) { const unsigned c = xb_ld(&bar[XB_XCNT(j)]); sum += c; cnt += (c > 0u) ? 1u : 0u; mine = (j == x) ? c : mine; }
        if (sum == G) break;
        __builtin_amdgcn_s_sleep(1);
        if ((++sp & 255u) == 0u) { if (xb_ld(&bar[XB_TMO])) break; if (sp > XB_SPIN_CAP) { atomicAdd(&bar[XB_TMO], 1u); break; } }
    }
    nloc = mine > 0u ? mine : 1u; nx = cnt > 0u ? cnt : 1u;
}

__device__ __forceinline__ void xcd_barrier(const XcdBarrier& b) {
    asm volatile("s_waitcnt vmcnt(0)" ::: "memory");
    __syncthreads();
    int t_ = threadIdx.x; asm volatile("" : "+v"(t_));
    if (t_ == 0) {
        unsigned* bar = b.bar;
        __builtin_amdgcn_s_waitcnt(0);
        unsigned nloc = b.st[0], nx = b.st[1];
        if (nloc == 0u) { xcd_barrier_complete(bar, b.x, nloc, nx); b.st[0] = nloc; b.st[1] = nx; }
        const unsigned old = xb_add(&bar[XB_XSUB(b.x)], 1u);
        const unsigned gen = old / nloc;
        if (old + 1u == (gen + 1u) * nloc) {
            __builtin_amdgcn_fence(__ATOMIC_RELEASE, "agent");
            asm volatile("s_waitcnt vmcnt(0)" ::: "memory");
            const unsigned og = xb_add(&bar[XB_TOP], 1u);
            const unsigned tg = og / nx;
            if (og + 1u == (tg + 1u) * nx) xb_add(&bar[XB_TOPGEN], 1u);
            else XB_SPIN(xb_ld(&bar[XB_TOPGEN]) == tg, bar);
            __builtin_amdgcn_fence(__ATOMIC_ACQUIRE, "agent");
            xb_add(&bar[XB_XGEN(b.x)], 1u);
            asm volatile("s_waitcnt vmcnt(0)" ::: "memory");
        } else {
            XB_SPIN(xb_ld(&bar[XB_XGEN(b.x)]) == gen, bar);
            __builtin_amdgcn_fence(__ATOMIC_ACQUIRE, "agent");
            asm volatile("s_waitcnt vmcnt(0)" ::: "memory");
        }
    }
    __syncthreads();
}

__device__ __forceinline__ void tr_item(const float* W, int K, int N, int k0, int nsrc0, bf16_t* WT, int dst_row0, const float* kscale, LAS float* scr, int lane) {
#pragma unroll 8
    for (int i = 0; i < 32; ++i) { const int kk = 2 * i + (lane >> 5); float s = kscale ? kscale[k0 + kk] : 1.f; scr[kk * 33 + (lane & 31)] = W[(size_t)(k0 + kk) * N + nsrc0 + (lane & 31)] * s; }
    asm volatile("s_waitcnt lgkmcnt(0)" ::: "memory");
    const int ch = lane & 7;
#pragma unroll
    for (int j = 0; j < 4; ++j) { const int n = (lane >> 3) + 8 * j; const LAS float* s = scr + (8 * ch) * 33 + n;
        u32x4 o; o.x = pk2(s[0 * 33], s[1 * 33]); o.y = pk2(s[2 * 33], s[3 * 33]); o.z = pk2(s[4 * 33], s[5 * 33]); o.w = pk2(s[6 * 33], s[7 * 33]);
        *(u32x4*)(WT + (size_t)(dst_row0 + n) * K + k0 + 8 * ch) = o; }
    asm volatile("s_waitcnt lgkmcnt(0)" ::: "memory");
}

__device__ __forceinline__ void p0_weights(const Ctx& c, LAS unsigned char* lds) {
    LAS float* scr = (LAS float*)(lds + c.wave * 16384);
    constexpr int I_IN = 16 * (NIN / 32), I_OUT = 16 * 32, I_G = 16 * (DFF / 32), I_D = (DFF / 64) * 32, I_L = I_IN + I_OUT + 2 * I_G + I_D;
    for (int it = c.gw; it < 2 * I_L; it += c.NGW) {
        const int l = it / I_L; int r = it - l * I_L;
        if (r < I_IN) { const int kb = r / (NIN / 32), nb = r % (NIN / 32), n0 = nb * 32;
            tr_item(c.win + (size_t)l * DM * INCOLS, DM, INCOLS, kb * 64, n0 + (n0 >= 1536 ? 8 : 0), wptr(c, l, W_IN), n0, c.nmw + l * DM, scr, c.lane); continue; }
        r -= I_IN;
        if (r < I_OUT) { const int kb = r / 32, nb = r % 32; tr_item(c.wout + (size_t)l * DM * DM, DM, DM, kb * 64, nb * 32, wptr(c, l, W_OUT), nb * 32, nullptr, scr, c.lane); continue; }
        r -= I_OUT;
        if (r < 2 * I_G) { const int up = r >= I_G; if (up) r -= I_G; const int kb = r / (DFF / 32), nb = r % (DFF / 32), f0 = nb * 32;
            tr_item((up ? c.wu : c.wg) + (size_t)l * DM * DFF, DM, DFF, kb * 64, f0, wptr(c, l, W_GU), 256 * (f0 >> 7) + (f0 & 127) + (up ? 128 : 0), c.nfw + l * DM, scr, c.lane); continue; }
        r -= 2 * I_G;
        { const int kb = r / 32, nb = r % 32; tr_item(c.wd + (size_t)l * DFF * DM, DFF, DM, kb * 64, nb * 32, wptr(c, l, W_DN), nb * 32, nullptr, scr, c.lane); }
    }
}

__device__ __forceinline__ void h_build(const Ctx& c) {
    float* ssq = c.sumsq;
    for (int r = c.gw; r < MROWS; r += c.NGW) {
        const int b = r / LV, vp = r - b * LV;
        f32x4 v[4];
        float* hp = hrow(c, r);
        const float* src = vp >= 64 ? c.x + (size_t)(b * SEQ + vp - 64) * DM : (vp >= PADF ? c.meta + (size_t)(vp - PADF) * DM : nullptr);
        float s = 0.f;
#pragma unroll
        for (int j = 0; j < 4; ++j) { v[j] = src ? *(const f32x4*)(src + 4 * c.lane + 256 * j) : (f32x4){0.f, 0.f, 0.f, 0.f}; *(f32x4*)(hp + 4 * c.lane + 256 * j) = v[j];
            unsigned long long w = (unsigned long long)pk2(v[j].x, v[j].y) | ((unsigned long long)pk2(v[j].z, v[j].w) << 32);
            *(unsigned long long*)(c.HB + (size_t)r * DM + 4 * c.lane + 256 * j) = w;
            s += (v[j].x * v[j].x + v[j].y * v[j].y) + (v[j].z * v[j].z + v[j].w * v[j].w); }
        s = wave_sum(s);
        if (c.lane == 0) ssq[r] = s;
    }
}

__device__ __forceinline__ void kbias_job(const Ctx& c, LAS unsigned char* lds, int job) {
    const int b = job >> 3, h = job & 7;
    LAS float* wt = (LAS float*)lds;
    const int v0 = 9 * c.tid;
    float g[9]; float s = 0.f;
#pragma unroll
    for (int i = 0; i < 9; ++i) { const int vp = v0 + i; g[i] = (vp >= PADF && vp < LV) ? c.logf8[(size_t)(b * LV + vp) * 8 + h] : 0.f; s += g[i]; }
    float inc = s;
#pragma unroll
    for (int o = 1; o < 64; o <<= 1) { const float t = __shfl_up(inc, o); if (c.lane >= o) inc += t; }
    if (c.lane == 63) wt[c.wave] = inc;
    __syncthreads();
    float run = inc - s;
    for (int w = 0; w < c.wave; ++w) run += wt[w];
    float* kb = c.kbias + (size_t)job * KBL;
#pragma unroll
    for (int i = 0; i < 9; ++i) { const int vp = v0 + i; run += g[i]; if (vp < KBL) kb[vp] = vp < PADF ? -1e30f : (vp < LV ? -run * LOG2E : 0.f); }
    __syncthreads();
}

template <int MODE>
__device__ __forceinline__ void gemm_simple(const Ctx& c, int layer) {
    const int fr = c.lane & 15, g = c.lane >> 4;
    const bf16_t* A = MODE == 0 ? c.HB : MODE == 1 ? c.MIX : MODE == 2 ? c.HB : c.ACT;
    const bf16_t* Bt = wptr(c, layer, MODE == 0 ? W_IN : MODE == 1 ? W_OUT : MODE == 2 ? W_GU : W_DN);
    constexpr int K = MODE == 3 ? DFF : DM;
    constexpr int NCOL = MODE == 0 ? NIN : MODE == 2 ? DFF : DM;
    constexpr int ntn = NCOL / 64, ntm = MROWS / 16;
    for (int t = c.gw; t < ntm * ntn; t += c.NGW) {
        const int tm = t / ntn, tn = t - tm * ntn, row0 = tm * 16, col0 = tn * 64;
        f32x4 acc[4], acc2[4];
#pragma unroll
        for (int n = 0; n < 4; ++n) { acc[n] = (f32x4){0.f, 0.f, 0.f, 0.f}; acc2[n] = (f32x4){0.f, 0.f, 0.f, 0.f}; }
        const bf16_t* ap = A + (size_t)(row0 + fr) * K + 8 * g;
        const bf16_t* bp[4];
#pragma unroll
        for (int n = 0; n < 4; ++n) { const int cn = col0 + 16 * n + fr; const int br = MODE == 2 ? 256 * (cn >> 7) + (cn & 127) : cn; bp[n] = Bt + (size_t)br * K + 8 * g; }
        for (int k0 = 0; k0 < K; k0 += 32) {
            const bf16x8 a = *(const bf16x8*)(ap + k0);
#pragma unroll
            for (int n = 0; n < 4; ++n) { const bf16x8 b = *(const bf16x8*)(bp[n] + k0); acc[n] = __builtin_amdgcn_mfma_f32_16x16x32_bf16(a, b, acc[n], 0, 0, 0);
                if (MODE == 2) { const bf16x8 b2 = *(const bf16x8*)(bp[n] + (size_t)128 * K + k0); acc2[n] = __builtin_amdgcn_mfma_f32_16x16x32_bf16(a, b2, acc2[n], 0, 0, 0); } }
        }
        if (MODE == 0) {
            const float* ssq = c.sumsq + (size_t)layer * MALLOC;
#pragma unroll
            for (int j = 0; j < 4; ++j) { const int r = row0 + 4 * g + j; const float rstd = 1.f / sqrtf(ssq[r] * (1.f / DM) + EPS);
#pragma unroll
                for (int n = 0; n < 4; ++n) { const int cn = col0 + 16 * n + fr; const float xv = acc[n][j] * rstd; const int part = cn >> 9, cc = cn & 511; const size_t o = (size_t)r * 512 + cc;
                    if (part == 0) c.QB[o] = (bf16_t)f2bf(xv * C2);
                    else if (part == 1) c.KB[o] = (bf16_t)f2bf(xv);
                    else if (part == 2) c.VB[o] = (bf16_t)f2bf(xv);
                    else if (part == 3) c.HXQ[o] = (bf16_t)f2bf(siluf(xv) * HGQS);
                    else if (part == 4) { const float lb = layer ? c.lbv[cc] : 0.f; const float omf = (1.f - lb) / (1.f + __expf(xv)); c.LOGF[o] = fmaxf(log1pf(-omf), -30.f); }
                    else if (part == 5) c.HV[o] = (bf16_t)f2bf(xv);
                    else c.HG[o] = (bf16_t)f2bf(siluf(xv)); } }
        } else if (MODE == 1 || MODE == 3) {
            float* ssq = c.sumsq + (size_t)(2 + layer) * MALLOC;
#pragma unroll
            for (int j = 0; j < 4; ++j) { const int r = row0 + 4 * g + j; float* hp = hrow(c, r); float q = 0.f;
#pragma unroll
                for (int n = 0; n < 4; ++n) { const int cn = col0 + 16 * n + fr; const float hn = hp[cn] + acc[n][j]; hp[cn] = hn; c.HB[(size_t)r * DM + cn] = (bf16_t)f2bf(hn); q += hn * hn; }
                if (MODE == 1) { q += __shfl_xor(q, 1); q += __shfl_xor(q, 2); q += __shfl_xor(q, 4); q += __shfl_xor(q, 8); if (fr == 0) atomicAdd(ssq + r, q); } }
        } else {
            const float* ssq = c.sumsq + (size_t)(2 + layer) * MALLOC;
#pragma unroll
            for (int j = 0; j < 4; ++j) { const int r = row0 + 4 * g + j; const float rstd = 1.f / sqrtf(ssq[r] * (1.f / DM) + EPS);
#pragma unroll
                for (int n = 0; n < 4; ++n) { const int cn = col0 + 16 * n + fr; const float gv = acc[n][j] * rstd, uv = acc2[n][j] * rstd; c.ACT[(size_t)r * DFF + cn] = (bf16_t)f2bf(siluf(gv) * uv); } }
        }
    }
}

template <int MODE>
__device__ __forceinline__ void tail_job(const Ctx& c, LAS unsigned char* lds, int layer) {
    constexpr int K = MODE == 3 ? DFF : DM, KW = K / 8;
    const bf16_t* A = MODE == 1 ? c.MIX : c.ACT;
    const bf16_t* Bt = wptr(c, layer, MODE == 1 ? W_OUT : W_DN);
    float* ssq = MODE == 1 ? c.sumsq + (size_t)(2 + layer) * MALLOC : (layer == 0 ? c.sumsq + (size_t)MALLOC : nullptr);
    int tid_ = threadIdx.x; asm volatile("" : "+v"(tid_)); const int tid = tid_, lane = tid & 63, w = __builtin_amdgcn_readfirstlane(tid >> 6);
    const int fr = lane & 15, g = lane >> 4;
    LAS float* P = (LAS float*)lds;
    for (int job = blockIdx.x; job < 256; job += gridDim.x) {
        const int tm = job >> 4, tn = job & 15, row0 = 16384 + tm * 16, col0 = tn * 64;
        f32x4 acc[4];
#pragma unroll
        for (int n = 0; n < 4; ++n) acc[n] = (f32x4){0.f, 0.f, 0.f, 0.f};
        const bf16_t* ap = A + (size_t)(row0 + fr) * K + w * KW + 8 * g;
        const bf16_t* bp = Bt + (size_t)(col0 + fr) * K + w * KW + 8 * g;
#pragma unroll 4
        for (int k0 = 0; k0 < KW; k0 += 32) {
            const bf16x8 a = *(const bf16x8*)(ap + k0);
#pragma unroll
            for (int n = 0; n < 4; ++n) { const bf16x8 b = *(const bf16x8*)(bp + (size_t)n * 16 * K + k0); acc[n] = __builtin_amdgcn_mfma_f32_16x16x32_bf16(a, b, acc[n], 0, 0, 0); }
        }
#pragma unroll
        for (int n = 0; n < 4; ++n)
#pragma unroll
            for (int j = 0; j < 4; ++j) P[(w * 16 + 4 * g + j) * 64 + 16 * n + fr] = acc[n][j];
        __syncthreads();
        { const int row = tid >> 5, c2 = (tid & 31) * 2; float s0 = 0.f, s1 = 0.f;
#pragma unroll
          for (int ww = 0; ww < 8; ++ww) { s0 += P[(ww * 16 + row) * 64 + c2]; s1 += P[(ww * 16 + row) * 64 + c2 + 1]; }
          const int r = row0 + row; float* hp = hrow(c, r) + col0 + c2;
          const float h0 = hp[0] + s0, h1 = hp[1] + s1; hp[0] = h0; hp[1] = h1;
          *(unsigned*)(c.HB + (size_t)r * DM + col0 + c2) = pk2(h0, h1);
          if (ssq) { float q = h0 * h0 + h1 * h1; q += __shfl_xor(q, 1); q += __shfl_xor(q, 2); q += __shfl_xor(q, 4); q += __shfl_xor(q, 8); q += __shfl_xor(q, 16); if ((tid & 31) == 0) atomicAdd(ssq + r, q); } }
        __syncthreads();
    }
}

template <int MODE>
__device__ __forceinline__ void gemm_fast(const Ctx& c, LAS unsigned char* lds, int layer, unsigned skip = 0u) {
    const bf16_t* A = MODE == 0 ? c.HB : MODE == 1 ? c.MIX : MODE == 2 ? c.HB : c.ACT;
    const bf16_t* Bt = wptr(c, layer, MODE == 0 ? W_IN : MODE == 1 ? W_OUT : MODE == 2 ? W_GU : W_DN);
    constexpr int K = MODE == 3 ? DFF : DM;
    constexpr int N = MODE == 0 ? NINP : MODE == 2 ? 2 * DFF : DM;
    int bx_ = blockIdx.x; asm volatile("" : "+s"(bx_));
    constexpr int MG = (MODE == 1 || MODE == 3) ? 16384 : MROWS;
    pg8::Gemm g{A, Bt, MG, N, K}; pg8::StaticOrder S; S.init(MG, N, (int)gridDim.x, bx_);
    if constexpr (MODE == 0) {
        pg8::EpiInProj E{c.sumsq + (size_t)layer * MALLOC, layer ? c.lbv : nullptr, c.QB, c.KB, c.VB, c.HXQ, c.HV, c.HG, c.LOGF, c.fbias + layer * 8, c.logf8};
        pg8::gemm_phase<pg8::EpiInProj, pg8::StaticOrder, true, true>(lds, g, S, E);
    } else if constexpr (MODE == 2) {
        pg8::EpiSwiGLU E{c.sumsq + (size_t)(2 + layer) * MALLOC, c.ACT};
        pg8::gemm_phase<pg8::EpiSwiGLU, pg8::StaticOrder, true, true>(lds, g, S, E);
    } else {
        pg8::EpiResid E{c.out, c.hs, c.HB, MODE == 1 ? c.sumsq + (size_t)(2 + layer) * MALLOC : (layer == 0 ? c.sumsq + (size_t)MALLOC : nullptr), skip};
        pg8::gemm_phase<pg8::EpiResid, pg8::StaticOrder, true, true>(lds, g, S, E);
        if (!skip) tail_job<MODE>(c, lds, layer);
    }
}

#include <hip/hip_bf16.h>
#include <cmath>
namespace attn_body {
using bf16=__hip_bfloat16;
using bf16x8=__attribute__((ext_vector_type(8)))short;
using s16x4=__attribute__((ext_vector_type(4)))short;
using f32x16=__attribute__((ext_vector_type(16)))float;
using u32x4=__attribute__((ext_vector_type(4)))unsigned;
constexpr int BATCH=4,NHEAD=8,SEQ=4160,D=64,DM=NHEAD*D,OP=1024;
constexpr int NW=8,QBLK=32,QB=QBLK*NW,KVBLK=64,NQB=17;
constexpr int ATTN_PITCH=DM, ATTN_UNIT_ROWS=QB;
__device__ __forceinline__ int crow(int r,int hi){return (r&3)+8*(r>>2)+4*hi;}
#define SBAR() __builtin_amdgcn_sched_barrier(0)
__device__ __forceinline__ void cmask(f32x16&p0,f32x16&p1,int jb,int qrel,int hi){
  const float NEG=-INFINITY; int kb=64*jb+4*hi;
  #pragma unroll
  for(int r=0;r<16;++r){int kv=kb+(r&3)+8*(r>>2); if(kv>qrel)p0[r]=NEG; if(kv+32>qrel)p1[r]=NEG;}
}

constexpr int NSLOT=3, SLOTB=8192;
constexpr int LDS_K=0, LDS_V=NSLOT*SLOTB, LDS_WS=2*NSLOT*SLOTB, LDS_OST=LDS_WS+NW*64*4, LDS_KB=LDS_OST+NW*4096, LDS_BYTES=LDS_KB+4352*4+256;
constexpr float C2=0.125f*1.4426950408889634f;
__device__ __forceinline__ void glds16(const void*gsrc,unsigned lds_dst){unsigned keep;
  asm volatile("s_mov_b32 %0, m0\n\ts_mov_b32 m0, %2\n\ts_nop 0\n\tglobal_load_lds_dwordx4 %1, off\n\ts_mov_b32 m0, %0":"=&s"(keep):"v"(gsrc),"s"(lds_dst):"memory");}
__device__ __forceinline__ float max3f(float a,float b,float c){float r;asm("v_max3_f32 %0, %1, %2, %3":"=v"(r):"v"(a),"v"(b),"v"(c));return r;}
__device__ __forceinline__ float max2f(float a,float b){float r;asm("v_max_f32_e32 %0, %1, %2":"=v"(r):"v"(a),"v"(b));return r;}
__device__ __forceinline__ float fadd_s(float a,float b){float r;asm("v_add_f32_e32 %0, %1, %2":"=v"(r):"v"(a),"v"(b));return r;}
__device__ __forceinline__ float fsub_s(float a,float b){float r;asm("v_sub_f32_e32 %0, %1, %2":"=v"(r):"v"(a),"v"(b));return r;}
typedef float f32x2_t __attribute__((ext_vector_type(2))); typedef __bf16 bf16x2_t __attribute__((ext_vector_type(2)));
__device__ __forceinline__ unsigned cvtpk_s(float lo,float hi){f32x2_t v={lo,hi};bf16x2_t b=__builtin_convertvector(v,bf16x2_t);return __builtin_bit_cast(unsigned,b);}
#define WAIT_BAR(N) asm volatile("s_waitcnt vmcnt(" #N ") lgkmcnt(0)\n\ts_barrier":::"memory")

__device__ __forceinline__ void qkt(f32x16&p0,f32x16&p1,const char*Kslot,const bf16x8*qr,int r32,int hi){
  const char*kb=Kslot+hi*1024+r32*16;
  #pragma unroll
  for(int d0=0;d0<4;++d0){
    const bf16x8 b0=*reinterpret_cast<const bf16x8*>(kb+d0*2048);
    const bf16x8 b1=*reinterpret_cast<const bf16x8*>(kb+d0*2048+512);
    p0=__builtin_amdgcn_mfma_f32_32x32x16_bf16(b0,qr[d0],p0,0,0,0);p1=__builtin_amdgcn_mfma_f32_32x32x16_bf16(b1,qr[d0],p1,0,0,0);}
}
typedef __attribute__((address_space(3))) const char* lds_cptr;
typedef short v4i16_t __attribute__((ext_vector_type(4)));
__device__ __forceinline__ void kload8(bf16x8*kf,lds_cptr kp){
  kf[0]=*(const __attribute__((address_space(3))) bf16x8*)(kp);      kf[1]=*(const __attribute__((address_space(3))) bf16x8*)(kp+512);
  kf[2]=*(const __attribute__((address_space(3))) bf16x8*)(kp+2048); kf[3]=*(const __attribute__((address_space(3))) bf16x8*)(kp+2560);
  kf[4]=*(const __attribute__((address_space(3))) bf16x8*)(kp+4096); kf[5]=*(const __attribute__((address_space(3))) bf16x8*)(kp+4608);
  kf[6]=*(const __attribute__((address_space(3))) bf16x8*)(kp+6144); kf[7]=*(const __attribute__((address_space(3))) bf16x8*)(kp+6656);
}
__device__ __forceinline__ void kload2(bf16x8*kf,lds_cptr kp,int j){ kf[2*j]=*(const __attribute__((address_space(3))) bf16x8*)(kp+j*2048); kf[2*j+1]=*(const __attribute__((address_space(3))) bf16x8*)(kp+j*2048+512); }
__device__ __forceinline__ s16x4 vtr(lds_cptr p){ return __builtin_bit_cast(s16x4,__builtin_amdgcn_ds_read_tr16_b64_v4i16((__attribute__((address_space(3))) v4i16_t*)p)); }
__device__ __forceinline__ float rowmax(const f32x16&p0,const f32x16&p1){
  float a=max3f(p0[0],p0[1],p1[0]),b=max3f(p0[2],p0[3],p1[1]);a=max3f(a,p1[2],p1[3]);
  #pragma unroll
  for(int r=4;r<16;r+=4){a=max3f(a,p0[r],p0[r+1]);b=max3f(b,p0[r+2],p0[r+3]);a=max3f(a,p1[r],p1[r+1]);b=max3f(b,p1[r+2],p1[r+3]);}
  const float m=max2f(a,b);
  auto rr=__builtin_amdgcn_permlane32_swap(__float_as_uint(m),__float_as_uint(m),false,false);
  return max2f(__uint_as_float(rr[0]),__uint_as_float(rr[1]));
}
__device__ __forceinline__ void pv(f32x16*o,int vb,bf16x8 pa0,bf16x8 pa1,bf16x8 pa2,bf16x8 pa3){
  #pragma unroll
  for(int d0=0;d0<2;++d0){s16x4 lo[4],hi[4];
    #pragma unroll
    for(int ks=0;ks<4;++ks){
      asm volatile("ds_read_b64_tr_b16 %0,%1 offset:%c2":"=&v"(lo[ks]):"v"(vb),"i"(d0*4096+ks*1024):"memory");
      asm volatile("ds_read_b64_tr_b16 %0,%1 offset:%c2":"=&v"(hi[ks]):"v"(vb),"i"(d0*4096+ks*1024+512):"memory");}
    asm volatile("s_waitcnt lgkmcnt(0)":::"memory");SBAR();
    #define PK(k) (bf16x8){lo[k][0],lo[k][1],lo[k][2],lo[k][3],hi[k][0],hi[k][1],hi[k][2],hi[k][3]}
    o[d0]=__builtin_amdgcn_mfma_f32_32x32x16_bf16(pa0,PK(0),o[d0],0,0,0);
    o[d0]=__builtin_amdgcn_mfma_f32_32x32x16_bf16(pa1,PK(1),o[d0],0,0,0);
    o[d0]=__builtin_amdgcn_mfma_f32_32x32x16_bf16(pa2,PK(2),o[d0],0,0,0);
    o[d0]=__builtin_amdgcn_mfma_f32_32x32x16_bf16(pa3,PK(3),o[d0],0,0,0);
    #undef PK
  }
}

#ifndef ATTN_STORE16
#define ATTN_STORE16(p,v) (*(u32x4*)(p)=(v))
#endif
template<int THRL> __device__ __forceinline__ void attn_unit(int b,int h,int qb,const bf16*Q,const bf16*__restrict__ K,const bf16*__restrict__ V,bf16*O,const float*__restrict__ kbg,char*shm){
  int tid_=threadIdx.x; asm volatile("":"+v"(tid_)); const int tid=tid_,lane=tid&63,r32=lane&31,hi=lane>>5; const int wid=__builtin_amdgcn_readfirstlane(tid>>6);
  const long rowbase=(long)b*SEQ; const int q0=qb*QB;
  const bf16*Qw=Q+(rowbase+q0+wid*QBLK)*DM+h*D;
  const bf16*Kh=K+rowbase*DM+h*D,*Vh=V+rowbase*DM+h*D;
  const unsigned lds0=(unsigned)(uintptr_t)shm;
  float*wsf=(float*)(shm+LDS_WS)+wid*64;
  const bf16*ksrc=Kh+(long)lane*DM+wid*8;
  const bf16*vsrc=Vh+(long)(16*(wid&3)+(lane>>2))*DM+(wid>>2)*32+(lane&3)*8;
  const unsigned kdst=lds0+LDS_K+wid*1024, vdst=lds0+LDS_V+wid*1024;
  #define DMA_K(t,slot) glds16(ksrc+(long)(t)*KVBLK*DM,(unsigned)__builtin_amdgcn_readfirstlane(kdst+(slot)))
  #define DMA_V(t,slot) glds16(vsrc+(long)(t)*KVBLK*DM,(unsigned)__builtin_amdgcn_readfirstlane(vdst+(slot)))
  const int vb0=(int)(lds0+LDS_V)+((lane>>4)&1)*32+(lane&3)*8+(4*hi+((lane&15)>>2))*64;
  const char*Kbase=shm+LDS_K; bf16x8 kf[8];
  const lds_cptr shm3=(lds_cptr)shm; const lds_cptr kp0=shm3+LDS_K+hi*1024+r32*16; const lds_cptr vp0=shm3+LDS_V+((lane>>4)&1)*32+(lane&3)*8+(4*hi+((lane&15)>>2))*64;
  const int NT=(q0+QB)/KVBLK;
  typedef __attribute__((address_space(3))) float lds_f32; typedef float kb4_t __attribute__((ext_vector_type(4)));
  { lds_f32*kw=(lds_f32*)(shm3+LDS_KB); for(int i=tid;i<NT*KVBLK;i+=NW*64)kw[i]=kbg[i]; }
  const __attribute__((address_space(3))) kb4_t*kbl=(const __attribute__((address_space(3))) kb4_t*)(shm3+LDS_KB)+hi;
  #define KBLOAD(P0,P1,t) do{ const __attribute__((address_space(3))) kb4_t*kb_=kbl+16*(t); \
    _Pragma("unroll") for(int g_=0;g_<4;++g_){ const kb4_t a_=kb_[2*g_], b_=kb_[2*g_+8]; \
      P0[4*g_]=a_[0];P0[4*g_+1]=a_[1];P0[4*g_+2]=a_[2];P0[4*g_+3]=a_[3]; P1[4*g_]=b_[0];P1[4*g_+1]=b_[1];P1[4*g_+2]=b_[2];P1[4*g_+3]=b_[3]; } }while(0)
  DMA_K(0,0);DMA_V(0,0);DMA_K(1,SLOTB);
  bf16x8 qr[4];
  #pragma unroll
  for(int d0=0;d0<4;++d0)qr[d0]=*reinterpret_cast<const bf16x8*>(&Qw[(long)r32*DM+d0*16+hi*8]);
  float mhat=0.f,l_reg=0.f;f32x16 o[2];o[0]=f32x16{};o[1]=f32x16{};
  const int qrel=wid*QBLK+r32;
  #define CMASK(P0,P1,t) do{int jb_=(t)-(NT-4); if(jb_>=0)cmask(P0,P1,jb_,qrel,hi);}while(0)
  bool resc=false;
  #define START(P0,P1) do{ const float rm=rowmax(P0,P1); resc=false; \
    { const float dl=rm; mhat=fadd_s(mhat,dl); \
      _Pragma("unroll") for(int r=0;r<16;++r){P0[r]=fsub_s(P0[r],dl);P1[r]=fsub_s(P1[r],dl);} } \
    _Pragma("unroll") for(int r=0;r<16;++r)P0[r]=__builtin_amdgcn_exp2f(P0[r]); }while(0)
  #define RESC() do{ if(resc){ asm volatile("s_waitcnt lgkmcnt(0)":::"memory"); \
      _Pragma("unroll") for(int d_=0;d_<2;++d_) _Pragma("unroll") for(int r=0;r<16;++r)o[d_][r]*=wsf[crow(r,hi)]; } }while(0)
  f32x16 pA0,pA1,pB0,pB1;
  int sl_prev=0,sl_cur=0,sl_next=SLOTB;
  #define ROT() do{sl_prev=sl_cur;sl_cur=sl_next;sl_next=(sl_next==(NSLOT-1)*SLOTB)?0:sl_next+SLOTB;}while(0)
  DMA_K(2,2*SLOTB);
  WAIT_BAR(3);
  KBLOAD(pA0,pA1,0);
  qkt(pA0,pA1,Kbase,qr,r32,hi);asm volatile("s_nop 15\n\ts_nop 7":"+v"(pA0),"+v"(pA1));CMASK(pA0,pA1,0);
  START(pA0,pA1);
  _Pragma("unroll") for(int r=0;r<16;++r)pA1[r]=__builtin_amdgcn_exp2f(pA1[r]);
  KBLOAD(pB0,pB1,1);
  WAIT_BAR(0);
  DMA_K(3,0);DMA_V(1,SLOTB);
  ROT();
  kload8(kf,kp0+sl_cur);
  WAIT_BAR(2);
  s16x4 vlo[8],vhi[8]; u32x4 pw0,pw1,pw2,pw3;
  #define PKW(P,B) cvtpk_s(P[B],P[B+1])
  #define PAF(k) __builtin_bit_cast(bf16x8,pw##k)
  #define VFR(i) (bf16x8){vlo[i][0],vlo[i][1],vlo[i][2],vlo[i][3],vhi[i][0],vhi[i][1],vhi[i][2],vhi[i][3]}
  #define PIN(x) asm volatile("":"+v"(x))
  #define MX3(a,b,c) __builtin_fmaxf(__builtin_fmaxf((a),(b)),(c))
  #define GAPA(MF,A0,A1,A2,A3,W0,W1,PW) do{ MF; sacc+=A0; sacc+=A1; sacc+=A2; sacc+=A3; PIN(sacc); W0; W1; PIN(PW); SBAR(); }while(0)
  #define EX(v) __builtin_amdgcn_exp2f(v)
  #define GAPB(MF,X,B) do{ MF; X[B]=EX(X[B]); X[B+1]=EX(X[B+1]); X[B+2]=EX(X[B+2]); X[B+3]=EX(X[B+3]); PIN(X); SBAR(); }while(0)
  #define VRD(i) do{ vlo[i]=vtr(vp_+(((i)>>2)*4096+((i)&3)*1024)); vhi[i]=vtr(vp_+(((i)>>2)*4096+((i)&3)*1024+512)); }while(0)
  #define KRD(G,j) do{ if(G){ kload2(kf,kp0+sl_next,j); SBAR(); } }while(0)
  #define STEP(C0,C1,P0,P1,t,GK,GV,GL) do{ SBAR(); \
    const lds_cptr vp_=vp0+sl_prev; \
    VRD(0); SBAR(); float sacc=(P0[0]+P0[1]); \
    GAPA(C0=__builtin_amdgcn_mfma_f32_32x32x16_bf16(kf[0],qr[0],C0,0,0,0), P0[2],P0[3],P0[4],P0[5],     pw0[0]=PKW(P0,0), pw0[1]=PKW(P0,2), pw0); \
    VRD(4); SBAR(); GAPA(C1=__builtin_amdgcn_mfma_f32_32x32x16_bf16(kf[1],qr[0],C1,0,0,0), P0[6],P0[7],P0[8],P0[9],     pw0[2]=PKW(P0,4), pw0[3]=PKW(P0,6), pw0); \
    VRD(1); SBAR(); GAPA(C0=__builtin_amdgcn_mfma_f32_32x32x16_bf16(kf[2],qr[1],C0,0,0,0),   P0[10],P0[11],P0[12],P0[13], pw1[0]=PKW(P0,8), pw1[1]=PKW(P0,10), pw1); \
    VRD(5); SBAR(); GAPA(C1=__builtin_amdgcn_mfma_f32_32x32x16_bf16(kf[3],qr[1],C1,0,0,0),   P0[14],P0[15],P1[0],P1[1],   pw1[2]=PKW(P0,12),pw1[3]=PKW(P0,14), pw1); \
    VRD(2); SBAR(); GAPA(C0=__builtin_amdgcn_mfma_f32_32x32x16_bf16(kf[4],qr[2],C0,0,0,0),   P1[2],P1[3],P1[4],P1[5],     pw2[0]=PKW(P1,0), pw2[1]=PKW(P1,2), pw2); \
    VRD(6); SBAR(); GAPA(C1=__builtin_amdgcn_mfma_f32_32x32x16_bf16(kf[5],qr[2],C1,0,0,0),   P1[6],P1[7],P1[8],P1[9],     pw2[2]=PKW(P1,4), pw2[3]=PKW(P1,6), pw2); \
    VRD(3); SBAR(); GAPA(C0=__builtin_amdgcn_mfma_f32_32x32x16_bf16(kf[6],qr[3],C0,0,0,0),   P1[10],P1[11],P1[12],P1[13], pw3[0]=PKW(P1,8), pw3[1]=PKW(P1,10), pw3); \
    VRD(7); SBAR(); GAPA(C1=__builtin_amdgcn_mfma_f32_32x32x16_bf16(kf[7],qr[3],C1,0,0,0),   P1[14],P1[15],0.f,0.f,       pw3[2]=PKW(P1,12),pw3[3]=PKW(P1,14), pw3); \
    l_reg+=sacc; \
    if(GK){DMA_K((t)+3,sl_cur);} if(GV){DMA_V((t)+1,sl_next);} \
    _Pragma("unroll") for(int r=0;r<16;++r){C0[r]-=mhat;C1[r]-=mhat;} \
    CMASK(C0,C1,t); \
    { float a=MX3(C0[0],C0[1],C1[0]),b=MX3(C0[2],C0[3],C1[1]); a=MX3(a,C1[2],C1[3]); \
      _Pragma("unroll") for(int r=4;r<16;r+=4){a=MX3(a,C0[r],C0[r+1]);b=MX3(b,C0[r+2],C0[r+3]);a=MX3(a,C1[r],C1[r+1]);b=MX3(b,C1[r+2],C1[r+3]);} \
      float rm=__builtin_fmaxf(a,b); { auto rr=__builtin_amdgcn_permlane32_swap(__float_as_uint(rm),__float_as_uint(rm),false,false); rm=__builtin_fmaxf(__uint_as_float(rr[0]),__uint_as_float(rr[1])); } \
      resc=false; \
      if(__builtin_expect(__any(rm>(float)THRL),0)){ const float dl=__builtin_fmaxf(rm,0.f); mhat+=dl; \
        _Pragma("unroll") for(int r=0;r<16;++r){C0[r]-=dl;C1[r]-=dl;} \
        const float f=__builtin_amdgcn_exp2f(-dl); l_reg*=f; if(hi==0)wsf[r32]=f; resc=true; } } \
    SBAR(); \
    KBLOAD(P0,P1,(t)+1); SBAR(); \
    GAPB(o[0]=__builtin_amdgcn_mfma_f32_32x32x16_bf16(PAF(0),VFR(0),o[0],0,0,0), C0,0); \
    GAPB(o[1]=__builtin_amdgcn_mfma_f32_32x32x16_bf16(PAF(0),VFR(4),o[1],0,0,0), C0,4); \
    KRD(GL,0); GAPB(o[0]=__builtin_amdgcn_mfma_f32_32x32x16_bf16(PAF(1),VFR(1),o[0],0,0,0), C0,8); \
    KRD(GL,1); GAPB(o[1]=__builtin_amdgcn_mfma_f32_32x32x16_bf16(PAF(1),VFR(5),o[1],0,0,0), C0,12); \
    KRD(GL,2); GAPB(o[0]=__builtin_amdgcn_mfma_f32_32x32x16_bf16(PAF(2),VFR(2),o[0],0,0,0), C1,0); \
    KRD(GL,3); GAPB(o[1]=__builtin_amdgcn_mfma_f32_32x32x16_bf16(PAF(2),VFR(6),o[1],0,0,0), C1,4); \
    GAPB(o[0]=__builtin_amdgcn_mfma_f32_32x32x16_bf16(PAF(3),VFR(3),o[0],0,0,0), C1,8); \
    GAPB(o[1]=__builtin_amdgcn_mfma_f32_32x32x16_bf16(PAF(3),VFR(7),o[1],0,0,0), C1,12); \
    }while(0)
  int t=1;
  #undef CMASK
  #define CMASK(P0,P1,t) do{}while(0)
  for(;t+5<NT;t+=2){
    STEP(pB0,pB1,pA0,pA1,t,true,true,true);     WAIT_BAR(2); RESC(); ROT();
    STEP(pA0,pA1,pB0,pB1,t+1,true,true,true);   WAIT_BAR(2); RESC(); ROT();
  }
  #undef CMASK
  #define CMASK(P0,P1,t) do{int jb_=(t)-(NT-4); if(jb_>=0)cmask(P0,P1,jb_,qrel,hi);}while(0)
  #define ENDW(tt) do{ if((tt)+3<NT){WAIT_BAR(2);} else if((tt)+2<NT){WAIT_BAR(1);} else {WAIT_BAR(0);} }while(0)
  for(;t+1<NT;t+=2){
    STEP(pB0,pB1,pA0,pA1,t,(t+3<NT),(t+1<NT),(t+1<NT));       ENDW(t);   RESC(); ROT();
    STEP(pA0,pA1,pB0,pB1,t+1,(t+4<NT),(t+2<NT),(t+2<NT));     ENDW(t+1); RESC(); ROT();
  }
  STEP(pB0,pB1,pA0,pA1,NT-1,false,false,false); RESC();
  { float sacc=pB0[0]+pB0[1]; _Pragma("unroll") for(int r=2;r<16;++r)sacc+=pB0[r]; _Pragma("unroll") for(int r=0;r<16;++r)sacc+=pB1[r]; l_reg+=sacc;
    pw0=(u32x4){PKW(pB0,0),PKW(pB0,2),PKW(pB0,4),PKW(pB0,6)};pw1=(u32x4){PKW(pB0,8),PKW(pB0,10),PKW(pB0,12),PKW(pB0,14)};pw2=(u32x4){PKW(pB1,0),PKW(pB1,2),PKW(pB1,4),PKW(pB1,6)};pw3=(u32x4){PKW(pB1,8),PKW(pB1,10),PKW(pB1,12),PKW(pB1,14)};
    SBAR(); pv(o,vb0+sl_cur,PAF(0),PAF(1),PAF(2),PAF(3)); }
  #undef PKW
  #undef PAF
  #undef VFR
  #undef PIN
  #undef MX3
  #undef GAPA
  #undef GAPB
  #undef EX
  #undef VRD
  #undef KRD
  #undef STEP
  #undef ENDW
  {auto rr=__builtin_amdgcn_permlane32_swap(__float_as_uint(l_reg),__float_as_uint(l_reg),false,false);l_reg=__uint_as_float(rr[0])+__uint_as_float(rr[1]);}
  if(hi==0)wsf[32+r32]=l_reg;asm volatile("s_waitcnt lgkmcnt(0)":::"memory");
  float rli[16];
  #pragma unroll
  for(int r=0;r<16;++r)rli[r]=__builtin_amdgcn_rcpf(wsf[32+crow(r,hi)]);
  bf16*Ow=O+(rowbase+q0+wid*QBLK)*OP+h*D;
  { bf16*stg=(bf16*)(shm+LDS_OST)+wid*2048;
    #pragma unroll
    for(int r=0;r<16;++r){const int orow=crow(r,hi);
      #pragma unroll
      for(int d0=0;d0<2;++d0)stg[orow*64+d0*32+r32]=__float2bfloat16(o[d0][r]*rli[r]);}
    asm volatile("s_waitcnt lgkmcnt(0)":::"memory");
    #pragma unroll
    for(int i=0;i<4;++i){const int row=i*8+(lane>>3),ch=lane&7; const u32x4 v=*(const u32x4*)(stg+row*64+ch*8); if(q0+wid*QBLK+row<SEQ)ATTN_STORE16(Ow+(long)row*OP+ch*8,v);} }
  asm volatile("s_waitcnt lgkmcnt(0)\n\ts_barrier":::"memory");
  #undef KBLOAD
  #undef DMA_K
  #undef DMA_V
  #undef CMASK
  #undef START
  #undef RESC
  #undef ROT
}
constexpr int ATTN_LDS_BYTES=LDS_BYTES;
#undef SBAR
#undef WAIT_BAR
}

__device__ __forceinline__ void mix_queue(const Ctx& c, unsigned char* lds_generic, int layer, const bf16_t* SD, unsigned* qctr);

namespace hg {
constexpr int P = 272, PA = 144;
constexpr int O_QE = 0, O_QS = 17408, O_KS = 34816, O_VT = 52224, O_ST = 69632, O_AM = 104448, O_QT = 113664, O_RS = 115712, O_END = 117760;
typedef short v4i16_t __attribute__((ext_vector_type(4)));
__device__ __forceinline__ f32x4 mfma16(bf16x8 a, bf16x8 b, f32x4 c) { return __builtin_amdgcn_mfma_f32_16x16x32_bf16(a, b, c, 0, 0, 0); }
__device__ __forceinline__ bf16x8 tr_frag(const LAS unsigned char* p, int pitch) {
    const v4i16_t lo = __builtin_amdgcn_ds_read_tr16_b64_v4i16((LAS v4i16_t*)p);
    const v4i16_t hi = __builtin_amdgcn_ds_read_tr16_b64_v4i16((LAS v4i16_t*)(p + 4 * pitch));
    return (bf16x8){lo[0], lo[1], lo[2], lo[3], hi[0], hi[1], hi[2], hi[3]};
}
}

__device__ __forceinline__ void hgrn_A_unit(const Ctx& c, LAS unsigned char* lds, int bh, int ch, bf16_t* SD, float* DV) {
    using namespace hg;
    int tid_ = threadIdx.x; asm volatile("" : "+v"(tid_)); const int tid = tid_, lane = tid & 63, w = __builtin_amdgcn_readfirstlane(tid >> 6);
    const int b = bh >> 2, hh = bh & 3; const size_t r0 = (size_t)b * LV + 64 * ch;
    const int k = tid & 127, sq = tid >> 7;
    float g[16], bl[16];
    { const float* gp = c.LOGF + (r0 + 16 * sq) * 512 + hh * 128 + k; float s = 0.f;
#pragma unroll
      for (int i = 0; i < 16; ++i) { g[i] = gp[(size_t)i * 512]; s += g[i]; bl[i] = s; }
      ((LAS float*)(lds + O_QT))[sq * 128 + k] = s; }
#pragma unroll
    for (int i = 0; i < 2; ++i) { const int id = tid + 512 * i, row = id >> 4, cc = id & 15;
        const u32x4 v = *(const u32x4*)(c.HV + (r0 + row) * 512 + hh * 128 + cc * 8); *(LAS u32x4*)(lds + O_VT + row * P + cc * 16) = v; }
    __syncthreads();
    { const LAS float* qt = (const LAS float*)(lds + O_QT); float pre = 0.f, tot = 0.f;
#pragma unroll
      for (int q = 0; q < 4; ++q) { const float t = qt[q * 128 + k]; tot += t; if (q < sq) pre += t; }
#pragma unroll
      for (int i = 0; i < 16; ++i) { const float kd = (1.f - __expf(g[i])) * __expf(tot - (pre + bl[i])); *(LAS bf16_t*)(lds + O_KS + (16 * sq + i) * P + 2 * k) = (bf16_t)f2bf(kd); }
      if (sq == 0) DV[((size_t)bh * 64 + ch) * 128 + k] = __expf(tot); }
    __syncthreads();
    const int fr = lane & 15, g4 = lane >> 4, q = fr >> 2, p = lane & 3;
    const LAS unsigned char* abase = lds + O_VT + (8 * g4 + q) * P + w * 32 + p * 8;
    const LAS unsigned char* bbase = lds + O_KS + (8 * g4 + q) * P + p * 8;
    bf16x8 a[2]; a[0] = tr_frag(abase, P); a[1] = tr_frag(abase + 32 * P, P);
    bf16_t* od = SD + ((size_t)bh * 64 + ch) * 16384 + (size_t)(16 * w + 4 * g4) * 128 + fr;
#pragma unroll
    for (int ct = 0; ct < 8; ++ct) { f32x4 acc = (f32x4){0.f, 0.f, 0.f, 0.f};
        acc = mfma16(a[0], tr_frag(bbase + ct * 32, P), acc); acc = mfma16(a[1], tr_frag(bbase + 32 * P + ct * 32, P), acc);
#pragma unroll
        for (int j = 0; j < 4; ++j) od[j * 128 + 16 * ct] = (bf16_t)f2bf(acc[j]); }
    __syncthreads();
}

__device__ __forceinline__ void hgrn_B_scan(const Ctx& c, bf16_t* SD, const float* DV) {
    const int gt = blockIdx.x * NTHREADS + c.tid, NGT = gridDim.x * NTHREADS;
    for (int pidx = gt; pidx < 16 * 8192; pidx += NGT) {
        const int bh = pidx >> 13, e2 = pidx & 8191, k = (e2 & 63) * 2;
        unsigned* sp = (unsigned*)(SD + (size_t)bh * 64 * 16384 + 2 * e2);
        const float* dp = DV + (size_t)bh * 64 * 128 + k;
        float s0 = 0.f, s1 = 0.f;
#pragma unroll 8
        for (int ch = 0; ch < 64; ++ch) { const unsigned d = sp[(size_t)ch * 8192]; const float d0 = dp[ch * 128], d1 = dp[ch * 128 + 1];
            s0 = d0 * s0 + __builtin_bit_cast(float, d << 16); s1 = d1 * s1 + __builtin_bit_cast(float, d & 0xffff0000u);
            sp[(size_t)ch * 8192] = pk2(s0, s1); }
    }
}

__device__ __forceinline__ void hgrn_C_unit(const Ctx& c, LAS unsigned char* lds, int layer, int bh, int ch, const bf16_t* SD) {
    using namespace hg;
    int tid_ = threadIdx.x; asm volatile("" : "+v"(tid_)); const int tid = tid_, lane = tid & 63, w = __builtin_amdgcn_readfirstlane(tid >> 6);
    const int b = bh >> 2, hh = bh & 3; const size_t r0 = (size_t)b * LV + 64 * ch;
    const int k = tid & 127, sq = tid >> 7;
    float g[16], bl[16], qv[16];
    { const float* gp = c.LOGF + (r0 + 16 * sq) * 512 + hh * 128 + k; const bf16_t* qp = c.HXQ + (r0 + 16 * sq) * 512 + hh * 128 + k; float s = 0.f;
#pragma unroll
      for (int i = 0; i < 16; ++i) { g[i] = gp[(size_t)i * 512]; qv[i] = bf2f(qp[(size_t)i * 512]); s += g[i]; bl[i] = s; }
      ((LAS float*)(lds + O_QT))[sq * 128 + k] = s; }
#pragma unroll
    for (int i = 0; i < 2; ++i) { const int id = tid + 512 * i, row = id >> 4, cc = id & 15;
        const u32x4 v = *(const u32x4*)(c.HV + (r0 + row) * 512 + hh * 128 + cc * 8); *(LAS u32x4*)(lds + O_VT + row * P + cc * 16) = v; }
    if (ch > 0) {
        const bf16_t* sp = SD + ((size_t)bh * 64 + ch - 1) * 16384;
#pragma unroll
        for (int i = 0; i < 4; ++i) { const int id = tid + 512 * i, row = id >> 4, cc = id & 15; const u32x4 v = *(const u32x4*)(sp + row * 128 + cc * 8); *(LAS u32x4*)(lds + O_ST + row * P + cc * 16) = v; }
    }
    __syncthreads();
    { const LAS float* qt = (const LAS float*)(lds + O_QT); float pre = 0.f;
#pragma unroll
      for (int q = 0; q < 4; ++q) { const float t = qt[q * 128 + k]; if (q < sq) pre += t; }
      const float rr = qt[k] + qt[128 + k];
#pragma unroll
      for (int i = 0; i < 16; ++i) { const float bb = pre + bl[i]; const int off = (16 * sq + i) * P + 2 * k;
          *(LAS bf16_t*)(lds + O_QE + off) = (bf16_t)f2bf(qv[i] * __expf(bb));
          *(LAS bf16_t*)(lds + O_QS + off) = (bf16_t)f2bf(qv[i] * __expf(fminf(bb - rr, 80.f)));
          *(LAS bf16_t*)(lds + O_KS + off) = (bf16_t)f2bf((1.f - __expf(g[i])) * __expf(fminf(rr - bb, 80.f))); } }
    __syncthreads();
    const int fr = lane & 15, g4 = lane >> 4, q = fr >> 2, p = lane & 3;
#pragma unroll
    for (int tl = 0; tl < 2; ++tl) { const int tile = 2 * w + tl, ti = tile >> 2, sj = tile & 3;
        f32x4 acc = (f32x4){0.f, 0.f, 0.f, 0.f};
        if (sj <= ti) {
#pragma unroll
            for (int ks = 0; ks < 4; ++ks) { const bf16x8 a = *(const LAS bf16x8*)(lds + O_QS + (16 * ti + fr) * P + (32 * ks + 8 * g4) * 2);
                const bf16x8 bb = *(const LAS bf16x8*)(lds + O_KS + (16 * sj + fr) * P + (32 * ks + 8 * g4) * 2); acc = mfma16(a, bb, acc); } }
#pragma unroll
        for (int j = 0; j < 4; ++j) { const int t = 16 * ti + 4 * g4 + j, s = 16 * sj + fr; const float v = (s <= t) ? acc[j] : 0.f; *(LAS bf16_t*)(lds + O_AM + t * PA + 2 * s) = (bf16_t)f2bf(v); } }
    __syncthreads();
    f32x4 acc[4];
#pragma unroll
    for (int tt = 0; tt < 4; ++tt) acc[tt] = (f32x4){0.f, 0.f, 0.f, 0.f};
    if (ch > 0) {
#pragma unroll
        for (int ks = 0; ks < 4; ++ks) { const bf16x8 bfr = *(const LAS bf16x8*)(lds + O_ST + (16 * w + fr) * P + (32 * ks + 8 * g4) * 2);
#pragma unroll
            for (int tt = 0; tt < 4; ++tt) { const bf16x8 a = *(const LAS bf16x8*)(lds + O_QE + (16 * tt + fr) * P + (32 * ks + 8 * g4) * 2); acc[tt] = mfma16(a, bfr, acc[tt]); } }
    }
#pragma unroll
    for (int ks = 0; ks < 2; ++ks) { const bf16x8 bfr = tr_frag(lds + O_VT + (32 * ks + 8 * g4 + q) * P + w * 32 + p * 8, P);
#pragma unroll
        for (int tt = 0; tt < 4; ++tt) { const bf16x8 a = *(const LAS bf16x8*)(lds + O_AM + (16 * tt + fr) * PA + (32 * ks + 8 * g4) * 2); acc[tt] = mfma16(a, bfr, acc[tt]); } }
    LAS float* rs = (LAS float*)(lds + O_RS);
#pragma unroll
    for (int tt = 0; tt < 4; ++tt)
#pragma unroll
        for (int j = 0; j < 4; ++j) { float s2 = acc[tt][j] * acc[tt][j]; s2 += __shfl_xor(s2, 1); s2 += __shfl_xor(s2, 2); s2 += __shfl_xor(s2, 4); s2 += __shfl_xor(s2, 8);
            if (fr == 0) rs[(16 * tt + 4 * g4 + j) * 8 + w] = s2; }
    __syncthreads();
    { const int v = 16 * w + fr; const float nw = c.hnw[layer * 128 + v];
#pragma unroll
      for (int tt = 0; tt < 4; ++tt)
#pragma unroll
        for (int j = 0; j < 4; ++j) { const int t = 16 * tt + 4 * g4 + j; const f32x4 s0 = *(const LAS f32x4*)(rs + t * 8), s1 = *(const LAS f32x4*)(rs + t * 8 + 4);
            const float ss = ((s0[0] + s0[1]) + (s0[2] + s0[3])) + ((s1[0] + s1[1]) + (s1[2] + s1[3])); const float rstd = 1.f / sqrtf(ss * (1.f / 128.f) + EPS);
            const float gate = bf2f(c.HG[(r0 + t) * 512 + hh * 128 + v]);
            c.MIX[(r0 + t) * DM + 512 + hh * 128 + v] = (bf16_t)f2bf(acc[tt][j] * rstd * nw * gate); } }
    __syncthreads();
}

__device__ __forceinline__ void mix_queue(const Ctx& c, unsigned char* lds_generic, int layer, const bf16_t* SD, unsigned* qctr) {
    LAS volatile int* slot = (LAS volatile int*)((LAS unsigned char*)lds_generic + 131072);
    for (;;) {
        if (c.tid == 0) slot[0] = (int)atomicAdd(qctr, 1u);
        __syncthreads();
        const int n = slot[0];
        if (n >= 17 * 32 + 16 * 65) break;
        if (n < 17 * 32) {
            const int qb = 16 - (n >> 5), bh = n & 31;
            attn_body::attn_unit<8>(bh >> 3, bh & 7, qb, (const attn_body::bf16*)c.QB, (const attn_body::bf16*)c.KB, (const attn_body::bf16*)c.VB, (attn_body::bf16*)c.MIX,
                                    c.kbias + (size_t)bh * KBL, (char*)lds_generic);
        } else {
            const int u = n - 17 * 32, bh = u / 65, ch = u - bh * 65;
            hgrn_C_unit(c, (LAS unsigned char*)lds_generic, layer, bh, ch, SD);
        }
    }
}

__device__ __forceinline__ void fox_simple(const Ctx& c, LAS unsigned char* lds, int first_block) {
    LAS float* sc = (LAS float*)(lds + c.wave * 16896);
    LAS float* qs = sc; LAS float* ps = sc + 64;
    const int nblk = gridDim.x - first_block; if ((int)blockIdx.x < first_block) return;
    const int gw = ((int)blockIdx.x - first_block) * NWAVES + c.wave, NGW = nblk * NWAVES;
    for (int it = gw; it < MROWS * FOXH; it += NGW) {
        const int r = it >> 3, h = it & 7, b = r / LV, vp = r - b * LV;
        bf16_t* op = c.MIX + (size_t)r * DM + h * 64;
        if (vp < PADF) { op[c.lane] = 0; continue; }
        qs[c.lane] = bf2f(c.QB[(size_t)r * 512 + h * 64 + c.lane]);
        asm volatile("s_waitcnt lgkmcnt(0)" ::: "memory");
        const float* kb = c.kbias + (size_t)(b * 8 + h) * KBL;
        float mx = -3.0e38f;
        for (int j = PADF + c.lane; j <= vp; j += 64) {
            const bf16_t* kr = c.KB + (size_t)(b * LV + j) * 512 + h * 64; float s = 0.f;
#pragma unroll
            for (int d8 = 0; d8 < 8; ++d8) { const bf16x8 kv = *(const bf16x8*)(kr + d8 * 8);
#pragma unroll
                for (int e = 0; e < 8; ++e) s += qs[d8 * 8 + e] * bf2f((unsigned short)kv[e]); }
            s += kb[j]; ps[j] = s; mx = fmaxf(mx, s);
        }
        mx = wave_max(mx);
        float l = 0.f;
        for (int j = PADF + c.lane; j <= vp; j += 64) { const float p = exp2f(ps[j] - mx); ps[j] = p; l += p; }
        l = wave_sum(l);
        asm volatile("s_waitcnt lgkmcnt(0)" ::: "memory");
        float o = 0.f;
        const bf16_t* vr = c.VB + (size_t)(b * LV) * 512 + h * 64 + c.lane;
        for (int j = PADF; j <= vp; ++j) o += ps[j] * bf2f(vr[(size_t)j * 512]);
        op[c.lane] = (bf16_t)f2bf(o / l);
        asm volatile("s_waitcnt lgkmcnt(0)" ::: "memory");
    }
}

__device__ __forceinline__ void hgrn_simple(const Ctx& c, LAS unsigned char* lds, int layer) {
    if (blockIdx.x >= NB * HGH) return;
    const int b = blockIdx.x >> 2, hh = blockIdx.x & 3;
    LAS float* fL = (LAS float*)lds;
    LAS float* kL = fL + 2048; LAS float* qL = kL + 2048; LAS float* vL = qL + 2048; LAS float* oP = vL + 2048;
    const int v = c.tid & 127, kg = c.tid >> 7;
    float S[32];
#pragma unroll
    for (int i = 0; i < 32; ++i) S[i] = 0.f;
    for (int i = c.tid; i < PADF * 128; i += NTHREADS) { const int vp = i >> 7; c.MIX[(size_t)(b * LV + vp) * DM + 512 + hh * 128 + (i & 127)] = 0; }
    for (int t0 = PADF; t0 < LV; t0 += 16) {
        for (int i = c.tid; i < 2048; i += NTHREADS) { const int t = i >> 7, k = i & 127; const size_t o = (size_t)(b * LV + t0 + t) * 512 + hh * 128 + k;
            const float f = __expf(c.LOGF[o]); fL[i] = f; kL[i] = 1.f - f; qL[i] = bf2f(c.HXQ[o]); vL[i] = bf2f(c.HV[o]); }
        __syncthreads();
        for (int t = 0; t < 16; ++t) { const float vv = vL[t * 128 + v]; float part = 0.f;
#pragma unroll
            for (int i = 0; i < 32; ++i) { const int k = kg * 32 + i; S[i] = fL[t * 128 + k] * S[i] + kL[t * 128 + k] * vv; part += S[i] * qL[t * 128 + k]; }
            oP[(kg * 16 + t) * 128 + v] = part; }
        __syncthreads();
        for (int tt = 0; tt < 2; ++tt) { const int t = c.wave * 2 + tt; float o0, o1;
            { const int v0 = c.lane, v1 = c.lane + 64; o0 = oP[t * 128 + v0] + oP[(16 + t) * 128 + v0] + oP[(32 + t) * 128 + v0] + oP[(48 + t) * 128 + v0];
              o1 = oP[t * 128 + v1] + oP[(16 + t) * 128 + v1] + oP[(32 + t) * 128 + v1] + oP[(48 + t) * 128 + v1]; }
            const float ss = wave_sum(o0 * o0 + o1 * o1); const float rstd = 1.f / sqrtf(ss * (1.f / 128.f) + EPS);
            const size_t ro = (size_t)(b * LV + t0 + t);
            const float g0 = bf2f(c.HG[ro * 512 + hh * 128 + c.lane]), g1 = bf2f(c.HG[ro * 512 + hh * 128 + c.lane + 64]);
            c.MIX[ro * DM + 512 + hh * 128 + c.lane] = (bf16_t)f2bf(o0 * rstd * c.hnw[layer * 128 + c.lane] * g0);
            c.MIX[ro * DM + 512 + hh * 128 + c.lane + 64] = (bf16_t)f2bf(o1 * rstd * c.hnw[layer * 128 + c.lane + 64] * g1); }
        __syncthreads();
    }
}

__device__ __forceinline__ void final_norm(const Ctx& c) {
    for (int r = c.gw; r < NB * SEQ; r += c.NGW) {
        float* hp = c.out + (size_t)r * DM; f32x4 v[4]; float s = 0.f;
#pragma unroll
        for (int j = 0; j < 4; ++j) { v[j] = *(const f32x4*)(hp + 4 * c.lane + 256 * j); s += (v[j].x * v[j].x + v[j].y * v[j].y) + (v[j].z * v[j].z + v[j].w * v[j].w); }
        s = wave_sum(s); const float rstd = 1.f / sqrtf(s * (1.f / DM) + EPS);
#pragma unroll
        for (int j = 0; j < 4; ++j) { const f32x4 w = *(const f32x4*)(c.nfinal + 4 * c.lane + 256 * j); *(f32x4*)(hp + 4 * c.lane + 256 * j) = v[j] * rstd * w; }
    }
}

__global__ void __launch_bounds__(NTHREADS, 2) fwd_kernel(Args a) {
    extern __shared__ __attribute__((aligned(16))) unsigned char lds_raw[];
    LAS unsigned char* lds = (LAS unsigned char*)lds_raw;
    cg::grid_group grid = cg::this_grid();
    Ctx c;
    c.x = a.in[0]; c.meta = a.in[1]; c.nmw = a.in[2]; c.win = a.in[3]; c.fbias = a.in[4]; c.lbraw = a.in[5]; c.hnw = a.in[6]; c.wout = a.in[7];
    c.nfw = a.in[8]; c.wg = a.in[9]; c.wu = a.in[10]; c.wd = a.in[11]; c.nfinal = a.in[12];
    c.out = a.out; c.ws = a.ws;
    c.ctl = (unsigned*)(a.ws + WS_CTL); c.sumsq = (float*)(a.ws + WS_SUMSQ); c.lbv = (float*)(a.ws + WS_LBV); c.logf8 = (float*)(a.ws + WS_LOGF8);
    c.kbias = (float*)(a.ws + WS_KBIAS); c.hs = (float*)(a.ws + WS_HS);
    c.HB = (bf16_t*)(a.ws + WS_HB); c.MIX = (bf16_t*)(a.ws + WS_MIX); c.QB = (bf16_t*)(a.ws + WS_QB); c.KB = (bf16_t*)(a.ws + WS_KB); c.VB = (bf16_t*)(a.ws + WS_VB);
    c.HXQ = (bf16_t*)(a.ws + WS_HXQ); c.LOGF = (float*)(a.ws + WS_LOGF); c.HV = (bf16_t*)(a.ws + WS_HV); c.HG = (bf16_t*)(a.ws + WS_HG); c.ACT = (bf16_t*)(a.ws + WS_ACT);
    c.tid = threadIdx.x; c.lane = c.tid & 63; c.wave = __builtin_amdgcn_readfirstlane(c.tid >> 6);
    c.gw = blockIdx.x * NWAVES + c.wave; c.NGW = gridDim.x * NWAVES;
    volatile LAS unsigned* bst = (volatile LAS unsigned*)(lds + 131072 + 64);
    if (c.tid == 0) { bst[0] = 0u; bst[1] = 0u; }
    __syncthreads();
    const XcdBarrier bar = xcd_barrier_post((unsigned*)(a.ws + WS_BAR), bst);
#define GSYNC() xcd_barrier(bar)
    bf16_t* SD = (bf16_t*)(a.ws + WS_HB);
    float* DV = (float*)(a.ws + WS_DV);

    { const int gt = blockIdx.x * NTHREADS + c.tid, NGT = gridDim.x * NTHREADS;
      for (int i = gt; i < 16384; i += NGT) c.ctl[i] = (i == 8) ? 1u : 0u;
      for (int i = gt; i < 3 * MALLOC; i += NGT) c.sumsq[MALLOC + i] = 0.f;
      for (int i = gt; i < HGW; i += NGT) c.lbv[i] = 1.f / (1.f + __expf(c.lbraw[i] - c.lbraw[HGW + i])); }
    p0_weights(c, lds);
    { const int gt = blockIdx.x * NTHREADS + c.tid, NGT = gridDim.x * NTHREADS;
      for (int i = gt; i < 2 * 8 * DM; i += NGT) { const int l = i >> 13, cc = (i >> 10) & 7, k = i & 1023;
          wptr(c, l, W_IN)[(size_t)(NIN + cc) * DM + k] = (bf16_t)f2bf(c.win[(size_t)l * DM * INCOLS + (size_t)k * INCOLS + 1536 + cc] * c.nmw[l * DM + k]); }
      for (int i = gt; i < 2 * 248 * 128; i += NGT) { const int l = i / (248 * 128), r = i - l * (248 * 128); *(u32x4*)(wptr(c, l, W_IN) + (size_t)(NIN + 8) * DM + (size_t)r * 8) = (u32x4){0u, 0u, 0u, 0u}; } }
    __syncthreads();
    if constexpr (DUPMASK & 1) { LAUNDER0(); p0_weights(c, lds); __syncthreads(); }
    h_build(c);
    grid.sync();
#define LAUNDER() do { int t_ = threadIdx.x; asm volatile("" : "+v"(t_)); c.tid = t_; c.lane = t_ & 63; } while (0)
    for (int layer = 0; layer < 2; ++layer) {
        LAUNDER();
        if constexpr (FASTMASK & 1) gemm_fast<0>(c, lds, layer); else gemm_simple<0>(c, layer);
        if constexpr (DUPMASK & 2) { LAUNDER(); gemm_fast<0>(c, lds, layer); }
        GSYNC();
        LAUNDER();
        for (int u = blockIdx.x; u < 16 * 64; u += gridDim.x) hgrn_A_unit(c, lds, u >> 6, u & 63, SD, DV);
        if (blockIdx.x >= gridDim.x - 32) { LAUNDER(); kbias_job(c, lds, (int)(gridDim.x - 1 - blockIdx.x)); }
        if constexpr (DUPMASK & 4) { LAUNDER(); for (int u = blockIdx.x; u < 16 * 64; u += gridDim.x) hgrn_A_unit(c, lds, u >> 6, u & 63, SD, DV); }
        GSYNC();
        LAUNDER();
        hgrn_B_scan(c, SD, DV);
        GSYNC();
        LAUNDER();
        mix_queue(c, lds_raw, layer, SD, c.ctl + 64 * (1 + layer));
        if constexpr (DUPMASK & 8) { LAUNDER(); mix_queue(c, lds_raw, layer, SD, c.ctl + 64 * (3 + layer)); }
        if constexpr (DUPMASK & 128) { for (int i = 0; i < 8; ++i) GSYNC(); }
        GSYNC();
        LAUNDER();
        if constexpr (DUPMASK & 16) { gemm_fast<1>(c, lds, layer, c.ctl[8]); LAUNDER(); }
        if constexpr (FASTMASK & 2) gemm_fast<1>(c, lds, layer); else gemm_simple<1>(c, layer);
        GSYNC();
        if constexpr (FASTMASK & 4) gemm_fast<2>(c, lds, layer); else gemm_simple<2>(c, layer);
        if constexpr (DUPMASK & 32) { LAUNDER(); gemm_fast<2>(c, lds, layer); }
        GSYNC();
        if constexpr (DUPMASK & 64) { gemm_fast<3>(c, lds, layer, c.ctl[8]); LAUNDER(); }
        if constexpr (FASTMASK & 8) gemm_fast<3>(c, lds, layer); else gemm_simple<3>(c, layer);
        GSYNC();
    }
    LAUNDER();
    final_norm(c);
}

extern "C" void kernel_launch(void* const* d_in, const int* in_sizes, int n_in, void* d_out, int out_size, void* d_ws, size_t ws_size, hipStream_t stream) {
    static int grid = 0;
    if (grid == 0) {
        if (n_in != 13 || out_size != NB * SEQ * DM || ws_size < WS_END) { fprintf(stderr, "kernel_launch: unexpected shapes n_in %d out %d ws %zu\n", n_in, out_size, ws_size); grid = -1; return; }
        int dev = 0, cus = 0, per_cu = 0;
        (void)hipGetDevice(&dev); (void)hipDeviceGetAttribute(&cus, hipDeviceAttributeMultiprocessorCount, dev);
        (void)hipFuncSetAttribute((const void*)fwd_kernel, hipFuncAttributeMaxDynamicSharedMemorySize, LDS_BYTES);
        (void)hipOccupancyMaxActiveBlocksPerMultiprocessor(&per_cu, (const void*)fwd_kernel, NTHREADS, LDS_BYTES);
        if (per_cu < 1) per_cu = 1;
        grid = cus * per_cu;
        (void)hipGetLastError();
    }
    if (grid < 0) return;
    Args a{};
    for (int i = 0; i < 13; ++i) a.in[i] = (const float*)d_in[i];
    a.out = (float*)d_out; a.ws = (unsigned char*)d_ws;
    (void)hipMemsetAsync((unsigned char*)d_ws + WS_BAR, 0, 16384, stream);
    void* args[] = {&a};
    hipError_t e = hipLaunchCooperativeKernel((const void*)fwd_kernel, dim3(grid), dim3(NTHREADS), args, LDS_BYTES, stream);
    if (e != hipSuccess) fprintf(stderr, "cooperative launch failed: %s (grid %d)\n", hipGetErrorString(e), grid);
}
```

```cpp
#include <hip/hip_runtime.h>
#include <hip/hip_cooperative_groups.h>
#include <cstdint>
#include <cstdio>
namespace cg = cooperative_groups;

typedef unsigned short bf16_t;
typedef short bf16x8 __attribute__((ext_vector_type(8)));
typedef float f32x4 __attribute__((ext_vector_type(4)));
typedef unsigned u32x4 __attribute__((ext_vector_type(4)));
#define LAS __attribute__((address_space(3)))

constexpr int DM = 1024, NB = 4, SEQ = 4096, NMETA = 16, PADF = 48, LV = 4160, MROWS = NB * LV, MALLOC = MROWS + 256;
constexpr int FOXH = 8, FOXD = 64, FOXW = 512, HGH = 4, HGK = 128, HGV = 128, HGW = 512, DFF = 2816, INCOLS = 3592, NIN = 3584, NINP = 3840;
constexpr int KBL = 4352;
constexpr float EPS = 1e-6f, LOG2E = 1.4426950408889634f, C2 = 0.125f * LOG2E, HGQS = 0.08838834764831845f;
constexpr int NTHREADS = 512, NWAVES = 8;
constexpr int LDS_BYTES = 147456;
#ifndef FASTMASK
#define FASTMASK 15
#endif
#ifndef DUPMASK
#define DUPMASK 0
#endif

constexpr size_t MiB = 1u << 20;
constexpr size_t WS_CTL = 0;
constexpr size_t WS_SUMSQ = 64 * 1024;
constexpr size_t SUMSQ_STRIDE = (size_t)MALLOC * 4;
constexpr size_t WS_LBV = WS_SUMSQ + 4 * SUMSQ_STRIDE;
constexpr size_t WS_LOGF8 = WS_LBV + 4096;
constexpr size_t WS_KBIAS = WS_LOGF8 + (size_t)MALLOC * 32;
constexpr size_t WS_DV = WS_KBIAS + 32 * KBL * 4;
constexpr size_t WS_BAR = WS_DV + 16 * 64 * 128 * 4;
constexpr size_t WS_HS = 2 * MiB;
constexpr size_t WS_W = 3 * MiB;
constexpr size_t W_IN = 0, W_OUT = W_IN + (size_t)NINP * DM * 2, W_GU = W_OUT + (size_t)DM * DM * 2, W_DN = W_GU + (size_t)2 * DFF * DM * 2, W_LAYER = W_DN + (size_t)DM * DFF * 2;
constexpr size_t WS_HB = WS_W + 2 * W_LAYER + 65536;
constexpr size_t WS_MIX = WS_HB + (size_t)MALLOC * DM * 2;
constexpr size_t WS_QB = WS_MIX + (size_t)MALLOC * DM * 2;
constexpr size_t WS_KB = WS_QB + (size_t)MALLOC * 512 * 2, WS_VB = WS_KB + (size_t)MALLOC * 512 * 2;
constexpr size_t WS_HXQ = WS_VB + (size_t)MALLOC * 512 * 2;
constexpr size_t WS_LOGF = WS_HXQ + (size_t)MALLOC * 512 * 2;
constexpr size_t WS_HV = WS_LOGF + (size_t)MALLOC * 512 * 4, WS_HG = WS_HV + (size_t)MALLOC * 512 * 2;
constexpr size_t WS_END = WS_HG + (size_t)MALLOC * 512 * 2;
constexpr size_t WS_ACT = WS_QB;
static_assert(WS_BAR + 16384 <= WS_HS && 3456 * 4 <= 16384 && (size_t)16 * 64 * 16384 * 2 <= (size_t)MALLOC * DM * 2 && WS_HS + 4 * 64 * 1024 * 4 <= WS_W, "small map");
static_assert(WS_ACT + (size_t)MALLOC * DFF * 2 <= WS_END, "ACT overlay");
static_assert(WS_END <= 256 * MiB, "d_ws");

#define LAUNDER0() do { int t_ = threadIdx.x; asm volatile("" : "+v"(t_)); c.tid = t_; c.lane = t_ & 63; } while (0)
struct Args { const float* in[13]; float* out; unsigned char* ws; };

struct Ctx {
    const float *x, *meta, *nmw, *win, *fbias, *lbraw, *hnw, *wout, *nfw, *wg, *wu, *wd, *nfinal;
    float* out; unsigned char* ws;
    unsigned* ctl; float* sumsq; float* lbv; float* logf8; float* kbias; float* hs;
    bf16_t *HB, *MIX, *QB, *KB, *VB, *HXQ, *HV, *HG, *ACT; float* LOGF;
    int tid, lane, wave, gw, NGW;
};

__device__ __forceinline__ unsigned f2bf(float f) { unsigned u = __builtin_bit_cast(unsigned, f); return (u + 0x7fffu + ((u >> 16) & 1u)) >> 16; }
__device__ __forceinline__ unsigned pk2(float lo, float hi) { return f2bf(lo) | (f2bf(hi) << 16); }
__device__ __forceinline__ float bf2f(unsigned short b) { return __builtin_bit_cast(float, (unsigned)b << 16); }
__device__ __forceinline__ float wave_sum(float v) {
#pragma unroll
    for (int o = 1; o < 64; o <<= 1) v += __shfl_xor(v, o);
    return v;
}
__device__ __forceinline__ float wave_max(float v) {
#pragma unroll
    for (int o = 1; o < 64; o <<= 1) v = fmaxf(v, __shfl_xor(v, o));
    return v;
}
__device__ __forceinline__ float siluf(float x) { return x / (1.f + __expf(-x)); }
__device__ __forceinline__ float* hrow(const Ctx& c, int r) {
    const int b = r / LV, vp = r - b * LV;
    return vp >= 64 ? c.out + (size_t)(b * SEQ + vp - 64) * DM : c.hs + (size_t)(b * 64 + vp) * DM;
}
__device__ __forceinline__ bf16_t* wptr(const Ctx& c, int layer, size_t off) { return (bf16_t*)(c.ws + WS_W + (size_t)layer * W_LAYER + off); }

namespace pg8 {
#define PG8_LAS __attribute__((address_space(3)))
typedef unsigned short bf16_t;
typedef short bf16x8 __attribute__((ext_vector_type(8)));
typedef float f32x4 __attribute__((ext_vector_type(4)));
typedef unsigned u32x4 __attribute__((ext_vector_type(4)));
constexpr int BM = 256, BK = 64, HALF = 128, HTB = HALF * BK * 2  , STAGE_BYTES = 8 * HTB, NXCD = 8, WGM = 8;

__host__ __device__ __forceinline__ int lds_byte(int r, int c) { const int st = (r >> 4) * 2 + (c >> 5), rr = r & 15, cc = c & 31, ob = rr * 64 + cc * 2; return st * 1024 + (ob ^ (((ob >> 9) & 1) << 5)); }
__host__ __device__ __forceinline__ void stage_rc(int b, int& R, int& C) { const int st = b / 1024, sb = b % 1024, swz = sb ^ (((sb >> 9) & 1) << 5); R = (st >> 1) * 16 + swz / 64; C = (st & 1) * 32 + (swz % 64) / 2; }
__host__ __device__ __forceinline__ int perm32(int rho) { const int n = rho >> 4, i = rho & 15; return 8 * (i >> 2) + 4 * n + (i & 3); }

struct Unit { int pm, pn; };
struct Gemm { const bf16_t* A; const bf16_t* Bt; int M, N, K; };

struct StaticOrder {
    int nM, nN, nwg, G, c;
    __host__ __device__ void init(int M, int N, int G_, int c_) { nM = M / BM; nN = N / BM; nwg = nM * nN; G = G_; c = c_; }
    __host__ __device__ bool next(int i, Unit& u) const {
        const long L = (long)i * G + c; if (L >= nwg) return false;
        int wgid = (int)L; { const int q = nwg / NXCD, r = nwg % NXCD, xcd = wgid % NXCD, off = wgid / NXCD; wgid = (xcd < r ? xcd * (q + 1) : r * (q + 1) + (xcd - r) * q) + off; }
        const int nig = WGM * nN, gid = wgid / nig, fm = gid * WGM, gsz = (nM - fm) < WGM ? (nM - fm) : WGM;
        u.pm = fm + ((wgid % nig) % gsz); u.pn = (wgid % nig) / gsz; return true;
    }
    __device__ __forceinline__ void a_ready(const Unit&) const {}
    __device__ __forceinline__ void done(const Unit&) const {}
};

__device__ __forceinline__ unsigned cvt_pk_bf16(float lo, float hi) { unsigned r; asm volatile("v_cvt_pk_bf16_f32 %0, %1, %2" : "=v"(r) : "v"(lo), "v"(hi)); return r; }
typedef float f32x2 __attribute__((ext_vector_type(2)));
template <class Epi, class Sched, bool ALIGN_EPI = false, bool SP2 = false>
__device__ __forceinline__ void gemm_phase(PG8_LAS unsigned char* lds, const Gemm g, const Sched& S, const Epi& E) {
    int tid_ = threadIdx.x; asm volatile("" : "+v"(tid_));
    const int tid = tid_, wid = __builtin_amdgcn_readfirstlane(tid >> 6), lane = tid & 63, wr = wid >> 2, wc = wid & 3, fr = lane & 15, fq = lane >> 4;
    const int K = g.K, nt = K / BK;
    unsigned voffA[2], voffB[2];
#pragma unroll
    for (int i = 0; i < 2; ++i) { int R, C; stage_rc(tid * 16 + i * 8192, R, C); const int Rb = Epi::PERM ? ((R & ~31) + perm32(R & 31)) : R;
        voffA[i] = (unsigned)(R * K + C) * 2u; voffB[i] = (unsigned)(Rb * K + C) * 2u; }
    const size_t kstep = (size_t)(BK * 2);
    const size_t hstep = (size_t)HALF * K * 2;
    const size_t tstep = 2 * hstep;
    const unsigned ldsw = (unsigned)wid * 1024u;
    const int aoff = lds_byte(wr * 64 + fr, fq * 8), boff = lds_byte(wc * 32 + fr, fq * 8);
#define PG8_SA(b, h) (((b) * 2 + (h)) * HTB)
#define PG8_SB(b, h) ((4 + (b) * 2 + (h)) * HTB)
#define PG8_STAGE(bufoff, gbase, voff) do { _Pragma("unroll") for (int _i = 0; _i < 2; ++_i) \
        __builtin_amdgcn_global_load_lds((const unsigned*)((const char*)(gbase) + (voff)[_i]), (PG8_LAS unsigned*)(lds + (bufoff) + ldsw + _i * 8192), 16, 0, 0); } while (0)
#define PG8_LDA(dst, b, h) do { _Pragma("unroll") for (int m = 0; m < 4; ++m) _Pragma("unroll") for (int k = 0; k < 2; ++k) dst[m][k] = *(const PG8_LAS bf16x8*)(lds + PG8_SA(b, h) + aoff + m * 2048 + k * 1024); } while (0)
#define PG8_LDB(dst, b, h) do { _Pragma("unroll") for (int n = 0; n < 2; ++n) _Pragma("unroll") for (int k = 0; k < 2; ++k) dst[n][k] = *(const PG8_LAS bf16x8*)(lds + PG8_SB(b, h) + boff + n * 2048 + k * 1024); } while (0)
#define PG8_MMA(ai, bj, At, Bt) do { __builtin_amdgcn_s_setprio(1); _Pragma("unroll") for (int m = 0; m < 4; ++m) _Pragma("unroll") for (int n = 0; n < 2; ++n) _Pragma("unroll") for (int k = 0; k < 2; ++k) \
        acc[ai][bj][m][n] = __builtin_amdgcn_mfma_f32_16x16x32_bf16(Bt[n][k], At[m][k], acc[ai][bj][m][n], 0, 0, 0); __builtin_amdgcn_s_setprio(0); } while (0)
#define PG8_WAIT_V(n) asm volatile("s_waitcnt vmcnt(" #n ")" ::: "memory")
#define PG8_WAIT_L(n) asm volatile("s_waitcnt lgkmcnt(" #n ")" ::: "memory")
#define PG8_BAR __builtin_amdgcn_s_barrier()
#define PG8_SCHED __builtin_amdgcn_sched_barrier(0)
    Unit cur, nxt; int ui = 0;
    if (!S.next(0, cur)) return;
    f32x4 acc[2][2][4][2];
#pragma unroll
    for (int a = 0; a < 2; ++a)
#pragma unroll
        for (int b = 0; b < 2; ++b)
#pragma unroll
            for (int m = 0; m < 4; ++m)
#pragma unroll
                for (int n = 0; n < 2; ++n) acc[a][b][m][n] = (f32x4){0.f, 0.f, 0.f, 0.f};
    bf16x8 At[4][2], B0[2][2], B1[2][2];
    const char* cA = (const char*)g.A + (size_t)cur.pm * tstep; const char* cB = (const char*)g.Bt + (size_t)cur.pn * tstep;
    S.a_ready(cur);
    if constexpr (SP2) {
        PG8_STAGE(PG8_SB(0, 0), cB, voffB); PG8_STAGE(PG8_SB(0, 1), cB + hstep, voffB); PG8_STAGE(PG8_SA(0, 0), cA, voffA); PG8_STAGE(PG8_SA(0, 1), cA + hstep, voffA);
        if (wr == 1) PG8_BAR;
        PG8_WAIT_V(2); PG8_BAR;
        PG8_STAGE(PG8_SB(1, 0), cB + kstep, voffB); PG8_STAGE(PG8_SA(1, 0), cA + kstep, voffA); PG8_STAGE(PG8_SB(1, 1), cB + hstep + kstep, voffB);
        PG8_WAIT_V(6); PG8_BAR;
    } else {
        PG8_STAGE(PG8_SB(0, 0), cB, voffB); PG8_STAGE(PG8_SA(0, 0), cA, voffA); PG8_STAGE(PG8_SB(0, 1), cB + hstep, voffB); PG8_STAGE(PG8_SA(0, 1), cA + hstep, voffA);
        if (wr == 1) PG8_BAR;
        PG8_WAIT_V(4); PG8_BAR;
        PG8_STAGE(PG8_SB(1, 0), cB + kstep, voffB); PG8_STAGE(PG8_SA(1, 0), cA + kstep, voffA); PG8_STAGE(PG8_SB(1, 1), cB + hstep + kstep, voffB);
        PG8_WAIT_V(6); PG8_BAR;
    }
    for (;;) {
        const bool has_next = S.next(ui + 1, nxt);
        const char* nA = has_next ? (const char*)g.A + (size_t)nxt.pm * tstep : cA; const char* nB = has_next ? (const char*)g.Bt + (size_t)nxt.pn * tstep : cB;
        for (int t = 0; t < nt; t += 2) {
            const bool last = (t == nt - 2);
            const char* a1 = cA + (size_t)(t + 1) * kstep;
            const char* a2 = last ? nA : cA + (size_t)(t + 2) * kstep; const char* b2 = last ? nB : cB + (size_t)(t + 2) * kstep;
            const char* a3 = a2 + kstep; const char* b3 = b2 + kstep;
            if (last && has_next) S.a_ready(nxt);
            if constexpr (SP2) {
            PG8_LDB(B0, 0, 0); PG8_LDB(B1, 0, 1); PG8_SCHED; PG8_LDA(At, 0, 0); PG8_STAGE(PG8_SA(1, 1), a1 + hstep, voffA);
            PG8_WAIT_V(8); PG8_WAIT_L(0); PG8_BAR; PG8_MMA(0, 0, At, B0); PG8_MMA(0, 1, At, B1); PG8_BAR; PG8_SCHED;
            PG8_LDA(At, 0, 1); PG8_STAGE(PG8_SB(0, 0), b2, voffB); PG8_STAGE(PG8_SB(0, 1), b2 + hstep, voffB); PG8_STAGE(PG8_SA(0, 0), a2, voffA);
            PG8_WAIT_V(8); PG8_WAIT_L(0); PG8_BAR; PG8_MMA(1, 0, At, B0); PG8_MMA(1, 1, At, B1); PG8_BAR; PG8_SCHED;
            PG8_LDB(B0, 1, 0); PG8_LDB(B1, 1, 1); PG8_SCHED; PG8_LDA(At, 1, 0); PG8_STAGE(PG8_SA(0, 1), a2 + hstep, voffA);
            PG8_WAIT_V(8); PG8_WAIT_L(0); PG8_BAR; PG8_MMA(0, 0, At, B0); PG8_MMA(0, 1, At, B1); PG8_BAR; PG8_SCHED;
            PG8_LDA(At, 1, 1); PG8_STAGE(PG8_SB(1, 0), b3, voffB); PG8_STAGE(PG8_SB(1, 1), b3 + hstep, voffB); PG8_STAGE(PG8_SA(1, 0), a3, voffA);
            PG8_WAIT_V(8); PG8_WAIT_L(0); PG8_BAR; PG8_MMA(1, 0, At, B0); PG8_MMA(1, 1, At, B1); PG8_BAR; PG8_SCHED;
            } else {
            PG8_LDB(B0, 0, 0); PG8_SCHED; PG8_LDA(At, 0, 0); PG8_STAGE(PG8_SA(1, 1), a1 + hstep, voffA);
            PG8_WAIT_L(8); PG8_BAR; PG8_WAIT_L(0); PG8_MMA(0, 0, At, B0); PG8_BAR; PG8_SCHED;
            PG8_LDB(B1, 0, 1); PG8_STAGE(PG8_SB(0, 0), b2, voffB);
            PG8_BAR; PG8_WAIT_L(0); PG8_MMA(0, 1, At, B1); PG8_BAR;
            PG8_LDA(At, 0, 1); PG8_STAGE(PG8_SA(0, 0), a2, voffA);
            PG8_BAR; PG8_WAIT_L(0); PG8_MMA(1, 0, At, B0); PG8_BAR; PG8_SCHED;
            PG8_STAGE(PG8_SB(0, 1), b2 + hstep, voffB);
            PG8_WAIT_V(6); PG8_BAR; PG8_MMA(1, 1, At, B1); PG8_BAR;
            PG8_LDB(B0, 1, 0); PG8_SCHED; PG8_LDA(At, 1, 0); PG8_STAGE(PG8_SA(0, 1), a2 + hstep, voffA);
            PG8_WAIT_L(8); PG8_BAR; PG8_WAIT_L(0); PG8_MMA(0, 0, At, B0); PG8_BAR; PG8_SCHED;
            PG8_LDB(B1, 1, 1); PG8_STAGE(PG8_SB(1, 0), b3, voffB);
            PG8_BAR; PG8_WAIT_L(0); PG8_MMA(0, 1, At, B1); PG8_BAR;
            PG8_LDA(At, 1, 1); PG8_STAGE(PG8_SA(1, 0), a3, voffA);
            PG8_BAR; PG8_WAIT_L(0); PG8_MMA(1, 0, At, B0); PG8_BAR; PG8_SCHED;
            PG8_STAGE(PG8_SB(1, 1), b3 + hstep, voffB);
            PG8_WAIT_V(6); PG8_BAR; PG8_MMA(1, 1, At, B1); PG8_BAR;
            }
        }
        if constexpr (ALIGN_EPI) { if (wr == 0) PG8_BAR; }
        if constexpr (!Epi::AFTER_DRAIN) { E(acc, cur, wr, wc, fr, fq); S.done(cur); }
        if (!has_next) break;
#pragma unroll
        for (int a = 0; a < 2; ++a)
#pragma unroll
            for (int b = 0; b < 2; ++b)
#pragma unroll
                for (int m = 0; m < 4; ++m)
#pragma unroll
                    for (int n = 0; n < 2; ++n) acc[a][b][m][n] = (f32x4){0.f, 0.f, 0.f, 0.f};
        cur = nxt; cA = nA; cB = nB; ++ui;
        if constexpr (ALIGN_EPI) { if (wr == 1) PG8_BAR; }
    }
    PG8_WAIT_V(0);
    if constexpr (!ALIGN_EPI) { if (wr == 0) PG8_BAR; }
    PG8_BAR;
    if constexpr (Epi::AFTER_DRAIN) { E.fused(acc, cur, wr, wc, fr, fq, lds, wid, lane); S.done(cur); }
#undef PG8_SA
#undef PG8_SB
#undef PG8_STAGE
#undef PG8_LDA
#undef PG8_LDB
#undef PG8_MMA
#undef PG8_WAIT_V
#undef PG8_WAIT_L
#undef PG8_BAR
#undef PG8_SCHED
}
}

namespace pg8 {
__device__ __forceinline__ float silu_f(float x) { return x * __builtin_amdgcn_rcpf(1.f + __expf(-x)); }
struct EpiInProj {
    static constexpr bool PERM = true, AFTER_DRAIN = false;
    const float* ssq; const float* lbv; bf16_t *QB, *KB, *VB, *HXQ, *HV, *HG; float* LOGF; const float* fbias; float* logf8;
    __device__ __forceinline__ void operator()(const f32x4 (&acc)[2][2][4][2], const Unit& u, int wr, int wc, int fr, int fq) const {
        const int part = u.pn >> 1;
        const int cbase = (u.pn & 1) * 256 + wc * 32 + 8 * fq;
        if (part == 7) {
            if (wc == 0 && fq == 0) {
                const f32x4 b0 = *(const f32x4*)fbias, b1 = *(const f32x4*)(fbias + 4);
#pragma unroll
                for (int ai = 0; ai < 2; ++ai)
#pragma unroll
                    for (int m = 0; m < 4; ++m) {
                        const int r = u.pm * BM + ai * HALF + wr * 64 + m * 16 + fr;
                        const float rstd = 1.f / sqrtf(ssq[r] * (1.f / 1024.f) + 1e-6f);
                        f32x4 z0 = acc[ai][0][m][0] * rstd + b0, z1 = acc[ai][0][m][1] * rstd + b1;
#pragma unroll
                        for (int e = 0; e < 4; ++e) { z0[e] = fminf(z0[e], 0.f) - __logf(1.f + __expf(-fabsf(z0[e]))); z1[e] = fminf(z1[e], 0.f) - __logf(1.f + __expf(-fabsf(z1[e]))); }
                        *(f32x4*)(logf8 + (size_t)r * 8) = z0; *(f32x4*)(logf8 + (size_t)r * 8 + 4) = z1;
                    }
            }
        } else if (part == 4) {
#pragma unroll
            for (int bj = 0; bj < 2; ++bj)
#pragma unroll
                for (int n = 0; n < 2; ++n) {
                    const int cc = cbase + bj * HALF + 4 * n;
                    f32x4 lb1 = (f32x4){1.f, 1.f, 1.f, 1.f};
                    if (lbv) lb1 = lb1 - *(const f32x4*)(lbv + cc);
#pragma unroll
                    for (int ai = 0; ai < 2; ++ai)
#pragma unroll
                        for (int m = 0; m < 4; ++m) {
                            const int r = u.pm * BM + ai * HALF + wr * 64 + m * 16 + fr;
                            const float rstd = 1.f / sqrtf(ssq[r] * (1.f / 1024.f) + 1e-6f);
                            f32x4 a;
#pragma unroll
                            for (int e = 0; e < 4; ++e) { const float xv = acc[ai][bj][m][n][e] * rstd; const float omf = lb1[e] * __builtin_amdgcn_rcpf(1.f + __expf(xv)); a[e] = fmaxf(__logf(1.f - omf), -30.f); }
                            *(f32x4*)(LOGF + (size_t)r * 512 + cc) = a;
                        }
                }
        } else {
            bf16_t* dst = part == 0 ? QB : part == 1 ? KB : part == 2 ? VB : part == 3 ? HXQ : part == 5 ? HV : HG;
            const float sc = part == 0 ? 0.125f * 1.4426950408889634f : part == 3 ? 0.08838834764831845f : 1.f;
            const bool dosilu = (part == 3) || (part == 6);
#pragma unroll
            for (int ai = 0; ai < 2; ++ai)
#pragma unroll
                for (int m = 0; m < 4; ++m) {
                    const int r = u.pm * BM + ai * HALF + wr * 64 + m * 16 + fr;
                    const float rstd = sc / sqrtf(ssq[r] * (1.f / 1024.f) + 1e-6f);
#pragma unroll
                    for (int bj = 0; bj < 2; ++bj) {
                        f32x4 v0 = acc[ai][bj][m][0], v1 = acc[ai][bj][m][1];
                        if (dosilu) {
#pragma unroll
                            for (int e = 0; e < 4; ++e) { const float a0 = v0[e] * (rstd / sc), a1 = v1[e] * (rstd / sc); v0[e] = silu_f(a0) * sc; v1[e] = silu_f(a1) * sc; }
                        } else { v0 = v0 * rstd; v1 = v1 * rstd; }
                        u32x4 w; w.x = cvt_pk_bf16(v0[0], v0[1]); w.y = cvt_pk_bf16(v0[2], v0[3]); w.z = cvt_pk_bf16(v1[0], v1[1]); w.w = cvt_pk_bf16(v1[2], v1[3]);
                        *(u32x4*)(dst + (size_t)r * 512 + cbase + bj * HALF) = w;
                    }
                }
        }
    }
};
struct EpiResid {
    static constexpr bool PERM = false, AFTER_DRAIN = false;
    float* out; float* hs; bf16_t* HB; float* ssq; unsigned skip;
    __device__ __forceinline__ void operator()(const f32x4 (&acc)[2][2][4][2], const Unit& u, int wr, int wc, int fr, int fq) const {
        if (skip) return;
        const int col0 = u.pn * BM + wc * 32 + 4 * fq;
#pragma unroll
        for (int ai = 0; ai < 2; ++ai)
#pragma unroll
            for (int m = 0; m < 4; ++m) {
                const int r = u.pm * BM + ai * HALF + wr * 64 + m * 16 + fr;
                const int b = r / 4160, vp = r - b * 4160;
                float* hp = vp >= 64 ? out + (size_t)(b * 4096 + vp - 64) * 1024 : hs + (size_t)(b * 64 + vp) * 1024;
                float q = 0.f;
#pragma unroll
                for (int bj = 0; bj < 2; ++bj)
#pragma unroll
                    for (int n = 0; n < 2; ++n) { const int c = col0 + bj * HALF + n * 16; const f32x4 h = *(const f32x4*)(hp + c) + acc[ai][bj][m][n]; *(f32x4*)(hp + c) = h;
                        unsigned long long w = (unsigned long long)cvt_pk_bf16(h[0], h[1]) | ((unsigned long long)cvt_pk_bf16(h[2], h[3]) << 32);
                        *(unsigned long long*)(HB + (size_t)r * 1024 + c) = w; q += (h[0] * h[0] + h[1] * h[1]) + (h[2] * h[2] + h[3] * h[3]); }
                if (ssq) { q += __shfl_xor(q, 16); q += __shfl_xor(q, 32); if (fq == 0) atomicAdd(ssq + r, q); }
            }
    }
};
struct EpiSwiGLU {
    static constexpr bool PERM = true, AFTER_DRAIN = false;
    const float* ssq; bf16_t* ACT;
    __device__ __forceinline__ void operator()(const f32x4 (&acc)[2][2][4][2], const Unit& u, int wr, int wc, int fr, int fq) const {
        const int f0 = u.pn * HALF + wc * 32 + 8 * fq;
#pragma unroll
        for (int ai = 0; ai < 2; ++ai)
#pragma unroll
            for (int m = 0; m < 4; ++m) {
                const int r = u.pm * BM + ai * HALF + wr * 64 + m * 16 + fr;
                const float rstd = 1.f / sqrtf(ssq[r] * (1.f / 1024.f) + 1e-6f);
                float y[8];
#pragma unroll
                for (int n = 0; n < 2; ++n)
#pragma unroll
                    for (int e = 0; e < 4; ++e) { const float g = acc[ai][0][m][n][e] * rstd, uu = acc[ai][1][m][n][e] * rstd; y[4 * n + e] = silu_f(g) * uu; }
                u32x4 w; w.x = cvt_pk_bf16(y[0], y[1]); w.y = cvt_pk_bf16(y[2], y[3]); w.z = cvt_pk_bf16(y[4], y[5]); w.w = cvt_pk_bf16(y[6], y[7]);
                *(u32x4*)(ACT + (size_t)r * 2816 + f0) = w;
            }
    }
};
}

#define GAS __attribute__((address_space(1)))
typedef unsigned v4u __attribute__((ext_vector_type(4)));
typedef GAS unsigned gu32;
typedef GAS unsigned long long gu64;
#define RLX_AGENT __ATOMIC_RELAXED, __HIP_MEMORY_SCOPE_AGENT
#define LDS_WAIT() asm volatile("s_waitcnt lgkmcnt(0)" ::: "memory")
#define VM_WAIT() asm volatile("s_waitcnt vmcnt(0)" ::: "memory")
__device__ __forceinline__ unsigned long long rt() { return __builtin_amdgcn_s_memrealtime(); }
#define XB_TMO      128
#define XB_XCNT(j)  (256  + 64 * (j))
#define XB_XSUB(j)  (1280 + 64 * (j))
#define XB_XGEN(j)  (2304 + 64 * (j))
#define XB_TOP      3328
#define XB_TOPGEN   3392
#define XCD_BAR_WORDS 3456
#define XB_SPIN_CAP (1u << 18)

__device__ __forceinline__ unsigned xb_ld(unsigned* p)              { return __hip_atomic_load(p, __ATOMIC_RELAXED, __HIP_MEMORY_SCOPE_AGENT); }
__device__ __forceinline__ unsigned xb_add(unsigned* p, unsigned v) { return __hip_atomic_fetch_add(p, v, __ATOMIC_RELAXED, __HIP_MEMORY_SCOPE_AGENT); }
__device__ __forceinline__ unsigned xb_xcc_id() { return (unsigned)__builtin_amdgcn_s_getreg((3 << 11) | 20) & 0xFu; }
#define XB_SPIN(cond, bar) do { unsigned _sp = 0; while (cond) { __builtin_amdgcn_s_sleep(1); \
    if ((++_sp & 255u) == 0u) { if (xb_ld(&(bar)[XB_TMO])) break; if (_sp > XB_SPIN_CAP) { atomicAdd(&(bar)[XB_TMO], 1u); break; } } } } while (0)

struct XcdBarrier {
    unsigned* bar; unsigned x;
    volatile LAS unsigned* st;
};

__device__ __forceinline__ XcdBarrier xcd_barrier_post(unsigned* bar, volatile LAS unsigned* st) {
    XcdBarrier b; b.bar = bar; b.x = xb_xcc_id(); b.st = st;
    if (threadIdx.x == 0) (void)xb_add(&bar[XB_XCNT(b.x)], 1u);
    return b;
}
__device__ __forceinline__ void xcd_barrier_complete(unsigned* bar, unsigned x, unsigned& nloc, unsigned& nx) {
    const unsigned G = gridDim.x * gridDim.y * gridDim.z;
    unsigned sum, cnt, mine, sp = 0u;
    for (;;) {
        sum = 0u; cnt = 0u; mine = 0u;
#pragma unroll
        for (unsigned j = 0; j < 16; ++j) { const unsigned c = xb_ld(&bar[XB_XCNT(j)]); sum += c; cnt += (c > 0u) ? 1u : 0u; mine = (j == x) ? c : mine; }
        if (sum == G) break;
        __builtin_amdgcn_s_sleep(1);
        if ((++sp & 255u) == 0u) { if (xb_ld(&bar[XB_TMO])) break; if (sp > XB_SPIN_CAP) { atomicAdd(&bar[XB_TMO], 1u); break; } }
    }
    nloc = mine > 0u ? mine : 1u; nx = cnt > 0u ? cnt : 1u;
}

__device__ __forceinline__ void xcd_barrier(const XcdBarrier& b) {
    asm volatile("s_waitcnt vmcnt(0)" ::: "memory");
    __syncthreads();
    int t_ = threadIdx.x; asm volatile("" : "+v"(t_));
    if (t_ == 0) {
        unsigned* bar = b.bar;
        __builtin_amdgcn_s_waitcnt(0);
        unsigned nloc = b.st[0], nx = b.st[1];
        if (nloc == 0u) { xcd_barrier_complete(bar, b.x, nloc, nx); b.st[0] = nloc; b.st[1] = nx; }
        const unsigned old = xb_add(&bar[XB_XSUB(b.x)], 1u);
        const unsigned gen = old / nloc;
        if (old + 1u == (gen + 1u) * nloc) {
            __builtin_amdgcn_fence(__ATOMIC_RELEASE, "agent");
            asm volatile("s_waitcnt vmcnt(0)" ::: "memory");
            const unsigned og = xb_add(&bar[XB_TOP], 1u);
            const unsigned tg = og / nx;
            if (og + 1u == (tg + 1u) * nx) xb_add(&bar[XB_TOPGEN], 1u);
            else XB_SPIN(xb_ld(&bar[XB_TOPGEN]) == tg, bar);
            __builtin_amdgcn_fence(__ATOMIC_ACQUIRE, "agent");
            xb_add(&bar[XB_XGEN(b.x)], 1u);
            asm volatile("s_waitcnt vmcnt(0)" ::: "memory");
        } else {
            XB_SPIN(xb_ld(&bar[XB_XGEN(b.x)]) == gen, bar);
            __builtin_amdgcn_fence(__ATOMIC_ACQUIRE, "agent");
            asm volatile("s_waitcnt vmcnt(0)" ::: "memory");
        }
    }
    __syncthreads();
}

__device__ __forceinline__ void tr_item(const float* W, int K, int N, int k0, int nsrc0, bf16_t* WT, int dst_row0, const float* kscale, LAS float* scr, int lane) {
    float wv[32];
#pragma unroll
    for (int i = 0; i < 32; ++i) { const int kk = 2 * i + (lane >> 5); wv[i] = W[(size_t)(k0 + kk) * N + nsrc0 + (lane & 31)]; }
#pragma unroll
    for (int i = 0; i < 32; ++i) { const int kk = 2 * i + (lane >> 5); const float s = kscale ? kscale[k0 + kk] : 1.f; scr[kk * 33 + (lane & 31)] = wv[i] * s; }
    asm volatile("s_waitcnt lgkmcnt(0)" ::: "memory");
    const int ch = lane & 7;
#pragma unroll
    for (int j = 0; j < 4; ++j) { const int n = (lane >> 3) + 8 * j; const LAS float* s = scr + (8 * ch) * 33 + n;
        u32x4 o; o.x = pk2(s[0 * 33], s[1 * 33]); o.y = pk2(s[2 * 33], s[3 * 33]); o.z = pk2(s[4 * 33], s[5 * 33]); o.w = pk2(s[6 * 33], s[7 * 33]);
        *(u32x4*)(WT + (size_t)(dst_row0 + n) * K + k0 + 8 * ch) = o; }
    asm volatile("s_waitcnt lgkmcnt(0)" ::: "memory");
}

__device__ __forceinline__ void p0_weights(const Ctx& c, LAS unsigned char* lds, int l, int it0, int it1, int w0, int nw) {
    LAS float* scr = (LAS float*)(lds + c.wave * 16384);
    constexpr int I_IN = 16 * (NIN / 32), I_OUT = 16 * 32, I_G = 16 * (DFF / 32), I_D = (DFF / 64) * 32, I_L = I_IN + I_OUT + 2 * I_G + I_D;
    if (it1 > I_L) it1 = I_L;
#pragma nounroll
    for (int it = it0 + w0; it < it1; it += nw) {
        int r = it;
        if (r < I_IN) { const int kb = r / (NIN / 32), nb = r % (NIN / 32), n0 = nb * 32;
            tr_item(c.win + (size_t)l * DM * INCOLS, DM, INCOLS, kb * 64, n0 + (n0 >= 1536 ? 8 : 0), wptr(c, l, W_IN), n0, c.nmw + l * DM, scr, c.lane); continue; }
        r -= I_IN;
        if (r < I_OUT) { const int kb = r / 32, nb = r % 32; tr_item(c.wout + (size_t)l * DM * DM, DM, DM, kb * 64, nb * 32, wptr(c, l, W_OUT), nb * 32, nullptr, scr, c.lane); continue; }
        r -= I_OUT;
        if (r < 2 * I_G) { const int up = r >= I_G; if (up) r -= I_G; const int kb = r / (DFF / 32), nb = r % (DFF / 32), f0 = nb * 32;
            tr_item((up ? c.wu : c.wg) + (size_t)l * DM * DFF, DM, DFF, kb * 64, f0, wptr(c, l, W_GU), 256 * (f0 >> 7) + (f0 & 127) + (up ? 128 : 0), c.nfw + l * DM, scr, c.lane); continue; }
        r -= 2 * I_G;
        { const int kb = r / 32, nb = r % 32; tr_item(c.wd + (size_t)l * DFF * DM, DFF, DM, kb * 64, nb * 32, wptr(c, l, W_DN), nb * 32, nullptr, scr, c.lane); }
    }
}

__device__ __forceinline__ void p0_extra_rows(const Ctx& c, int l, int gt, int NGT) {
#pragma nounroll
    for (int i = gt; i < 8 * DM; i += NGT) { const int cc = i >> 10, k = i & 1023;
        wptr(c, l, W_IN)[(size_t)(NIN + cc) * DM + k] = (bf16_t)f2bf(c.win[(size_t)l * DM * INCOLS + (size_t)k * INCOLS + 1536 + cc] * c.nmw[l * DM + k]); }
#pragma nounroll
    for (int i = gt; i < 248 * 128; i += NGT) *(u32x4*)(wptr(c, l, W_IN) + (size_t)(NIN + 8) * DM + (size_t)i * 8) = (u32x4){0u, 0u, 0u, 0u};
}
__device__ __forceinline__ void h_build(const Ctx& c) {
    float* ssq = c.sumsq;
    for (int rb = c.gw; rb < MROWS; rb += 4 * c.NGW) {
        f32x4 v[4][4];
#pragma unroll
        for (int q = 0; q < 4; ++q) { const int r = rb + q * c.NGW;
            if (r < MROWS) { const int b = r / LV, vp = r - b * LV;
                const float* src = vp >= 64 ? c.x + (size_t)(b * SEQ + vp - 64) * DM : (vp >= PADF ? c.meta + (size_t)(vp - PADF) * DM : nullptr);
#pragma unroll
                for (int j = 0; j < 4; ++j) v[q][j] = src ? *(const f32x4*)(src + 4 * c.lane + 256 * j) : (f32x4){0.f, 0.f, 0.f, 0.f}; } }
#pragma unroll
        for (int q = 0; q < 4; ++q) { const int r = rb + q * c.NGW;
            if (r < MROWS) { float* hp = hrow(c, r); float s = 0.f;
#pragma unroll
                for (int j = 0; j < 4; ++j) { *(f32x4*)(hp + 4 * c.lane + 256 * j) = v[q][j];
                    unsigned long long w = (unsigned long long)pk2(v[q][j].x, v[q][j].y) | ((unsigned long long)pk2(v[q][j].z, v[q][j].w) << 32);
                    *(unsigned long long*)(c.HB + (size_t)r * DM + 4 * c.lane + 256 * j) = w;
                    s += (v[q][j].x * v[q][j].x + v[q][j].y * v[q][j].y) + (v[q][j].z * v[q][j].z + v[q][j].w * v[q][j].w); }
                s = wave_sum(s);
                if (c.lane == 0) ssq[r] = s; } }
    }
}

__device__ __forceinline__ void kbias_job(const Ctx& c, LAS unsigned char* lds, int job) {
    const int b = job >> 3, h = job & 7;
    LAS float* wt = (LAS float*)lds;
    const int v0 = 9 * c.tid;
    float g[9]; float s = 0.f;
#pragma unroll
    for (int i = 0; i < 9; ++i) { const int vp = v0 + i; g[i] = (vp >= PADF && vp < LV) ? c.logf8[(size_t)(b * LV + vp) * 8 + h] : 0.f; s += g[i]; }
    float inc = s;
#pragma unroll
    for (int o = 1; o < 64; o <<= 1) { const float t = __shfl_up(inc, o); if (c.lane >= o) inc += t; }
    if (c.lane == 63) wt[c.wave] = inc;
    __syncthreads();
    float run = inc - s;
    for (int w = 0; w < c.wave; ++w) run += wt[w];
    float* kb = c.kbias + (size_t)job * KBL;
#pragma unroll
    for (int i = 0; i < 9; ++i) { const int vp = v0 + i; run += g[i]; if (vp < KBL) kb[vp] = vp < PADF ? -1e30f : (vp < LV ? -run * LOG2E : 0.f); }
    __syncthreads();
}

template <int MODE>
__device__ __forceinline__ void gemm_simple(const Ctx& c, int layer) {
    const int fr = c.lane & 15, g = c.lane >> 4;
    const bf16_t* A = MODE == 0 ? c.HB : MODE == 1 ? c.MIX : MODE == 2 ? c.HB : c.ACT;
    const bf16_t* Bt = wptr(c, layer, MODE == 0 ? W_IN : MODE == 1 ? W_OUT : MODE == 2 ? W_GU : W_DN);
    constexpr int K = MODE == 3 ? DFF : DM;
    constexpr int NCOL = MODE == 0 ? NIN : MODE == 2 ? DFF : DM;
    constexpr int ntn = NCOL / 64, ntm = MROWS / 16;
    for (int t = c.gw; t < ntm * ntn; t += c.NGW) {
        const int tm = t / ntn, tn = t - tm * ntn, row0 = tm * 16, col0 = tn * 64;
        f32x4 acc[4], acc2[4];
#pragma unroll
        for (int n = 0; n < 4; ++n) { acc[n] = (f32x4){0.f, 0.f, 0.f, 0.f}; acc2[n] = (f32x4){0.f, 0.f, 0.f, 0.f}; }
        const bf16_t* ap = A + (size_t)(row0 + fr) * K + 8 * g;
        const bf16_t* bp[4];
#pragma unroll
        for (int n = 0; n < 4; ++n) { const int cn = col0 + 16 * n + fr; const int br = MODE == 2 ? 256 * (cn >> 7) + (cn & 127) : cn; bp[n] = Bt + (size_t)br * K + 8 * g; }
        for (int k0 = 0; k0 < K; k0 += 32) {
            const bf16x8 a = *(const bf16x8*)(ap + k0);
#pragma unroll
            for (int n = 0; n < 4; ++n) { const bf16x8 b = *(const bf16x8*)(bp[n] + k0); acc[n] = __builtin_amdgcn_mfma_f32_16x16x32_bf16(a, b, acc[n], 0, 0, 0);
                if (MODE == 2) { const bf16x8 b2 = *(const bf16x8*)(bp[n] + (size_t)128 * K + k0); acc2[n] = __builtin_amdgcn_mfma_f32_16x16x32_bf16(a, b2, acc2[n], 0, 0, 0); } }
        }
        if (MODE == 0) {
            const float* ssq = c.sumsq + (size_t)layer * MALLOC;
#pragma unroll
            for (int j = 0; j < 4; ++j) { const int r = row0 + 4 * g + j; const float rstd = 1.f / sqrtf(ssq[r] * (1.f / DM) + EPS);
#pragma unroll
                for (int n = 0; n < 4; ++n) { const int cn = col0 + 16 * n + fr; const float xv = acc[n][j] * rstd; const int part = cn >> 9, cc = cn & 511; const size_t o = (size_t)r * 512 + cc;
                    if (part == 0) c.QB[o] = (bf16_t)f2bf(xv * C2);
                    else if (part == 1) c.KB[o] = (bf16_t)f2bf(xv);
                    else if (part == 2) c.VB[o] = (bf16_t)f2bf(xv);
                    else if (part == 3) c.HXQ[o] = (bf16_t)f2bf(siluf(xv) * HGQS);
                    else if (part == 4) { const float lb = layer ? c.lbv[cc] : 0.f; const float omf = (1.f - lb) / (1.f + __expf(xv)); c.LOGF[o] = fmaxf(log1pf(-omf), -30.f); }
                    else if (part == 5) c.HV[o] = (bf16_t)f2bf(xv);
                    else c.HG[o] = (bf16_t)f2bf(siluf(xv)); } }
        } else if (MODE == 1 || MODE == 3) {
            float* ssq = c.sumsq + (size_t)(2 + layer) * MALLOC;
#pragma unroll
            for (int j = 0; j < 4; ++j) { const int r = row0 + 4 * g + j; float* hp = hrow(c, r); float q = 0.f;
#pragma unroll
                for (int n = 0; n < 4; ++n) { const int cn = col0 + 16 * n + fr; const float hn = hp[cn] + acc[n][j]; hp[cn] = hn; c.HB[(size_t)r * DM + cn] = (bf16_t)f2bf(hn); q += hn * hn; }
                if (MODE == 1) { q += __shfl_xor(q, 1); q += __shfl_xor(q, 2); q += __shfl_xor(q, 4); q += __shfl_xor(q, 8); if (fr == 0) atomicAdd(ssq + r, q); } }
        } else {
            const float* ssq = c.sumsq + (size_t)(2 + layer) * MALLOC;
#pragma unroll
            for (int j = 0; j < 4; ++j) { const int r = row0 + 4 * g + j; const float rstd = 1.f / sqrtf(ssq[r] * (1.f / DM) + EPS);
#pragma unroll
                for (int n = 0; n < 4; ++n) { const int cn = col0 + 16 * n + fr; const float gv = acc[n][j] * rstd, uv = acc2[n][j] * rstd; c.ACT[(size_t)r * DFF + cn] = (bf16_t)f2bf(siluf(gv) * uv); } }
        }
    }
}

template <int MODE>
__device__ __forceinline__ void tail_job(const Ctx& c, LAS unsigned char* lds, int layer) {
    constexpr int K = MODE == 3 ? DFF : DM, KW = K / 8;
    const bf16_t* A = MODE == 1 ? c.MIX : c.ACT;
    const bf16_t* Bt = wptr(c, layer, MODE == 1 ? W_OUT : W_DN);
    float* ssq = MODE == 1 ? c.sumsq + (size_t)(2 + layer) * MALLOC : (layer == 0 ? c.sumsq + (size_t)MALLOC : nullptr);
    int tid_ = threadIdx.x; asm volatile("" : "+v"(tid_)); const int tid = tid_, lane = tid & 63, w = __builtin_amdgcn_readfirstlane(tid >> 6);
    const int fr = lane & 15, g = lane >> 4;
    LAS float* P = (LAS float*)lds;
    for (int job = blockIdx.x; job < 256; job += gridDim.x) {
        const int tm = job >> 4, tn = job & 15, row0 = 16384 + tm * 16, col0 = tn * 64;
        f32x4 acc[4];
#pragma unroll
        for (int n = 0; n < 4; ++n) acc[n] = (f32x4){0.f, 0.f, 0.f, 0.f};
        const bf16_t* ap = A + (size_t)(row0 + fr) * K + w * KW + 8 * g;
        const bf16_t* bp = Bt + (size_t)(col0 + fr) * K + w * KW + 8 * g;
#pragma unroll 4
        for (int k0 = 0; k0 < KW; k0 += 32) {
            const bf16x8 a = *(const bf16x8*)(ap + k0);
#pragma unroll
            for (int n = 0; n < 4; ++n) { const bf16x8 b = *(const bf16x8*)(bp + (size_t)n * 16 * K + k0); acc[n] = __builtin_amdgcn_mfma_f32_16x16x32_bf16(a, b, acc[n], 0, 0, 0); }
        }
#pragma unroll
        for (int n = 0; n < 4; ++n)
#pragma unroll
            for (int j = 0; j < 4; ++j) P[(w * 16 + 4 * g + j) * 64 + 16 * n + fr] = acc[n][j];
        __syncthreads();
        { const int row = tid >> 5, c2 = (tid & 31) * 2; float s0 = 0.f, s1 = 0.f;
#pragma unroll
          for (int ww = 0; ww < 8; ++ww) { s0 += P[(ww * 16 + row) * 64 + c2]; s1 += P[(ww * 16 + row) * 64 + c2 + 1]; }
          const int r = row0 + row; float* hp = hrow(c, r) + col0 + c2;
          const float h0 = hp[0] + s0, h1 = hp[1] + s1; hp[0] = h0; hp[1] = h1;
          *(unsigned*)(c.HB + (size_t)r * DM + col0 + c2) = pk2(h0, h1);
          if (ssq) { float q = h0 * h0 + h1 * h1; q += __shfl_xor(q, 1); q += __shfl_xor(q, 2); q += __shfl_xor(q, 4); q += __shfl_xor(q, 8); q += __shfl_xor(q, 16); if ((tid & 31) == 0) atomicAdd(ssq + r, q); } }
        __syncthreads();
    }
}

template <int MODE>
__device__ __forceinline__ void gemm_fast(const Ctx& c, LAS unsigned char* lds, int layer, unsigned skip = 0u) {
    const bf16_t* A = MODE == 0 ? c.HB : MODE == 1 ? c.MIX : MODE == 2 ? c.HB : c.ACT;
    const bf16_t* Bt = wptr(c, layer, MODE == 0 ? W_IN : MODE == 1 ? W_OUT : MODE == 2 ? W_GU : W_DN);
    constexpr int K = MODE == 3 ? DFF : DM;
    constexpr int N = MODE == 0 ? NINP : MODE == 2 ? 2 * DFF : DM;
    int bx_ = blockIdx.x; asm volatile("" : "+s"(bx_));
    constexpr int MG = (MODE == 1 || MODE == 3) ? 16384 : MROWS;
    pg8::Gemm g{A, Bt, MG, N, K}; pg8::StaticOrder S; S.init(MG, N, (int)gridDim.x, bx_);
    if constexpr (MODE == 0) {
        pg8::EpiInProj E{c.sumsq + (size_t)layer * MALLOC, layer ? c.lbv : nullptr, c.QB, c.KB, c.VB, c.HXQ, c.HV, c.HG, c.LOGF, c.fbias + layer * 8, c.logf8};
        pg8::gemm_phase<pg8::EpiInProj, pg8::StaticOrder, true, true>(lds, g, S, E);
    } else if constexpr (MODE == 2) {
        pg8::EpiSwiGLU E{c.sumsq + (size_t)(2 + layer) * MALLOC, c.ACT};
        pg8::gemm_phase<pg8::EpiSwiGLU, pg8::StaticOrder, true, true>(lds, g, S, E);
    } else {
        pg8::EpiResid E{c.out, c.hs, c.HB, MODE == 1 ? c.sumsq + (size_t)(2 + layer) * MALLOC : (layer == 0 ? c.sumsq + (size_t)MALLOC : nullptr), skip};
        pg8::gemm_phase<pg8::EpiResid, pg8::StaticOrder, true, true>(lds, g, S, E);
        if (!skip) tail_job<MODE>(c, lds, layer);
    }
}

#include <hip/hip_bf16.h>
#include <cmath>
namespace attn_body {
using bf16=__hip_bfloat16;
using bf16x8=__attribute__((ext_vector_type(8)))short;
using s16x4=__attribute__((ext_vector_type(4)))short;
using f32x16=__attribute__((ext_vector_type(16)))float;
using u32x4=__attribute__((ext_vector_type(4)))unsigned;
constexpr int BATCH=4,NHEAD=8,SEQ=4160,D=64,DM=NHEAD*D,OP=1024;
constexpr int NW=8,QBLK=32,QB=QBLK*NW,KVBLK=64,NQB=17;
constexpr int ATTN_PITCH=DM, ATTN_UNIT_ROWS=QB;
__device__ __forceinline__ int crow(int r,int hi){return (r&3)+8*(r>>2)+4*hi;}
#define SBAR() __builtin_amdgcn_sched_barrier(0)
__device__ __forceinline__ void cmask(f32x16&p0,f32x16&p1,int jb,int qrel,int hi){
  const float NEG=-INFINITY; int kb=64*jb+4*hi;
  #pragma unroll
  for(int r=0;r<16;++r){int kv=kb+(r&3)+8*(r>>2); if(kv>qrel)p0[r]=NEG; if(kv+32>qrel)p1[r]=NEG;}
}

constexpr int NSLOT=3, SLOTB=8192;
constexpr int LDS_K=0, LDS_V=NSLOT*SLOTB, LDS_WS=2*NSLOT*SLOTB, LDS_OST=LDS_WS+NW*64*4, LDS_KB=LDS_OST+NW*4096, LDS_BYTES=LDS_KB+4352*4+256;
constexpr float C2=0.125f*1.4426950408889634f;
__device__ __forceinline__ void glds16(const void*gsrc,unsigned lds_dst){unsigned keep;
  asm volatile("s_mov_b32 %0, m0\n\ts_mov_b32 m0, %2\n\ts_nop 0\n\tglobal_load_lds_dwordx4 %1, off\n\ts_mov_b32 m0, %0":"=&s"(keep):"v"(gsrc),"s"(lds_dst):"memory");}
__device__ __forceinline__ float max3f(float a,float b,float c){float r;asm("v_max3_f32 %0, %1, %2, %3":"=v"(r):"v"(a),"v"(b),"v"(c));return r;}
__device__ __forceinline__ float max2f(float a,float b){float r;asm("v_max_f32_e32 %0, %1, %2":"=v"(r):"v"(a),"v"(b));return r;}
__device__ __forceinline__ float fadd_s(float a,float b){float r;asm("v_add_f32_e32 %0, %1, %2":"=v"(r):"v"(a),"v"(b));return r;}
__device__ __forceinline__ float fsub_s(float a,float b){float r;asm("v_sub_f32_e32 %0, %1, %2":"=v"(r):"v"(a),"v"(b));return r;}
typedef float f32x2_t __attribute__((ext_vector_type(2))); typedef __bf16 bf16x2_t __attribute__((ext_vector_type(2)));
__device__ __forceinline__ unsigned cvtpk_s(float lo,float hi){f32x2_t v={lo,hi};bf16x2_t b=__builtin_convertvector(v,bf16x2_t);return __builtin_bit_cast(unsigned,b);}
#define WAIT_BAR(N) asm volatile("s_waitcnt vmcnt(" #N ") lgkmcnt(0)\n\ts_barrier":::"memory")

__device__ __forceinline__ void qkt(f32x16&p0,f32x16&p1,const char*Kslot,const bf16x8*qr,int r32,int hi){
  const char*kb=Kslot+hi*1024+r32*16;
  #pragma unroll
  for(int d0=0;d0<4;++d0){
    const bf16x8 b0=*reinterpret_cast<const bf16x8*>(kb+d0*2048);
    const bf16x8 b1=*reinterpret_cast<const bf16x8*>(kb+d0*2048+512);
    p0=__builtin_amdgcn_mfma_f32_32x32x16_bf16(b0,qr[d0],p0,0,0,0);p1=__builtin_amdgcn_mfma_f32_32x32x16_bf16(b1,qr[d0],p1,0,0,0);}
}
typedef __attribute__((address_space(3))) const char* lds_cptr;
typedef short v4i16_t __attribute__((ext_vector_type(4)));
__device__ __forceinline__ void kload8(bf16x8*kf,lds_cptr kp){
  kf[0]=*(const __attribute__((address_space(3))) bf16x8*)(kp);      kf[1]=*(const __attribute__((address_space(3))) bf16x8*)(kp+512);
  kf[2]=*(const __attribute__((address_space(3))) bf16x8*)(kp+2048); kf[3]=*(const __attribute__((address_space(3))) bf16x8*)(kp+2560);
  kf[4]=*(const __attribute__((address_space(3))) bf16x8*)(kp+4096); kf[5]=*(const __attribute__((address_space(3))) bf16x8*)(kp+4608);
  kf[6]=*(const __attribute__((address_space(3))) bf16x8*)(kp+6144); kf[7]=*(const __attribute__((address_space(3))) bf16x8*)(kp+6656);
}
__device__ __forceinline__ void kload2(bf16x8*kf,lds_cptr kp,int j){ kf[2*j]=*(const __attribute__((address_space(3))) bf16x8*)(kp+j*2048); kf[2*j+1]=*(const __attribute__((address_space(3))) bf16x8*)(kp+j*2048+512); }
__device__ __forceinline__ s16x4 vtr(lds_cptr p){ return __builtin_bit_cast(s16x4,__builtin_amdgcn_ds_read_tr16_b64_v4i16((__attribute__((address_space(3))) v4i16_t*)p)); }
__device__ __forceinline__ float rowmax(const f32x16&p0,const f32x16&p1){
  float a=max3f(p0[0],p0[1],p1[0]),b=max3f(p0[2],p0[3],p1[1]);a=max3f(a,p1[2],p1[3]);
  #pragma unroll
  for(int r=4;r<16;r+=4){a=max3f(a,p0[r],p0[r+1]);b=max3f(b,p0[r+2],p0[r+3]);a=max3f(a,p1[r],p1[r+1]);b=max3f(b,p1[r+2],p1[r+3]);}
  const float m=max2f(a,b);
  auto rr=__builtin_amdgcn_permlane32_swap(__float_as_uint(m),__float_as_uint(m),false,false);
  return max2f(__uint_as_float(rr[0]),__uint_as_float(rr[1]));
}
__device__ __forceinline__ void pv(f32x16*o,int vb,bf16x8 pa0,bf16x8 pa1,bf16x8 pa2,bf16x8 pa3){
  #pragma unroll
  for(int d0=0;d0<2;++d0){s16x4 lo[4],hi[4];
    #pragma unroll
    for(int ks=0;ks<4;++ks){
      asm volatile("ds_read_b64_tr_b16 %0,%1 offset:%c2":"=&v"(lo[ks]):"v"(vb),"i"(d0*4096+ks*1024):"memory");
      asm volatile("ds_read_b64_tr_b16 %0,%1 offset:%c2":"=&v"(hi[ks]):"v"(vb),"i"(d0*4096+ks*1024+512):"memory");}
    asm volatile("s_waitcnt lgkmcnt(0)":::"memory");SBAR();
    #define PK(k) (bf16x8){lo[k][0],lo[k][1],lo[k][2],lo[k][3],hi[k][0],hi[k][1],hi[k][2],hi[k][3]}
    o[d0]=__builtin_amdgcn_mfma_f32_32x32x16_bf16(pa0,PK(0),o[d0],0,0,0);
    o[d0]=__builtin_amdgcn_mfma_f32_32x32x16_bf16(pa1,PK(1),o[d0],0,0,0);
    o[d0]=__builtin_amdgcn_mfma_f32_32x32x16_bf16(pa2,PK(2),o[d0],0,0,0);
    o[d0]=__builtin_amdgcn_mfma_f32_32x32x16_bf16(pa3,PK(3),o[d0],0,0,0);
    #undef PK
  }
}

#ifndef ATTN_STORE16
#define ATTN_STORE16(p,v) (*(u32x4*)(p)=(v))
#endif
template<int THRL> __device__ __forceinline__ void attn_unit(int b,int h,int qb,const bf16*Q,const bf16*__restrict__ K,const bf16*__restrict__ V,bf16*O,const float*__restrict__ kbg,char*shm){
  int tid_=threadIdx.x; asm volatile("":"+v"(tid_)); const int tid=tid_,lane=tid&63,r32=lane&31,hi=lane>>5; const int wid=__builtin_amdgcn_readfirstlane(tid>>6);
  const long rowbase=(long)b*SEQ; const int q0=qb*QB;
  const bf16*Qw=Q+(rowbase+q0+wid*QBLK)*DM+h*D;
  const bf16*Kh=K+rowbase*DM+h*D,*Vh=V+rowbase*DM+h*D;
  const unsigned lds0=(unsigned)(uintptr_t)shm;
  float*wsf=(float*)(shm+LDS_WS)+wid*64;
  const bf16*ksrc=Kh+(long)lane*DM+wid*8;
  const bf16*vsrc=Vh+(long)(16*(wid&3)+(lane>>2))*DM+(wid>>2)*32+(lane&3)*8;
  const unsigned kdst=lds0+LDS_K+wid*1024, vdst=lds0+LDS_V+wid*1024;
  #define DMA_K(t,slot) glds16(ksrc+(long)(t)*KVBLK*DM,(unsigned)__builtin_amdgcn_readfirstlane(kdst+(slot)))
  #define DMA_V(t,slot) glds16(vsrc+(long)(t)*KVBLK*DM,(unsigned)__builtin_amdgcn_readfirstlane(vdst+(slot)))
  const int vb0=(int)(lds0+LDS_V)+((lane>>4)&1)*32+(lane&3)*8+(4*hi+((lane&15)>>2))*64;
  const char*Kbase=shm+LDS_K; bf16x8 kf[8];
  const lds_cptr shm3=(lds_cptr)shm; const lds_cptr kp0=shm3+LDS_K+hi*1024+r32*16; const lds_cptr vp0=shm3+LDS_V+((lane>>4)&1)*32+(lane&3)*8+(4*hi+((lane&15)>>2))*64;
  const int NT=(q0+QB)/KVBLK;
  typedef __attribute__((address_space(3))) float lds_f32; typedef float kb4_t __attribute__((ext_vector_type(4)));
  { lds_f32*kw=(lds_f32*)(shm3+LDS_KB); for(int i=tid;i<NT*KVBLK;i+=NW*64)kw[i]=kbg[i]; }
  const __attribute__((address_space(3))) kb4_t*kbl=(const __attribute__((address_space(3))) kb4_t*)(shm3+LDS_KB)+hi;
  #define KBLOAD(P0,P1,t) do{ const __attribute__((address_space(3))) kb4_t*kb_=kbl+16*(t); \
    _Pragma("unroll") for(int g_=0;g_<4;++g_){ const kb4_t a_=kb_[2*g_], b_=kb_[2*g_+8]; \
      P0[4*g_]=a_[0];P0[4*g_+1]=a_[1];P0[4*g_+2]=a_[2];P0[4*g_+3]=a_[3]; P1[4*g_]=b_[0];P1[4*g_+1]=b_[1];P1[4*g_+2]=b_[2];P1[4*g_+3]=b_[3]; } }while(0)
  DMA_K(0,0);DMA_V(0,0);DMA_K(1,SLOTB);
  bf16x8 qr[4];
  #pragma unroll
  for(int d0=0;d0<4;++d0)qr[d0]=*reinterpret_cast<const bf16x8*>(&Qw[(long)r32*DM+d0*16+hi*8]);
  float mhat=0.f,l_reg=0.f;f32x16 o[2];o[0]=f32x16{};o[1]=f32x16{};
  const int qrel=wid*QBLK+r32;
  #define CMASK(P0,P1,t) do{int jb_=(t)-(NT-4); if(jb_>=0)cmask(P0,P1,jb_,qrel,hi);}while(0)
  bool resc=false;
  #define START(P0,P1) do{ const float rm=rowmax(P0,P1); resc=false; \
    { const float dl=rm; mhat=fadd_s(mhat,dl); \
      _Pragma("unroll") for(int r=0;r<16;++r){P0[r]=fsub_s(P0[r],dl);P1[r]=fsub_s(P1[r],dl);} } \
    _Pragma("unroll") for(int r=0;r<16;++r)P0[r]=__builtin_amdgcn_exp2f(P0[r]); }while(0)
  #define RESC() do{ if(resc){ asm volatile("s_waitcnt lgkmcnt(0)":::"memory"); \
      _Pragma("unroll") for(int d_=0;d_<2;++d_) _Pragma("unroll") for(int r=0;r<16;++r)o[d_][r]*=wsf[crow(r,hi)]; } }while(0)
  f32x16 pA0,pA1,pB0,pB1;
  int sl_prev=0,sl_cur=0,sl_next=SLOTB;
  #define ROT() do{sl_prev=sl_cur;sl_cur=sl_next;sl_next=(sl_next==(NSLOT-1)*SLOTB)?0:sl_next+SLOTB;}while(0)
  DMA_K(2,2*SLOTB);
  WAIT_BAR(3);
  KBLOAD(pA0,pA1,0);
  qkt(pA0,pA1,Kbase,qr,r32,hi);asm volatile("s_nop 15\n\ts_nop 7":"+v"(pA0),"+v"(pA1));CMASK(pA0,pA1,0);
  START(pA0,pA1);
  _Pragma("unroll") for(int r=0;r<16;++r)pA1[r]=__builtin_amdgcn_exp2f(pA1[r]);
  KBLOAD(pB0,pB1,1);
  _Pragma("unroll") for(int r=0;r<16;++r){pB0[r]-=mhat;pB1[r]-=mhat;}
  WAIT_BAR(0);
  DMA_K(3,0);DMA_V(1,SLOTB);
  ROT();
  kload8(kf,kp0+sl_cur);
  WAIT_BAR(2);
  s16x4 vlo[8],vhi[8]; u32x4 pw0,pw1,pw2,pw3;
  #define PKW(P,B) cvtpk_s(P[B],P[B+1])
  #define PAF(k) __builtin_bit_cast(bf16x8,pw##k)
  #define VFR(i) (bf16x8){vlo[i][0],vlo[i][1],vlo[i][2],vlo[i][3],vhi[i][0],vhi[i][1],vhi[i][2],vhi[i][3]}
  #define PIN(x) asm volatile("":"+v"(x))
  #define MX3(a,b,c) __builtin_fmaxf(__builtin_fmaxf((a),(b)),(c))
  #define GAPA(MF,A0,A1,A2,A3,W0,W1,PW) do{ MF; sacc+=A0; sacc+=A1; sacc+=A2; sacc+=A3; PIN(sacc); W0; W1; PIN(PW); SBAR(); }while(0)
  #define EX(v) __builtin_amdgcn_exp2f(v)
  #define GAPB(MF,X,B,Y) do{ MF; X[B]=EX(X[B]); X[B+1]=EX(X[B+1]); X[B+2]=EX(X[B+2]); X[B+3]=EX(X[B+3]); PIN(X); Y[B]-=mhat; Y[B+1]-=mhat; Y[B+2]-=mhat; Y[B+3]-=mhat; SBAR(); }while(0)
  #define VRD(i) do{ vlo[i]=vtr(vp_+(((i)>>2)*4096+((i)&3)*1024)); vhi[i]=vtr(vp_+(((i)>>2)*4096+((i)&3)*1024+512)); }while(0)
  #define KRD(G,j) do{ if(G){ kload2(kf,kp0+sl_next,j); SBAR(); } }while(0)
  #define STEP(C0,C1,P0,P1,t,GK,GV,GL) do{ SBAR(); \
    const lds_cptr vp_=vp0+sl_prev; \
    VRD(0); SBAR(); float sacc=(P0[0]+P0[1]); \
    GAPA(C0=__builtin_amdgcn_mfma_f32_32x32x16_bf16(kf[0],qr[0],C0,0,0,0), P0[2],P0[3],P0[4],P0[5],     pw0[0]=PKW(P0,0), pw0[1]=PKW(P0,2), pw0); \
    VRD(4); SBAR(); GAPA(C1=__builtin_amdgcn_mfma_f32_32x32x16_bf16(kf[1],qr[0],C1,0,0,0), P0[6],P0[7],P0[8],P0[9],     pw0[2]=PKW(P0,4), pw0[3]=PKW(P0,6), pw0); \
    VRD(1); SBAR(); GAPA(C0=__builtin_amdgcn_mfma_f32_32x32x16_bf16(kf[2],qr[1],C0,0,0,0),   P0[10],P0[11],P0[12],P0[13], pw1[0]=PKW(P0,8), pw1[1]=PKW(P0,10), pw1); \
    VRD(5); SBAR(); GAPA(C1=__builtin_amdgcn_mfma_f32_32x32x16_bf16(kf[3],qr[1],C1,0,0,0),   P0[14],P0[15],P1[0],P1[1],   pw1[2]=PKW(P0,12),pw1[3]=PKW(P0,14), pw1); \
    VRD(2); SBAR(); GAPA(C0=__builtin_amdgcn_mfma_f32_32x32x16_bf16(kf[4],qr[2],C0,0,0,0),   P1[2],P1[3],P1[4],P1[5],     pw2[0]=PKW(P1,0), pw2[1]=PKW(P1,2), pw2); \
    VRD(6); SBAR(); GAPA(C1=__builtin_amdgcn_mfma_f32_32x32x16_bf16(kf[5],qr[2],C1,0,0,0),   P1[6],P1[7],P1[8],P1[9],     pw2[2]=PKW(P1,4), pw2[3]=PKW(P1,6), pw2); \
    VRD(3); SBAR(); GAPA(C0=__builtin_amdgcn_mfma_f32_32x32x16_bf16(kf[6],qr[3],C0,0,0,0),   P1[10],P1[11],P1[12],P1[13], pw3[0]=PKW(P1,8), pw3[1]=PKW(P1,10), pw3); \
    VRD(7); SBAR(); GAPA(C1=__builtin_amdgcn_mfma_f32_32x32x16_bf16(kf[7],qr[3],C1,0,0,0),   P1[14],P1[15],0.f,0.f,       pw3[2]=PKW(P1,12),pw3[3]=PKW(P1,14), pw3); \
    l_reg+=sacc; \
    KBLOAD(P0,P1,(t)+1); \
    if(GK){DMA_K((t)+3,sl_cur);} if(GV){DMA_V((t)+1,sl_next);} \
    CMASK(C0,C1,t); \
    { float a=MX3(C0[0],C0[1],C1[0]),b=MX3(C0[2],C0[3],C1[1]); a=MX3(a,C1[2],C1[3]); \
      _Pragma("unroll") for(int r=4;r<16;r+=4){a=MX3(a,C0[r],C0[r+1]);b=MX3(b,C0[r+2],C0[r+3]);a=MX3(a,C1[r],C1[r+1]);b=MX3(b,C1[r+2],C1[r+3]);} \
      float rm=__builtin_fmaxf(a,b); { auto rr=__builtin_amdgcn_permlane32_swap(__float_as_uint(rm),__float_as_uint(rm),false,false); rm=__builtin_fmaxf(__uint_as_float(rr[0]),__uint_as_float(rr[1])); } \
      resc=false; \
      if(__builtin_expect(__any(rm>(float)THRL),0)){ const float dl=__builtin_fmaxf(rm,0.f); mhat+=dl; \
        _Pragma("unroll") for(int r=0;r<16;++r){C0[r]-=dl;C1[r]-=dl;} \
        const float f=__builtin_amdgcn_exp2f(-dl); l_reg*=f; if(hi==0)wsf[r32]=f; resc=true; } } \
    SBAR(); \
    GAPB(o[0]=__builtin_amdgcn_mfma_f32_32x32x16_bf16(PAF(0),VFR(0),o[0],0,0,0), C0,0,P0); \
    GAPB(o[1]=__builtin_amdgcn_mfma_f32_32x32x16_bf16(PAF(0),VFR(4),o[1],0,0,0), C0,4,P0); \
    KRD(GL,0); GAPB(o[0]=__builtin_amdgcn_mfma_f32_32x32x16_bf16(PAF(1),VFR(1),o[0],0,0,0), C0,8,P0); \
    KRD(GL,1); GAPB(o[1]=__builtin_amdgcn_mfma_f32_32x32x16_bf16(PAF(1),VFR(5),o[1],0,0,0), C0,12,P0); \
    KRD(GL,2); GAPB(o[0]=__builtin_amdgcn_mfma_f32_32x32x16_bf16(PAF(2),VFR(2),o[0],0,0,0), C1,0,P1); \
    KRD(GL,3); GAPB(o[1]=__builtin_amdgcn_mfma_f32_32x32x16_bf16(PAF(2),VFR(6),o[1],0,0,0), C1,4,P1); \
    GAPB(o[0]=__builtin_amdgcn_mfma_f32_32x32x16_bf16(PAF(3),VFR(3),o[0],0,0,0), C1,8,P1); \
    GAPB(o[1]=__builtin_amdgcn_mfma_f32_32x32x16_bf16(PAF(3),VFR(7),o[1],0,0,0), C1,12,P1); \
    }while(0)
  int t=1;
  #undef CMASK
  #define CMASK(P0,P1,t) do{}while(0)
  for(;t+5<NT;t+=2){
    STEP(pB0,pB1,pA0,pA1,t,true,true,true);     WAIT_BAR(2); RESC(); ROT();
    STEP(pA0,pA1,pB0,pB1,t+1,true,true,true);   WAIT_BAR(2); RESC(); ROT();
  }
  #undef CMASK
  #define CMASK(P0,P1,t) do{int jb_=(t)-(NT-4); if(jb_>=0)cmask(P0,P1,jb_,qrel,hi);}while(0)
  #define ENDW(tt) do{ if((tt)+3<NT){WAIT_BAR(2);} else if((tt)+2<NT){WAIT_BAR(1);} else {WAIT_BAR(0);} }while(0)
  for(;t+1<NT;t+=2){
    STEP(pB0,pB1,pA0,pA1,t,(t+3<NT),(t+1<NT),(t+1<NT));       ENDW(t);   RESC(); ROT();
    STEP(pA0,pA1,pB0,pB1,t+1,(t+4<NT),(t+2<NT),(t+2<NT));     ENDW(t+1); RESC(); ROT();
  }
  STEP(pB0,pB1,pA0,pA1,NT-1,false,false,false); RESC();
  { float sacc=pB0[0]+pB0[1]; _Pragma("unroll") for(int r=2;r<16;++r)sacc+=pB0[r]; _Pragma("unroll") for(int r=0;r<16;++r)sacc+=pB1[r]; l_reg+=sacc;
    pw0=(u32x4){PKW(pB0,0),PKW(pB0,2),PKW(pB0,4),PKW(pB0,6)};pw1=(u32x4){PKW(pB0,8),PKW(pB0,10),PKW(pB0,12),PKW(pB0,14)};pw2=(u32x4){PKW(pB1,0),PKW(pB1,2),PKW(pB1,4),PKW(pB1,6)};pw3=(u32x4){PKW(pB1,8),PKW(pB1,10),PKW(pB1,12),PKW(pB1,14)};
    SBAR(); pv(o,vb0+sl_cur,PAF(0),PAF(1),PAF(2),PAF(3)); }
  #undef PKW
  #undef PAF
  #undef VFR
  #undef PIN
  #undef MX3
  #undef GAPA
  #undef GAPB
  #undef EX
  #undef VRD
  #undef KRD
  #undef STEP
  #undef ENDW
  {auto rr=__builtin_amdgcn_permlane32_swap(__float_as_uint(l_reg),__float_as_uint(l_reg),false,false);l_reg=__uint_as_float(rr[0])+__uint_as_float(rr[1]);}
  if(hi==0)wsf[32+r32]=l_reg;asm volatile("s_waitcnt lgkmcnt(0)":::"memory");
  float rli[16];
  #pragma unroll
  for(int r=0;r<16;++r)rli[r]=__builtin_amdgcn_rcpf(wsf[32+crow(r,hi)]);
  bf16*Ow=O+(rowbase+q0+wid*QBLK)*OP+h*D;
  { bf16*stg=(bf16*)(shm+LDS_OST)+wid*2048;
    #pragma unroll
    for(int r=0;r<16;++r){const int orow=crow(r,hi);
      #pragma unroll
      for(int d0=0;d0<2;++d0)stg[orow*64+d0*32+r32]=__float2bfloat16(o[d0][r]*rli[r]);}
    asm volatile("s_waitcnt lgkmcnt(0)":::"memory");
    #pragma unroll
    for(int i=0;i<4;++i){const int row=i*8+(lane>>3),ch=lane&7; const u32x4 v=*(const u32x4*)(stg+row*64+ch*8); if(q0+wid*QBLK+row<SEQ)ATTN_STORE16(Ow+(long)row*OP+ch*8,v);} }
  asm volatile("s_waitcnt lgkmcnt(0)\n\ts_barrier":::"memory");
  #undef KBLOAD
  #undef DMA_K
  #undef DMA_V
  #undef CMASK
  #undef START
  #undef RESC
  #undef ROT
}
constexpr int ATTN_LDS_BYTES=LDS_BYTES;
#undef SBAR
#undef WAIT_BAR
}

__device__ __forceinline__ void mix_queue(const Ctx& c, unsigned char* lds_generic, int layer, const bf16_t* SD, unsigned* qctr);

namespace hg {
constexpr int P = 272, PA = 144;
constexpr int O_QE = 0, O_QS = 17408, O_KS = 34816, O_VT = 52224, O_ST = 69632, O_AM = 104448, O_QT = 113664, O_RS = 115712, O_END = 117760;
typedef short v4i16_t __attribute__((ext_vector_type(4)));
__device__ __forceinline__ f32x4 mfma16(bf16x8 a, bf16x8 b, f32x4 c) { return __builtin_amdgcn_mfma_f32_16x16x32_bf16(a, b, c, 0, 0, 0); }
__device__ __forceinline__ bf16x8 tr_frag(const LAS unsigned char* p, int pitch) {
    const v4i16_t lo = __builtin_amdgcn_ds_read_tr16_b64_v4i16((LAS v4i16_t*)p);
    const v4i16_t hi = __builtin_amdgcn_ds_read_tr16_b64_v4i16((LAS v4i16_t*)(p + 4 * pitch));
    return (bf16x8){lo[0], lo[1], lo[2], lo[3], hi[0], hi[1], hi[2], hi[3]};
}
}

struct ARegs { float g[16]; u32x4 vv[2]; };
__device__ __forceinline__ void hgrn_A_load(const Ctx& c, int tid, int bh, int ch, ARegs& R) {
    const int b = bh >> 2, hh = bh & 3; const size_t r0 = (size_t)b * LV + 64 * ch;
    const int k = tid & 127, sq = tid >> 7;
    const float* gp = c.LOGF + (r0 + 16 * sq) * 512 + hh * 128 + k;
#pragma unroll
    for (int i = 0; i < 16; ++i) R.g[i] = gp[(size_t)i * 512];
#pragma unroll
    for (int i = 0; i < 2; ++i) { const int id = tid + 512 * i, row = id >> 4, cc = id & 15; R.vv[i] = *(const u32x4*)(c.HV + (r0 + row) * 512 + hh * 128 + cc * 8); }
}
__device__ __forceinline__ void hgrn_A_compute(const Ctx& c, LAS unsigned char* lds, int tid, int bh, int ch, bf16_t* SD, float* DV, const ARegs& R) {
    using namespace hg;
    const int lane = tid & 63, w = __builtin_amdgcn_readfirstlane(tid >> 6);
    const int k = tid & 127, sq = tid >> 7;
    float bl[16];
    { float s = 0.f;
#pragma unroll
      for (int i = 0; i < 16; ++i) { s += R.g[i]; bl[i] = s; }
      ((LAS float*)(lds + O_QT))[sq * 128 + k] = s; }
#pragma unroll
    for (int i = 0; i < 2; ++i) { const int id = tid + 512 * i, row = id >> 4, cc = id & 15; *(LAS u32x4*)(lds + O_VT + row * P + cc * 16) = R.vv[i]; }
    asm volatile("s_waitcnt lgkmcnt(0)\n\ts_barrier" ::: "memory");
    { const LAS float* qt = (const LAS float*)(lds + O_QT); float pre = 0.f, tot = 0.f;
#pragma unroll
      for (int q = 0; q < 4; ++q) { const float t = qt[q * 128 + k]; tot += t; if (q < sq) pre += t; }
#pragma unroll
      for (int i = 0; i < 16; ++i) { const float kd = (1.f - __expf(R.g[i])) * __expf(tot - (pre + bl[i])); *(LAS bf16_t*)(lds + O_KS + (16 * sq + i) * P + 2 * k) = (bf16_t)f2bf(kd); }
      if (sq == 0) DV[((size_t)bh * 64 + ch) * 128 + k] = __expf(tot); }
    asm volatile("s_waitcnt lgkmcnt(0)\n\ts_barrier" ::: "memory");
    const int fr = lane & 15, g4 = lane >> 4, q = fr >> 2, p = lane & 3;
    const LAS unsigned char* abase = lds + O_VT + (8 * g4 + q) * P + w * 32 + p * 8;
    const LAS unsigned char* bbase = lds + O_KS + (8 * g4 + q) * P + p * 8;
    bf16x8 a[2]; a[0] = tr_frag(abase, P); a[1] = tr_frag(abase + 32 * P, P);
    bf16_t* od = SD + ((size_t)bh * 64 + ch) * 16384 + (size_t)(16 * w + 4 * g4) * 128 + fr;
#pragma unroll
    for (int ct = 0; ct < 8; ++ct) { f32x4 acc = (f32x4){0.f, 0.f, 0.f, 0.f};
        acc = mfma16(a[0], tr_frag(bbase + ct * 32, P), acc); acc = mfma16(a[1], tr_frag(bbase + 32 * P + ct * 32, P), acc);
#pragma unroll
        for (int j = 0; j < 4; ++j) od[j * 128 + 16 * ct] = (bf16_t)f2bf(acc[j]); }
    asm volatile("s_waitcnt lgkmcnt(0)\n\ts_barrier" ::: "memory");
}
__device__ __forceinline__ void hgrn_A_phase(const Ctx& c, LAS unsigned char* lds, bf16_t* SD, float* DV) {
    int tid_ = threadIdx.x; asm volatile("" : "+v"(tid_)); const int tid = tid_;
    ARegs R;
    int u = blockIdx.x;
    if (u < 16 * 64) hgrn_A_load(c, tid, u >> 6, u & 63, R);
    for (; u < 16 * 64; u += gridDim.x) {
        const ARegs Rc = R;
        const int un = u + gridDim.x;
        if (un < 16 * 64) hgrn_A_load(c, tid, un >> 6, un & 63, R);
        hgrn_A_compute(c, lds, tid, u >> 6, u & 63, SD, DV, Rc);
    }
    __syncthreads();
}

__device__ __forceinline__ void hgrn_B_scan(const Ctx& c, bf16_t* SD, const float* DV) {
    const int gt = blockIdx.x * NTHREADS + c.tid, NGT = gridDim.x * NTHREADS;
    for (int pidx = gt; pidx < 16 * 8192; pidx += NGT) {
        const int bh = pidx >> 13, e2 = pidx & 8191, k = (e2 & 63) * 2;
        unsigned* sp = (unsigned*)(SD + (size_t)bh * 64 * 16384 + 2 * e2);
        const float* dp = DV + (size_t)bh * 64 * 128 + k;
        float s0 = 0.f, s1 = 0.f;
#pragma unroll 8
        for (int ch = 0; ch < 64; ++ch) { const unsigned d = sp[(size_t)ch * 8192]; const float d0 = dp[ch * 128], d1 = dp[ch * 128 + 1];
            s0 = d0 * s0 + __builtin_bit_cast(float, d << 16); s1 = d1 * s1 + __builtin_bit_cast(float, d & 0xffff0000u);
            sp[(size_t)ch * 8192] = pk2(s0, s1); }
    }
}

struct CRegs { float g[16]; unsigned short q[16]; unsigned short gt[16]; u32x4 vv[2]; u32x4 st[4]; };
#define LBAR() asm volatile("s_waitcnt lgkmcnt(0)\n\ts_barrier" ::: "memory")
__device__ __forceinline__ void hgrn_C_load(const Ctx& c, int tid, int bh, int ch, const bf16_t* SD, CRegs& R) {
    const int lane = tid & 63, w = __builtin_amdgcn_readfirstlane(tid >> 6);
    const int b = bh >> 2, hh = bh & 3; const size_t r0 = (size_t)b * LV + 64 * ch;
    const int k = tid & 127, sq = tid >> 7, fr = lane & 15, g4 = lane >> 4;
    const float* gp = c.LOGF + (r0 + 16 * sq) * 512 + hh * 128 + k; const bf16_t* qp = c.HXQ + (r0 + 16 * sq) * 512 + hh * 128 + k;
#pragma unroll
    for (int i = 0; i < 16; ++i) { R.g[i] = gp[(size_t)i * 512]; R.q[i] = qp[(size_t)i * 512]; }
#pragma unroll
    for (int i = 0; i < 2; ++i) { const int id = tid + 512 * i, row = id >> 4, cc = id & 15; R.vv[i] = *(const u32x4*)(c.HV + (r0 + row) * 512 + hh * 128 + cc * 8); }
    if (ch > 0) { const bf16_t* sp = SD + ((size_t)bh * 64 + ch - 1) * 16384;
#pragma unroll
        for (int i = 0; i < 4; ++i) { const int id = tid + 512 * i, row = id >> 4, cc = id & 15; R.st[i] = *(const u32x4*)(sp + row * 128 + cc * 8); } }
#pragma unroll
    for (int tt = 0; tt < 4; ++tt)
#pragma unroll
        for (int j = 0; j < 4; ++j) R.gt[tt * 4 + j] = c.HG[(r0 + 16 * tt + 4 * g4 + j) * 512 + hh * 128 + 16 * w + fr];
}
__device__ __forceinline__ void hgrn_C_compute(const Ctx& c, LAS unsigned char* lds, int tid, int layer, int bh, int ch, const CRegs& R) {
    using namespace hg;
    const int lane = tid & 63, w = __builtin_amdgcn_readfirstlane(tid >> 6);
    const int b = bh >> 2, hh = bh & 3; const size_t r0 = (size_t)b * LV + 64 * ch;
    const int k = tid & 127, sq = tid >> 7;
    float bl[16];
    { float s = 0.f;
#pragma unroll
      for (int i = 0; i < 16; ++i) { s += R.g[i]; bl[i] = s; }
      ((LAS float*)(lds + O_QT))[sq * 128 + k] = s; }
#pragma unroll
    for (int i = 0; i < 2; ++i) { const int id = tid + 512 * i, row = id >> 4, cc = id & 15; *(LAS u32x4*)(lds + O_VT + row * P + cc * 16) = R.vv[i]; }
    if (ch > 0) {
#pragma unroll
        for (int i = 0; i < 4; ++i) { const int id = tid + 512 * i, row = id >> 4, cc = id & 15; *(LAS u32x4*)(lds + O_ST + row * P + cc * 16) = R.st[i]; }
    }
    LBAR();
    { const LAS float* qt = (const LAS float*)(lds + O_QT); float pre = 0.f;
#pragma unroll
      for (int q = 0; q < 4; ++q) { const float t = qt[q * 128 + k]; if (q < sq) pre += t; }
      const float rr = qt[k] + qt[128 + k];
#pragma unroll
      for (int i = 0; i < 16; ++i) { const float bb = pre + bl[i]; const int off = (16 * sq + i) * P + 2 * k; const float qv = bf2f(R.q[i]);
          *(LAS bf16_t*)(lds + O_QE + off) = (bf16_t)f2bf(qv * __expf(bb));
          *(LAS bf16_t*)(lds + O_QS + off) = (bf16_t)f2bf(qv * __expf(fminf(bb - rr, 80.f)));
          *(LAS bf16_t*)(lds + O_KS + off) = (bf16_t)f2bf((1.f - __expf(R.g[i])) * __expf(fminf(rr - bb, 80.f))); } }
    LBAR();
    const int fr = lane & 15, g4 = lane >> 4, q = fr >> 2, p = lane & 3;
#pragma unroll
    for (int tl = 0; tl < 2; ++tl) { const int tile = 2 * w + tl, ti = tile >> 2, sj = tile & 3;
        f32x4 acc = (f32x4){0.f, 0.f, 0.f, 0.f};
        if (sj <= ti) {
#pragma unroll
            for (int ks = 0; ks < 4; ++ks) { const bf16x8 a = *(const LAS bf16x8*)(lds + O_QS + (16 * ti + fr) * P + (32 * ks + 8 * g4) * 2);
                const bf16x8 bb = *(const LAS bf16x8*)(lds + O_KS + (16 * sj + fr) * P + (32 * ks + 8 * g4) * 2); acc = mfma16(a, bb, acc); } }
#pragma unroll
        for (int j = 0; j < 4; ++j) { const int t = 16 * ti + 4 * g4 + j, s = 16 * sj + fr; const float v = (s <= t) ? acc[j] : 0.f; *(LAS bf16_t*)(lds + O_AM + t * PA + 2 * s) = (bf16_t)f2bf(v); } }
    LBAR();
    f32x4 acc[4];
#pragma unroll
    for (int tt = 0; tt < 4; ++tt) acc[tt] = (f32x4){0.f, 0.f, 0.f, 0.f};
    if (ch > 0) {
#pragma unroll
        for (int ks = 0; ks < 4; ++ks) { const bf16x8 bfr = *(const LAS bf16x8*)(lds + O_ST + (16 * w + fr) * P + (32 * ks + 8 * g4) * 2);
#pragma unroll
            for (int tt = 0; tt < 4; ++tt) { const bf16x8 a = *(const LAS bf16x8*)(lds + O_QE + (16 * tt + fr) * P + (32 * ks + 8 * g4) * 2); acc[tt] = mfma16(a, bfr, acc[tt]); } }
    }
#pragma unroll
    for (int ks = 0; ks < 2; ++ks) { const bf16x8 bfr = tr_frag(lds + O_VT + (32 * ks + 8 * g4 + q) * P + w * 32 + p * 8, P);
#pragma unroll
        for (int tt = 0; tt < 4; ++tt) { const bf16x8 a = *(const LAS bf16x8*)(lds + O_AM + (16 * tt + fr) * PA + (32 * ks + 8 * g4) * 2); acc[tt] = mfma16(a, bfr, acc[tt]); } }
    LAS float* rs = (LAS float*)(lds + O_RS);
#pragma unroll
    for (int tt = 0; tt < 4; ++tt)
#pragma unroll
        for (int j = 0; j < 4; ++j) { float s2 = acc[tt][j] * acc[tt][j]; s2 += __shfl_xor(s2, 1); s2 += __shfl_xor(s2, 2); s2 += __shfl_xor(s2, 4); s2 += __shfl_xor(s2, 8);
            if (fr == 0) rs[(16 * tt + 4 * g4 + j) * 8 + w] = s2; }
    LBAR();
    { const int v = 16 * w + fr; const float nw = c.hnw[layer * 128 + v];
#pragma unroll
      for (int tt = 0; tt < 4; ++tt)
#pragma unroll
        for (int j = 0; j < 4; ++j) { const int t = 16 * tt + 4 * g4 + j; const f32x4 s0 = *(const LAS f32x4*)(rs + t * 8), s1 = *(const LAS f32x4*)(rs + t * 8 + 4);
            const float ss = ((s0[0] + s0[1]) + (s0[2] + s0[3])) + ((s1[0] + s1[1]) + (s1[2] + s1[3])); const float rstd = 1.f / sqrtf(ss * (1.f / 128.f) + EPS);
            c.MIX[(r0 + t) * DM + 512 + hh * 128 + v] = (bf16_t)f2bf(acc[tt][j] * rstd * nw * bf2f(R.gt[tt * 4 + j])); } }
    LBAR();
}
__device__ __forceinline__ void hgrn_C_phase(const Ctx& c, LAS unsigned char* lds, int layer, const bf16_t* SD) {
    int tid_ = threadIdx.x; asm volatile("" : "+v"(tid_)); const int tid = tid_;
    CRegs R;
    int u = blockIdx.x;
    if (u < 16 * 65) hgrn_C_load(c, tid, u / 65, u % 65, SD, R);
    for (; u < 16 * 65; u += gridDim.x) {
        const CRegs Rc = R;
        const int un = u + gridDim.x;
        if (un < 16 * 65) hgrn_C_load(c, tid, un / 65, un % 65, SD, R);
        hgrn_C_compute(c, lds, tid, layer, u / 65, u % 65, Rc);
    }
    __syncthreads();
}

__device__ __forceinline__ void mix_queue(const Ctx& c, unsigned char* lds_generic, int layer, const bf16_t* SD, unsigned* qctr) {
    LAS volatile int* slot = (LAS volatile int*)((LAS unsigned char*)lds_generic + 131072);
    for (;;) {
        if (c.tid == 0) slot[0] = (int)atomicAdd(qctr, 1u);
        __syncthreads();
        const int n = slot[0];
        if (n >= 17 * 32) break;
        const int qb = 16 - (n >> 5), bh = n & 31;
        attn_body::attn_unit<8>(bh >> 3, bh & 7, qb, (const attn_body::bf16*)c.QB, (const attn_body::bf16*)c.KB, (const attn_body::bf16*)c.VB, (attn_body::bf16*)c.MIX,
                                c.kbias + (size_t)bh * KBL, (char*)lds_generic);
    }
}

__device__ __forceinline__ void fox_simple(const Ctx& c, LAS unsigned char* lds, int first_block) {
    LAS float* sc = (LAS float*)(lds + c.wave * 16896);
    LAS float* qs = sc; LAS float* ps = sc + 64;
    const int nblk = gridDim.x - first_block; if ((int)blockIdx.x < first_block) return;
    const int gw = ((int)blockIdx.x - first_block) * NWAVES + c.wave, NGW = nblk * NWAVES;
    for (int it = gw; it < MROWS * FOXH; it += NGW) {
        const int r = it >> 3, h = it & 7, b = r / LV, vp = r - b * LV;
        bf16_t* op = c.MIX + (size_t)r * DM + h * 64;
        if (vp < PADF) { op[c.lane] = 0; continue; }
        qs[c.lane] = bf2f(c.QB[(size_t)r * 512 + h * 64 + c.lane]);
        asm volatile("s_waitcnt lgkmcnt(0)" ::: "memory");
        const float* kb = c.kbias + (size_t)(b * 8 + h) * KBL;
        float mx = -3.0e38f;
        for (int j = PADF + c.lane; j <= vp; j += 64) {
            const bf16_t* kr = c.KB + (size_t)(b * LV + j) * 512 + h * 64; float s = 0.f;
#pragma unroll
            for (int d8 = 0; d8 < 8; ++d8) { const bf16x8 kv = *(const bf16x8*)(kr + d8 * 8);
#pragma unroll
                for (int e = 0; e < 8; ++e) s += qs[d8 * 8 + e] * bf2f((unsigned short)kv[e]); }
            s += kb[j]; ps[j] = s; mx = fmaxf(mx, s);
        }
        mx = wave_max(mx);
        float l = 0.f;
        for (int j = PADF + c.lane; j <= vp; j += 64) { const float p = exp2f(ps[j] - mx); ps[j] = p; l += p; }
        l = wave_sum(l);
        asm volatile("s_waitcnt lgkmcnt(0)" ::: "memory");
        float o = 0.f;
        const bf16_t* vr = c.VB + (size_t)(b * LV) * 512 + h * 64 + c.lane;
        for (int j = PADF; j <= vp; ++j) o += ps[j] * bf2f(vr[(size_t)j * 512]);
        op[c.lane] = (bf16_t)f2bf(o / l);
        asm volatile("s_waitcnt lgkmcnt(0)" ::: "memory");
    }
}

__device__ __forceinline__ void hgrn_simple(const Ctx& c, LAS unsigned char* lds, int layer) {
    if (blockIdx.x >= NB * HGH) return;
    const int b = blockIdx.x >> 2, hh = blockIdx.x & 3;
    LAS float* fL = (LAS float*)lds;
    LAS float* kL = fL + 2048; LAS float* qL = kL + 2048; LAS float* vL = qL + 2048; LAS float* oP = vL + 2048;
    const int v = c.tid & 127, kg = c.tid >> 7;
    float S[32];
#pragma unroll
    for (int i = 0; i < 32; ++i) S[i] = 0.f;
    for (int i = c.tid; i < PADF * 128; i += NTHREADS) { const int vp = i >> 7; c.MIX[(size_t)(b * LV + vp) * DM + 512 + hh * 128 + (i & 127)] = 0; }
    for (int t0 = PADF; t0 < LV; t0 += 16) {
        for (int i = c.tid; i < 2048; i += NTHREADS) { const int t = i >> 7, k = i & 127; const size_t o = (size_t)(b * LV + t0 + t) * 512 + hh * 128 + k;
            const float f = __expf(c.LOGF[o]); fL[i] = f; kL[i] = 1.f - f; qL[i] = bf2f(c.HXQ[o]); vL[i] = bf2f(c.HV[o]); }
        __syncthreads();
        for (int t = 0; t < 16; ++t) { const float vv = vL[t * 128 + v]; float part = 0.f;
#pragma unroll
            for (int i = 0; i < 32; ++i) { const int k = kg * 32 + i; S[i] = fL[t * 128 + k] * S[i] + kL[t * 128 + k] * vv; part += S[i] * qL[t * 128 + k]; }
            oP[(kg * 16 + t) * 128 + v] = part; }
        __syncthreads();
        for (int tt = 0; tt < 2; ++tt) { const int t = c.wave * 2 + tt; float o0, o1;
            { const int v0 = c.lane, v1 = c.lane + 64; o0 = oP[t * 128 + v0] + oP[(16 + t) * 128 + v0] + oP[(32 + t) * 128 + v0] + oP[(48 + t) * 128 + v0];
              o1 = oP[t * 128 + v1] + oP[(16 + t) * 128 + v1] + oP[(32 + t) * 128 + v1] + oP[(48 + t) * 128 + v1]; }
            const float ss = wave_sum(o0 * o0 + o1 * o1); const float rstd = 1.f / sqrtf(ss * (1.f / 128.f) + EPS);
            const size_t ro = (size_t)(b * LV + t0 + t);
            const float g0 = bf2f(c.HG[ro * 512 + hh * 128 + c.lane]), g1 = bf2f(c.HG[ro * 512 + hh * 128 + c.lane + 64]);
            c.MIX[ro * DM + 512 + hh * 128 + c.lane] = (bf16_t)f2bf(o0 * rstd * c.hnw[layer * 128 + c.lane] * g0);
            c.MIX[ro * DM + 512 + hh * 128 + c.lane + 64] = (bf16_t)f2bf(o1 * rstd * c.hnw[layer * 128 + c.lane + 64] * g1); }
        __syncthreads();
    }
}

__device__ __forceinline__ void final_norm(const Ctx& c) {
    f32x4 w[4];
#pragma unroll
    for (int j = 0; j < 4; ++j) w[j] = *(const f32x4*)(c.nfinal + 4 * c.lane + 256 * j);
    for (int rb = c.gw; rb < NB * SEQ; rb += 4 * c.NGW) {
        f32x4 v[4][4];
#pragma unroll
        for (int q = 0; q < 4; ++q) { const int r = rb + q * c.NGW;
            if (r < NB * SEQ) {
#pragma unroll
                for (int j = 0; j < 4; ++j) v[q][j] = *(const f32x4*)(c.out + (size_t)r * DM + 4 * c.lane + 256 * j); } }
#pragma unroll
        for (int q = 0; q < 4; ++q) { const int r = rb + q * c.NGW;
            if (r < NB * SEQ) { float s = 0.f;
#pragma unroll
                for (int j = 0; j < 4; ++j) s += (v[q][j].x * v[q][j].x + v[q][j].y * v[q][j].y) + (v[q][j].z * v[q][j].z + v[q][j].w * v[q][j].w);
                s = wave_sum(s); const float rstd = 1.f / sqrtf(s * (1.f / DM) + EPS);
#pragma unroll
                for (int j = 0; j < 4; ++j) *(f32x4*)(c.out + (size_t)r * DM + 4 * c.lane + 256 * j) = v[q][j] * rstd * w[j]; } }
    }
}

__global__ void __launch_bounds__(NTHREADS, 2) fwd_kernel(Args a) {
    extern __shared__ __attribute__((aligned(16))) unsigned char lds_raw[];
    LAS unsigned char* lds = (LAS unsigned char*)lds_raw;
    cg::grid_group grid = cg::this_grid();
    Ctx c;
    c.x = a.in[0]; c.meta = a.in[1]; c.nmw = a.in[2]; c.win = a.in[3]; c.fbias = a.in[4]; c.lbraw = a.in[5]; c.hnw = a.in[6]; c.wout = a.in[7];
    c.nfw = a.in[8]; c.wg = a.in[9]; c.wu = a.in[10]; c.wd = a.in[11]; c.nfinal = a.in[12];
    c.out = a.out; c.ws = a.ws;
    c.ctl = (unsigned*)(a.ws + WS_CTL); c.sumsq = (float*)(a.ws + WS_SUMSQ); c.lbv = (float*)(a.ws + WS_LBV); c.logf8 = (float*)(a.ws + WS_LOGF8);
    c.kbias = (float*)(a.ws + WS_KBIAS); c.hs = (float*)(a.ws + WS_HS);
    c.HB = (bf16_t*)(a.ws + WS_HB); c.MIX = (bf16_t*)(a.ws + WS_MIX); c.QB = (bf16_t*)(a.ws + WS_QB); c.KB = (bf16_t*)(a.ws + WS_KB); c.VB = (bf16_t*)(a.ws + WS_VB);
    c.HXQ = (bf16_t*)(a.ws + WS_HXQ); c.LOGF = (float*)(a.ws + WS_LOGF); c.HV = (bf16_t*)(a.ws + WS_HV); c.HG = (bf16_t*)(a.ws + WS_HG); c.ACT = (bf16_t*)(a.ws + WS_ACT);
    c.tid = threadIdx.x; c.lane = c.tid & 63; c.wave = __builtin_amdgcn_readfirstlane(c.tid >> 6);
    c.gw = blockIdx.x * NWAVES + c.wave; c.NGW = gridDim.x * NWAVES;
    volatile LAS unsigned* bst = (volatile LAS unsigned*)(lds + 131072 + 64);
    if (c.tid == 0) { bst[0] = 0u; bst[1] = 0u; }
    __syncthreads();
    const XcdBarrier bar = xcd_barrier_post((unsigned*)(a.ws + WS_BAR), bst);
#define GSYNC() xcd_barrier(bar)
    bf16_t* SD = (bf16_t*)(a.ws + WS_HB);
    float* DV = (float*)(a.ws + WS_DV);

    { const int gt = blockIdx.x * NTHREADS + c.tid, NGT = gridDim.x * NTHREADS;
      for (int i = gt; i < 16384; i += NGT) c.ctl[i] = (i == 8) ? 1u : 0u;
      for (int i = gt; i < 3 * MALLOC; i += NGT) c.sumsq[MALLOC + i] = 0.f;
      for (int i = gt; i < HGW; i += NGT) c.lbv[i] = 1.f / (1.f + __expf(c.lbraw[i] - c.lbraw[HGW + i])); }
    p0_weights(c, lds, 0, 0, 1 << 30, c.gw, c.NGW);
    p0_weights(c, lds, 1, 0, 1 << 30, c.gw, c.NGW);
    p0_extra_rows(c, 0, blockIdx.x * NTHREADS + c.tid, gridDim.x * NTHREADS);
    p0_extra_rows(c, 1, blockIdx.x * NTHREADS + c.tid, gridDim.x * NTHREADS);
    __syncthreads();
    if constexpr (DUPMASK & 1) { LAUNDER0(); p0_weights(c, lds, 0, 0, 1 << 30, c.gw, c.NGW); __syncthreads(); }
    h_build(c);
    grid.sync();
#define LAUNDER() do { int t_ = threadIdx.x; asm volatile("" : "+v"(t_)); c.tid = t_; c.lane = t_ & 63; } while (0)
    for (int layer = 0; layer < 2; ++layer) {
        LAUNDER();
        if constexpr (FASTMASK & 1) gemm_fast<0>(c, lds, layer); else gemm_simple<0>(c, layer);
        if constexpr (DUPMASK & 2) { LAUNDER(); gemm_fast<0>(c, lds, layer); }
        GSYNC();
        LAUNDER();
        hgrn_A_phase(c, lds, SD, DV);
        if (blockIdx.x >= gridDim.x - 32) { LAUNDER(); kbias_job(c, lds, (int)(gridDim.x - 1 - blockIdx.x)); }
        if constexpr (DUPMASK & 4) { LAUNDER(); hgrn_A_phase(c, lds, SD, DV); }
        GSYNC();
        LAUNDER();
        hgrn_B_scan(c, SD, DV);
        GSYNC();
        LAUNDER();
        hgrn_C_phase(c, lds, layer, SD);
        LAUNDER();
        mix_queue(c, lds_raw, layer, SD, c.ctl + 64 * (1 + layer));
        if constexpr (DUPMASK & 8) { LAUNDER(); mix_queue(c, lds_raw, layer, SD, c.ctl + 64 * (3 + layer)); }
        if constexpr (DUPMASK & 256) { LAUNDER(); hgrn_C_phase(c, lds, layer, SD); }
        if constexpr (DUPMASK & 128) { for (int i = 0; i < 8; ++i) GSYNC(); }
        GSYNC();
        LAUNDER();
        if constexpr (DUPMASK & 16) { gemm_fast<1>(c, lds, layer, c.ctl[8]); LAUNDER(); }
        if constexpr (FASTMASK & 2) gemm_fast<1>(c, lds, layer); else gemm_simple<1>(c, layer);
        GSYNC();
        if constexpr (FASTMASK & 4) gemm_fast<2>(c, lds, layer); else gemm_simple<2>(c, layer);
        if constexpr (DUPMASK & 32) { LAUNDER(); gemm_fast<2>(c, lds, layer); }
        GSYNC();
        if constexpr (DUPMASK & 64) { gemm_fast<3>(c, lds, layer, c.ctl[8]); LAUNDER(); }
        if constexpr (FASTMASK & 8) gemm_fast<3>(c, lds, layer); else gemm_simple<3>(c, layer);
        GSYNC();
    }
    LAUNDER();
    final_norm(c);
}

extern "C" void kernel_launch(void* const* d_in, const int* in_sizes, int n_in, void* d_out, int out_size, void* d_ws, size_t ws_size, hipStream_t stream) {
    static int grid = 0;
    if (grid == 0) {
        if (n_in != 13 || out_size != NB * SEQ * DM || ws_size < WS_END) { fprintf(stderr, "kernel_launch: unexpected shapes n_in %d out %d ws %zu\n", n_in, out_size, ws_size); grid = -1; return; }
        int dev = 0, cus = 0, per_cu = 0;
        (void)hipGetDevice(&dev); (void)hipDeviceGetAttribute(&cus, hipDeviceAttributeMultiprocessorCount, dev);
        (void)hipFuncSetAttribute((const void*)fwd_kernel, hipFuncAttributeMaxDynamicSharedMemorySize, LDS_BYTES);
        (void)hipOccupancyMaxActiveBlocksPerMultiprocessor(&per_cu, (const void*)fwd_kernel, NTHREADS, LDS_BYTES);
        if (per_cu < 1) per_cu = 1;
        grid = cus * per_cu;
        (void)hipGetLastError();
    }
    if (grid < 0) return;
    Args a{};
    for (int i = 0; i < 13; ++i) a.in[i] = (const float*)d_in[i];
    a.out = (float*)d_out; a.ws = (unsigned char*)d_ws;
    (void)hipMemsetAsync((unsigned char*)d_ws + WS_BAR, 0, 16384, stream);
    void* args[] = {&a};
    hipError_t e = hipLaunchCooperativeKernel((const void*)fwd_kernel, dim3(grid), dim3(NTHREADS), args, LDS_BYTES, stream);
    if (e != hipSuccess) fprintf(stderr, "cooperative launch failed: %s (grid %d)\n", hipGetErrorString(e), grid);
}
```

```cpp
#include <hip/hip_runtime.h>
#include <hip/hip_cooperative_groups.h>
#include <cstdint>
#include <cstdio>
namespace cg = cooperative_groups;

typedef unsigned short bf16_t;
typedef short bf16x8 __attribute__((ext_vector_type(8)));
typedef float f32x4 __attribute__((ext_vector_type(4)));
typedef unsigned u32x4 __attribute__((ext_vector_type(4)));
#define LAS __attribute__((address_space(3)))

constexpr int DM = 1024, NB = 4, SEQ = 4096, NMETA = 16, PADF = 48, LV = 4160, MROWS = NB * LV, MALLOC = MROWS + 256;
constexpr int FOXH = 8, FOXD = 64, FOXW = 512, HGH = 4, HGK = 128, HGV = 128, HGW = 512, DFF = 2816, INCOLS = 3592, NIN = 3584, NINP = 3840;
constexpr int KBL = 4352;
constexpr float EPS = 1e-6f, LOG2E = 1.4426950408889634f, C2 = 0.125f * LOG2E, HGQS = 0.08838834764831845f;
constexpr int NTHREADS = 512, NWAVES = 8;
constexpr int LDS_BYTES = 147456;
#ifndef FASTMASK
#define FASTMASK 15
#endif
#ifndef DUPMASK
#define DUPMASK 0
#endif

constexpr size_t MiB = 1u << 20;
constexpr size_t WS_CTL = 0;
constexpr size_t WS_SUMSQ = 64 * 1024;
constexpr size_t SUMSQ_STRIDE = (size_t)MALLOC * 4;
constexpr size_t WS_LBV = WS_SUMSQ + 4 * SUMSQ_STRIDE;
constexpr size_t WS_LOGF8 = WS_LBV + 4096;
constexpr size_t WS_KBIAS = WS_LOGF8 + (size_t)MALLOC * 32;
constexpr size_t WS_DV = WS_KBIAS + 32 * KBL * 4;
constexpr size_t WS_BAR = WS_DV + 16 * 64 * 128 * 4;
constexpr size_t WS_HS = 2 * MiB;
constexpr size_t WS_W = 3 * MiB;
constexpr size_t W_IN = 0, W_OUT = W_IN + (size_t)NINP * DM * 2, W_GU = W_OUT + (size_t)DM * DM * 2, W_DN = W_GU + (size_t)2 * DFF * DM * 2, W_LAYER = W_DN + (size_t)DM * DFF * 2;
constexpr size_t WS_HB = WS_W + 2 * W_LAYER + 65536;
constexpr size_t WS_MIX = WS_HB + (size_t)MALLOC * DM * 2;
constexpr size_t WS_QB = WS_MIX + (size_t)MALLOC * DM * 2;
constexpr size_t WS_KB = WS_QB + (size_t)MALLOC * 512 * 2, WS_VB = WS_KB + (size_t)MALLOC * 512 * 2;
constexpr size_t WS_HXQ = WS_VB + (size_t)MALLOC * 512 * 2;
constexpr size_t WS_LOGF = WS_HXQ + (size_t)MALLOC * 512 * 2;
constexpr size_t WS_HV = WS_LOGF + (size_t)MALLOC * 512 * 4, WS_HG = WS_HV + (size_t)MALLOC * 512 * 2;
constexpr size_t WS_END = WS_HG + (size_t)MALLOC * 512 * 2;
constexpr size_t WS_ACT = WS_QB;
static_assert(WS_BAR + 16384 <= WS_HS && 3456 * 4 <= 16384 && (size_t)16 * 64 * 16384 * 2 <= (size_t)MALLOC * DM * 2 && WS_HS + 4 * 64 * 1024 * 4 <= WS_W, "small map");
static_assert(WS_ACT + (size_t)MALLOC * DFF * 2 <= WS_END, "ACT overlay");
static_assert(WS_END <= 256 * MiB, "d_ws");

#define LAUNDER0() do { int t_ = threadIdx.x; asm volatile("" : "+v"(t_)); c.tid = t_; c.lane = t_ & 63; } while (0)
struct Args { const float* in[13]; float* out; unsigned char* ws; };

struct Ctx {
    const float *x, *meta, *nmw, *win, *fbias, *lbraw, *hnw, *wout, *nfw, *wg, *wu, *wd, *nfinal;
    float* out; unsigned char* ws;
    unsigned* ctl; float* sumsq; float* lbv; float* logf8; float* kbias; float* hs;
    bf16_t *HB, *MIX, *QB, *KB, *VB, *HXQ, *HV, *HG, *ACT; float* LOGF;
    int tid, lane, wave, gw, NGW;
};

__device__ __forceinline__ unsigned f2bf(float f) { unsigned u = __builtin_bit_cast(unsigned, f); return (u + 0x7fffu + ((u >> 16) & 1u)) >> 16; }
__device__ __forceinline__ unsigned pk2(float lo, float hi) { return f2bf(lo) | (f2bf(hi) << 16); }
__device__ __forceinline__ float bf2f(unsigned short b) { return __builtin_bit_cast(float, (unsigned)b << 16); }
__device__ __forceinline__ float wave_sum(float v) {
#pragma unroll
    for (int o = 1; o < 64; o <<= 1) v += __shfl_xor(v, o);
    return v;
}
__device__ __forceinline__ float wave_max(float v) {
#pragma unroll
    for (int o = 1; o < 64; o <<= 1) v = fmaxf(v, __shfl_xor(v, o));
    return v;
}
__device__ __forceinline__ float siluf(float x) { return x / (1.f + __expf(-x)); }
__device__ __forceinline__ float* hrow(const Ctx& c, int r) {
    const int b = r / LV, vp = r - b * LV;
    return vp >= 64 ? c.out + (size_t)(b * SEQ + vp - 64) * DM : c.hs + (size_t)(b * 64 + vp) * DM;
}
__device__ __forceinline__ bf16_t* wptr(const Ctx& c, int layer, size_t off) { return (bf16_t*)(c.ws + WS_W + (size_t)layer * W_LAYER + off); }

namespace pg8 {
#define PG8_LAS __attribute__((address_space(3)))
typedef unsigned short bf16_t;
typedef short bf16x8 __attribute__((ext_vector_type(8)));
typedef float f32x4 __attribute__((ext_vector_type(4)));
typedef unsigned u32x4 __attribute__((ext_vector_type(4)));
constexpr int BM = 256, BK = 64, HALF = 128, HTB = HALF * BK * 2  , STAGE_BYTES = 8 * HTB, NXCD = 8, WGM = 8;

__host__ __device__ __forceinline__ int lds_byte(int r, int c) { const int st = (r >> 4) * 2 + (c >> 5), rr = r & 15, cc = c & 31, ob = rr * 64 + cc * 2; return st * 1024 + (ob ^ (((ob >> 9) & 1) << 5)); }
__host__ __device__ __forceinline__ void stage_rc(int b, int& R, int& C) { const int st = b / 1024, sb = b % 1024, swz = sb ^ (((sb >> 9) & 1) << 5); R = (st >> 1) * 16 + swz / 64; C = (st & 1) * 32 + (swz % 64) / 2; }
__host__ __device__ __forceinline__ int perm32(int rho) { const int n = rho >> 4, i = rho & 15; return 8 * (i >> 2) + 4 * n + (i & 3); }

struct Unit { int pm, pn; };
struct Gemm { const bf16_t* A; const bf16_t* Bt; int M, N, K; };

struct StaticOrder {
    int nM, nN, nwg, G, c;
    __host__ __device__ void init(int M, int N, int G_, int c_) { nM = M / BM; nN = N / BM; nwg = nM * nN; G = G_; c = c_; }
    __host__ __device__ bool next(int i, Unit& u) const {
        const long L = (long)i * G + c; if (L >= nwg) return false;
        int wgid = (int)L; { const int q = nwg / NXCD, r = nwg % NXCD, xcd = wgid % NXCD, off = wgid / NXCD; wgid = (xcd < r ? xcd * (q + 1) : r * (q + 1) + (xcd - r) * q) + off; }
        const int nig = WGM * nN, gid = wgid / nig, fm = gid * WGM, gsz = (nM - fm) < WGM ? (nM - fm) : WGM;
        u.pm = fm + ((wgid % nig) % gsz); u.pn = (wgid % nig) / gsz; return true;
    }
    __device__ __forceinline__ void a_ready(const Unit&) const {}
    __device__ __forceinline__ void done(const Unit&) const {}
};

__device__ __forceinline__ unsigned cvt_pk_bf16(float lo, float hi) { unsigned r; asm volatile("v_cvt_pk_bf16_f32 %0, %1, %2" : "=v"(r) : "v"(lo), "v"(hi)); return r; }
typedef float f32x2 __attribute__((ext_vector_type(2)));
template <class Epi, class Sched, bool ALIGN_EPI = false, bool SP2 = false>
__device__ __forceinline__ void gemm_phase(PG8_LAS unsigned char* lds, const Gemm g, const Sched& S, const Epi& E) {
    int tid_ = threadIdx.x; asm volatile("" : "+v"(tid_));
    const int tid = tid_, wid = __builtin_amdgcn_readfirstlane(tid >> 6), lane = tid & 63, wr = wid >> 2, wc = wid & 3, fr = lane & 15, fq = lane >> 4;
    const int K = g.K, nt = K / BK;
    unsigned voffA[2], voffB[2];
#pragma unroll
    for (int i = 0; i < 2; ++i) { int R, C; stage_rc(tid * 16 + i * 8192, R, C); const int Rb = Epi::PERM ? ((R & ~31) + perm32(R & 31)) : R;
        voffA[i] = (unsigned)(R * K + C) * 2u; voffB[i] = (unsigned)(Rb * K + C) * 2u; }
    const size_t kstep = (size_t)(BK * 2);
    const size_t hstep = (size_t)HALF * K * 2;
    const size_t tstep = 2 * hstep;
    const unsigned ldsw = (unsigned)wid * 1024u;
    const int aoff = lds_byte(wr * 64 + fr, fq * 8), boff = lds_byte(wc * 32 + fr, fq * 8);
#define PG8_SA(b, h) (((b) * 2 + (h)) * HTB)
#define PG8_SB(b, h) ((4 + (b) * 2 + (h)) * HTB)
#define PG8_STAGE(bufoff, gbase, voff) do { _Pragma("unroll") for (int _i = 0; _i < 2; ++_i) \
        __builtin_amdgcn_global_load_lds((const unsigned*)((const char*)(gbase) + (voff)[_i]), (PG8_LAS unsigned*)(lds + (bufoff) + ldsw + _i * 8192), 16, 0, 0); } while (0)
#define PG8_LDA(dst, b, h) do { _Pragma("unroll") for (int m = 0; m < 4; ++m) _Pragma("unroll") for (int k = 0; k < 2; ++k) dst[m][k] = *(const PG8_LAS bf16x8*)(lds + PG8_SA(b, h) + aoff + m * 2048 + k * 1024); } while (0)
#define PG8_LDB(dst, b, h) do { _Pragma("unroll") for (int n = 0; n < 2; ++n) _Pragma("unroll") for (int k = 0; k < 2; ++k) dst[n][k] = *(const PG8_LAS bf16x8*)(lds + PG8_SB(b, h) + boff + n * 2048 + k * 1024); } while (0)
#define PG8_MMA(ai, bj, At, Bt) do { __builtin_amdgcn_s_setprio(1); _Pragma("unroll") for (int m = 0; m < 4; ++m) _Pragma("unroll") for (int n = 0; n < 2; ++n) _Pragma("unroll") for (int k = 0; k < 2; ++k) \
        acc[ai][bj][m][n] = __builtin_amdgcn_mfma_f32_16x16x32_bf16(Bt[n][k], At[m][k], acc[ai][bj][m][n], 0, 0, 0); __builtin_amdgcn_s_setprio(0); } while (0)
#define PG8_WAIT_V(n) asm volatile("s_waitcnt vmcnt(" #n ")" ::: "memory")
#define PG8_WAIT_L(n) asm volatile("s_waitcnt lgkmcnt(" #n ")" ::: "memory")
#define PG8_BAR __builtin_amdgcn_s_barrier()
#define PG8_SCHED __builtin_amdgcn_sched_barrier(0)
    Unit cur, nxt; int ui = 0;
    if (!S.next(0, cur)) return;
    f32x4 acc[2][2][4][2];
#pragma unroll
    for (int a = 0; a < 2; ++a)
#pragma unroll
        for (int b = 0; b < 2; ++b)
#pragma unroll
            for (int m = 0; m < 4; ++m)
#pragma unroll
                for (int n = 0; n < 2; ++n) acc[a][b][m][n] = (f32x4){0.f, 0.f, 0.f, 0.f};
    bf16x8 At[4][2], B0[2][2], B1[2][2];
    const char* cA = (const char*)g.A + (size_t)cur.pm * tstep; const char* cB = (const char*)g.Bt + (size_t)cur.pn * tstep;
    S.a_ready(cur);
    if constexpr (SP2) {
        PG8_STAGE(PG8_SB(0, 0), cB, voffB); PG8_STAGE(PG8_SB(0, 1), cB + hstep, voffB); PG8_STAGE(PG8_SA(0, 0), cA, voffA); PG8_STAGE(PG8_SA(0, 1), cA + hstep, voffA);
        if (wr == 1) PG8_BAR;
        PG8_WAIT_V(2); PG8_BAR;
        PG8_STAGE(PG8_SB(1, 0), cB + kstep, voffB); PG8_STAGE(PG8_SA(1, 0), cA + kstep, voffA); PG8_STAGE(PG8_SB(1, 1), cB + hstep + kstep, voffB);
        PG8_WAIT_V(6); PG8_BAR;
    } else {
        PG8_STAGE(PG8_SB(0, 0), cB, voffB); PG8_STAGE(PG8_SA(0, 0), cA, voffA); PG8_STAGE(PG8_SB(0, 1), cB + hstep, voffB); PG8_STAGE(PG8_SA(0, 1), cA + hstep, voffA);
        if (wr == 1) PG8_BAR;
        PG8_WAIT_V(4); PG8_BAR;
        PG8_STAGE(PG8_SB(1, 0), cB + kstep, voffB); PG8_STAGE(PG8_SA(1, 0), cA + kstep, voffA); PG8_STAGE(PG8_SB(1, 1), cB + hstep + kstep, voffB);
        PG8_WAIT_V(6); PG8_BAR;
    }
    for (;;) {
        const bool has_next = S.next(ui + 1, nxt);
        const char* nA = has_next ? (const char*)g.A + (size_t)nxt.pm * tstep : cA; const char* nB = has_next ? (const char*)g.Bt + (size_t)nxt.pn * tstep : cB;
        for (int t = 0; t < nt; t += 2) {
            const bool last = (t == nt - 2);
            const char* a1 = cA + (size_t)(t + 1) * kstep;
            const char* a2 = last ? nA : cA + (size_t)(t + 2) * kstep; const char* b2 = last ? nB : cB + (size_t)(t + 2) * kstep;
            const char* a3 = a2 + kstep; const char* b3 = b2 + kstep;
            if (last && has_next) S.a_ready(nxt);
            if constexpr (SP2) {
            PG8_LDB(B0, 0, 0); PG8_LDB(B1, 0, 1); PG8_SCHED; PG8_LDA(At, 0, 0); PG8_STAGE(PG8_SA(1, 1), a1 + hstep, voffA);
            PG8_WAIT_V(8); PG8_WAIT_L(0); PG8_BAR; PG8_MMA(0, 0, At, B0); PG8_MMA(0, 1, At, B1); PG8_BAR; PG8_SCHED;
            PG8_LDA(At, 0, 1); PG8_STAGE(PG8_SB(0, 0), b2, voffB); PG8_STAGE(PG8_SB(0, 1), b2 + hstep, voffB); PG8_STAGE(PG8_SA(0, 0), a2, voffA);
            PG8_WAIT_V(8); PG8_WAIT_L(0); PG8_BAR; PG8_MMA(1, 0, At, B0); PG8_MMA(1, 1, At, B1); PG8_BAR; PG8_SCHED;
            PG8_LDB(B0, 1, 0); PG8_LDB(B1, 1, 1); PG8_SCHED; PG8_LDA(At, 1, 0); PG8_STAGE(PG8_SA(0, 1), a2 + hstep, voffA);
            PG8_WAIT_V(8); PG8_WAIT_L(0); PG8_BAR; PG8_MMA(0, 0, At, B0); PG8_MMA(0, 1, At, B1); PG8_BAR; PG8_SCHED;
            PG8_LDA(At, 1, 1); PG8_STAGE(PG8_SB(1, 0), b3, voffB); PG8_STAGE(PG8_SB(1, 1), b3 + hstep, voffB); PG8_STAGE(PG8_SA(1, 0), a3, voffA);
            PG8_WAIT_V(8); PG8_WAIT_L(0); PG8_BAR; PG8_MMA(1, 0, At, B0); PG8_MMA(1, 1, At, B1); PG8_BAR; PG8_SCHED;
            } else {
            PG8_LDB(B0, 0, 0); PG8_SCHED; PG8_LDA(At, 0, 0); PG8_STAGE(PG8_SA(1, 1), a1 + hstep, voffA);
            PG8_WAIT_L(8); PG8_BAR; PG8_WAIT_L(0); PG8_MMA(0, 0, At, B0); PG8_BAR; PG8_SCHED;
            PG8_LDB(B1, 0, 1); PG8_STAGE(PG8_SB(0, 0), b2, voffB);
            PG8_BAR; PG8_WAIT_L(0); PG8_MMA(0, 1, At, B1); PG8_BAR;
            PG8_LDA(At, 0, 1); PG8_STAGE(PG8_SA(0, 0), a2, voffA);
            PG8_BAR; PG8_WAIT_L(0); PG8_MMA(1, 0, At, B0); PG8_BAR; PG8_SCHED;
            PG8_STAGE(PG8_SB(0, 1), b2 + hstep, voffB);
            PG8_WAIT_V(6); PG8_BAR; PG8_MMA(1, 1, At, B1); PG8_BAR;
            PG8_LDB(B0, 1, 0); PG8_SCHED; PG8_LDA(At, 1, 0); PG8_STAGE(PG8_SA(0, 1), a2 + hstep, voffA);
            PG8_WAIT_L(8); PG8_BAR; PG8_WAIT_L(0); PG8_MMA(0, 0, At, B0); PG8_BAR; PG8_SCHED;
            PG8_LDB(B1, 1, 1); PG8_STAGE(PG8_SB(1, 0), b3, voffB);
            PG8_BAR; PG8_WAIT_L(0); PG8_MMA(0, 1, At, B1); PG8_BAR;
            PG8_LDA(At, 1, 1); PG8_STAGE(PG8_SA(1, 0), a3, voffA);
            PG8_BAR; PG8_WAIT_L(0); PG8_MMA(1, 0, At, B0); PG8_BAR; PG8_SCHED;
            PG8_STAGE(PG8_SB(1, 1), b3 + hstep, voffB);
            PG8_WAIT_V(6); PG8_BAR; PG8_MMA(1, 1, At, B1); PG8_BAR;
            }
        }
        if constexpr (ALIGN_EPI) { if (wr == 0) PG8_BAR; }
        if constexpr (!Epi::AFTER_DRAIN) { E(acc, cur, wr, wc, fr, fq); S.done(cur); }
        if (!has_next) break;
#pragma unroll
        for (int a = 0; a < 2; ++a)
#pragma unroll
            for (int b = 0; b < 2; ++b)
#pragma unroll
                for (int m = 0; m < 4; ++m)
#pragma unroll
                    for (int n = 0; n < 2; ++n) acc[a][b][m][n] = (f32x4){0.f, 0.f, 0.f, 0.f};
        cur = nxt; cA = nA; cB = nB; ++ui;
        if constexpr (ALIGN_EPI) { if (wr == 1) PG8_BAR; }
    }
    PG8_WAIT_V(0);
    if constexpr (!ALIGN_EPI) { if (wr == 0) PG8_BAR; }
    PG8_BAR;
    if constexpr (Epi::AFTER_DRAIN) { E.fused(acc, cur, wr, wc, fr, fq, lds, wid, lane); S.done(cur); }
#undef PG8_SA
#undef PG8_SB
#undef PG8_STAGE
#undef PG8_LDA
#undef PG8_LDB
#undef PG8_MMA
#undef PG8_WAIT_V
#undef PG8_WAIT_L
#undef PG8_BAR
#undef PG8_SCHED
}
}

namespace pg8 {
__device__ __forceinline__ float silu_f(float x) { return x * __builtin_amdgcn_rcpf(1.f + __expf(-x)); }
struct EpiInProj {
    static constexpr bool PERM = true, AFTER_DRAIN = false;
    const float* ssq; const float* lbv; bf16_t *QB, *KB, *VB, *HXQ, *HV, *HG; float* LOGF; const float* fbias; float* logf8;
    __device__ __forceinline__ void operator()(const f32x4 (&acc)[2][2][4][2], const Unit& u, int wr, int wc, int fr, int fq) const {
        const int part = u.pn >> 1;
        const int cbase = (u.pn & 1) * 256 + wc * 32 + 8 * fq;
        if (part == 7) {
            if (wc == 0 && fq == 0) {
                const f32x4 b0 = *(const f32x4*)fbias, b1 = *(const f32x4*)(fbias + 4);
#pragma unroll
                for (int ai = 0; ai < 2; ++ai)
#pragma unroll
                    for (int m = 0; m < 4; ++m) {
                        const int r = u.pm * BM + ai * HALF + wr * 64 + m * 16 + fr;
                        const float rstd = 1.f / sqrtf(ssq[r] * (1.f / 1024.f) + 1e-6f);
                        f32x4 z0 = acc[ai][0][m][0] * rstd + b0, z1 = acc[ai][0][m][1] * rstd + b1;
#pragma unroll
                        for (int e = 0; e < 4; ++e) { z0[e] = fminf(z0[e], 0.f) - __logf(1.f + __expf(-fabsf(z0[e]))); z1[e] = fminf(z1[e], 0.f) - __logf(1.f + __expf(-fabsf(z1[e]))); }
                        *(f32x4*)(logf8 + (size_t)r * 8) = z0; *(f32x4*)(logf8 + (size_t)r * 8 + 4) = z1;
                    }
            }
        } else if (part == 4) {
#pragma unroll
            for (int bj = 0; bj < 2; ++bj)
#pragma unroll
                for (int n = 0; n < 2; ++n) {
                    const int cc = cbase + bj * HALF + 4 * n;
                    f32x4 lb1 = (f32x4){1.f, 1.f, 1.f, 1.f};
                    if (lbv) lb1 = lb1 - *(const f32x4*)(lbv + cc);
#pragma unroll
                    for (int ai = 0; ai < 2; ++ai)
#pragma unroll
                        for (int m = 0; m < 4; ++m) {
                            const int r = u.pm * BM + ai * HALF + wr * 64 + m * 16 + fr;
                            const float rstd = 1.f / sqrtf(ssq[r] * (1.f / 1024.f) + 1e-6f);
                            f32x4 a;
#pragma unroll
                            for (int e = 0; e < 4; ++e) { const float xv = acc[ai][bj][m][n][e] * rstd; const float omf = lb1[e] * __builtin_amdgcn_rcpf(1.f + __expf(xv)); a[e] = fmaxf(__logf(1.f - omf), -30.f); }
                            *(f32x4*)(LOGF + (size_t)r * 512 + cc) = a;
                        }
                }
        } else {
            bf16_t* dst = part == 0 ? QB : part == 1 ? KB : part == 2 ? VB : part == 3 ? HXQ : part == 5 ? HV : HG;
            const float sc = part == 0 ? 0.125f * 1.4426950408889634f : part == 3 ? 0.08838834764831845f : 1.f;
            const bool dosilu = (part == 3) || (part == 6);
#pragma unroll
            for (int ai = 0; ai < 2; ++ai)
#pragma unroll
                for (int m = 0; m < 4; ++m) {
                    const int r = u.pm * BM + ai * HALF + wr * 64 + m * 16 + fr;
                    const float rstd = sc / sqrtf(ssq[r] * (1.f / 1024.f) + 1e-6f);
#pragma unroll
                    for (int bj = 0; bj < 2; ++bj) {
                        f32x4 v0 = acc[ai][bj][m][0], v1 = acc[ai][bj][m][1];
                        if (dosilu) {
#pragma unroll
                            for (int e = 0; e < 4; ++e) { const float a0 = v0[e] * (rstd / sc), a1 = v1[e] * (rstd / sc); v0[e] = silu_f(a0) * sc; v1[e] = silu_f(a1) * sc; }
                        } else { v0 = v0 * rstd; v1 = v1 * rstd; }
                        u32x4 w; w.x = cvt_pk_bf16(v0[0], v0[1]); w.y = cvt_pk_bf16(v0[2], v0[3]); w.z = cvt_pk_bf16(v1[0], v1[1]); w.w = cvt_pk_bf16(v1[2], v1[3]);
                        *(u32x4*)(dst + (size_t)r * 512 + cbase + bj * HALF) = w;
                    }
                }
        }
    }
};
struct EpiResid {
    static constexpr bool PERM = false, AFTER_DRAIN = false;
    float* out; float* hs; bf16_t* HB; float* ssq; unsigned skip;
    __device__ __forceinline__ void operator()(const f32x4 (&acc)[2][2][4][2], const Unit& u, int wr, int wc, int fr, int fq) const {
        if (skip) return;
        const int col0 = u.pn * BM + wc * 32 + 4 * fq;
#pragma unroll
        for (int ai = 0; ai < 2; ++ai)
#pragma unroll
            for (int m = 0; m < 4; ++m) {
                const int r = u.pm * BM + ai * HALF + wr * 64 + m * 16 + fr;
                const int b = r / 4160, vp = r - b * 4160;
                float* hp = vp >= 64 ? out + (size_t)(b * 4096 + vp - 64) * 1024 : hs + (size_t)(b * 64 + vp) * 1024;
                float q = 0.f;
#pragma unroll
                for (int bj = 0; bj < 2; ++bj)
#pragma unroll
                    for (int n = 0; n < 2; ++n) { const int c = col0 + bj * HALF + n * 16; const f32x4 h = *(const f32x4*)(hp + c) + acc[ai][bj][m][n]; *(f32x4*)(hp + c) = h;
                        unsigned long long w = (unsigned long long)cvt_pk_bf16(h[0], h[1]) | ((unsigned long long)cvt_pk_bf16(h[2], h[3]) << 32);
                        *(unsigned long long*)(HB + (size_t)r * 1024 + c) = w; q += (h[0] * h[0] + h[1] * h[1]) + (h[2] * h[2] + h[3] * h[3]); }
                if (ssq) { q += __shfl_xor(q, 16); q += __shfl_xor(q, 32); if (fq == 0) atomicAdd(ssq + r, q); }
            }
    }
};
struct EpiSwiGLU {
    static constexpr bool PERM = true, AFTER_DRAIN = false;
    const float* ssq; bf16_t* ACT;
    __device__ __forceinline__ void operator()(const f32x4 (&acc)[2][2][4][2], const Unit& u, int wr, int wc, int fr, int fq) const {
        const int f0 = u.pn * HALF + wc * 32 + 8 * fq;
#pragma unroll
        for (int ai = 0; ai < 2; ++ai)
#pragma unroll
            for (int m = 0; m < 4; ++m) {
                const int r = u.pm * BM + ai * HALF + wr * 64 + m * 16 + fr;
                const float rstd = 1.f / sqrtf(ssq[r] * (1.f / 1024.f) + 1e-6f);
                float y[8];
#pragma unroll
                for (int n = 0; n < 2; ++n)
#pragma unroll
                    for (int e = 0; e < 4; ++e) { const float g = acc[ai][0][m][n][e] * rstd, uu = acc[ai][1][m][n][e] * rstd; y[4 * n + e] = silu_f(g) * uu; }
                u32x4 w; w.x = cvt_pk_bf16(y[0], y[1]); w.y = cvt_pk_bf16(y[2], y[3]); w.z = cvt_pk_bf16(y[4], y[5]); w.w = cvt_pk_bf16(y[6], y[7]);
                *(u32x4*)(ACT + (size_t)r * 2816 + f0) = w;
            }
    }
};
}

#define GAS __attribute__((address_space(1)))
typedef unsigned v4u __attribute__((ext_vector_type(4)));
typedef GAS unsigned gu32;
typedef GAS unsigned long long gu64;
#define RLX_AGENT __ATOMIC_RELAXED, __HIP_MEMORY_SCOPE_AGENT
#define LDS_WAIT() asm volatile("s_waitcnt lgkmcnt(0)" ::: "memory")
#define VM_WAIT() asm volatile("s_waitcnt vmcnt(0)" ::: "memory")
__device__ __forceinline__ unsigned long long rt() { return __builtin_amdgcn_s_memrealtime(); }
#define XB_TMO      128
#define XB_XCNT(j)  (256  + 64 * (j))
#define XB_XSUB(j)  (1280 + 64 * (j))
#define XB_XGEN(j)  (2304 + 64 * (j))
#define XB_TOP      3328
#define XB_TOPGEN   3392
#define XCD_BAR_WORDS 3456
#define XB_SPIN_CAP (1u << 18)

__device__ __forceinline__ unsigned xb_ld(unsigned* p)              { return __hip_atomic_load(p, __ATOMIC_RELAXED, __HIP_MEMORY_SCOPE_AGENT); }
__device__ __forceinline__ unsigned xb_add(unsigned* p, unsigned v) { return __hip_atomic_fetch_add(p, v, __ATOMIC_RELAXED, __HIP_MEMORY_SCOPE_AGENT); }
__device__ __forceinline__ unsigned xb_xcc_id() { return (unsigned)__builtin_amdgcn_s_getreg((3 << 11) | 20) & 0xFu; }
#define XB_SPIN(cond, bar) do { unsigned _sp = 0; while (cond) { __builtin_amdgcn_s_sleep(1); \
    if ((++_sp & 255u) == 0u) { if (xb_ld(&(bar)[XB_TMO])) break; if (_sp > XB_SPIN_CAP) { atomicAdd(&(bar)[XB_TMO], 1u); break; } } } } while (0)

struct XcdBarrier {
    unsigned* bar; unsigned x;
    volatile LAS unsigned* st;
};

__device__ __forceinline__ XcdBarrier xcd_barrier_post(unsigned* bar, volatile LAS unsigned* st) {
    XcdBarrier b; b.bar = bar; b.x = xb_xcc_id(); b.st = st;
    if (threadIdx.x == 0) (void)xb_add(&bar[XB_XCNT(b.x)], 1u);
    return b;
}
__device__ __forceinline__ void xcd_barrier_complete(unsigned* bar, unsigned x, unsigned& nloc, unsigned& nx) {
    const unsigned G = gridDim.x * gridDim.y * gridDim.z;
    unsigned sum, cnt, mine, sp = 0u;
    for (;;) {
        sum = 0u; cnt = 0u; mine = 0u;
#pragma unroll
        for (unsigned j = 0; j < 16; ++j) { const unsigned c = xb_ld(&bar[XB_XCNT(j)]); sum += c; cnt += (c > 0u) ? 1u : 0u; mine = (j == x) ? c : mine; }
        if (sum == G) break;
        __builtin_amdgcn_s_sleep(1);
        if ((++sp & 255u) == 0u) { if (xb_ld(&bar[XB_TMO])) break; if (sp > XB_SPIN_CAP) { atomicAdd(&bar[XB_TMO], 1u); break; } }
    }
    nloc = mine > 0u ? mine : 1u; nx = cnt > 0u ? cnt : 1u;
}

__device__ __forceinline__ void xcd_barrier(const XcdBarrier& b) {
    asm volatile("s_waitcnt vmcnt(0)" ::: "memory");
    __syncthreads();
    int t_ = threadIdx.x; asm volatile("" : "+v"(t_));
    if (t_ == 0) {
        unsigned* bar = b.bar;
        __builtin_amdgcn_s_waitcnt(0);
        unsigned nloc = b.st[0], nx = b.st[1];
        if (nloc == 0u) { xcd_barrier_complete(bar, b.x, nloc, nx); b.st[0] = nloc; b.st[1] = nx; }
        const unsigned old = xb_add(&bar[XB_XSUB(b.x)], 1u);
        const unsigned gen = old / nloc;
        if (old + 1u == (gen + 1u) * nloc) {
            __builtin_amdgcn_fence(__ATOMIC_RELEASE, "agent");
            asm volatile("s_waitcnt vmcnt(0)" ::: "memory");
            const unsigned og = xb_add(&bar[XB_TOP], 1u);
            const unsigned tg = og / nx;
            if (og + 1u == (tg + 1u) * nx) xb_add(&bar[XB_TOPGEN], 1u);
            else XB_SPIN(xb_ld(&bar[XB_TOPGEN]) == tg, bar);
            __builtin_amdgcn_fence(__ATOMIC_ACQUIRE, "agent");
            xb_add(&bar[XB_XGEN(b.x)], 1u);
            asm volatile("s_waitcnt vmcnt(0)" ::: "memory");
        } else {
            XB_SPIN(xb_ld(&bar[XB_XGEN(b.x)]) == gen, bar);
            __builtin_amdgcn_fence(__ATOMIC_ACQUIRE, "agent");
            asm volatile("s_waitcnt vmcnt(0)" ::: "memory");
        }
    }
    __syncthreads();
}

__device__ __forceinline__ void tr_item(const float* W, int K, int N, int k0, int nsrc0, bf16_t* WT, int dst_row0, const float* kscale, LAS float* scr, int lane) {
    float wv[32];
#pragma unroll
    for (int i = 0; i < 32; ++i) { const int kk = 2 * i + (lane >> 5); wv[i] = W[(size_t)(k0 + kk) * N + nsrc0 + (lane & 31)]; }
#pragma unroll
    for (int i = 0; i < 32; ++i) { const int kk = 2 * i + (lane >> 5); const float s = kscale ? kscale[k0 + kk] : 1.f; scr[kk * 33 + (lane & 31)] = wv[i] * s; }
    asm volatile("s_waitcnt lgkmcnt(0)" ::: "memory");
    const int ch = lane & 7;
#pragma unroll
    for (int j = 0; j < 4; ++j) { const int n = (lane >> 3) + 8 * j; const LAS float* s = scr + (8 * ch) * 33 + n;
        u32x4 o; o.x = pk2(s[0 * 33], s[1 * 33]); o.y = pk2(s[2 * 33], s[3 * 33]); o.z = pk2(s[4 * 33], s[5 * 33]); o.w = pk2(s[6 * 33], s[7 * 33]);
        *(u32x4*)(WT + (size_t)(dst_row0 + n) * K + k0 + 8 * ch) = o; }
    asm volatile("s_waitcnt lgkmcnt(0)" ::: "memory");
}

__device__ __forceinline__ void p0_weights(const Ctx& c, LAS unsigned char* lds, int l, int it0, int it1, int w0, int nw) {
    LAS float* scr = (LAS float*)(lds + c.wave * 16384);
    constexpr int I_IN = 16 * (NIN / 32), I_OUT = 16 * 32, I_G = 16 * (DFF / 32), I_D = (DFF / 64) * 32, I_L = I_IN + I_OUT + 2 * I_G + I_D;
    if (it1 > I_L) it1 = I_L;
#pragma nounroll
    for (int it = it0 + w0; it < it1; it += nw) {
        int r = it;
        if (r < I_IN) { const int kb = r / (NIN / 32), nb = r % (NIN / 32), n0 = nb * 32;
            tr_item(c.win + (size_t)l * DM * INCOLS, DM, INCOLS, kb * 64, n0 + (n0 >= 1536 ? 8 : 0), wptr(c, l, W_IN), n0, c.nmw + l * DM, scr, c.lane); continue; }
        r -= I_IN;
        if (r < I_OUT) { const int kb = r / 32, nb = r % 32; tr_item(c.wout + (size_t)l * DM * DM, DM, DM, kb * 64, nb * 32, wptr(c, l, W_OUT), nb * 32, nullptr, scr, c.lane); continue; }
        r -= I_OUT;
        if (r < 2 * I_G) { const int up = r >= I_G; if (up) r -= I_G; const int kb = r / (DFF / 32), nb = r % (DFF / 32), f0 = nb * 32;
            tr_item((up ? c.wu : c.wg) + (size_t)l * DM * DFF, DM, DFF, kb * 64, f0, wptr(c, l, W_GU), 256 * (f0 >> 7) + (f0 & 127) + (up ? 128 : 0), c.nfw + l * DM, scr, c.lane); continue; }
        r -= 2 * I_G;
        { const int kb = r / 32, nb = r % 32; tr_item(c.wd + (size_t)l * DFF * DM, DFF, DM, kb * 64, nb * 32, wptr(c, l, W_DN), nb * 32, nullptr, scr, c.lane); }
    }
}

__device__ __forceinline__ void p0_extra_rows(const Ctx& c, int l, int gt, int NGT) {
#pragma nounroll
    for (int i = gt; i < 8 * DM; i += NGT) { const int cc = i >> 10, k = i & 1023;
        wptr(c, l, W_IN)[(size_t)(NIN + cc) * DM + k] = (bf16_t)f2bf(c.win[(size_t)l * DM * INCOLS + (size_t)k * INCOLS + 1536 + cc] * c.nmw[l * DM + k]); }
#pragma nounroll
    for (int i = gt; i < 248 * 128; i += NGT) *(u32x4*)(wptr(c, l, W_IN) + (size_t)(NIN + 8) * DM + (size_t)i * 8) = (u32x4){0u, 0u, 0u, 0u};
}
__device__ __forceinline__ void h_build(const Ctx& c) {
    float* ssq = c.sumsq;
    for (int rb = c.gw; rb < MROWS; rb += 4 * c.NGW) {
        f32x4 v[4][4];
#pragma unroll
        for (int q = 0; q < 4; ++q) { const int r = rb + q * c.NGW;
            if (r < MROWS) { const int b = r / LV, vp = r - b * LV;
                const float* src = vp >= 64 ? c.x + (size_t)(b * SEQ + vp - 64) * DM : (vp >= PADF ? c.meta + (size_t)(vp - PADF) * DM : nullptr);
#pragma unroll
                for (int j = 0; j < 4; ++j) v[q][j] = src ? *(const f32x4*)(src + 4 * c.lane + 256 * j) : (f32x4){0.f, 0.f, 0.f, 0.f}; } }
#pragma unroll
        for (int q = 0; q < 4; ++q) { const int r = rb + q * c.NGW;
            if (r < MROWS) { float* hp = hrow(c, r); float s = 0.f;
#pragma unroll
                for (int j = 0; j < 4; ++j) { *(f32x4*)(hp + 4 * c.lane + 256 * j) = v[q][j];
                    unsigned long long w = (unsigned long long)pk2(v[q][j].x, v[q][j].y) | ((unsigned long long)pk2(v[q][j].z, v[q][j].w) << 32);
                    *(unsigned long long*)(c.HB + (size_t)r * DM + 4 * c.lane + 256 * j) = w;
                    s += (v[q][j].x * v[q][j].x + v[q][j].y * v[q][j].y) + (v[q][j].z * v[q][j].z + v[q][j].w * v[q][j].w); }
                s = wave_sum(s);
                if (c.lane == 0) ssq[r] = s; } }
    }
}

__device__ __forceinline__ void kbias_job(const Ctx& c, LAS unsigned char* lds, int job) {
    const int b = job >> 3, h = job & 7;
    LAS float* wt = (LAS float*)lds;
    const int v0 = 9 * c.tid;
    float g[9]; float s = 0.f;
#pragma unroll
    for (int i = 0; i < 9; ++i) { const int vp = v0 + i; g[i] = (vp >= PADF && vp < LV) ? c.logf8[(size_t)(b * LV + vp) * 8 + h] : 0.f; s += g[i]; }
    float inc = s;
#pragma unroll
    for (int o = 1; o < 64; o <<= 1) { const float t = __shfl_up(inc, o); if (c.lane >= o) inc += t; }
    if (c.lane == 63) wt[c.wave] = inc;
    __syncthreads();
    float run = inc - s;
    for (int w = 0; w < c.wave; ++w) run += wt[w];
    float* kb = c.kbias + (size_t)job * KBL;
#pragma unroll
    for (int i = 0; i < 9; ++i) { const int vp = v0 + i; run += g[i]; if (vp < KBL) kb[vp] = vp < PADF ? -1e30f : (vp < LV ? -run * LOG2E : 0.f); }
    __syncthreads();
}

template <int MODE>
__device__ __forceinline__ void gemm_simple(const Ctx& c, int layer) {
    const int fr = c.lane & 15, g = c.lane >> 4;
    const bf16_t* A = MODE == 0 ? c.HB : MODE == 1 ? c.MIX : MODE == 2 ? c.HB : c.ACT;
    const bf16_t* Bt = wptr(c, layer, MODE == 0 ? W_IN : MODE == 1 ? W_OUT : MODE == 2 ? W_GU : W_DN);
    constexpr int K = MODE == 3 ? DFF : DM;
    constexpr int NCOL = MODE == 0 ? NIN : MODE == 2 ? DFF : DM;
    constexpr int ntn = NCOL / 64, ntm = MROWS / 16;
    for (int t = c.gw; t < ntm * ntn; t += c.NGW) {
        const int tm = t / ntn, tn = t - tm * ntn, row0 = tm * 16, col0 = tn * 64;
        f32x4 acc[4], acc2[4];
#pragma unroll
        for (int n = 0; n < 4; ++n) { acc[n] = (f32x4){0.f, 0.f, 0.f, 0.f}; acc2[n] = (f32x4){0.f, 0.f, 0.f, 0.f}; }
        const bf16_t* ap = A + (size_t)(row0 + fr) * K + 8 * g;
        const bf16_t* bp[4];
#pragma unroll
        for (int n = 0; n < 4; ++n) { const int cn = col0 + 16 * n + fr; const int br = MODE == 2 ? 256 * (cn >> 7) + (cn & 127) : cn; bp[n] = Bt + (size_t)br * K + 8 * g; }
        for (int k0 = 0; k0 < K; k0 += 32) {
            const bf16x8 a = *(const bf16x8*)(ap + k0);
#pragma unroll
            for (int n = 0; n < 4; ++n) { const bf16x8 b = *(const bf16x8*)(bp[n] + k0); acc[n] = __builtin_amdgcn_mfma_f32_16x16x32_bf16(a, b, acc[n], 0, 0, 0);
                if (MODE == 2) { const bf16x8 b2 = *(const bf16x8*)(bp[n] + (size_t)128 * K + k0); acc2[n] = __builtin_amdgcn_mfma_f32_16x16x32_bf16(a, b2, acc2[n], 0, 0, 0); } }
        }
        if (MODE == 0) {
            const float* ssq = c.sumsq + (size_t)layer * MALLOC;
#pragma unroll
            for (int j = 0; j < 4; ++j) { const int r = row0 + 4 * g + j; const float rstd = 1.f / sqrtf(ssq[r] * (1.f / DM) + EPS);
#pragma unroll
                for (int n = 0; n < 4; ++n) { const int cn = col0 + 16 * n + fr; const float xv = acc[n][j] * rstd; const int part = cn >> 9, cc = cn & 511; const size_t o = (size_t)r * 512 + cc;
                    if (part == 0) c.QB[o] = (bf16_t)f2bf(xv * C2);
                    else if (part == 1) c.KB[o] = (bf16_t)f2bf(xv);
                    else if (part == 2) c.VB[o] = (bf16_t)f2bf(xv);
                    else if (part == 3) c.HXQ[o] = (bf16_t)f2bf(siluf(xv) * HGQS);
                    else if (part == 4) { const float lb = layer ? c.lbv[cc] : 0.f; const float omf = (1.f - lb) / (1.f + __expf(xv)); c.LOGF[o] = fmaxf(log1pf(-omf), -30.f); }
                    else if (part == 5) c.HV[o] = (bf16_t)f2bf(xv);
                    else c.HG[o] = (bf16_t)f2bf(siluf(xv)); } }
        } else if (MODE == 1 || MODE == 3) {
            float* ssq = c.sumsq + (size_t)(2 + layer) * MALLOC;
#pragma unroll
            for (int j = 0; j < 4; ++j) { const int r = row0 + 4 * g + j; float* hp = hrow(c, r); float q = 0.f;
#pragma unroll
                for (int n = 0; n < 4; ++n) { const int cn = col0 + 16 * n + fr; const float hn = hp[cn] + acc[n][j]; hp[cn] = hn; c.HB[(size_t)r * DM + cn] = (bf16_t)f2bf(hn); q += hn * hn; }
                if (MODE == 1) { q += __shfl_xor(q, 1); q += __shfl_xor(q, 2); q += __shfl_xor(q, 4); q += __shfl_xor(q, 8); if (fr == 0) atomicAdd(ssq + r, q); } }
        } else {
            const float* ssq = c.sumsq + (size_t)(2 + layer) * MALLOC;
#pragma unroll
            for (int j = 0; j < 4; ++j) { const int r = row0 + 4 * g + j; const float rstd = 1.f / sqrtf(ssq[r] * (1.f / DM) + EPS);
#pragma unroll
                for (int n = 0; n < 4; ++n) { const int cn = col0 + 16 * n + fr; const float gv = acc[n][j] * rstd, uv = acc2[n][j] * rstd; c.ACT[(size_t)r * DFF + cn] = (bf16_t)f2bf(siluf(gv) * uv); } }
        }
    }
}

template <int MODE>
__device__ __forceinline__ void tail_job(const Ctx& c, LAS unsigned char* lds, int layer) {
    constexpr int K = MODE == 3 ? DFF : DM, KW = K / 8;
    const bf16_t* A = MODE == 1 ? c.MIX : c.ACT;
    const bf16_t* Bt = wptr(c, layer, MODE == 1 ? W_OUT : W_DN);
    float* ssq = MODE == 1 ? c.sumsq + (size_t)(2 + layer) * MALLOC : (layer == 0 ? c.sumsq + (size_t)MALLOC : nullptr);
    int tid_ = threadIdx.x; asm volatile("" : "+v"(tid_)); const int tid = tid_, lane = tid & 63, w = __builtin_amdgcn_readfirstlane(tid >> 6);
    const int fr = lane & 15, g = lane >> 4;
    LAS float* P = (LAS float*)lds;
    for (int job = blockIdx.x; job < 256; job += gridDim.x) {
        const int tm = job >> 4, tn = job & 15, row0 = 16384 + tm * 16, col0 = tn * 64;
        f32x4 acc[4];
#pragma unroll
        for (int n = 0; n < 4; ++n) acc[n] = (f32x4){0.f, 0.f, 0.f, 0.f};
        const bf16_t* ap = A + (size_t)(row0 + fr) * K + w * KW + 8 * g;
        const bf16_t* bp = Bt + (size_t)(col0 + fr) * K + w * KW + 8 * g;
#pragma unroll 4
        for (int k0 = 0; k0 < KW; k0 += 32) {
            const bf16x8 a = *(const bf16x8*)(ap + k0);
#pragma unroll
            for (int n = 0; n < 4; ++n) { const bf16x8 b = *(const bf16x8*)(bp + (size_t)n * 16 * K + k0); acc[n] = __builtin_amdgcn_mfma_f32_16x16x32_bf16(a, b, acc[n], 0, 0, 0); }
        }
#pragma unroll
        for (int n = 0; n < 4; ++n)
#pragma unroll
            for (int j = 0; j < 4; ++j) P[(w * 16 + 4 * g + j) * 64 + 16 * n + fr] = acc[n][j];
        __syncthreads();
        { const int row = tid >> 5, c2 = (tid & 31) * 2; float s0 = 0.f, s1 = 0.f;
#pragma unroll
          for (int ww = 0; ww < 8; ++ww) { s0 += P[(ww * 16 + row) * 64 + c2]; s1 += P[(ww * 16 + row) * 64 + c2 + 1]; }
          const int r = row0 + row; float* hp = hrow(c, r) + col0 + c2;
          const float h0 = hp[0] + s0, h1 = hp[1] + s1; hp[0] = h0; hp[1] = h1;
          *(unsigned*)(c.HB + (size_t)r * DM + col0 + c2) = pk2(h0, h1);
          if (ssq) { float q = h0 * h0 + h1 * h1; q += __shfl_xor(q, 1); q += __shfl_xor(q, 2); q += __shfl_xor(q, 4); q += __shfl_xor(q, 8); q += __shfl_xor(q, 16); if ((tid & 31) == 0) atomicAdd(ssq + r, q); } }
        __syncthreads();
    }
}

template <int MODE>
__device__ __forceinline__ void gemm_fast(const Ctx& c, LAS unsigned char* lds, int layer, unsigned skip = 0u) {
    const bf16_t* A = MODE == 0 ? c.HB : MODE == 1 ? c.MIX : MODE == 2 ? c.HB : c.ACT;
    const bf16_t* Bt = wptr(c, layer, MODE == 0 ? W_IN : MODE == 1 ? W_OUT : MODE == 2 ? W_GU : W_DN);
    constexpr int K = MODE == 3 ? DFF : DM;
    constexpr int N = MODE == 0 ? NINP : MODE == 2 ? 2 * DFF : DM;
    int bx_ = blockIdx.x; asm volatile("" : "+s"(bx_));
    constexpr int MG = (MODE == 1 || MODE == 3) ? 16384 : MROWS;
    pg8::Gemm g{A, Bt, MG, N, K}; pg8::StaticOrder S; S.init(MG, N, (int)gridDim.x, bx_);
    if constexpr (MODE == 0) {
        pg8::EpiInProj E{c.sumsq + (size_t)layer * MALLOC, layer ? c.lbv : nullptr, c.QB, c.KB, c.VB, c.HXQ, c.HV, c.HG, c.LOGF, c.fbias + layer * 8, c.logf8};
        pg8::gemm_phase<pg8::EpiInProj, pg8::StaticOrder, true, true>(lds, g, S, E);
    } else if constexpr (MODE == 2) {
        pg8::EpiSwiGLU E{c.sumsq + (size_t)(2 + layer) * MALLOC, c.ACT};
        pg8::gemm_phase<pg8::EpiSwiGLU, pg8::StaticOrder, true, true>(lds, g, S, E);
    } else {
        pg8::EpiResid E{c.out, c.hs, c.HB, MODE == 1 ? c.sumsq + (size_t)(2 + layer) * MALLOC : (layer == 0 ? c.sumsq + (size_t)MALLOC : nullptr), skip};
        pg8::gemm_phase<pg8::EpiResid, pg8::StaticOrder, true, true>(lds, g, S, E);
        if (!skip) tail_job<MODE>(c, lds, layer);
    }
}

#include <hip/hip_bf16.h>
#include <cmath>
namespace attn_body {
using bf16=__hip_bfloat16;
using bf16x8=__attribute__((ext_vector_type(8)))short;
using s16x4=__attribute__((ext_vector_type(4)))short;
using f32x16=__attribute__((ext_vector_type(16)))float;
using u32x4=__attribute__((ext_vector_type(4)))unsigned;
constexpr int BATCH=4,NHEAD=8,SEQ=4160,D=64,DM=NHEAD*D,OP=1024;
constexpr int NW=8,QBLK=32,QB=QBLK*NW,KVBLK=64,NQB=17;
constexpr int ATTN_PITCH=DM, ATTN_UNIT_ROWS=QB;
__device__ __forceinline__ int crow(int r,int hi){return (r&3)+8*(r>>2)+4*hi;}
#define SBAR() __builtin_amdgcn_sched_barrier(0)
__device__ __forceinline__ void cmask(f32x16&p0,f32x16&p1,int jb,int qrel,int hi){
  const float NEG=-INFINITY; int kb=64*jb+4*hi;
  #pragma unroll
  for(int r=0;r<16;++r){int kv=kb+(r&3)+8*(r>>2); if(kv>qrel)p0[r]=NEG; if(kv+32>qrel)p1[r]=NEG;}
}

constexpr int NSLOT=3, SLOTB=8192;
constexpr int LDS_K=0, LDS_V=NSLOT*SLOTB, LDS_WS=2*NSLOT*SLOTB, LDS_OST=LDS_WS+NW*64*4, LDS_KB=LDS_OST+NW*4096, LDS_BYTES=LDS_KB+4352*4+256;
constexpr float C2=0.125f*1.4426950408889634f;
__device__ __forceinline__ void glds16(const void*gsrc,unsigned lds_dst){unsigned keep;
  asm volatile("s_mov_b32 %0, m0\n\ts_mov_b32 m0, %2\n\ts_nop 0\n\tglobal_load_lds_dwordx4 %1, off\n\ts_mov_b32 m0, %0":"=&s"(keep):"v"(gsrc),"s"(lds_dst):"memory");}
__device__ __forceinline__ float max3f(float a,float b,float c){float r;asm("v_max3_f32 %0, %1, %2, %3":"=v"(r):"v"(a),"v"(b),"v"(c));return r;}
__device__ __forceinline__ float max2f(float a,float b){float r;asm("v_max_f32_e32 %0, %1, %2":"=v"(r):"v"(a),"v"(b));return r;}
__device__ __forceinline__ float fadd_s(float a,float b){float r;asm("v_add_f32_e32 %0, %1, %2":"=v"(r):"v"(a),"v"(b));return r;}
__device__ __forceinline__ float fsub_s(float a,float b){float r;asm("v_sub_f32_e32 %0, %1, %2":"=v"(r):"v"(a),"v"(b));return r;}
typedef float f32x2_t __attribute__((ext_vector_type(2))); typedef __bf16 bf16x2_t __attribute__((ext_vector_type(2)));
__device__ __forceinline__ unsigned cvtpk_s(float lo,float hi){f32x2_t v={lo,hi};bf16x2_t b=__builtin_convertvector(v,bf16x2_t);return __builtin_bit_cast(unsigned,b);}
#define WAIT_BAR(N) asm volatile("s_waitcnt vmcnt(" #N ") lgkmcnt(0)\n\ts_barrier":::"memory")

__device__ __forceinline__ void qkt(f32x16&p0,f32x16&p1,const char*Kslot,const bf16x8*qr,int r32,int hi){
  const char*kb=Kslot+hi*1024+r32*16;
  #pragma unroll
  for(int d0=0;d0<4;++d0){
    const bf16x8 b0=*reinterpret_cast<const bf16x8*>(kb+d0*2048);
    const bf16x8 b1=*reinterpret_cast<const bf16x8*>(kb+d0*2048+512);
    p0=__builtin_amdgcn_mfma_f32_32x32x16_bf16(b0,qr[d0],p0,0,0,0);p1=__builtin_amdgcn_mfma_f32_32x32x16_bf16(b1,qr[d0],p1,0,0,0);}
}
typedef __attribute__((address_space(3))) const char* lds_cptr;
typedef short v4i16_t __attribute__((ext_vector_type(4)));
__device__ __forceinline__ void kload8(bf16x8*kf,lds_cptr kp){
  kf[0]=*(const __attribute__((address_space(3))) bf16x8*)(kp);      kf[1]=*(const __attribute__((address_space(3))) bf16x8*)(kp+512);
  kf[2]=*(const __attribute__((address_space(3))) bf16x8*)(kp+2048); kf[3]=*(const __attribute__((address_space(3))) bf16x8*)(kp+2560);
  kf[4]=*(const __attribute__((address_space(3))) bf16x8*)(kp+4096); kf[5]=*(const __attribute__((address_space(3))) bf16x8*)(kp+4608);
  kf[6]=*(const __attribute__((address_space(3))) bf16x8*)(kp+6144); kf[7]=*(const __attribute__((address_space(3))) bf16x8*)(kp+6656);
}
__device__ __forceinline__ void kload2(bf16x8*kf,lds_cptr kp,int j){ kf[2*j]=*(const __attribute__((address_space(3))) bf16x8*)(kp+j*2048); kf[2*j+1]=*(const __attribute__((address_space(3))) bf16x8*)(kp+j*2048+512); }
__device__ __forceinline__ s16x4 vtr(lds_cptr p){ return __builtin_bit_cast(s16x4,__builtin_amdgcn_ds_read_tr16_b64_v4i16((__attribute__((address_space(3))) v4i16_t*)p)); }
__device__ __forceinline__ float rowmax(const f32x16&p0,const f32x16&p1){
  float a=max3f(p0[0],p0[1],p1[0]),b=max3f(p0[2],p0[3],p1[1]);a=max3f(a,p1[2],p1[3]);
  #pragma unroll
  for(int r=4;r<16;r+=4){a=max3f(a,p0[r],p0[r+1]);b=max3f(b,p0[r+2],p0[r+3]);a=max3f(a,p1[r],p1[r+1]);b=max3f(b,p1[r+2],p1[r+3]);}
  const float m=max2f(a,b);
  auto rr=__builtin_amdgcn_permlane32_swap(__float_as_uint(m),__float_as_uint(m),false,false);
  return max2f(__uint_as_float(rr[0]),__uint_as_float(rr[1]));
}
__device__ __forceinline__ void pv(f32x16*o,int vb,bf16x8 pa0,bf16x8 pa1,bf16x8 pa2,bf16x8 pa3){
  #pragma unroll
  for(int d0=0;d0<2;++d0){s16x4 lo[4],hi[4];
    #pragma unroll
    for(int ks=0;ks<4;++ks){
      asm volatile("ds_read_b64_tr_b16 %0,%1 offset:%c2":"=&v"(lo[ks]):"v"(vb),"i"(d0*4096+ks*1024):"memory");
      asm volatile("ds_read_b64_tr_b16 %0,%1 offset:%c2":"=&v"(hi[ks]):"v"(vb),"i"(d0*4096+ks*1024+512):"memory");}
    asm volatile("s_waitcnt lgkmcnt(0)":::"memory");SBAR();
    #define PK(k) (bf16x8){lo[k][0],lo[k][1],lo[k][2],lo[k][3],hi[k][0],hi[k][1],hi[k][2],hi[k][3]}
    o[d0]=__builtin_amdgcn_mfma_f32_32x32x16_bf16(pa0,PK(0),o[d0],0,0,0);
    o[d0]=__builtin_amdgcn_mfma_f32_32x32x16_bf16(pa1,PK(1),o[d0],0,0,0);
    o[d0]=__builtin_amdgcn_mfma_f32_32x32x16_bf16(pa2,PK(2),o[d0],0,0,0);
    o[d0]=__builtin_amdgcn_mfma_f32_32x32x16_bf16(pa3,PK(3),o[d0],0,0,0);
    #undef PK
  }
}

#ifndef ATTN_STORE16
#define ATTN_STORE16(p,v) (*(u32x4*)(p)=(v))
#endif
template<int THRL> __device__ __forceinline__ void attn_unit(int b,int h,int qb,const bf16*Q,const bf16*__restrict__ K,const bf16*__restrict__ V,bf16*O,const float*__restrict__ kbg,char*shm){
  int tid_=threadIdx.x; asm volatile("":"+v"(tid_)); const int tid=tid_,lane=tid&63,r32=lane&31,hi=lane>>5; const int wid=__builtin_amdgcn_readfirstlane(tid>>6);
  const long rowbase=(long)b*SEQ; const int q0=qb*QB;
  const bf16*Qw=Q+(rowbase+q0+wid*QBLK)*DM+h*D;
  const bf16*Kh=K+rowbase*DM+h*D,*Vh=V+rowbase*DM+h*D;
  const unsigned lds0=(unsigned)(uintptr_t)shm;
  float*wsf=(float*)(shm+LDS_WS)+wid*64;
  const bf16*ksrc=Kh+(long)lane*DM+wid*8;
  const bf16*vsrc=Vh+(long)(16*(wid&3)+(lane>>2))*DM+(wid>>2)*32+(lane&3)*8;
  const unsigned kdst=lds0+LDS_K+wid*1024, vdst=lds0+LDS_V+wid*1024;
  #define DMA_K(t,slot) glds16(ksrc+(long)(NT-1-(t))*KVBLK*DM,(unsigned)__builtin_amdgcn_readfirstlane(kdst+(slot)))
  #define DMA_V(t,slot) glds16(vsrc+(long)(NT-1-(t))*KVBLK*DM,(unsigned)__builtin_amdgcn_readfirstlane(vdst+(slot)))
  const int vb0=(int)(lds0+LDS_V)+((lane>>4)&1)*32+(lane&3)*8+(4*hi+((lane&15)>>2))*64;
  const char*Kbase=shm+LDS_K; bf16x8 kf[8];
  const lds_cptr shm3=(lds_cptr)shm; const lds_cptr kp0=shm3+LDS_K+hi*1024+r32*16; const lds_cptr vp0=shm3+LDS_V+((lane>>4)&1)*32+(lane&3)*8+(4*hi+((lane&15)>>2))*64;
  const int NT=(q0+QB)/KVBLK;
  typedef __attribute__((address_space(3))) float lds_f32; typedef float kb4_t __attribute__((ext_vector_type(4)));
  { lds_f32*kw=(lds_f32*)(shm3+LDS_KB); float kv_[9];
    _Pragma("unroll") for(int j=0;j<9;++j){const int i=tid+j*NW*64; kv_[j]=(i<NT*KVBLK)?kbg[i]:0.f;}
    _Pragma("unroll") for(int j=0;j<9;++j){const int i=tid+j*NW*64; if(i<NT*KVBLK)kw[i]=kv_[j];} }
  const __attribute__((address_space(3))) kb4_t*kbl=(const __attribute__((address_space(3))) kb4_t*)(shm3+LDS_KB)+hi;
  #define KBLOAD(P0,P1,t) do{ const __attribute__((address_space(3))) kb4_t*kb_=kbl+16*(NT-1-(t)); \
    _Pragma("unroll") for(int g_=0;g_<4;++g_){ const kb4_t a_=kb_[2*g_], b_=kb_[2*g_+8]; \
      P0[4*g_]=a_[0];P0[4*g_+1]=a_[1];P0[4*g_+2]=a_[2];P0[4*g_+3]=a_[3]; P1[4*g_]=b_[0];P1[4*g_+1]=b_[1];P1[4*g_+2]=b_[2];P1[4*g_+3]=b_[3]; } }while(0)
  DMA_K(0,0);DMA_V(0,0);DMA_K(1,SLOTB);
  bf16x8 qr[4];
  #pragma unroll
  for(int d0=0;d0<4;++d0)qr[d0]=*reinterpret_cast<const bf16x8*>(&Qw[(long)r32*DM+d0*16+hi*8]);
  float mhat=0.f,l_reg=0.f;f32x16 o[2];o[0]=f32x16{};o[1]=f32x16{};
  const int qrel=wid*QBLK+r32;
  #define CMASK(P0,P1,t) do{ if((t)<4)cmask(P0,P1,3-(t),qrel,hi); }while(0)
  bool resc=false;
  #define START(P0,P1) do{ const float rm=rowmax(P0,P1); resc=false; \
    { const float dl=(rm==-INFINITY)?-1.0e4f:rm; mhat=fadd_s(mhat,dl); \
      _Pragma("unroll") for(int r=0;r<16;++r){P0[r]=fsub_s(P0[r],dl);P1[r]=fsub_s(P1[r],dl);} } \
    _Pragma("unroll") for(int r=0;r<16;++r)P0[r]=__builtin_amdgcn_exp2f(P0[r]); }while(0)
  #define RESC() do{ if(resc){ asm volatile("s_waitcnt lgkmcnt(0)":::"memory"); \
      _Pragma("unroll") for(int d_=0;d_<2;++d_) _Pragma("unroll") for(int r=0;r<16;++r)o[d_][r]*=wsf[crow(r,hi)]; } }while(0)
  f32x16 pA0,pA1,pB0,pB1;
  int sl_prev=0,sl_cur=0,sl_next=SLOTB;
  #define ROT() do{sl_prev=sl_cur;sl_cur=sl_next;sl_next=(sl_next==(NSLOT-1)*SLOTB)?0:sl_next+SLOTB;}while(0)
  DMA_K(2,2*SLOTB);
  WAIT_BAR(3);
  KBLOAD(pA0,pA1,0);
  qkt(pA0,pA1,Kbase,qr,r32,hi);asm volatile("s_nop 15\n\ts_nop 7":"+v"(pA0),"+v"(pA1));CMASK(pA0,pA1,0);
  START(pA0,pA1);
  _Pragma("unroll") for(int r=0;r<16;++r)pA1[r]=__builtin_amdgcn_exp2f(pA1[r]);
  KBLOAD(pB0,pB1,1);
  _Pragma("unroll") for(int r=0;r<16;++r){pB0[r]-=mhat;pB1[r]-=mhat;}
  WAIT_BAR(0);
  DMA_K(3,0);DMA_V(1,SLOTB);
  ROT();
  kload8(kf,kp0+sl_cur);
  WAIT_BAR(2);
  s16x4 vlo[8],vhi[8]; u32x4 pw0,pw1,pw2,pw3;
  #define PKW(P,B) cvtpk_s(P[B],P[B+1])
  #define PAF(k) __builtin_bit_cast(bf16x8,pw##k)
  #define VFR(i) (bf16x8){vlo[i][0],vlo[i][1],vlo[i][2],vlo[i][3],vhi[i][0],vhi[i][1],vhi[i][2],vhi[i][3]}
  #define PIN(x) asm volatile("":"+v"(x))
  #define MX3(a,b,c) __builtin_fmaxf(__builtin_fmaxf((a),(b)),(c))
  #define GAPA(MF,A0,A1,A2,A3,W0,W1,PW) do{ MF; sacc+=A0; sacc+=A1; sacc+=A2; sacc+=A3; PIN(sacc); W0; W1; PIN(PW); SBAR(); }while(0)
  #define EX(v) __builtin_amdgcn_exp2f(v)
  #define GAPB(MF,X,B,Y) do{ MF; X[B]=EX(X[B]); X[B+1]=EX(X[B+1]); X[B+2]=EX(X[B+2]); X[B+3]=EX(X[B+3]); PIN(X); Y[B]-=mhat; Y[B+1]-=mhat; Y[B+2]-=mhat; Y[B+3]-=mhat; SBAR(); }while(0)
  #define VRD(i) do{ vlo[i]=vtr(vp_+(((i)>>2)*4096+((i)&3)*1024)); vhi[i]=vtr(vp_+(((i)>>2)*4096+((i)&3)*1024+512)); }while(0)
  #define KRD(G,j) do{ if(G){ kload2(kf,kp0+sl_next,j); SBAR(); } }while(0)
  #define STEP(C0,C1,P0,P1,t,GK,GV,GL) do{ SBAR(); \
    const lds_cptr vp_=vp0+sl_prev; \
    VRD(0); SBAR(); float sacc=(P0[0]+P0[1]); \
    GAPA(C0=__builtin_amdgcn_mfma_f32_32x32x16_bf16(kf[0],qr[0],C0,0,0,0), P0[2],P0[3],P0[4],P0[5],     pw0[0]=PKW(P0,0), pw0[1]=PKW(P0,2), pw0); \
    VRD(4); SBAR(); GAPA(C1=__builtin_amdgcn_mfma_f32_32x32x16_bf16(kf[1],qr[0],C1,0,0,0), P0[6],P0[7],P0[8],P0[9],     pw0[2]=PKW(P0,4), pw0[3]=PKW(P0,6), pw0); \
    VRD(1); SBAR(); GAPA(C0=__builtin_amdgcn_mfma_f32_32x32x16_bf16(kf[2],qr[1],C0,0,0,0),   P0[10],P0[11],P0[12],P0[13], pw1[0]=PKW(P0,8), pw1[1]=PKW(P0,10), pw1); \
    VRD(5); SBAR(); GAPA(C1=__builtin_amdgcn_mfma_f32_32x32x16_bf16(kf[3],qr[1],C1,0,0,0),   P0[14],P0[15],P1[0],P1[1],   pw1[2]=PKW(P0,12),pw1[3]=PKW(P0,14), pw1); \
    VRD(2); SBAR(); GAPA(C0=__builtin_amdgcn_mfma_f32_32x32x16_bf16(kf[4],qr[2],C0,0,0,0),   P1[2],P1[3],P1[4],P1[5],     pw2[0]=PKW(P1,0), pw2[1]=PKW(P1,2), pw2); \
    VRD(6); SBAR(); GAPA(C1=__builtin_amdgcn_mfma_f32_32x32x16_bf16(kf[5],qr[2],C1,0,0,0),   P1[6],P1[7],P1[8],P1[9],     pw2[2]=PKW(P1,4), pw2[3]=PKW(P1,6), pw2); \
    VRD(3); SBAR(); GAPA(C0=__builtin_amdgcn_mfma_f32_32x32x16_bf16(kf[6],qr[3],C0,0,0,0),   P1[10],P1[11],P1[12],P1[13], pw3[0]=PKW(P1,8), pw3[1]=PKW(P1,10), pw3); \
    VRD(7); SBAR(); GAPA(C1=__builtin_amdgcn_mfma_f32_32x32x16_bf16(kf[7],qr[3],C1,0,0,0),   P1[14],P1[15],0.f,0.f,       pw3[2]=PKW(P1,12),pw3[3]=PKW(P1,14), pw3); \
    l_reg+=sacc; \
    KBLOAD(P0,P1,(t)+1); \
    if(GK){DMA_K((t)+3,sl_cur);} if(GV){DMA_V((t)+1,sl_next);} \
    CMASK(C0,C1,t); \
    { float a=MX3(C0[0],C0[1],C1[0]),b=MX3(C0[2],C0[3],C1[1]); a=MX3(a,C1[2],C1[3]); \
      _Pragma("unroll") for(int r=4;r<16;r+=4){a=MX3(a,C0[r],C0[r+1]);b=MX3(b,C0[r+2],C0[r+3]);a=MX3(a,C1[r],C1[r+1]);b=MX3(b,C1[r+2],C1[r+3]);} \
      float rm=__builtin_fmaxf(a,b); { auto rr=__builtin_amdgcn_permlane32_swap(__float_as_uint(rm),__float_as_uint(rm),false,false); rm=__builtin_fmaxf(__uint_as_float(rr[0]),__uint_as_float(rr[1])); } \
      resc=false; \
      if(__builtin_expect(__any(rm>(float)THRL),0)){ const float dl=__builtin_fmaxf(rm,0.f); mhat+=dl; \
        _Pragma("unroll") for(int r=0;r<16;++r){C0[r]-=dl;C1[r]-=dl;} \
        const float f=__builtin_amdgcn_exp2f(-dl); l_reg*=f; if(hi==0)wsf[r32]=f; resc=true; } } \
    SBAR(); \
    GAPB(o[0]=__builtin_amdgcn_mfma_f32_32x32x16_bf16(PAF(0),VFR(0),o[0],0,0,0), C0,0,P0); \
    GAPB(o[1]=__builtin_amdgcn_mfma_f32_32x32x16_bf16(PAF(0),VFR(4),o[1],0,0,0), C0,4,P0); \
    KRD(GL,0); GAPB(o[0]=__builtin_amdgcn_mfma_f32_32x32x16_bf16(PAF(1),VFR(1),o[0],0,0,0), C0,8,P0); \
    KRD(GL,1); GAPB(o[1]=__builtin_amdgcn_mfma_f32_32x32x16_bf16(PAF(1),VFR(5),o[1],0,0,0), C0,12,P0); \
    KRD(GL,2); GAPB(o[0]=__builtin_amdgcn_mfma_f32_32x32x16_bf16(PAF(2),VFR(2),o[0],0,0,0), C1,0,P1); \
    KRD(GL,3); GAPB(o[1]=__builtin_amdgcn_mfma_f32_32x32x16_bf16(PAF(2),VFR(6),o[1],0,0,0), C1,4,P1); \
    GAPB(o[0]=__builtin_amdgcn_mfma_f32_32x32x16_bf16(PAF(3),VFR(3),o[0],0,0,0), C1,8,P1); \
    GAPB(o[1]=__builtin_amdgcn_mfma_f32_32x32x16_bf16(PAF(3),VFR(7),o[1],0,0,0), C1,12,P1); \
    }while(0)
  int t=1;
  #undef CMASK
  #define CMASK(P0,P1,t) do{ if((t)<4)cmask(P0,P1,3-(t),qrel,hi); }while(0)
  for(;t+5<NT;t+=2){
    STEP(pB0,pB1,pA0,pA1,t,true,true,true);     WAIT_BAR(2); RESC(); ROT();
    STEP(pA0,pA1,pB0,pB1,t+1,true,true,true);   WAIT_BAR(2); RESC(); ROT();
  }
  #undef CMASK
  #define CMASK(P0,P1,t) do{ if((t)<4)cmask(P0,P1,3-(t),qrel,hi); }while(0)
  #define ENDW(tt) do{ if((tt)+3<NT){WAIT_BAR(2);} else if((tt)+2<NT){WAIT_BAR(1);} else {WAIT_BAR(0);} }while(0)
  for(;t+1<NT;t+=2){
    STEP(pB0,pB1,pA0,pA1,t,(t+3<NT),(t+1<NT),(t+1<NT));       ENDW(t);   RESC(); ROT();
    STEP(pA0,pA1,pB0,pB1,t+1,(t+4<NT),(t+2<NT),(t+2<NT));     ENDW(t+1); RESC(); ROT();
  }
  STEP(pB0,pB1,pA0,pA1,NT-1,false,false,false); RESC();
  { float sacc=pB0[0]+pB0[1]; _Pragma("unroll") for(int r=2;r<16;++r)sacc+=pB0[r]; _Pragma("unroll") for(int r=0;r<16;++r)sacc+=pB1[r]; l_reg+=sacc;
    pw0=(u32x4){PKW(pB0,0),PKW(pB0,2),PKW(pB0,4),PKW(pB0,6)};pw1=(u32x4){PKW(pB0,8),PKW(pB0,10),PKW(pB0,12),PKW(pB0,14)};pw2=(u32x4){PKW(pB1,0),PKW(pB1,2),PKW(pB1,4),PKW(pB1,6)};pw3=(u32x4){PKW(pB1,8),PKW(pB1,10),PKW(pB1,12),PKW(pB1,14)};
    SBAR(); pv(o,vb0+sl_cur,PAF(0),PAF(1),PAF(2),PAF(3)); }
  #undef PKW
  #undef PAF
  #undef VFR
  #undef PIN
  #undef MX3
  #undef GAPA
  #undef GAPB
  #undef EX
  #undef VRD
  #undef KRD
  #undef STEP
  #undef ENDW
  {auto rr=__builtin_amdgcn_permlane32_swap(__float_as_uint(l_reg),__float_as_uint(l_reg),false,false);l_reg=__uint_as_float(rr[0])+__uint_as_float(rr[1]);}
  if(hi==0)wsf[32+r32]=l_reg;asm volatile("s_waitcnt lgkmcnt(0)":::"memory");
  float rli[16];
  #pragma unroll
  for(int r=0;r<16;++r){const float l_=wsf[32+crow(r,hi)]; rli[r]=l_>0.f?__builtin_amdgcn_rcpf(l_):0.f;}
  bf16*Ow=O+(rowbase+q0+wid*QBLK)*OP+h*D;
  { bf16*stg=(bf16*)(shm+LDS_OST)+wid*2048;
    #pragma unroll
    for(int r=0;r<16;++r){const int orow=crow(r,hi);
      #pragma unroll
      for(int d0=0;d0<2;++d0)stg[orow*64+d0*32+r32]=__float2bfloat16(o[d0][r]*rli[r]);}
    asm volatile("s_waitcnt lgkmcnt(0)":::"memory");
    #pragma unroll
    for(int i=0;i<4;++i){const int row=i*8+(lane>>3),ch=lane&7; const u32x4 v=*(const u32x4*)(stg+row*64+ch*8); if(q0+wid*QBLK+row<SEQ)ATTN_STORE16(Ow+(long)row*OP+ch*8,v);} }
  asm volatile("s_waitcnt lgkmcnt(0)\n\ts_barrier":::"memory");
  #undef KBLOAD
  #undef DMA_K
  #undef DMA_V
  #undef CMASK
  #undef START
  #undef RESC
  #undef ROT
}
constexpr int ATTN_LDS_BYTES=LDS_BYTES;
#undef SBAR
#undef WAIT_BAR
}

__device__ __forceinline__ void mix_queue(const Ctx& c, unsigned char* lds_generic, int layer, const bf16_t* SD, unsigned* qctr);

namespace hg {
constexpr int P = 272, PA = 144;
constexpr int O_QE = 0, O_QS = 17408, O_KS = 34816, O_VT = 52224, O_ST = 69632, O_AM = 104448, O_QT = 113664, O_RS = 115712, O_END = 117760;
typedef short v4i16_t __attribute__((ext_vector_type(4)));
__device__ __forceinline__ f32x4 mfma16(bf16x8 a, bf16x8 b, f32x4 c) { return __builtin_amdgcn_mfma_f32_16x16x32_bf16(a, b, c, 0, 0, 0); }
__device__ __forceinline__ bf16x8 tr_frag(const LAS unsigned char* p, int pitch) {
    const v4i16_t lo = __builtin_amdgcn_ds_read_tr16_b64_v4i16((LAS v4i16_t*)p);
    const v4i16_t hi = __builtin_amdgcn_ds_read_tr16_b64_v4i16((LAS v4i16_t*)(p + 4 * pitch));
    return (bf16x8){lo[0], lo[1], lo[2], lo[3], hi[0], hi[1], hi[2], hi[3]};
}
}

struct ARegs { float g[16]; u32x4 vv[2]; };
__device__ __forceinline__ void hgrn_A_load(const Ctx& c, int tid, int bh, int ch, ARegs& R) {
    const int b = bh >> 2, hh = bh & 3; const size_t r0 = (size_t)b * LV + 64 * ch;
    const int k = tid & 127, sq = tid >> 7;
    const float* gp = c.LOGF + (r0 + 16 * sq) * 512 + hh * 128 + k;
#pragma unroll
    for (int i = 0; i < 16; ++i) R.g[i] = gp[(size_t)i * 512];
#pragma unroll
    for (int i = 0; i < 2; ++i) { const int id = tid + 512 * i, row = id >> 4, cc = id & 15; R.vv[i] = *(const u32x4*)(c.HV + (r0 + row) * 512 + hh * 128 + cc * 8); }
}
__device__ __forceinline__ void hgrn_A_compute(const Ctx& c, LAS unsigned char* lds, int tid, int bh, int ch, bf16_t* SD, float* DV, const ARegs& R) {
    using namespace hg;
    const int lane = tid & 63, w = __builtin_amdgcn_readfirstlane(tid >> 6);
    const int k = tid & 127, sq = tid >> 7;
    float bl[16];
    { float s = 0.f;
#pragma unroll
      for (int i = 0; i < 16; ++i) { s += R.g[i]; bl[i] = s; }
      ((LAS float*)(lds + O_QT))[sq * 128 + k] = s; }
#pragma unroll
    for (int i = 0; i < 2; ++i) { const int id = tid + 512 * i, row = id >> 4, cc = id & 15; *(LAS u32x4*)(lds + O_VT + row * P + cc * 16) = R.vv[i]; }
    asm volatile("s_waitcnt lgkmcnt(0)\n\ts_barrier" ::: "memory");
    { const LAS float* qt = (const LAS float*)(lds + O_QT); float pre = 0.f, tot = 0.f;
#pragma unroll
      for (int q = 0; q < 4; ++q) { const float t = qt[q * 128 + k]; tot += t; if (q < sq) pre += t; }
#pragma unroll
      for (int i = 0; i < 16; ++i) { const float kd = (1.f - __expf(R.g[i])) * __expf(tot - (pre + bl[i])); *(LAS bf16_t*)(lds + O_KS + (16 * sq + i) * P + 2 * k) = (bf16_t)f2bf(kd); }
      if (sq == 0) DV[((size_t)bh * 64 + ch) * 128 + k] = __expf(tot); }
    asm volatile("s_waitcnt lgkmcnt(0)\n\ts_barrier" ::: "memory");
    const int fr = lane & 15, g4 = lane >> 4, q = fr >> 2, p = lane & 3;
    const LAS unsigned char* abase = lds + O_VT + (8 * g4 + q) * P + w * 32 + p * 8;
    const LAS unsigned char* bbase = lds + O_KS + (8 * g4 + q) * P + p * 8;
    bf16x8 a[2]; a[0] = tr_frag(abase, P); a[1] = tr_frag(abase + 32 * P, P);
    bf16_t* od = SD + ((size_t)bh * 64 + ch) * 16384 + (size_t)(16 * w + 4 * g4) * 128 + fr;
#pragma unroll
    for (int ct = 0; ct < 8; ++ct) { f32x4 acc = (f32x4){0.f, 0.f, 0.f, 0.f};
        acc = mfma16(a[0], tr_frag(bbase + ct * 32, P), acc); acc = mfma16(a[1], tr_frag(bbase + 32 * P + ct * 32, P), acc);
#pragma unroll
        for (int j = 0; j < 4; ++j) od[j * 128 + 16 * ct] = (bf16_t)f2bf(acc[j]); }
    asm volatile("s_waitcnt lgkmcnt(0)\n\ts_barrier" ::: "memory");
}
__device__ __forceinline__ void hgrn_A_phase(const Ctx& c, LAS unsigned char* lds, bf16_t* SD, float* DV) {
    int tid_ = threadIdx.x; asm volatile("" : "+v"(tid_)); const int tid = tid_;
    ARegs R;
    int u = blockIdx.x;
    if (u < 16 * 64) hgrn_A_load(c, tid, u >> 6, u & 63, R);
    for (; u < 16 * 64; u += gridDim.x) {
        const ARegs Rc = R;
        const int un = u + gridDim.x;
        if (un < 16 * 64) hgrn_A_load(c, tid, un >> 6, un & 63, R);
        hgrn_A_compute(c, lds, tid, u >> 6, u & 63, SD, DV, Rc);
    }
    __syncthreads();
}

__device__ __forceinline__ void hgrn_B_scan(const Ctx& c, bf16_t* SD, const float* DV) {
    const int gt = blockIdx.x * NTHREADS + c.tid, NGT = gridDim.x * NTHREADS;
    for (int pidx = gt; pidx < 16 * 8192; pidx += NGT) {
        const int bh = pidx >> 13, e2 = pidx & 8191, k = (e2 & 63) * 2;
        unsigned* sp = (unsigned*)(SD + (size_t)bh * 64 * 16384 + 2 * e2);
        const float* dp = DV + (size_t)bh * 64 * 128 + k;
        float s0 = 0.f, s1 = 0.f;
        for (int c0 = 0; c0 < 64; c0 += 16) {
            unsigned d[16]; float dv0[16], dv1[16];
#pragma unroll
            for (int i = 0; i < 16; ++i) { d[i] = sp[(size_t)(c0 + i) * 8192]; const float* q = dp + (c0 + i) * 128; dv0[i] = q[0]; dv1[i] = q[1]; }
#pragma unroll
            for (int i = 0; i < 16; ++i) { s0 = dv0[i] * s0 + __builtin_bit_cast(float, d[i] << 16); s1 = dv1[i] * s1 + __builtin_bit_cast(float, d[i] & 0xffff0000u);
                sp[(size_t)(c0 + i) * 8192] = pk2(s0, s1); }
        }
    }
}

struct CRegs { float g[16]; unsigned short q[16]; unsigned short gt[16]; u32x4 vv[2]; u32x4 st[4]; };
#define LBAR() asm volatile("s_waitcnt lgkmcnt(0)\n\ts_barrier" ::: "memory")
__device__ __forceinline__ void hgrn_C_load(const Ctx& c, int tid, int bh, int ch, const bf16_t* SD, CRegs& R) {
    const int lane = tid & 63, w = __builtin_amdgcn_readfirstlane(tid >> 6);
    const int b = bh >> 2, hh = bh & 3; const size_t r0 = (size_t)b * LV + 64 * ch;
    const int k = tid & 127, sq = tid >> 7, fr = lane & 15, g4 = lane >> 4;
    const float* gp = c.LOGF + (r0 + 16 * sq) * 512 + hh * 128 + k; const bf16_t* qp = c.HXQ + (r0 + 16 * sq) * 512 + hh * 128 + k;
#pragma unroll
    for (int i = 0; i < 16; ++i) { R.g[i] = gp[(size_t)i * 512]; R.q[i] = qp[(size_t)i * 512]; }
#pragma unroll
    for (int i = 0; i < 2; ++i) { const int id = tid + 512 * i, row = id >> 4, cc = id & 15; R.vv[i] = *(const u32x4*)(c.HV + (r0 + row) * 512 + hh * 128 + cc * 8); }
    if (ch > 0) { const bf16_t* sp = SD + ((size_t)bh * 64 + ch - 1) * 16384;
#pragma unroll
        for (int i = 0; i < 4; ++i) { const int id = tid + 512 * i, row = id >> 4, cc = id & 15; R.st[i] = *(const u32x4*)(sp + row * 128 + cc * 8); } }
#pragma unroll
    for (int tt = 0; tt < 4; ++tt)
#pragma unroll
        for (int j = 0; j < 4; ++j) R.gt[tt * 4 + j] = c.HG[(r0 + 16 * tt + 4 * g4 + j) * 512 + hh * 128 + 16 * w + fr];
}
__device__ __forceinline__ void hgrn_C_compute(const Ctx& c, LAS unsigned char* lds, int tid, int layer, int bh, int ch, const CRegs& R) {
    using namespace hg;
    const int lane = tid & 63, w = __builtin_amdgcn_readfirstlane(tid >> 6);
    const int b = bh >> 2, hh = bh & 3; const size_t r0 = (size_t)b * LV + 64 * ch;
    const int k = tid & 127, sq = tid >> 7;
    float bl[16];
    { float s = 0.f;
#pragma unroll
      for (int i = 0; i < 16; ++i) { s += R.g[i]; bl[i] = s; }
      ((LAS float*)(lds + O_QT))[sq * 128 + k] = s; }
#pragma unroll
    for (int i = 0; i < 2; ++i) { const int id = tid + 512 * i, row = id >> 4, cc = id & 15; *(LAS u32x4*)(lds + O_VT + row * P + cc * 16) = R.vv[i]; }
    if (ch > 0) {
#pragma unroll
        for (int i = 0; i < 4; ++i) { const int id = tid + 512 * i, row = id >> 4, cc = id & 15; *(LAS u32x4*)(lds + O_ST + row * P + cc * 16) = R.st[i]; }
    }
    LBAR();
    { const LAS float* qt = (const LAS float*)(lds + O_QT); float pre = 0.f;
#pragma unroll
      for (int q = 0; q < 4; ++q) { const float t = qt[q * 128 + k]; if (q < sq) pre += t; }
      const float rr = qt[k] + qt[128 + k];
#pragma unroll
      for (int i = 0; i < 16; ++i) { const float bb = pre + bl[i]; const int off = (16 * sq + i) * P + 2 * k; const float qv = bf2f(R.q[i]);
          *(LAS bf16_t*)(lds + O_QE + off) = (bf16_t)f2bf(qv * __expf(bb));
          *(LAS bf16_t*)(lds + O_QS + off) = (bf16_t)f2bf(qv * __expf(fminf(bb - rr, 80.f)));
          *(LAS bf16_t*)(lds + O_KS + off) = (bf16_t)f2bf((1.f - __expf(R.g[i])) * __expf(fminf(rr - bb, 80.f))); } }
    LBAR();
    const int fr = lane & 15, g4 = lane >> 4, q = fr >> 2, p = lane & 3;
#pragma unroll
    for (int tl = 0; tl < 2; ++tl) { const int tile = 2 * w + tl, ti = tile >> 2, sj = tile & 3;
        f32x4 acc = (f32x4){0.f, 0.f, 0.f, 0.f};
        if (sj <= ti) {
#pragma unroll
            for (int ks = 0; ks < 4; ++ks) { const bf16x8 a = *(const LAS bf16x8*)(lds + O_QS + (16 * ti + fr) * P + (32 * ks + 8 * g4) * 2);
                const bf16x8 bb = *(const LAS bf16x8*)(lds + O_KS + (16 * sj + fr) * P + (32 * ks + 8 * g4) * 2); acc = mfma16(a, bb, acc); } }
#pragma unroll
        for (int j = 0; j < 4; ++j) { const int t = 16 * ti + 4 * g4 + j, s = 16 * sj + fr; const float v = (s <= t) ? acc[j] : 0.f; *(LAS bf16_t*)(lds + O_AM + t * PA + 2 * s) = (bf16_t)f2bf(v); } }
    LBAR();
    f32x4 acc[4];
#pragma unroll
    for (int tt = 0; tt < 4; ++tt) acc[tt] = (f32x4){0.f, 0.f, 0.f, 0.f};
    if (ch > 0) {
#pragma unroll
        for (int ks = 0; ks < 4; ++ks) { const bf16x8 bfr = *(const LAS bf16x8*)(lds + O_ST + (16 * w + fr) * P + (32 * ks + 8 * g4) * 2);
#pragma unroll
            for (int tt = 0; tt < 4; ++tt) { const bf16x8 a = *(const LAS bf16x8*)(lds + O_QE + (16 * tt + fr) * P + (32 * ks + 8 * g4) * 2); acc[tt] = mfma16(a, bfr, acc[tt]); } }
    }
#pragma unroll
    for (int ks = 0; ks < 2; ++ks) { const bf16x8 bfr = tr_frag(lds + O_VT + (32 * ks + 8 * g4 + q) * P + w * 32 + p * 8, P);
#pragma unroll
        for (int tt = 0; tt < 4; ++tt) { const bf16x8 a = *(const LAS bf16x8*)(lds + O_AM + (16 * tt + fr) * PA + (32 * ks + 8 * g4) * 2); acc[tt] = mfma16(a, bfr, acc[tt]); } }
    LAS float* rs = (LAS float*)(lds + O_RS);
#pragma unroll
    for (int tt = 0; tt < 4; ++tt)
#pragma unroll
        for (int j = 0; j < 4; ++j) { float s2 = acc[tt][j] * acc[tt][j]; s2 += __shfl_xor(s2, 1); s2 += __shfl_xor(s2, 2); s2 += __shfl_xor(s2, 4); s2 += __shfl_xor(s2, 8);
            if (fr == 0) rs[(16 * tt + 4 * g4 + j) * 8 + w] = s2; }
    LBAR();
    { const int v = 16 * w + fr; const float nw = c.hnw[layer * 128 + v];
#pragma unroll
      for (int tt = 0; tt < 4; ++tt)
#pragma unroll
        for (int j = 0; j < 4; ++j) { const int t = 16 * tt + 4 * g4 + j; const f32x4 s0 = *(const LAS f32x4*)(rs + t * 8), s1 = *(const LAS f32x4*)(rs + t * 8 + 4);
            const float ss = ((s0[0] + s0[1]) + (s0[2] + s0[3])) + ((s1[0] + s1[1]) + (s1[2] + s1[3])); const float rstd = 1.f / sqrtf(ss * (1.f / 128.f) + EPS);
            c.MIX[(r0 + t) * DM + 512 + hh * 128 + v] = (bf16_t)f2bf(acc[tt][j] * rstd * nw * bf2f(R.gt[tt * 4 + j])); } }
    LBAR();
}
__device__ __forceinline__ void hgrn_C_phase(const Ctx& c, LAS unsigned char* lds, int layer, const bf16_t* SD) {
    int tid_ = threadIdx.x; asm volatile("" : "+v"(tid_)); const int tid = tid_;
    CRegs R;
    int u = blockIdx.x;
    if (u < 16 * 65) hgrn_C_load(c, tid, u / 65, u % 65, SD, R);
    for (; u < 16 * 65; u += gridDim.x) {
        const CRegs Rc = R;
        const int un = u + gridDim.x;
        if (un < 16 * 65) hgrn_C_load(c, tid, un / 65, un % 65, SD, R);
        hgrn_C_compute(c, lds, tid, layer, u / 65, u % 65, Rc);
    }
    __syncthreads();
}

__device__ __forceinline__ void mix_queue(const Ctx& c, unsigned char* lds_generic, int layer, const bf16_t* SD, unsigned* qctr) {
    LAS volatile int* slot = (LAS volatile int*)((LAS unsigned char*)lds_generic + 131072);
    for (;;) {
        if (c.tid == 0) slot[0] = (int)atomicAdd(qctr, 1u);
        __syncthreads();
        const int n = slot[0];
        if (n >= 17 * 32) break;
        const int qb = 16 - (n >> 5), bh = n & 31;
        attn_body::attn_unit<8>(bh >> 3, bh & 7, qb, (const attn_body::bf16*)c.QB, (const attn_body::bf16*)c.KB, (const attn_body::bf16*)c.VB, (attn_body::bf16*)c.MIX,
                                c.kbias + (size_t)bh * KBL, (char*)lds_generic);
    }
}

__device__ __forceinline__ void fox_simple(const Ctx& c, LAS unsigned char* lds, int first_block) {
    LAS float* sc = (LAS float*)(lds + c.wave * 16896);
    LAS float* qs = sc; LAS float* ps = sc + 64;
    const int nblk = gridDim.x - first_block; if ((int)blockIdx.x < first_block) return;
    const int gw = ((int)blockIdx.x - first_block) * NWAVES + c.wave, NGW = nblk * NWAVES;
    for (int it = gw; it < MROWS * FOXH; it += NGW) {
        const int r = it >> 3, h = it & 7, b = r / LV, vp = r - b * LV;
        bf16_t* op = c.MIX + (size_t)r * DM + h * 64;
        if (vp < PADF) { op[c.lane] = 0; continue; }
        qs[c.lane] = bf2f(c.QB[(size_t)r * 512 + h * 64 + c.lane]);
        asm volatile("s_waitcnt lgkmcnt(0)" ::: "memory");
        const float* kb = c.kbias + (size_t)(b * 8 + h) * KBL;
        float mx = -3.0e38f;
        for (int j = PADF + c.lane; j <= vp; j += 64) {
            const bf16_t* kr = c.KB + (size_t)(b * LV + j) * 512 + h * 64; float s = 0.f;
#pragma unroll
            for (int d8 = 0; d8 < 8; ++d8) { const bf16x8 kv = *(const bf16x8*)(kr + d8 * 8);
#pragma unroll
                for (int e = 0; e < 8; ++e) s += qs[d8 * 8 + e] * bf2f((unsigned short)kv[e]); }
            s += kb[j]; ps[j] = s; mx = fmaxf(mx, s);
        }
        mx = wave_max(mx);
        float l = 0.f;
        for (int j = PADF + c.lane; j <= vp; j += 64) { const float p = exp2f(ps[j] - mx); ps[j] = p; l += p; }
        l = wave_sum(l);
        asm volatile("s_waitcnt lgkmcnt(0)" ::: "memory");
        float o = 0.f;
        const bf16_t* vr = c.VB + (size_t)(b * LV) * 512 + h * 64 + c.lane;
        for (int j = PADF; j <= vp; ++j) o += ps[j] * bf2f(vr[(size_t)j * 512]);
        op[c.lane] = (bf16_t)f2bf(o / l);
        asm volatile("s_waitcnt lgkmcnt(0)" ::: "memory");
    }
}

__device__ __forceinline__ void hgrn_simple(const Ctx& c, LAS unsigned char* lds, int layer) {
    if (blockIdx.x >= NB * HGH) return;
    const int b = blockIdx.x >> 2, hh = blockIdx.x & 3;
    LAS float* fL = (LAS float*)lds;
    LAS float* kL = fL + 2048; LAS float* qL = kL + 2048; LAS float* vL = qL + 2048; LAS float* oP = vL + 2048;
    const int v = c.tid & 127, kg = c.tid >> 7;
    float S[32];
#pragma unroll
    for (int i = 0; i < 32; ++i) S[i] = 0.f;
    for (int i = c.tid; i < PADF * 128; i += NTHREADS) { const int vp = i >> 7; c.MIX[(size_t)(b * LV + vp) * DM + 512 + hh * 128 + (i & 127)] = 0; }
    for (int t0 = PADF; t0 < LV; t0 += 16) {
        for (int i = c.tid; i < 2048; i += NTHREADS) { const int t = i >> 7, k = i & 127; const size_t o = (size_t)(b * LV + t0 + t) * 512 + hh * 128 + k;
            const float f = __expf(c.LOGF[o]); fL[i] = f; kL[i] = 1.f - f; qL[i] = bf2f(c.HXQ[o]); vL[i] = bf2f(c.HV[o]); }
        __syncthreads();
        for (int t = 0; t < 16; ++t) { const float vv = vL[t * 128 + v]; float part = 0.f;
#pragma unroll
            for (int i = 0; i < 32; ++i) { const int k = kg * 32 + i; S[i] = fL[t * 128 + k] * S[i] + kL[t * 128 + k] * vv; part += S[i] * qL[t * 128 + k]; }
            oP[(kg * 16 + t) * 128 + v] = part; }
        __syncthreads();
        for (int tt = 0; tt < 2; ++tt) { const int t = c.wave * 2 + tt; float o0, o1;
            { const int v0 = c.lane, v1 = c.lane + 64; o0 = oP[t * 128 + v0] + oP[(16 + t) * 128 + v0] + oP[(32 + t) * 128 + v0] + oP[(48 + t) * 128 + v0];
              o1 = oP[t * 128 + v1] + oP[(16 + t) * 128 + v1] + oP[(32 + t) * 128 + v1] + oP[(48 + t) * 128 + v1]; }
            const float ss = wave_sum(o0 * o0 + o1 * o1); const float rstd = 1.f / sqrtf(ss * (1.f / 128.f) + EPS);
            const size_t ro = (size_t)(b * LV + t0 + t);
            const float g0 = bf2f(c.HG[ro * 512 + hh * 128 + c.lane]), g1 = bf2f(c.HG[ro * 512 + hh * 128 + c.lane + 64]);
            c.MIX[ro * DM + 512 + hh * 128 + c.lane] = (bf16_t)f2bf(o0 * rstd * c.hnw[layer * 128 + c.lane] * g0);
            c.MIX[ro * DM + 512 + hh * 128 + c.lane + 64] = (bf16_t)f2bf(o1 * rstd * c.hnw[layer * 128 + c.lane + 64] * g1); }
        __syncthreads();
    }
}

__device__ __forceinline__ void final_norm(const Ctx& c) {
    f32x4 w[4];
#pragma unroll
    for (int j = 0; j < 4; ++j) w[j] = *(const f32x4*)(c.nfinal + 4 * c.lane + 256 * j);
    for (int rb = c.gw; rb < NB * SEQ; rb += 4 * c.NGW) {
        f32x4 v[4][4];
#pragma unroll
        for (int q = 0; q < 4; ++q) { const int r = rb + q * c.NGW;
            if (r < NB * SEQ) {
#pragma unroll
                for (int j = 0; j < 4; ++j) v[q][j] = *(const f32x4*)(c.out + (size_t)r * DM + 4 * c.lane + 256 * j); } }
#pragma unroll
        for (int q = 0; q < 4; ++q) { const int r = rb + q * c.NGW;
            if (r < NB * SEQ) { float s = 0.f;
#pragma unroll
                for (int j = 0; j < 4; ++j) s += (v[q][j].x * v[q][j].x + v[q][j].y * v[q][j].y) + (v[q][j].z * v[q][j].z + v[q][j].w * v[q][j].w);
                s = wave_sum(s); const float rstd = 1.f / sqrtf(s * (1.f / DM) + EPS);
#pragma unroll
                for (int j = 0; j < 4; ++j) *(f32x4*)(c.out + (size_t)r * DM + 4 * c.lane + 256 * j) = v[q][j] * rstd * w[j]; } }
    }
}

__global__ void __launch_bounds__(NTHREADS, 2) fwd_kernel(Args a) {
    extern __shared__ __attribute__((aligned(16))) unsigned char lds_raw[];
    LAS unsigned char* lds = (LAS unsigned char*)lds_raw;
    cg::grid_group grid = cg::this_grid();
    Ctx c;
    c.x = a.in[0]; c.meta = a.in[1]; c.nmw = a.in[2]; c.win = a.in[3]; c.fbias = a.in[4]; c.lbraw = a.in[5]; c.hnw = a.in[6]; c.wout = a.in[7];
    c.nfw = a.in[8]; c.wg = a.in[9]; c.wu = a.in[10]; c.wd = a.in[11]; c.nfinal = a.in[12];
    c.out = a.out; c.ws = a.ws;
    c.ctl = (unsigned*)(a.ws + WS_CTL); c.sumsq = (float*)(a.ws + WS_SUMSQ); c.lbv = (float*)(a.ws + WS_LBV); c.logf8 = (float*)(a.ws + WS_LOGF8);
    c.kbias = (float*)(a.ws + WS_KBIAS); c.hs = (float*)(a.ws + WS_HS);
    c.HB = (bf16_t*)(a.ws + WS_HB); c.MIX = (bf16_t*)(a.ws + WS_MIX); c.QB = (bf16_t*)(a.ws + WS_QB); c.KB = (bf16_t*)(a.ws + WS_KB); c.VB = (bf16_t*)(a.ws + WS_VB);
    c.HXQ = (bf16_t*)(a.ws + WS_HXQ); c.LOGF = (float*)(a.ws + WS_LOGF); c.HV = (bf16_t*)(a.ws + WS_HV); c.HG = (bf16_t*)(a.ws + WS_HG); c.ACT = (bf16_t*)(a.ws + WS_ACT);
    c.tid = threadIdx.x; c.lane = c.tid & 63; c.wave = __builtin_amdgcn_readfirstlane(c.tid >> 6);
    c.gw = blockIdx.x * NWAVES + c.wave; c.NGW = gridDim.x * NWAVES;
    volatile LAS unsigned* bst = (volatile LAS unsigned*)(lds + 131072 + 64);
    if (c.tid == 0) { bst[0] = 0u; bst[1] = 0u; }
    __syncthreads();
    const XcdBarrier bar = xcd_barrier_post((unsigned*)(a.ws + WS_BAR), bst);
#define GSYNC() xcd_barrier(bar)
    bf16_t* SD = (bf16_t*)(a.ws + WS_HB);
    float* DV = (float*)(a.ws + WS_DV);

    { const int gt = blockIdx.x * NTHREADS + c.tid, NGT = gridDim.x * NTHREADS;
      for (int i = gt; i < 16384; i += NGT) c.ctl[i] = (i == 8) ? 1u : 0u;
      for (int i = gt; i < 3 * MALLOC; i += NGT) c.sumsq[MALLOC + i] = 0.f;
      for (int i = gt; i < HGW; i += NGT) c.lbv[i] = 1.f / (1.f + __expf(c.lbraw[i] - c.lbraw[HGW + i])); }
    p0_weights(c, lds, 0, 0, 1 << 30, c.gw, c.NGW);
    p0_weights(c, lds, 1, 0, 1 << 30, c.gw, c.NGW);
    p0_extra_rows(c, 0, blockIdx.x * NTHREADS + c.tid, gridDim.x * NTHREADS);
    p0_extra_rows(c, 1, blockIdx.x * NTHREADS + c.tid, gridDim.x * NTHREADS);
    __syncthreads();
    if constexpr (DUPMASK & 1) { LAUNDER0(); p0_weights(c, lds, 0, 0, 1 << 30, c.gw, c.NGW); __syncthreads(); }
    h_build(c);
    grid.sync();
#define LAUNDER() do { int t_ = threadIdx.x; asm volatile("" : "+v"(t_)); c.tid = t_; c.lane = t_ & 63; } while (0)
    for (int layer = 0; layer < 2; ++layer) {
        LAUNDER();
        if constexpr (FASTMASK & 1) gemm_fast<0>(c, lds, layer); else gemm_simple<0>(c, layer);
        if constexpr (DUPMASK & 2) { LAUNDER(); gemm_fast<0>(c, lds, layer); }
        GSYNC();
        LAUNDER();
        hgrn_A_phase(c, lds, SD, DV);
        if (blockIdx.x >= gridDim.x - 32) { LAUNDER(); kbias_job(c, lds, (int)(gridDim.x - 1 - blockIdx.x)); }
        if constexpr (DUPMASK & 4) { LAUNDER(); hgrn_A_phase(c, lds, SD, DV); }
        GSYNC();
        LAUNDER();
        hgrn_B_scan(c, SD, DV);
        GSYNC();
        LAUNDER();
        hgrn_C_phase(c, lds, layer, SD);
        LAUNDER();
        mix_queue(c, lds_raw, layer, SD, c.ctl + 64 * (1 + layer));
        if constexpr (DUPMASK & 8) { LAUNDER(); mix_queue(c, lds_raw, layer, SD, c.ctl + 64 * (3 + layer)); }
        if constexpr (DUPMASK & 256) { LAUNDER(); hgrn_C_phase(c, lds, layer, SD); }
        if constexpr (DUPMASK & 128) { for (int i = 0; i < 8; ++i) GSYNC(); }
        GSYNC();
        LAUNDER();
        if constexpr (DUPMASK & 16) { gemm_fast<1>(c, lds, layer, c.ctl[8]); LAUNDER(); }
        if constexpr (FASTMASK & 2) gemm_fast<1>(c, lds, layer); else gemm_simple<1>(c, layer);
        GSYNC();
        if constexpr (FASTMASK & 4) gemm_fast<2>(c, lds, layer); else gemm_simple<2>(c, layer);
        if constexpr (DUPMASK & 32) { LAUNDER(); gemm_fast<2>(c, lds, layer); }
        GSYNC();
        if constexpr (DUPMASK & 64) { gemm_fast<3>(c, lds, layer, c.ctl[8]); LAUNDER(); }
        if constexpr (FASTMASK & 8) gemm_fast<3>(c, lds, layer); else gemm_simple<3>(c, layer);
        GSYNC();
    }
    LAUNDER();
    final_norm(c);
}

extern "C" void kernel_launch(void* const* d_in, const int* in_sizes, int n_in, void* d_out, int out_size, void* d_ws, size_t ws_size, hipStream_t stream) {
    static int grid = 0;
    if (grid == 0) {
        if (n_in != 13 || out_size != NB * SEQ * DM || ws_size < WS_END) { fprintf(stderr, "kernel_launch: unexpected shapes n_in %d out %d ws %zu\n", n_in, out_size, ws_size); grid = -1; return; }
        int dev = 0, cus = 0, per_cu = 0;
        (void)hipGetDevice(&dev); (void)hipDeviceGetAttribute(&cus, hipDeviceAttributeMultiprocessorCount, dev);
        (void)hipFuncSetAttribute((const void*)fwd_kernel, hipFuncAttributeMaxDynamicSharedMemorySize, LDS_BYTES);
        (void)hipOccupancyMaxActiveBlocksPerMultiprocessor(&per_cu, (const void*)fwd_kernel, NTHREADS, LDS_BYTES);
        if (per_cu < 1) per_cu = 1;
        grid = cus * per_cu;
        (void)hipGetLastError();
    }
    if (grid < 0) return;
    Args a{};
    for (int i = 0; i < 13; ++i) a.in[i] = (const float*)d_in[i];
    a.out = (float*)d_out; a.ws = (unsigned char*)d_ws;
    (void)hipMemsetAsync((unsigned char*)d_ws + WS_BAR, 0, 16384, stream);
    void* args[] = {&a};
    hipError_t e = hipLaunchCooperativeKernel((const void*)fwd_kernel, dim3(grid), dim3(NTHREADS), args, LDS_BYTES, stream);
    if (e != hipSuccess) fprintf(stderr, "cooperative launch failed: %s (grid %d)\n", hipGetErrorString(e), grid);
}
```

```cpp
#include <hip/hip_runtime.h>
#include <hip/hip_cooperative_groups.h>
#include <cstdint>
#include <cstdio>
namespace cg = cooperative_groups;

typedef unsigned short bf16_t;
typedef short bf16x8 __attribute__((ext_vector_type(8)));
typedef float f32x4 __attribute__((ext_vector_type(4)));
typedef unsigned u32x4 __attribute__((ext_vector_type(4)));
#define LAS __attribute__((address_space(3)))

constexpr int DM = 1024, NB = 4, SEQ = 4096, NMETA = 16, PADF = 48, LV = 4160, MROWS = NB * LV, MALLOC = MROWS + 256;
constexpr int FOXH = 8, FOXD = 64, FOXW = 512, HGH = 4, HGK = 128, HGV = 128, HGW = 512, DFF = 2816, INCOLS = 3592, NIN = 3584, NINP = 3840;
constexpr int KBL = 4352;
constexpr float EPS = 1e-6f, LOG2E = 1.4426950408889634f, C2 = 0.125f * LOG2E, HGQS = 0.08838834764831845f;
constexpr int NTHREADS = 512, NWAVES = 8;
constexpr int LDS_BYTES = 147456;
#ifndef FASTMASK
#define FASTMASK 15
#endif
#ifndef DUPMASK
#define DUPMASK 0
#endif

constexpr size_t MiB = 1u << 20;
constexpr size_t WS_CTL = 0;
constexpr size_t WS_SUMSQ = 64 * 1024;
constexpr size_t SUMSQ_STRIDE = (size_t)MALLOC * 4;
constexpr size_t WS_LBV = WS_SUMSQ + 4 * SUMSQ_STRIDE;
constexpr size_t WS_LOGF8 = WS_LBV + 4096;
constexpr size_t WS_KBIAS = WS_LOGF8 + (size_t)MALLOC * 32;
constexpr size_t WS_DV = WS_KBIAS + 32 * KBL * 4;
constexpr size_t WS_BAR = WS_DV + 16 * 64 * 128 * 4;
constexpr size_t WS_HS = 2 * MiB;
constexpr size_t WS_W = 3 * MiB;
constexpr size_t W_IN = 0, W_OUT = W_IN + (size_t)NINP * DM * 2, W_GU = W_OUT + (size_t)DM * DM * 2, W_DN = W_GU + (size_t)2 * DFF * DM * 2, W_LAYER = W_DN + (size_t)DM * DFF * 2;
constexpr size_t WS_HB = WS_W + 2 * W_LAYER + 65536;
constexpr size_t WS_MIX = WS_HB + (size_t)MALLOC * DM * 2;
constexpr size_t WS_QB = WS_MIX + (size_t)MALLOC * DM * 2;
constexpr size_t WS_KB = WS_QB + (size_t)MALLOC * 512 * 2, WS_VB = WS_KB + (size_t)MALLOC * 512 * 2;
constexpr size_t WS_HXQ = WS_VB + (size_t)MALLOC * 512 * 2;
constexpr size_t WS_LOGF = WS_HXQ + (size_t)MALLOC * 512 * 2;
constexpr size_t WS_HV = WS_LOGF + (size_t)MALLOC * 512 * 4, WS_HG = WS_HV + (size_t)MALLOC * 512 * 2;
constexpr size_t WS_END = WS_HG + (size_t)MALLOC * 512 * 2;
constexpr size_t WS_ACT = WS_QB;
static_assert(WS_BAR + 16384 <= WS_HS && 3456 * 4 <= 16384 && (size_t)16 * 64 * 16384 * 2 <= (size_t)MALLOC * DM * 2 && WS_HS + 4 * 64 * 1024 * 4 <= WS_W, "small map");
static_assert(WS_ACT + (size_t)MALLOC * DFF * 2 <= WS_END, "ACT overlay");
static_assert(WS_END <= 256 * MiB, "d_ws");

#define LAUNDER0() do { int t_ = threadIdx.x; asm volatile("" : "+v"(t_)); c.tid = t_; c.lane = t_ & 63; } while (0)
struct Args { const float* in[13]; float* out; unsigned char* ws; };

struct Ctx {
    const float *x, *meta, *nmw, *win, *fbias, *lbraw, *hnw, *wout, *nfw, *wg, *wu, *wd, *nfinal;
    float* out; unsigned char* ws;
    unsigned* ctl; float* sumsq; float* lbv; float* logf8; float* kbias; float* hs;
    bf16_t *HB, *MIX, *QB, *KB, *VB, *HXQ, *HV, *HG, *ACT; float* LOGF;
    int tid, lane, wave, gw, NGW;
};

__device__ __forceinline__ unsigned f2bf(float f) { unsigned u = __builtin_bit_cast(unsigned, f); return (u + 0x7fffu + ((u >> 16) & 1u)) >> 16; }
__device__ __forceinline__ unsigned pk2(float lo, float hi) { return f2bf(lo) | (f2bf(hi) << 16); }
__device__ __forceinline__ float bf2f(unsigned short b) { return __builtin_bit_cast(float, (unsigned)b << 16); }
__device__ __forceinline__ float wave_sum(float v) {
#pragma unroll
    for (int o = 1; o < 64; o <<= 1) v += __shfl_xor(v, o);
    return v;
}
__device__ __forceinline__ float wave_max(float v) {
#pragma unroll
    for (int o = 1; o < 64; o <<= 1) v = fmaxf(v, __shfl_xor(v, o));
    return v;
}
__device__ __forceinline__ float siluf(float x) { return x / (1.f + __expf(-x)); }
__device__ __forceinline__ float* hrow(const Ctx& c, int r) {
    const int b = r / LV, vp = r - b * LV;
    return vp >= 64 ? c.out + (size_t)(b * SEQ + vp - 64) * DM : c.hs + (size_t)(b * 64 + vp) * DM;
}
__device__ __forceinline__ bf16_t* wptr(const Ctx& c, int layer, size_t off) { return (bf16_t*)(c.ws + WS_W + (size_t)layer * W_LAYER + off); }

namespace pg8 {
#define PG8_LAS __attribute__((address_space(3)))
typedef unsigned short bf16_t;
typedef short bf16x8 __attribute__((ext_vector_type(8)));
typedef float f32x4 __attribute__((ext_vector_type(4)));
typedef unsigned u32x4 __attribute__((ext_vector_type(4)));
constexpr int BM = 256, BK = 64, HALF = 128, HTB = HALF * BK * 2  , STAGE_BYTES = 8 * HTB, NXCD = 8, WGM = 8;

__host__ __device__ __forceinline__ int lds_byte(int r, int c) { const int st = (r >> 4) * 2 + (c >> 5), rr = r & 15, cc = c & 31, ob = rr * 64 + cc * 2; return st * 1024 + (ob ^ (((ob >> 9) & 1) << 5)); }
__host__ __device__ __forceinline__ void stage_rc(int b, int& R, int& C) { const int st = b / 1024, sb = b % 1024, swz = sb ^ (((sb >> 9) & 1) << 5); R = (st >> 1) * 16 + swz / 64; C = (st & 1) * 32 + (swz % 64) / 2; }
__host__ __device__ __forceinline__ int perm32(int rho) { const int n = rho >> 4, i = rho & 15; return 8 * (i >> 2) + 4 * n + (i & 3); }

struct Unit { int pm, pn; };
struct Gemm { const bf16_t* A; const bf16_t* Bt; int M, N, K; };

struct StaticOrder {
    int nM, nN, nwg, G, c;
    __host__ __device__ void init(int M, int N, int G_, int c_) { nM = M / BM; nN = N / BM; nwg = nM * nN; G = G_; c = c_; }
    __host__ __device__ bool next(int i, Unit& u) const {
        const long L = (long)i * G + c; if (L >= nwg) return false;
        int wgid = (int)L; { const int q = nwg / NXCD, r = nwg % NXCD, xcd = wgid % NXCD, off = wgid / NXCD; wgid = (xcd < r ? xcd * (q + 1) : r * (q + 1) + (xcd - r) * q) + off; }
        const int nig = WGM * nN, gid = wgid / nig, fm = gid * WGM, gsz = (nM - fm) < WGM ? (nM - fm) : WGM;
        u.pm = fm + ((wgid % nig) % gsz); u.pn = (wgid % nig) / gsz; return true;
    }
    __device__ __forceinline__ void a_ready(const Unit&) const {}
    __device__ __forceinline__ void done(const Unit&) const {}
};

__device__ __forceinline__ unsigned cvt_pk_bf16(float lo, float hi) { unsigned r; asm volatile("v_cvt_pk_bf16_f32 %0, %1, %2" : "=v"(r) : "v"(lo), "v"(hi)); return r; }
typedef float f32x2 __attribute__((ext_vector_type(2)));
template <class Epi, class Sched, bool ALIGN_EPI = false, bool SP2 = false>
__device__ __forceinline__ void gemm_phase(PG8_LAS unsigned char* lds, const Gemm g, const Sched& S, const Epi& E) {
    int tid_ = threadIdx.x; asm volatile("" : "+v"(tid_));
    const int tid = tid_, wid = __builtin_amdgcn_readfirstlane(tid >> 6), lane = tid & 63, wr = wid >> 2, wc = wid & 3, fr = lane & 15, fq = lane >> 4;
    const int K = g.K, nt = K / BK;
    unsigned voffA[2], voffB[2];
#pragma unroll
    for (int i = 0; i < 2; ++i) { int R, C; stage_rc(tid * 16 + i * 8192, R, C); const int Rb = Epi::PERM ? ((R & ~31) + perm32(R & 31)) : R;
        voffA[i] = (unsigned)(R * K + C) * 2u; voffB[i] = (unsigned)(Rb * K + C) * 2u; }
    const size_t kstep = (size_t)(BK * 2);
    const size_t hstep = (size_t)HALF * K * 2;
    const size_t tstep = 2 * hstep;
    const unsigned ldsw = (unsigned)wid * 1024u;
    const int aoff = lds_byte(wr * 64 + fr, fq * 8), boff = lds_byte(wc * 32 + fr, fq * 8);
#define PG8_SA(b, h) (((b) * 2 + (h)) * HTB)
#define PG8_SB(b, h) ((4 + (b) * 2 + (h)) * HTB)
#define PG8_STAGE(bufoff, gbase, voff) do { _Pragma("unroll") for (int _i = 0; _i < 2; ++_i) \
        __builtin_amdgcn_global_load_lds((const unsigned*)((const char*)(gbase) + (voff)[_i]), (PG8_LAS unsigned*)(lds + (bufoff) + ldsw + _i * 8192), 16, 0, 0); } while (0)
#define PG8_LDA(dst, b, h) do { _Pragma("unroll") for (int m = 0; m < 4; ++m) _Pragma("unroll") for (int k = 0; k < 2; ++k) dst[m][k] = *(const PG8_LAS bf16x8*)(lds + PG8_SA(b, h) + aoff + m * 2048 + k * 1024); } while (0)
#define PG8_LDB(dst, b, h) do { _Pragma("unroll") for (int n = 0; n < 2; ++n) _Pragma("unroll") for (int k = 0; k < 2; ++k) dst[n][k] = *(const PG8_LAS bf16x8*)(lds + PG8_SB(b, h) + boff + n * 2048 + k * 1024); } while (0)
#define PG8_MMA(ai, bj, At, Bt) do { __builtin_amdgcn_s_setprio(1); _Pragma("unroll") for (int m = 0; m < 4; ++m) _Pragma("unroll") for (int n = 0; n < 2; ++n) _Pragma("unroll") for (int k = 0; k < 2; ++k) \
        acc[ai][bj][m][n] = __builtin_amdgcn_mfma_f32_16x16x32_bf16(Bt[n][k], At[m][k], acc[ai][bj][m][n], 0, 0, 0); __builtin_amdgcn_s_setprio(0); } while (0)
#define PG8_WAIT_V(n) asm volatile("s_waitcnt vmcnt(" #n ")" ::: "memory")
#define PG8_WAIT_L(n) asm volatile("s_waitcnt lgkmcnt(" #n ")" ::: "memory")
#define PG8_BAR __builtin_amdgcn_s_barrier()
#define PG8_SCHED __builtin_amdgcn_sched_barrier(0)
    Unit cur, nxt; int ui = 0;
    if (!S.next(0, cur)) return;
    f32x4 acc[2][2][4][2];
#pragma unroll
    for (int a = 0; a < 2; ++a)
#pragma unroll
        for (int b = 0; b < 2; ++b)
#pragma unroll
            for (int m = 0; m < 4; ++m)
#pragma unroll
                for (int n = 0; n < 2; ++n) acc[a][b][m][n] = (f32x4){0.f, 0.f, 0.f, 0.f};
    bf16x8 At[4][2], B0[2][2], B1[2][2];
    const char* cA = (const char*)g.A + (size_t)cur.pm * tstep; const char* cB = (const char*)g.Bt + (size_t)cur.pn * tstep;
    S.a_ready(cur);
    if constexpr (SP2) {
        PG8_STAGE(PG8_SB(0, 0), cB, voffB); PG8_STAGE(PG8_SB(0, 1), cB + hstep, voffB); PG8_STAGE(PG8_SA(0, 0), cA, voffA); PG8_STAGE(PG8_SA(0, 1), cA + hstep, voffA);
        if (wr == 1) PG8_BAR;
        PG8_WAIT_V(2); PG8_BAR;
        PG8_STAGE(PG8_SB(1, 0), cB + kstep, voffB); PG8_STAGE(PG8_SA(1, 0), cA + kstep, voffA); PG8_STAGE(PG8_SB(1, 1), cB + hstep + kstep, voffB);
        PG8_WAIT_V(6); PG8_BAR;
    } else {
        PG8_STAGE(PG8_SB(0, 0), cB, voffB); PG8_STAGE(PG8_SA(0, 0), cA, voffA); PG8_STAGE(PG8_SB(0, 1), cB + hstep, voffB); PG8_STAGE(PG8_SA(0, 1), cA + hstep, voffA);
        if (wr == 1) PG8_BAR;
        PG8_WAIT_V(4); PG8_BAR;
        PG8_STAGE(PG8_SB(1, 0), cB + kstep, voffB); PG8_STAGE(PG8_SA(1, 0), cA + kstep, voffA); PG8_STAGE(PG8_SB(1, 1), cB + hstep + kstep, voffB);
        PG8_WAIT_V(6); PG8_BAR;
    }
    for (;;) {
        const bool has_next = S.next(ui + 1, nxt);
        const char* nA = has_next ? (const char*)g.A + (size_t)nxt.pm * tstep : cA; const char* nB = has_next ? (const char*)g.Bt + (size_t)nxt.pn * tstep : cB;
        for (int t = 0; t < nt; t += 2) {
            const bool last = (t == nt - 2);
            const char* a1 = cA + (size_t)(t + 1) * kstep;
            const char* a2 = last ? nA : cA + (size_t)(t + 2) * kstep; const char* b2 = last ? nB : cB + (size_t)(t + 2) * kstep;
            const char* a3 = a2 + kstep; const char* b3 = b2 + kstep;
            if (last && has_next) S.a_ready(nxt);
            if constexpr (SP2) {
            PG8_LDB(B0, 0, 0); PG8_LDB(B1, 0, 1); PG8_SCHED; PG8_LDA(At, 0, 0); PG8_STAGE(PG8_SA(1, 1), a1 + hstep, voffA);
            PG8_WAIT_V(8); PG8_WAIT_L(0); PG8_BAR; PG8_MMA(0, 0, At, B0); PG8_MMA(0, 1, At, B1); PG8_BAR; PG8_SCHED;
            PG8_LDA(At, 0, 1); PG8_STAGE(PG8_SB(0, 0), b2, voffB); PG8_STAGE(PG8_SB(0, 1), b2 + hstep, voffB); PG8_STAGE(PG8_SA(0, 0), a2, voffA);
            PG8_WAIT_V(8); PG8_WAIT_L(0); PG8_BAR; PG8_MMA(1, 0, At, B0); PG8_MMA(1, 1, At, B1); PG8_BAR; PG8_SCHED;
            PG8_LDB(B0, 1, 0); PG8_LDB(B1, 1, 1); PG8_SCHED; PG8_LDA(At, 1, 0); PG8_STAGE(PG8_SA(0, 1), a2 + hstep, voffA);
            PG8_WAIT_V(8); PG8_WAIT_L(0); PG8_BAR; PG8_MMA(0, 0, At, B0); PG8_MMA(0, 1, At, B1); PG8_BAR; PG8_SCHED;
            PG8_LDA(At, 1, 1); PG8_STAGE(PG8_SB(1, 0), b3, voffB); PG8_STAGE(PG8_SB(1, 1), b3 + hstep, voffB); PG8_STAGE(PG8_SA(1, 0), a3, voffA);
            PG8_WAIT_V(8); PG8_WAIT_L(0); PG8_BAR; PG8_MMA(1, 0, At, B0); PG8_MMA(1, 1, At, B1); PG8_BAR; PG8_SCHED;
            } else {
            PG8_LDB(B0, 0, 0); PG8_SCHED; PG8_LDA(At, 0, 0); PG8_STAGE(PG8_SA(1, 1), a1 + hstep, voffA);
            PG8_WAIT_L(8); PG8_BAR; PG8_WAIT_L(0); PG8_MMA(0, 0, At, B0); PG8_BAR; PG8_SCHED;
            PG8_LDB(B1, 0, 1); PG8_STAGE(PG8_SB(0, 0), b2, voffB);
            PG8_BAR; PG8_WAIT_L(0); PG8_MMA(0, 1, At, B1); PG8_BAR;
            PG8_LDA(At, 0, 1); PG8_STAGE(PG8_SA(0, 0), a2, voffA);
            PG8_BAR; PG8_WAIT_L(0); PG8_MMA(1, 0, At, B0); PG8_BAR; PG8_SCHED;
            PG8_STAGE(PG8_SB(0, 1), b2 + hstep, voffB);
            PG8_WAIT_V(6); PG8_BAR; PG8_MMA(1, 1, At, B1); PG8_BAR;
            PG8_LDB(B0, 1, 0); PG8_SCHED; PG8_LDA(At, 1, 0); PG8_STAGE(PG8_SA(0, 1), a2 + hstep, voffA);
            PG8_WAIT_L(8); PG8_BAR; PG8_WAIT_L(0); PG8_MMA(0, 0, At, B0); PG8_BAR; PG8_SCHED;
            PG8_LDB(B1, 1, 1); PG8_STAGE(PG8_SB(1, 0), b3, voffB);
            PG8_BAR; PG8_WAIT_L(0); PG8_MMA(0, 1, At, B1); PG8_BAR;
            PG8_LDA(At, 1, 1); PG8_STAGE(PG8_SA(1, 0), a3, voffA);
            PG8_BAR; PG8_WAIT_L(0); PG8_MMA(1, 0, At, B0); PG8_BAR; PG8_SCHED;
            PG8_STAGE(PG8_SB(1, 1), b3 + hstep, voffB);
            PG8_WAIT_V(6); PG8_BAR; PG8_MMA(1, 1, At, B1); PG8_BAR;
            }
        }
        if constexpr (ALIGN_EPI) { if (wr == 0) PG8_BAR; }
        if constexpr (!Epi::AFTER_DRAIN) { E(acc, cur, wr, wc, fr, fq); S.done(cur); }
        if (!has_next) break;
#pragma unroll
        for (int a = 0; a < 2; ++a)
#pragma unroll
            for (int b = 0; b < 2; ++b)
#pragma unroll
                for (int m = 0; m < 4; ++m)
#pragma unroll
                    for (int n = 0; n < 2; ++n) acc[a][b][m][n] = (f32x4){0.f, 0.f, 0.f, 0.f};
        cur = nxt; cA = nA; cB = nB; ++ui;
        if constexpr (ALIGN_EPI) { if (wr == 1) PG8_BAR; }
    }
    PG8_WAIT_V(0);
    if constexpr (!ALIGN_EPI) { if (wr == 0) PG8_BAR; }
    PG8_BAR;
    if constexpr (Epi::AFTER_DRAIN) { E.fused(acc, cur, wr, wc, fr, fq, lds, wid, lane); S.done(cur); }
#undef PG8_SA
#undef PG8_SB
#undef PG8_STAGE
#undef PG8_LDA
#undef PG8_LDB
#undef PG8_MMA
#undef PG8_WAIT_V
#undef PG8_WAIT_L
#undef PG8_BAR
#undef PG8_SCHED
}
}

namespace pg8 {
__device__ __forceinline__ float silu_f(float x) { return x * __builtin_amdgcn_rcpf(1.f + __expf(-x)); }
struct EpiInProj {
    static constexpr bool PERM = true, AFTER_DRAIN = false;
    const float* ssq; const float* lbv; bf16_t *QB, *KB, *VB, *HXQ, *HV, *HG; float* LOGF; const float* fbias; float* logf8;
    __device__ __forceinline__ void operator()(const f32x4 (&acc)[2][2][4][2], const Unit& u, int wr, int wc, int fr, int fq) const {
        const int part = u.pn >> 1;
        const int cbase = (u.pn & 1) * 256 + wc * 32 + 8 * fq;
        if (part == 7) {
            if (wc == 0 && fq == 0) {
                const f32x4 b0 = *(const f32x4*)fbias, b1 = *(const f32x4*)(fbias + 4);
#pragma unroll
                for (int ai = 0; ai < 2; ++ai)
#pragma unroll
                    for (int m = 0; m < 4; ++m) {
                        const int r = u.pm * BM + ai * HALF + wr * 64 + m * 16 + fr;
                        const float rstd = 1.f / sqrtf(ssq[r] * (1.f / 1024.f) + 1e-6f);
                        f32x4 z0 = acc[ai][0][m][0] * rstd + b0, z1 = acc[ai][0][m][1] * rstd + b1;
#pragma unroll
                        for (int e = 0; e < 4; ++e) { z0[e] = fminf(z0[e], 0.f) - __logf(1.f + __expf(-fabsf(z0[e]))); z1[e] = fminf(z1[e], 0.f) - __logf(1.f + __expf(-fabsf(z1[e]))); }
                        *(f32x4*)(logf8 + (size_t)r * 8) = z0; *(f32x4*)(logf8 + (size_t)r * 8 + 4) = z1;
                    }
            }
        } else if (part == 4) {
#pragma unroll
            for (int bj = 0; bj < 2; ++bj)
#pragma unroll
                for (int n = 0; n < 2; ++n) {
                    const int cc = cbase + bj * HALF + 4 * n;
                    f32x4 lb1 = (f32x4){1.f, 1.f, 1.f, 1.f};
                    if (lbv) lb1 = lb1 - *(const f32x4*)(lbv + cc);
#pragma unroll
                    for (int ai = 0; ai < 2; ++ai)
#pragma unroll
                        for (int m = 0; m < 4; ++m) {
                            const int r = u.pm * BM + ai * HALF + wr * 64 + m * 16 + fr;
                            const float rstd = 1.f / sqrtf(ssq[r] * (1.f / 1024.f) + 1e-6f);
                            f32x4 a;
#pragma unroll
                            for (int e = 0; e < 4; ++e) { const float xv = acc[ai][bj][m][n][e] * rstd; const float omf = lb1[e] * __builtin_amdgcn_rcpf(1.f + __expf(xv)); a[e] = fmaxf(__logf(1.f - omf), -30.f); }
                            *(f32x4*)(LOGF + (size_t)r * 512 + cc) = a;
                        }
                }
        } else {
            bf16_t* dst = part == 0 ? QB : part == 1 ? KB : part == 2 ? VB : part == 3 ? HXQ : part == 5 ? HV : HG;
            const float sc = part == 0 ? 0.125f * 1.4426950408889634f : part == 3 ? 0.08838834764831845f : 1.f;
            const bool dosilu = (part == 3) || (part == 6);
#pragma unroll
            for (int ai = 0; ai < 2; ++ai)
#pragma unroll
                for (int m = 0; m < 4; ++m) {
                    const int r = u.pm * BM + ai * HALF + wr * 64 + m * 16 + fr;
                    const float rstd = sc / sqrtf(ssq[r] * (1.f / 1024.f) + 1e-6f);
#pragma unroll
                    for (int bj = 0; bj < 2; ++bj) {
                        f32x4 v0 = acc[ai][bj][m][0], v1 = acc[ai][bj][m][1];
                        if (dosilu) {
#pragma unroll
                            for (int e = 0; e < 4; ++e) { const float a0 = v0[e] * (rstd / sc), a1 = v1[e] * (rstd / sc); v0[e] = silu_f(a0) * sc; v1[e] = silu_f(a1) * sc; }
                        } else { v0 = v0 * rstd; v1 = v1 * rstd; }
                        u32x4 w; w.x = cvt_pk_bf16(v0[0], v0[1]); w.y = cvt_pk_bf16(v0[2], v0[3]); w.z = cvt_pk_bf16(v1[0], v1[1]); w.w = cvt_pk_bf16(v1[2], v1[3]);
                        *(u32x4*)(dst + (size_t)r * 512 + cbase + bj * HALF) = w;
                    }
                }
        }
    }
};
struct EpiResid {
    static constexpr bool PERM = false, AFTER_DRAIN = false;
    float* out; float* hs; bf16_t* HB; float* ssq; unsigned skip;
    __device__ __forceinline__ void operator()(const f32x4 (&acc)[2][2][4][2], const Unit& u, int wr, int wc, int fr, int fq) const {
        if (skip) return;
        const int col0 = u.pn * BM + wc * 32 + 4 * fq;
#pragma unroll
        for (int ai = 0; ai < 2; ++ai)
#pragma unroll
            for (int m = 0; m < 4; ++m) {
                const int r = u.pm * BM + ai * HALF + wr * 64 + m * 16 + fr;
                const int b = r / 4160, vp = r - b * 4160;
                float* hp = vp >= 64 ? out + (size_t)(b * 4096 + vp - 64) * 1024 : hs + (size_t)(b * 64 + vp) * 1024;
                float q = 0.f;
#pragma unroll
                for (int bj = 0; bj < 2; ++bj)
#pragma unroll
                    for (int n = 0; n < 2; ++n) { const int c = col0 + bj * HALF + n * 16; const f32x4 h = *(const f32x4*)(hp + c) + acc[ai][bj][m][n]; *(f32x4*)(hp + c) = h;
                        unsigned long long w = (unsigned long long)cvt_pk_bf16(h[0], h[1]) | ((unsigned long long)cvt_pk_bf16(h[2], h[3]) << 32);
                        *(unsigned long long*)(HB + (size_t)r * 1024 + c) = w; q += (h[0] * h[0] + h[1] * h[1]) + (h[2] * h[2] + h[3] * h[3]); }
                if (ssq) { q += __shfl_xor(q, 16); q += __shfl_xor(q, 32); if (fq == 0) atomicAdd(ssq + r, q); }
            }
    }
};
struct EpiSwiGLU {
    static constexpr bool PERM = true, AFTER_DRAIN = false;
    const float* ssq; bf16_t* ACT;
    __device__ __forceinline__ void operator()(const f32x4 (&acc)[2][2][4][2], const Unit& u, int wr, int wc, int fr, int fq) const {
        const int f0 = u.pn * HALF + wc * 32 + 8 * fq;
#pragma unroll
        for (int ai = 0; ai < 2; ++ai)
#pragma unroll
            for (int m = 0; m < 4; ++m) {
                const int r = u.pm * BM + ai * HALF + wr * 64 + m * 16 + fr;
                const float rstd = 1.f / sqrtf(ssq[r] * (1.f / 1024.f) + 1e-6f);
                float y[8];
#pragma unroll
                for (int n = 0; n < 2; ++n)
#pragma unroll
                    for (int e = 0; e < 4; ++e) { const float g = acc[ai][0][m][n][e] * rstd, uu = acc[ai][1][m][n][e] * rstd; y[4 * n + e] = silu_f(g) * uu; }
                u32x4 w; w.x = cvt_pk_bf16(y[0], y[1]); w.y = cvt_pk_bf16(y[2], y[3]); w.z = cvt_pk_bf16(y[4], y[5]); w.w = cvt_pk_bf16(y[6], y[7]);
                *(u32x4*)(ACT + (size_t)r * 2816 + f0) = w;
            }
    }
};
}

#define GAS __attribute__((address_space(1)))
typedef unsigned v4u __attribute__((ext_vector_type(4)));
typedef GAS unsigned gu32;
typedef GAS unsigned long long gu64;
#define RLX_AGENT __ATOMIC_RELAXED, __HIP_MEMORY_SCOPE_AGENT
#define LDS_WAIT() asm volatile("s_waitcnt lgkmcnt(0)" ::: "memory")
#define VM_WAIT() asm volatile("s_waitcnt vmcnt(0)" ::: "memory")
__device__ __forceinline__ unsigned long long rt() { return __builtin_amdgcn_s_memrealtime(); }
#define XB_TMO      128
#define XB_XCNT(j)  (256  + 64 * (j))
#define XB_XSUB(j)  (1280 + 64 * (j))
#define XB_XGEN(j)  (2304 + 64 * (j))
#define XB_TOP      3328
#define XB_TOPGEN   3392
#define XCD_BAR_WORDS 3456
#define XB_SPIN_CAP (1u << 18)

__device__ __forceinline__ unsigned xb_ld(unsigned* p)              { return __hip_atomic_load(p, __ATOMIC_RELAXED, __HIP_MEMORY_SCOPE_AGENT); }
__device__ __forceinline__ unsigned xb_add(unsigned* p, unsigned v) { return __hip_atomic_fetch_add(p, v, __ATOMIC_RELAXED, __HIP_MEMORY_SCOPE_AGENT); }
__device__ __forceinline__ unsigned xb_xcc_id() { return (unsigned)__builtin_amdgcn_s_getreg((3 << 11) | 20) & 0xFu; }
#define XB_SPIN(cond, bar) do { unsigned _sp = 0; while (cond) { __builtin_amdgcn_s_sleep(1); \
    if ((++_sp & 255u) == 0u) { if (xb_ld(&(bar)[XB_TMO])) break; if (_sp > XB_SPIN_CAP) { atomicAdd(&(bar)[XB_TMO], 1u); break; } } } } while (0)

struct XcdBarrier {
    unsigned* bar; unsigned x;
    volatile LAS unsigned* st;
};

__device__ __forceinline__ XcdBarrier xcd_barrier_post(unsigned* bar, volatile LAS unsigned* st) {
    XcdBarrier b; b.bar = bar; b.x = xb_xcc_id(); b.st = st;
    if (threadIdx.x == 0) (void)xb_add(&bar[XB_XCNT(b.x)], 1u);
    return b;
}
__device__ __forceinline__ void xcd_barrier_complete(unsigned* bar, unsigned x, unsigned& nloc, unsigned& nx) {
    const unsigned G = gridDim.x * gridDim.y * gridDim.z;
    unsigned sum, cnt, mine, sp = 0u;
    for (;;) {
        sum = 0u; cnt = 0u; mine = 0u;
#pragma unroll
        for (unsigned j = 0; j < 16; ++j) { const unsigned c = xb_ld(&bar[XB_XCNT(j)]); sum += c; cnt += (c > 0u) ? 1u : 0u; mine = (j == x) ? c : mine; }
        if (sum == G) break;
        __builtin_amdgcn_s_sleep(1);
        if ((++sp & 255u) == 0u) { if (xb_ld(&bar[XB_TMO])) break; if (sp > XB_SPIN_CAP) { atomicAdd(&bar[XB_TMO], 1u); break; } }
    }
    nloc = mine > 0u ? mine : 1u; nx = cnt > 0u ? cnt : 1u;
}

__device__ __forceinline__ void xcd_barrier(const XcdBarrier& b) {
    asm volatile("s_waitcnt vmcnt(0)" ::: "memory");
    __syncthreads();
    int t_ = threadIdx.x; asm volatile("" : "+v"(t_));
    if (t_ == 0) {
        unsigned* bar = b.bar;
        __builtin_amdgcn_s_waitcnt(0);
        unsigned nloc = b.st[0], nx = b.st[1];
        if (nloc == 0u) { xcd_barrier_complete(bar, b.x, nloc, nx); b.st[0] = nloc; b.st[1] = nx; }
        const unsigned old = xb_add(&bar[XB_XSUB(b.x)], 1u);
        const unsigned gen = old / nloc;
        if (old + 1u == (gen + 1u) * nloc) {
            __builtin_amdgcn_fence(__ATOMIC_RELEASE, "agent");
            asm volatile("s_waitcnt vmcnt(0)" ::: "memory");
            const unsigned og = xb_add(&bar[XB_TOP], 1u);
            const unsigned tg = og / nx;
            if (og + 1u == (tg + 1u) * nx) xb_add(&bar[XB_TOPGEN], 1u);
            else XB_SPIN(xb_ld(&bar[XB_TOPGEN]) == tg, bar);
            __builtin_amdgcn_fence(__ATOMIC_ACQUIRE, "agent");
            xb_add(&bar[XB_XGEN(b.x)], 1u);
            asm volatile("s_waitcnt vmcnt(0)" ::: "memory");
        } else {
            XB_SPIN(xb_ld(&bar[XB_XGEN(b.x)]) == gen, bar);
            __builtin_amdgcn_fence(__ATOMIC_ACQUIRE, "agent");
            asm volatile("s_waitcnt vmcnt(0)" ::: "memory");
        }
    }
    __syncthreads();
}

__device__ __forceinline__ void tr_item(const float* W, int K, int N, int k0, int nsrc0, bf16_t* WT, int dst_row0, const float* kscale, LAS float* scr, int lane) {
    float wv[32];
#pragma unroll
    for (int i = 0; i < 32; ++i) { const int kk = 2 * i + (lane >> 5); wv[i] = W[(size_t)(k0 + kk) * N + nsrc0 + (lane & 31)]; }
#pragma unroll
    for (int i = 0; i < 32; ++i) { const int kk = 2 * i + (lane >> 5); const float s = kscale ? kscale[k0 + kk] : 1.f; scr[kk * 33 + (lane & 31)] = wv[i] * s; }
    asm volatile("s_waitcnt lgkmcnt(0)" ::: "memory");
    const int ch = lane & 7;
#pragma unroll
    for (int j = 0; j < 4; ++j) { const int n = (lane >> 3) + 8 * j; const LAS float* s = scr + (8 * ch) * 33 + n;
        u32x4 o; o.x = pk2(s[0 * 33], s[1 * 33]); o.y = pk2(s[2 * 33], s[3 * 33]); o.z = pk2(s[4 * 33], s[5 * 33]); o.w = pk2(s[6 * 33], s[7 * 33]);
        *(u32x4*)(WT + (size_t)(dst_row0 + n) * K + k0 + 8 * ch) = o; }
    asm volatile("s_waitcnt lgkmcnt(0)" ::: "memory");
}

__device__ __forceinline__ void p0_weights(const Ctx& c, LAS unsigned char* lds, int l, int it0, int it1, int w0, int nw) {
    LAS float* scr = (LAS float*)(lds + c.wave * 16384);
    constexpr int I_IN = 16 * (NIN / 32), I_OUT = 16 * 32, I_G = 16 * (DFF / 32), I_D = (DFF / 64) * 32, I_L = I_IN + I_OUT + 2 * I_G + I_D;
    if (it1 > I_L) it1 = I_L;
#pragma nounroll
    for (int it = it0 + w0; it < it1; it += nw) {
        int r = it;
        if (r < I_IN) { const int kb = r / (NIN / 32), nb = r % (NIN / 32), n0 = nb * 32;
            tr_item(c.win + (size_t)l * DM * INCOLS, DM, INCOLS, kb * 64, n0 + (n0 >= 1536 ? 8 : 0), wptr(c, l, W_IN), n0, c.nmw + l * DM, scr, c.lane); continue; }
        r -= I_IN;
        if (r < I_OUT) { const int kb = r / 32, nb = r % 32; tr_item(c.wout + (size_t)l * DM * DM, DM, DM, kb * 64, nb * 32, wptr(c, l, W_OUT), nb * 32, nullptr, scr, c.lane); continue; }
        r -= I_OUT;
        if (r < 2 * I_G) { const int up = r >= I_G; if (up) r -= I_G; const int kb = r / (DFF / 32), nb = r % (DFF / 32), f0 = nb * 32;
            tr_item((up ? c.wu : c.wg) + (size_t)l * DM * DFF, DM, DFF, kb * 64, f0, wptr(c, l, W_GU), 256 * (f0 >> 7) + (f0 & 127) + (up ? 128 : 0), c.nfw + l * DM, scr, c.lane); continue; }
        r -= 2 * I_G;
        { const int kb = r / 32, nb = r % 32; tr_item(c.wd + (size_t)l * DFF * DM, DFF, DM, kb * 64, nb * 32, wptr(c, l, W_DN), nb * 32, nullptr, scr, c.lane); }
    }
}

__device__ __forceinline__ void p0_extra_rows(const Ctx& c, int l, int gt, int NGT) {
#pragma nounroll
    for (int i = gt; i < 8 * DM; i += NGT) { const int cc = i >> 10, k = i & 1023;
        wptr(c, l, W_IN)[(size_t)(NIN + cc) * DM + k] = (bf16_t)f2bf(c.win[(size_t)l * DM * INCOLS + (size_t)k * INCOLS + 1536 + cc] * c.nmw[l * DM + k]); }
#pragma nounroll
    for (int i = gt; i < 248 * 128; i += NGT) *(u32x4*)(wptr(c, l, W_IN) + (size_t)(NIN + 8) * DM + (size_t)i * 8) = (u32x4){0u, 0u, 0u, 0u};
}
__device__ __forceinline__ void h_build(const Ctx& c) {
    float* ssq = c.sumsq;
    for (int rb = c.gw; rb < MROWS; rb += 4 * c.NGW) {
        f32x4 v[4][4];
#pragma unroll
        for (int q = 0; q < 4; ++q) { const int r = rb + q * c.NGW;
            if (r < MROWS) { const int b = r / LV, vp = r - b * LV;
                const float* src = vp >= 64 ? c.x + (size_t)(b * SEQ + vp - 64) * DM : (vp >= PADF ? c.meta + (size_t)(vp - PADF) * DM : nullptr);
#pragma unroll
                for (int j = 0; j < 4; ++j) v[q][j] = src ? *(const f32x4*)(src + 4 * c.lane + 256 * j) : (f32x4){0.f, 0.f, 0.f, 0.f}; } }
#pragma unroll
        for (int q = 0; q < 4; ++q) { const int r = rb + q * c.NGW;
            if (r < MROWS) { float* hp = hrow(c, r); float s = 0.f;
#pragma unroll
                for (int j = 0; j < 4; ++j) { *(f32x4*)(hp + 4 * c.lane + 256 * j) = v[q][j];
                    unsigned long long w = (unsigned long long)pk2(v[q][j].x, v[q][j].y) | ((unsigned long long)pk2(v[q][j].z, v[q][j].w) << 32);
                    *(unsigned long long*)(c.HB + (size_t)r * DM + 4 * c.lane + 256 * j) = w;
                    s += (v[q][j].x * v[q][j].x + v[q][j].y * v[q][j].y) + (v[q][j].z * v[q][j].z + v[q][j].w * v[q][j].w); }
                s = wave_sum(s);
                if (c.lane == 0) ssq[r] = s; } }
    }
}

__device__ __forceinline__ void kbias_job(const Ctx& c, LAS unsigned char* lds, int job) {
    const int b = job >> 3, h = job & 7;
    LAS float* wt = (LAS float*)lds;
    const int v0 = 9 * c.tid;
    float g[9]; float s = 0.f;
#pragma unroll
    for (int i = 0; i < 9; ++i) { const int vp = v0 + i; g[i] = (vp >= PADF && vp < LV) ? c.logf8[(size_t)(b * LV + vp) * 8 + h] : 0.f; s += g[i]; }
    float inc = s;
#pragma unroll
    for (int o = 1; o < 64; o <<= 1) { const float t = __shfl_up(inc, o); if (c.lane >= o) inc += t; }
    if (c.lane == 63) wt[c.wave] = inc;
    __syncthreads();
    float run = inc - s;
    for (int w = 0; w < c.wave; ++w) run += wt[w];
    float* kb = c.kbias + (size_t)job * KBL;
#pragma unroll
    for (int i = 0; i < 9; ++i) { const int vp = v0 + i; run += g[i]; if (vp < KBL) kb[vp] = vp < PADF ? -1e30f : (vp < LV ? -run * LOG2E : 0.f); }
    __syncthreads();
}

template <int MODE>
__device__ __forceinline__ void gemm_simple(const Ctx& c, int layer) {
    const int fr = c.lane & 15, g = c.lane >> 4;
    const bf16_t* A = MODE == 0 ? c.HB : MODE == 1 ? c.MIX : MODE == 2 ? c.HB : c.ACT;
    const bf16_t* Bt = wptr(c, layer, MODE == 0 ? W_IN : MODE == 1 ? W_OUT : MODE == 2 ? W_GU : W_DN);
    constexpr int K = MODE == 3 ? DFF : DM;
    constexpr int NCOL = MODE == 0 ? NIN : MODE == 2 ? DFF : DM;
    constexpr int ntn = NCOL / 64, ntm = MROWS / 16;
    for (int t = c.gw; t < ntm * ntn; t += c.NGW) {
        const int tm = t / ntn, tn = t - tm * ntn, row0 = tm * 16, col0 = tn * 64;
        f32x4 acc[4], acc2[4];
#pragma unroll
        for (int n = 0; n < 4; ++n) { acc[n] = (f32x4){0.f, 0.f, 0.f, 0.f}; acc2[n] = (f32x4){0.f, 0.f, 0.f, 0.f}; }
        const bf16_t* ap = A + (size_t)(row0 + fr) * K + 8 * g;
        const bf16_t* bp[4];
#pragma unroll
        for (int n = 0; n < 4; ++n) { const int cn = col0 + 16 * n + fr; const int br = MODE == 2 ? 256 * (cn >> 7) + (cn & 127) : cn; bp[n] = Bt + (size_t)br * K + 8 * g; }
        for (int k0 = 0; k0 < K; k0 += 32) {
            const bf16x8 a = *(const bf16x8*)(ap + k0);
#pragma unroll
            for (int n = 0; n < 4; ++n) { const bf16x8 b = *(const bf16x8*)(bp[n] + k0); acc[n] = __builtin_amdgcn_mfma_f32_16x16x32_bf16(a, b, acc[n], 0, 0, 0);
                if (MODE == 2) { const bf16x8 b2 = *(const bf16x8*)(bp[n] + (size_t)128 * K + k0); acc2[n] = __builtin_amdgcn_mfma_f32_16x16x32_bf16(a, b2, acc2[n], 0, 0, 0); } }
        }
        if (MODE == 0) {
            const float* ssq = c.sumsq + (size_t)layer * MALLOC;
#pragma unroll
            for (int j = 0; j < 4; ++j) { const int r = row0 + 4 * g + j; const float rstd = 1.f / sqrtf(ssq[r] * (1.f / DM) + EPS);
#pragma unroll
                for (int n = 0; n < 4; ++n) { const int cn = col0 + 16 * n + fr; const float xv = acc[n][j] * rstd; const int part = cn >> 9, cc = cn & 511; const size_t o = (size_t)r * 512 + cc;
                    if (part == 0) c.QB[o] = (bf16_t)f2bf(xv * C2);
                    else if (part == 1) c.KB[o] = (bf16_t)f2bf(xv);
                    else if (part == 2) c.VB[o] = (bf16_t)f2bf(xv);
                    else if (part == 3) c.HXQ[o] = (bf16_t)f2bf(siluf(xv) * HGQS);
                    else if (part == 4) { const float lb = layer ? c.lbv[cc] : 0.f; const float omf = (1.f - lb) / (1.f + __expf(xv)); c.LOGF[o] = fmaxf(log1pf(-omf), -30.f); }
                    else if (part == 5) c.HV[o] = (bf16_t)f2bf(xv);
                    else c.HG[o] = (bf16_t)f2bf(siluf(xv)); } }
        } else if (MODE == 1 || MODE == 3) {
            float* ssq = c.sumsq + (size_t)(2 + layer) * MALLOC;
#pragma unroll
            for (int j = 0; j < 4; ++j) { const int r = row0 + 4 * g + j; float* hp = hrow(c, r); float q = 0.f;
#pragma unroll
                for (int n = 0; n < 4; ++n) { const int cn = col0 + 16 * n + fr; const float hn = hp[cn] + acc[n][j]; hp[cn] = hn; c.HB[(size_t)r * DM + cn] = (bf16_t)f2bf(hn); q += hn * hn; }
                if (MODE == 1) { q += __shfl_xor(q, 1); q += __shfl_xor(q, 2); q += __shfl_xor(q, 4); q += __shfl_xor(q, 8); if (fr == 0) atomicAdd(ssq + r, q); } }
        } else {
            const float* ssq = c.sumsq + (size_t)(2 + layer) * MALLOC;
#pragma unroll
            for (int j = 0; j < 4; ++j) { const int r = row0 + 4 * g + j; const float rstd = 1.f / sqrtf(ssq[r] * (1.f / DM) + EPS);
#pragma unroll
                for (int n = 0; n < 4; ++n) { const int cn = col0 + 16 * n + fr; const float gv = acc[n][j] * rstd, uv = acc2[n][j] * rstd; c.ACT[(size_t)r * DFF + cn] = (bf16_t)f2bf(siluf(gv) * uv); } }
        }
    }
}

template <int MODE>
__device__ __forceinline__ void tail_job(const Ctx& c, LAS unsigned char* lds, int layer) {
    constexpr int K = MODE == 3 ? DFF : DM, KW = K / 8;
    const bf16_t* A = MODE == 1 ? c.MIX : c.ACT;
    const bf16_t* Bt = wptr(c, layer, MODE == 1 ? W_OUT : W_DN);
    float* ssq = MODE == 1 ? c.sumsq + (size_t)(2 + layer) * MALLOC : (layer == 0 ? c.sumsq + (size_t)MALLOC : nullptr);
    int tid_ = threadIdx.x; asm volatile("" : "+v"(tid_)); const int tid = tid_, lane = tid & 63, w = __builtin_amdgcn_readfirstlane(tid >> 6);
    const int fr = lane & 15, g = lane >> 4;
    LAS float* P = (LAS float*)lds;
    for (int job = blockIdx.x; job < 256; job += gridDim.x) {
        const int tm = job >> 4, tn = job & 15, row0 = 16384 + tm * 16, col0 = tn * 64;
        f32x4 acc[4];
#pragma unroll
        for (int n = 0; n < 4; ++n) acc[n] = (f32x4){0.f, 0.f, 0.f, 0.f};
        const bf16_t* ap = A + (size_t)(row0 + fr) * K + w * KW + 8 * g;
        const bf16_t* bp = Bt + (size_t)(col0 + fr) * K + w * KW + 8 * g;
#pragma unroll 4
        for (int k0 = 0; k0 < KW; k0 += 32) {
            const bf16x8 a = *(const bf16x8*)(ap + k0);
#pragma unroll
            for (int n = 0; n < 4; ++n) { const bf16x8 b = *(const bf16x8*)(bp + (size_t)n * 16 * K + k0); acc[n] = __builtin_amdgcn_mfma_f32_16x16x32_bf16(a, b, acc[n], 0, 0, 0); }
        }
#pragma unroll
        for (int n = 0; n < 4; ++n)
#pragma unroll
            for (int j = 0; j < 4; ++j) P[(w * 16 + 4 * g + j) * 64 + 16 * n + fr] = acc[n][j];
        __syncthreads();
        { const int row = tid >> 5, c2 = (tid & 31) * 2; float s0 = 0.f, s1 = 0.f;
#pragma unroll
          for (int ww = 0; ww < 8; ++ww) { s0 += P[(ww * 16 + row) * 64 + c2]; s1 += P[(ww * 16 + row) * 64 + c2 + 1]; }
          const int r = row0 + row; float* hp = hrow(c, r) + col0 + c2;
          const float h0 = hp[0] + s0, h1 = hp[1] + s1; hp[0] = h0; hp[1] = h1;
          *(unsigned*)(c.HB + (size_t)r * DM + col0 + c2) = pk2(h0, h1);
          if (ssq) { float q = h0 * h0 + h1 * h1; q += __shfl_xor(q, 1); q += __shfl_xor(q, 2); q += __shfl_xor(q, 4); q += __shfl_xor(q, 8); q += __shfl_xor(q, 16); if ((tid & 31) == 0) atomicAdd(ssq + r, q); } }
        __syncthreads();
    }
}

template <int MODE>
__device__ __forceinline__ void gemm_fast(const Ctx& c, LAS unsigned char* lds, int layer, unsigned skip = 0u) {
    const bf16_t* A = MODE == 0 ? c.HB : MODE == 1 ? c.MIX : MODE == 2 ? c.HB : c.ACT;
    const bf16_t* Bt = wptr(c, layer, MODE == 0 ? W_IN : MODE == 1 ? W_OUT : MODE == 2 ? W_GU : W_DN);
    constexpr int K = MODE == 3 ? DFF : DM;
    constexpr int N = MODE == 0 ? NINP : MODE == 2 ? 2 * DFF : DM;
    int bx_ = blockIdx.x; asm volatile("" : "+s"(bx_));
    constexpr int MG = (MODE == 1 || MODE == 3) ? 16384 : MROWS;
    pg8::Gemm g{A, Bt, MG, N, K}; pg8::StaticOrder S; S.init(MG, N, (int)gridDim.x, bx_);
    if constexpr (MODE == 0) {
        pg8::EpiInProj E{c.sumsq + (size_t)layer * MALLOC, layer ? c.lbv : nullptr, c.QB, c.KB, c.VB, c.HXQ, c.HV, c.HG, c.LOGF, c.fbias + layer * 8, c.logf8};
        pg8::gemm_phase<pg8::EpiInProj, pg8::StaticOrder, true, true>(lds, g, S, E);
    } else if constexpr (MODE == 2) {
        pg8::EpiSwiGLU E{c.sumsq + (size_t)(2 + layer) * MALLOC, c.ACT};
        pg8::gemm_phase<pg8::EpiSwiGLU, pg8::StaticOrder, true, true>(lds, g, S, E);
    } else {
        pg8::EpiResid E{c.out, c.hs, c.HB, MODE == 1 ? c.sumsq + (size_t)(2 + layer) * MALLOC : (layer == 0 ? c.sumsq + (size_t)MALLOC : nullptr), skip};
        pg8::gemm_phase<pg8::EpiResid, pg8::StaticOrder, true, true>(lds, g, S, E);
        if (!skip) tail_job<MODE>(c, lds, layer);
    }
}

#include <hip/hip_bf16.h>
#include <cmath>
namespace attn_body {
using bf16=__hip_bfloat16;
using bf16x8=__attribute__((ext_vector_type(8)))short;
using s16x4=__attribute__((ext_vector_type(4)))short;
using f32x16=__attribute__((ext_vector_type(16)))float;
using u32x4=__attribute__((ext_vector_type(4)))unsigned;
constexpr int BATCH=4,NHEAD=8,SEQ=4160,D=64,DM=NHEAD*D,OP=1024;
constexpr int NW=8,QBLK=32,QB=QBLK*NW,KVBLK=64,NQB=17;
constexpr int ATTN_PITCH=DM, ATTN_UNIT_ROWS=QB;
__device__ __forceinline__ int crow(int r,int hi){return (r&3)+8*(r>>2)+4*hi;}
#define SBAR() __builtin_amdgcn_sched_barrier(0)
__device__ __forceinline__ void cmask(f32x16&p0,f32x16&p1,int jb,int qrel,int hi){
  const float NEG=-INFINITY; int kb=64*jb+4*hi;
  #pragma unroll
  for(int r=0;r<16;++r){int kv=kb+(r&3)+8*(r>>2); if(kv>qrel)p0[r]=NEG; if(kv+32>qrel)p1[r]=NEG;}
}

constexpr int NSLOT=3, SLOTB=8192;
constexpr int LDS_K=0, LDS_V=NSLOT*SLOTB, LDS_WS=2*NSLOT*SLOTB, LDS_OST=LDS_WS+NW*64*4, LDS_KB=LDS_OST+NW*4096, LDS_BYTES=LDS_KB+4352*4+256;
constexpr float C2=0.125f*1.4426950408889634f;
__device__ __forceinline__ void glds16(const void*gsrc,unsigned lds_dst){unsigned keep;
  asm volatile("s_mov_b32 %0, m0\n\ts_mov_b32 m0, %2\n\ts_nop 0\n\tglobal_load_lds_dwordx4 %1, off\n\ts_mov_b32 m0, %0":"=&s"(keep):"v"(gsrc),"s"(lds_dst):"memory");}
__device__ __forceinline__ float max3f(float a,float b,float c){float r;asm("v_max3_f32 %0, %1, %2, %3":"=v"(r):"v"(a),"v"(b),"v"(c));return r;}
__device__ __forceinline__ float max2f(float a,float b){float r;asm("v_max_f32_e32 %0, %1, %2":"=v"(r):"v"(a),"v"(b));return r;}
__device__ __forceinline__ float fadd_s(float a,float b){float r;asm("v_add_f32_e32 %0, %1, %2":"=v"(r):"v"(a),"v"(b));return r;}
__device__ __forceinline__ float fsub_s(float a,float b){float r;asm("v_sub_f32_e32 %0, %1, %2":"=v"(r):"v"(a),"v"(b));return r;}
typedef float f32x2_t __attribute__((ext_vector_type(2))); typedef __bf16 bf16x2_t __attribute__((ext_vector_type(2)));
__device__ __forceinline__ unsigned cvtpk_s(float lo,float hi){f32x2_t v={lo,hi};bf16x2_t b=__builtin_convertvector(v,bf16x2_t);return __builtin_bit_cast(unsigned,b);}
#define WAIT_BAR(N) asm volatile("s_waitcnt vmcnt(" #N ") lgkmcnt(0)\n\ts_barrier":::"memory")

__device__ __forceinline__ void qkt(f32x16&p0,f32x16&p1,const char*Kslot,const bf16x8*qr,int r32,int hi){
  const char*kb=Kslot+hi*1024+r32*16;
  #pragma unroll
  for(int d0=0;d0<4;++d0){
    const bf16x8 b0=*reinterpret_cast<const bf16x8*>(kb+d0*2048);
    const bf16x8 b1=*reinterpret_cast<const bf16x8*>(kb+d0*2048+512);
    p0=__builtin_amdgcn_mfma_f32_32x32x16_bf16(b0,qr[d0],p0,0,0,0);p1=__builtin_amdgcn_mfma_f32_32x32x16_bf16(b1,qr[d0],p1,0,0,0);}
}
typedef __attribute__((address_space(3))) const char* lds_cptr;
typedef short v4i16_t __attribute__((ext_vector_type(4)));
__device__ __forceinline__ void kload8(bf16x8*kf,lds_cptr kp){
  kf[0]=*(const __attribute__((address_space(3))) bf16x8*)(kp);      kf[1]=*(const __attribute__((address_space(3))) bf16x8*)(kp+512);
  kf[2]=*(const __attribute__((address_space(3))) bf16x8*)(kp+2048); kf[3]=*(const __attribute__((address_space(3))) bf16x8*)(kp+2560);
  kf[4]=*(const __attribute__((address_space(3))) bf16x8*)(kp+4096); kf[5]=*(const __attribute__((address_space(3))) bf16x8*)(kp+4608);
  kf[6]=*(const __attribute__((address_space(3))) bf16x8*)(kp+6144); kf[7]=*(const __attribute__((address_space(3))) bf16x8*)(kp+6656);
}
__device__ __forceinline__ void kload2(bf16x8*kf,lds_cptr kp,int j){ kf[2*j]=*(const __attribute__((address_space(3))) bf16x8*)(kp+j*2048); kf[2*j+1]=*(const __attribute__((address_space(3))) bf16x8*)(kp+j*2048+512); }
__device__ __forceinline__ s16x4 vtr(lds_cptr p){ return __builtin_bit_cast(s16x4,__builtin_amdgcn_ds_read_tr16_b64_v4i16((__attribute__((address_space(3))) v4i16_t*)p)); }
__device__ __forceinline__ float rowmax(const f32x16&p0,const f32x16&p1){
  float a=max3f(p0[0],p0[1],p1[0]),b=max3f(p0[2],p0[3],p1[1]);a=max3f(a,p1[2],p1[3]);
  #pragma unroll
  for(int r=4;r<16;r+=4){a=max3f(a,p0[r],p0[r+1]);b=max3f(b,p0[r+2],p0[r+3]);a=max3f(a,p1[r],p1[r+1]);b=max3f(b,p1[r+2],p1[r+3]);}
  const float m=max2f(a,b);
  auto rr=__builtin_amdgcn_permlane32_swap(__float_as_uint(m),__float_as_uint(m),false,false);
  return max2f(__uint_as_float(rr[0]),__uint_as_float(rr[1]));
}
__device__ __forceinline__ void pv(f32x16*o,int vb,bf16x8 pa0,bf16x8 pa1,bf16x8 pa2,bf16x8 pa3){
  #pragma unroll
  for(int d0=0;d0<2;++d0){s16x4 lo[4],hi[4];
    #pragma unroll
    for(int ks=0;ks<4;++ks){
      asm volatile("ds_read_b64_tr_b16 %0,%1 offset:%c2":"=&v"(lo[ks]):"v"(vb),"i"(d0*4096+ks*1024):"memory");
      asm volatile("ds_read_b64_tr_b16 %0,%1 offset:%c2":"=&v"(hi[ks]):"v"(vb),"i"(d0*4096+ks*1024+512):"memory");}
    asm volatile("s_waitcnt lgkmcnt(0)":::"memory");SBAR();
    #define PK(k) (bf16x8){lo[k][0],lo[k][1],lo[k][2],lo[k][3],hi[k][0],hi[k][1],hi[k][2],hi[k][3]}
    o[d0]=__builtin_amdgcn_mfma_f32_32x32x16_bf16(pa0,PK(0),o[d0],0,0,0);
    o[d0]=__builtin_amdgcn_mfma_f32_32x32x16_bf16(pa1,PK(1),o[d0],0,0,0);
    o[d0]=__builtin_amdgcn_mfma_f32_32x32x16_bf16(pa2,PK(2),o[d0],0,0,0);
    o[d0]=__builtin_amdgcn_mfma_f32_32x32x16_bf16(pa3,PK(3),o[d0],0,0,0);
    #undef PK
  }
}

#ifndef ATTN_STORE16
#define ATTN_STORE16(p,v) (*(u32x4*)(p)=(v))
#endif
template<int THRL> __device__ __forceinline__ void attn_unit(int b,int h,int qb,const bf16*Q,const bf16*__restrict__ K,const bf16*__restrict__ V,bf16*O,const float*__restrict__ kbg,const unsigned*__restrict__ kn2p,char*shm){
  int tid_=threadIdx.x; asm volatile("":"+v"(tid_)); const int tid=tid_,lane=tid&63,r32=lane&31,hi=lane>>5; const int wid=__builtin_amdgcn_readfirstlane(tid>>6);
  const long rowbase=(long)b*SEQ; const int q0=qb*QB;
  const bf16*Qw=Q+(rowbase+q0+wid*QBLK)*DM+h*D;
  const bf16*Kh=K+rowbase*DM+h*D,*Vh=V+rowbase*DM+h*D;
  const unsigned lds0=(unsigned)(uintptr_t)shm;
  float*wsf=(float*)(shm+LDS_WS)+wid*64;
  const bf16*ksrc=Kh+(long)lane*DM+wid*8;
  const bf16*vsrc=Vh+(long)(16*(wid&3)+(lane>>2))*DM+(wid>>2)*32+(lane&3)*8;
  const unsigned kdst=lds0+LDS_K+wid*1024, vdst=lds0+LDS_V+wid*1024;
  #define DMA_K(t,slot) glds16(ksrc+(long)(NT-1-(t))*KVBLK*DM,(unsigned)__builtin_amdgcn_readfirstlane(kdst+(slot)))
  #define DMA_V(t,slot) glds16(vsrc+(long)(NT-1-(t))*KVBLK*DM,(unsigned)__builtin_amdgcn_readfirstlane(vdst+(slot)))
  const int vb0=(int)(lds0+LDS_V)+((lane>>4)&1)*32+(lane&3)*8+(4*hi+((lane&15)>>2))*64;
  const char*Kbase=shm+LDS_K; bf16x8 kf[8];
  const lds_cptr shm3=(lds_cptr)shm; const lds_cptr kp0=shm3+LDS_K+hi*1024+r32*16; const lds_cptr vp0=shm3+LDS_V+((lane>>4)&1)*32+(lane&3)*8+(4*hi+((lane&15)>>2))*64;
  const int NT=(q0+QB)/KVBLK;
  typedef __attribute__((address_space(3))) float lds_f32; typedef float kb4_t __attribute__((ext_vector_type(4)));
  { lds_f32*kw=(lds_f32*)(shm3+LDS_KB); float kv_[9];
    _Pragma("unroll") for(int j=0;j<9;++j){const int i=tid+j*NW*64; kv_[j]=(i<NT*KVBLK)?kbg[i]:0.f;}
    _Pragma("unroll") for(int j=0;j<9;++j){const int i=tid+j*NW*64; if(i<NT*KVBLK)kw[i]=kv_[j];} }
  const __attribute__((address_space(3))) kb4_t*kbl=(const __attribute__((address_space(3))) kb4_t*)(shm3+LDS_KB)+hi;
  #define KBLOAD(P0,P1,t) do{ const __attribute__((address_space(3))) kb4_t*kb_=kbl+16*(NT-1-(t)); \
    _Pragma("unroll") for(int g_=0;g_<4;++g_){ const kb4_t a_=kb_[2*g_], b_=kb_[2*g_+8]; \
      P0[4*g_]=a_[0];P0[4*g_+1]=a_[1];P0[4*g_+2]=a_[2];P0[4*g_+3]=a_[3]; P1[4*g_]=b_[0];P1[4*g_+1]=b_[1];P1[4*g_+2]=b_[2];P1[4*g_+3]=b_[3]; } }while(0)
  DMA_K(0,0);DMA_V(0,0);DMA_K(1,SLOTB);
  bf16x8 qr[4];
  #pragma unroll
  for(int d0=0;d0<4;++d0)qr[d0]=*reinterpret_cast<const bf16x8*>(&Qw[(long)r32*DM+d0*16+hi*8]);
  float mhat=0.f,l_reg=0.f;f32x16 o[2];o[0]=f32x16{};o[1]=f32x16{};
  const int qrel=wid*QBLK+r32;
  #define CMASK(P0,P1,t) do{ if((t)<4)cmask(P0,P1,3-(t),qrel,hi); }while(0)
  bool resc=false;
  #define START(P0,P1) do{ const float rm=rowmax(P0,P1); resc=false; \
    { const float dl=(rm==-INFINITY)?-1.0e4f:rm; mhat=fadd_s(mhat,dl); \
      _Pragma("unroll") for(int r=0;r<16;++r){P0[r]=fsub_s(P0[r],dl);P1[r]=fsub_s(P1[r],dl);} } \
    _Pragma("unroll") for(int r=0;r<16;++r)P0[r]=__builtin_amdgcn_exp2f(P0[r]); }while(0)
  #define RESC() do{ if(resc){ asm volatile("s_waitcnt lgkmcnt(0)":::"memory"); \
      _Pragma("unroll") for(int d_=0;d_<2;++d_) _Pragma("unroll") for(int r=0;r<16;++r)o[d_][r]*=wsf[crow(r,hi)]; } }while(0)
  f32x16 pA0,pA1,pB0,pB1;
  int sl_prev=0,sl_cur=0,sl_next=SLOTB;
  #define ROT() do{sl_prev=sl_cur;sl_cur=sl_next;sl_next=(sl_next==(NSLOT-1)*SLOTB)?0:sl_next+SLOTB;}while(0)
  DMA_K(2,2*SLOTB);
  {
    float s_=0.f;
    _Pragma("unroll") for(int d0=0;d0<4;++d0) _Pragma("unroll") for(int e_=0;e_<8;++e_){ const float x_=__builtin_bit_cast(float,(unsigned)(unsigned short)qr[d0][e_]<<16); s_+=x_*x_; }
    { auto rr_=__builtin_amdgcn_permlane32_swap(__float_as_uint(s_),__float_as_uint(s_),false,false); s_=__uint_as_float(rr_[0])+__uint_as_float(rr_[1]); }
    _Pragma("unroll") for(int o_=1;o_<32;o_<<=1) s_=fmaxf(s_,__shfl_xor(s_,o_));
    if(lane==0)wsf[0]=s_; }
  WAIT_BAR(3);
  int NTe=NT;
  { const float*wl_=(const float*)(shm+LDS_WS); float q2_=0.f;
    _Pragma("unroll") for(int w_=0;w_<NW;++w_) q2_=fmaxf(q2_,wl_[w_*64]);
    const float qk_=sqrtf(q2_*__uint_as_float(*kn2p));
    const lds_f32*kbs_=(const lds_f32*)(shm3+LDS_KB);
    const float thr_=kbs_[q0]-(64.f+(float)THRL+8.f+2.f*qk_);
    const int T0_=lane, T1_=lane+64;
    const bool c0_=(T0_<NT-4)&&(kbs_[64*T0_+63]<thr_), c1_=(T1_<NT-4)&&(kbs_[64*T1_+63]<thr_);
    const int cut_=(__popcll(__ballot(c0_))+__popcll(__ballot(c1_)))&~1;
    NTe=NT-cut_; }
  KBLOAD(pA0,pA1,0);
  qkt(pA0,pA1,Kbase,qr,r32,hi);asm volatile("s_nop 15\n\ts_nop 7":"+v"(pA0),"+v"(pA1));CMASK(pA0,pA1,0);
  START(pA0,pA1);
  _Pragma("unroll") for(int r=0;r<16;++r)pA1[r]=__builtin_amdgcn_exp2f(pA1[r]);
  KBLOAD(pB0,pB1,1);
  _Pragma("unroll") for(int r=0;r<16;++r){pB0[r]-=mhat;pB1[r]-=mhat;}
  WAIT_BAR(0);
  DMA_K(3,0);DMA_V(1,SLOTB);
  ROT();
  kload8(kf,kp0+sl_cur);
  WAIT_BAR(2);
  s16x4 vlo[8],vhi[8]; u32x4 pw0,pw1,pw2,pw3;
  #define PKW(P,B) cvtpk_s(P[B],P[B+1])
  #define PAF(k) __builtin_bit_cast(bf16x8,pw##k)
  #define VFR(i) (bf16x8){vlo[i][0],vlo[i][1],vlo[i][2],vlo[i][3],vhi[i][0],vhi[i][1],vhi[i][2],vhi[i][3]}
  #define PIN(x) asm volatile("":"+v"(x))
  #define MX3(a,b,c) __builtin_fmaxf(__builtin_fmaxf((a),(b)),(c))
  #define GAPA(MF,A0,A1,A2,A3,W0,W1,PW) do{ MF; sacc+=A0; sacc+=A1; sacc+=A2; sacc+=A3; PIN(sacc); W0; W1; PIN(PW); SBAR(); }while(0)
  #define EX(v) __builtin_amdgcn_exp2f(v)
  #define GAPB(MF,X,B,Y) do{ MF; X[B]=EX(X[B]); X[B+1]=EX(X[B+1]); X[B+2]=EX(X[B+2]); X[B+3]=EX(X[B+3]); PIN(X); Y[B]-=mhat; Y[B+1]-=mhat; Y[B+2]-=mhat; Y[B+3]-=mhat; SBAR(); }while(0)
  #define VRD(i) do{ vlo[i]=vtr(vp_+(((i)>>2)*4096+((i)&3)*1024)); vhi[i]=vtr(vp_+(((i)>>2)*4096+((i)&3)*1024+512)); }while(0)
  #define KRD(G,j) do{ if(G){ kload2(kf,kp0+sl_next,j); SBAR(); } }while(0)
  #define STEP(C0,C1,P0,P1,t,GK,GV,GL) do{ SBAR(); \
    const lds_cptr vp_=vp0+sl_prev; \
    VRD(0); SBAR(); float sacc=(P0[0]+P0[1]); \
    GAPA(C0=__builtin_amdgcn_mfma_f32_32x32x16_bf16(kf[0],qr[0],C0,0,0,0), P0[2],P0[3],P0[4],P0[5],     pw0[0]=PKW(P0,0), pw0[1]=PKW(P0,2), pw0); \
    VRD(4); SBAR(); GAPA(C1=__builtin_amdgcn_mfma_f32_32x32x16_bf16(kf[1],qr[0],C1,0,0,0), P0[6],P0[7],P0[8],P0[9],     pw0[2]=PKW(P0,4), pw0[3]=PKW(P0,6), pw0); \
    VRD(1); SBAR(); GAPA(C0=__builtin_amdgcn_mfma_f32_32x32x16_bf16(kf[2],qr[1],C0,0,0,0),   P0[10],P0[11],P0[12],P0[13], pw1[0]=PKW(P0,8), pw1[1]=PKW(P0,10), pw1); \
    VRD(5); SBAR(); GAPA(C1=__builtin_amdgcn_mfma_f32_32x32x16_bf16(kf[3],qr[1],C1,0,0,0),   P0[14],P0[15],P1[0],P1[1],   pw1[2]=PKW(P0,12),pw1[3]=PKW(P0,14), pw1); \
    VRD(2); SBAR(); GAPA(C0=__builtin_amdgcn_mfma_f32_32x32x16_bf16(kf[4],qr[2],C0,0,0,0),   P1[2],P1[3],P1[4],P1[5],     pw2[0]=PKW(P1,0), pw2[1]=PKW(P1,2), pw2); \
    VRD(6); SBAR(); GAPA(C1=__builtin_amdgcn_mfma_f32_32x32x16_bf16(kf[5],qr[2],C1,0,0,0),   P1[6],P1[7],P1[8],P1[9],     pw2[2]=PKW(P1,4), pw2[3]=PKW(P1,6), pw2); \
    VRD(3); SBAR(); GAPA(C0=__builtin_amdgcn_mfma_f32_32x32x16_bf16(kf[6],qr[3],C0,0,0,0),   P1[10],P1[11],P1[12],P1[13], pw3[0]=PKW(P1,8), pw3[1]=PKW(P1,10), pw3); \
    VRD(7); SBAR(); GAPA(C1=__builtin_amdgcn_mfma_f32_32x32x16_bf16(kf[7],qr[3],C1,0,0,0),   P1[14],P1[15],0.f,0.f,       pw3[2]=PKW(P1,12),pw3[3]=PKW(P1,14), pw3); \
    l_reg+=sacc; \
    KBLOAD(P0,P1,(t)+1); \
    if(GK){DMA_K((t)+3,sl_cur);} if(GV){DMA_V((t)+1,sl_next);} \
    CMASK(C0,C1,t); \
    { float a=MX3(C0[0],C0[1],C1[0]),b=MX3(C0[2],C0[3],C1[1]); a=MX3(a,C1[2],C1[3]); \
      _Pragma("unroll") for(int r=4;r<16;r+=4){a=MX3(a,C0[r],C0[r+1]);b=MX3(b,C0[r+2],C0[r+3]);a=MX3(a,C1[r],C1[r+1]);b=MX3(b,C1[r+2],C1[r+3]);} \
      float rm=__builtin_fmaxf(a,b); { auto rr=__builtin_amdgcn_permlane32_swap(__float_as_uint(rm),__float_as_uint(rm),false,false); rm=__builtin_fmaxf(__uint_as_float(rr[0]),__uint_as_float(rr[1])); } \
      resc=false; \
      if(__builtin_expect(__any(rm>(float)THRL),0)){ const float dl=__builtin_fmaxf(rm,0.f); mhat+=dl; \
        _Pragma("unroll") for(int r=0;r<16;++r){C0[r]-=dl;C1[r]-=dl;} \
        const float f=__builtin_amdgcn_exp2f(-dl); l_reg*=f; if(hi==0)wsf[r32]=f; resc=true; } } \
    SBAR(); \
    GAPB(o[0]=__builtin_amdgcn_mfma_f32_32x32x16_bf16(PAF(0),VFR(0),o[0],0,0,0), C0,0,P0); \
    GAPB(o[1]=__builtin_amdgcn_mfma_f32_32x32x16_bf16(PAF(0),VFR(4),o[1],0,0,0), C0,4,P0); \
    KRD(GL,0); GAPB(o[0]=__builtin_amdgcn_mfma_f32_32x32x16_bf16(PAF(1),VFR(1),o[0],0,0,0), C0,8,P0); \
    KRD(GL,1); GAPB(o[1]=__builtin_amdgcn_mfma_f32_32x32x16_bf16(PAF(1),VFR(5),o[1],0,0,0), C0,12,P0); \
    KRD(GL,2); GAPB(o[0]=__builtin_amdgcn_mfma_f32_32x32x16_bf16(PAF(2),VFR(2),o[0],0,0,0), C1,0,P1); \
    KRD(GL,3); GAPB(o[1]=__builtin_amdgcn_mfma_f32_32x32x16_bf16(PAF(2),VFR(6),o[1],0,0,0), C1,4,P1); \
    GAPB(o[0]=__builtin_amdgcn_mfma_f32_32x32x16_bf16(PAF(3),VFR(3),o[0],0,0,0), C1,8,P1); \
    GAPB(o[1]=__builtin_amdgcn_mfma_f32_32x32x16_bf16(PAF(3),VFR(7),o[1],0,0,0), C1,12,P1); \
    }while(0)
  int t=1;
  #undef CMASK
  #define CMASK(P0,P1,t) do{ if((t)<4)cmask(P0,P1,3-(t),qrel,hi); }while(0)
  for(;t+5<NTe;t+=2){
    STEP(pB0,pB1,pA0,pA1,t,true,true,true);     WAIT_BAR(2); RESC(); ROT();
    STEP(pA0,pA1,pB0,pB1,t+1,true,true,true);   WAIT_BAR(2); RESC(); ROT();
  }
  #undef CMASK
  #define CMASK(P0,P1,t) do{ if((t)<4)cmask(P0,P1,3-(t),qrel,hi); }while(0)
  #define ENDW(tt) do{ if((tt)+3<NTe){WAIT_BAR(2);} else if((tt)+2<NTe){WAIT_BAR(1);} else {WAIT_BAR(0);} }while(0)
  for(;t+1<NTe;t+=2){
    STEP(pB0,pB1,pA0,pA1,t,(t+3<NTe),(t+1<NTe),(t+1<NTe));       ENDW(t);   RESC(); ROT();
    STEP(pA0,pA1,pB0,pB1,t+1,(t+4<NTe),(t+2<NTe),(t+2<NTe));     ENDW(t+1); RESC(); ROT();
  }
  STEP(pB0,pB1,pA0,pA1,NTe-1,false,false,false); RESC();
  { float sacc=pB0[0]+pB0[1]; _Pragma("unroll") for(int r=2;r<16;++r)sacc+=pB0[r]; _Pragma("unroll") for(int r=0;r<16;++r)sacc+=pB1[r]; l_reg+=sacc;
    pw0=(u32x4){PKW(pB0,0),PKW(pB0,2),PKW(pB0,4),PKW(pB0,6)};pw1=(u32x4){PKW(pB0,8),PKW(pB0,10),PKW(pB0,12),PKW(pB0,14)};pw2=(u32x4){PKW(pB1,0),PKW(pB1,2),PKW(pB1,4),PKW(pB1,6)};pw3=(u32x4){PKW(pB1,8),PKW(pB1,10),PKW(pB1,12),PKW(pB1,14)};
    SBAR(); pv(o,vb0+sl_cur,PAF(0),PAF(1),PAF(2),PAF(3)); }
  #undef PKW
  #undef PAF
  #undef VFR
  #undef PIN
  #undef MX3
  #undef GAPA
  #undef GAPB
  #undef EX
  #undef VRD
  #undef KRD
  #undef STEP
  #undef ENDW
  {auto rr=__builtin_amdgcn_permlane32_swap(__float_as_uint(l_reg),__float_as_uint(l_reg),false,false);l_reg=__uint_as_float(rr[0])+__uint_as_float(rr[1]);}
  if(hi==0)wsf[32+r32]=l_reg;asm volatile("s_waitcnt lgkmcnt(0)":::"memory");
  float rli[16];
  #pragma unroll
  for(int r=0;r<16;++r){const float l_=wsf[32+crow(r,hi)]; rli[r]=l_>0.f?__builtin_amdgcn_rcpf(l_):0.f;}
  bf16*Ow=O+(rowbase+q0+wid*QBLK)*OP+h*D;
  { bf16*stg=(bf16*)(shm+LDS_OST)+wid*2048;
    #pragma unroll
    for(int r=0;r<16;++r){const int orow=crow(r,hi);
      #pragma unroll
      for(int d0=0;d0<2;++d0)stg[orow*64+d0*32+r32]=__float2bfloat16(o[d0][r]*rli[r]);}
    asm volatile("s_waitcnt lgkmcnt(0)":::"memory");
    #pragma unroll
    for(int i=0;i<4;++i){const int row=i*8+(lane>>3),ch=lane&7; const u32x4 v=*(const u32x4*)(stg+row*64+ch*8); if(q0+wid*QBLK+row<SEQ)ATTN_STORE16(Ow+(long)row*OP+ch*8,v);} }
  asm volatile("s_waitcnt lgkmcnt(0)\n\ts_barrier":::"memory");
  #undef KBLOAD
  #undef DMA_K
  #undef DMA_V
  #undef CMASK
  #undef START
  #undef RESC
  #undef ROT
}
constexpr int ATTN_LDS_BYTES=LDS_BYTES;
#undef SBAR
#undef WAIT_BAR
}

__device__ __forceinline__ void mix_queue(const Ctx& c, unsigned char* lds_generic, int layer, const bf16_t* SD, unsigned* qctr);

namespace hg {
constexpr int P = 272, PA = 144;
constexpr int O_QE = 0, O_QS = 17408, O_KS = 34816, O_VT = 52224, O_ST = 69632, O_AM = 104448, O_QT = 113664, O_RS = 115712, O_END = 117760;
typedef short v4i16_t __attribute__((ext_vector_type(4)));
__device__ __forceinline__ f32x4 mfma16(bf16x8 a, bf16x8 b, f32x4 c) { return __builtin_amdgcn_mfma_f32_16x16x32_bf16(a, b, c, 0, 0, 0); }
__device__ __forceinline__ bf16x8 tr_frag(const LAS unsigned char* p, int pitch) {
    const v4i16_t lo = __builtin_amdgcn_ds_read_tr16_b64_v4i16((LAS v4i16_t*)p);
    const v4i16_t hi = __builtin_amdgcn_ds_read_tr16_b64_v4i16((LAS v4i16_t*)(p + 4 * pitch));
    return (bf16x8){lo[0], lo[1], lo[2], lo[3], hi[0], hi[1], hi[2], hi[3]};
}
}

struct ARegs { float g[16]; u32x4 vv[2]; };
__device__ __forceinline__ void hgrn_A_load(const Ctx& c, int tid, int bh, int ch, ARegs& R) {
    const int b = bh >> 2, hh = bh & 3; const size_t r0 = (size_t)b * LV + 64 * ch;
    const int k = tid & 127, sq = tid >> 7;
    const float* gp = c.LOGF + (r0 + 16 * sq) * 512 + hh * 128 + k;
#pragma unroll
    for (int i = 0; i < 16; ++i) R.g[i] = gp[(size_t)i * 512];
#pragma unroll
    for (int i = 0; i < 2; ++i) { const int id = tid + 512 * i, row = id >> 4, cc = id & 15; R.vv[i] = *(const u32x4*)(c.HV + (r0 + row) * 512 + hh * 128 + cc * 8); }
}
__device__ __forceinline__ void hgrn_A_compute(const Ctx& c, LAS unsigned char* lds, int tid, int bh, int ch, bf16_t* SD, float* DV, const ARegs& R) {
    using namespace hg;
    const int lane = tid & 63, w = __builtin_amdgcn_readfirstlane(tid >> 6);
    const int k = tid & 127, sq = tid >> 7;
    float bl[16];
    { float s = 0.f;
#pragma unroll
      for (int i = 0; i < 16; ++i) { s += R.g[i]; bl[i] = s; }
      ((LAS float*)(lds + O_QT))[sq * 128 + k] = s; }
#pragma unroll
    for (int i = 0; i < 2; ++i) { const int id = tid + 512 * i, row = id >> 4, cc = id & 15; *(LAS u32x4*)(lds + O_VT + row * P + cc * 16) = R.vv[i]; }
    asm volatile("s_waitcnt lgkmcnt(0)\n\ts_barrier" ::: "memory");
    { const LAS float* qt = (const LAS float*)(lds + O_QT); float pre = 0.f, tot = 0.f;
#pragma unroll
      for (int q = 0; q < 4; ++q) { const float t = qt[q * 128 + k]; tot += t; if (q < sq) pre += t; }
#pragma unroll
      for (int i = 0; i < 16; ++i) { const float kd = (1.f - __expf(R.g[i])) * __expf(tot - (pre + bl[i])); *(LAS bf16_t*)(lds + O_KS + (16 * sq + i) * P + 2 * k) = (bf16_t)f2bf(kd); }
      if (sq == 0) DV[((size_t)bh * 64 + ch) * 128 + k] = __expf(tot); }
    asm volatile("s_waitcnt lgkmcnt(0)\n\ts_barrier" ::: "memory");
    const int fr = lane & 15, g4 = lane >> 4, q = fr >> 2, p = lane & 3;
    const LAS unsigned char* abase = lds + O_VT + (8 * g4 + q) * P + w * 32 + p * 8;
    const LAS unsigned char* bbase = lds + O_KS + (8 * g4 + q) * P + p * 8;
    bf16x8 a[2]; a[0] = tr_frag(abase, P); a[1] = tr_frag(abase + 32 * P, P);
    bf16_t* od = SD + ((size_t)bh * 64 + ch) * 16384 + (size_t)(16 * w + 4 * g4) * 128 + fr;
#pragma unroll
    for (int ct = 0; ct < 8; ++ct) { f32x4 acc = (f32x4){0.f, 0.f, 0.f, 0.f};
        acc = mfma16(a[0], tr_frag(bbase + ct * 32, P), acc); acc = mfma16(a[1], tr_frag(bbase + 32 * P + ct * 32, P), acc);
#pragma unroll
        for (int j = 0; j < 4; ++j) od[j * 128 + 16 * ct] = (bf16_t)f2bf(acc[j]); }
    asm volatile("s_waitcnt lgkmcnt(0)\n\ts_barrier" ::: "memory");
}
__device__ __forceinline__ void hgrn_A_phase(const Ctx& c, LAS unsigned char* lds, bf16_t* SD, float* DV) {
    int tid_ = threadIdx.x; asm volatile("" : "+v"(tid_)); const int tid = tid_;
    ARegs R;
    int u = blockIdx.x;
    if (u < 16 * 64) hgrn_A_load(c, tid, u >> 6, u & 63, R);
    for (; u < 16 * 64; u += gridDim.x) {
        const ARegs Rc = R;
        const int un = u + gridDim.x;
        if (un < 16 * 64) hgrn_A_load(c, tid, un >> 6, un & 63, R);
        hgrn_A_compute(c, lds, tid, u >> 6, u & 63, SD, DV, Rc);
    }
    __syncthreads();
}

__device__ __forceinline__ void hgrn_B_scan(const Ctx& c, bf16_t* SD, const float* DV) {
    const int gt = blockIdx.x * NTHREADS + c.tid, NGT = gridDim.x * NTHREADS;
    for (int pidx = gt; pidx < 16 * 8192; pidx += NGT) {
        const int bh = pidx >> 13, e2 = pidx & 8191, k = (e2 & 63) * 2;
        unsigned* sp = (unsigned*)(SD + (size_t)bh * 64 * 16384 + 2 * e2);
        const float* dp = DV + (size_t)bh * 64 * 128 + k;
        float s0 = 0.f, s1 = 0.f;
        for (int c0 = 0; c0 < 64; c0 += 16) {
            unsigned d[16]; float dv0[16], dv1[16];
#pragma unroll
            for (int i = 0; i < 16; ++i) { d[i] = sp[(size_t)(c0 + i) * 8192]; const float* q = dp + (c0 + i) * 128; dv0[i] = q[0]; dv1[i] = q[1]; }
#pragma unroll
            for (int i = 0; i < 16; ++i) { s0 = dv0[i] * s0 + __builtin_bit_cast(float, d[i] << 16); s1 = dv1[i] * s1 + __builtin_bit_cast(float, d[i] & 0xffff0000u);
                sp[(size_t)(c0 + i) * 8192] = pk2(s0, s1); }
        }
    }
}

struct CRegs { float g[16]; unsigned short q[16]; unsigned short gt[16]; u32x4 vv[2]; u32x4 st[4]; };
#define LBAR() asm volatile("s_waitcnt lgkmcnt(0)\n\ts_barrier" ::: "memory")
__device__ __forceinline__ void hgrn_C_load(const Ctx& c, int tid, int bh, int ch, const bf16_t* SD, CRegs& R) {
    const int lane = tid & 63, w = __builtin_amdgcn_readfirstlane(tid >> 6);
    const int b = bh >> 2, hh = bh & 3; const size_t r0 = (size_t)b * LV + 64 * ch;
    const int k = tid & 127, sq = tid >> 7, fr = lane & 15, g4 = lane >> 4;
    const float* gp = c.LOGF + (r0 + 16 * sq) * 512 + hh * 128 + k; const bf16_t* qp = c.HXQ + (r0 + 16 * sq) * 512 + hh * 128 + k;
#pragma unroll
    for (int i = 0; i < 16; ++i) { R.g[i] = gp[(size_t)i * 512]; R.q[i] = qp[(size_t)i * 512]; }
#pragma unroll
    for (int i = 0; i < 2; ++i) { const int id = tid + 512 * i, row = id >> 4, cc = id & 15; R.vv[i] = *(const u32x4*)(c.HV + (r0 + row) * 512 + hh * 128 + cc * 8); }
    if (ch > 0) { const bf16_t* sp = SD + ((size_t)bh * 64 + ch - 1) * 16384;
#pragma unroll
        for (int i = 0; i < 4; ++i) { const int id = tid + 512 * i, row = id >> 4, cc = id & 15; R.st[i] = *(const u32x4*)(sp + row * 128 + cc * 8); } }
#pragma unroll
    for (int tt = 0; tt < 4; ++tt)
#pragma unroll
        for (int j = 0; j < 4; ++j) R.gt[tt * 4 + j] = c.HG[(r0 + 16 * tt + 4 * g4 + j) * 512 + hh * 128 + 16 * w + fr];
}
__device__ __forceinline__ void hgrn_C_compute(const Ctx& c, LAS unsigned char* lds, int tid, int layer, int bh, int ch, const CRegs& R) {
    using namespace hg;
    const int lane = tid & 63, w = __builtin_amdgcn_readfirstlane(tid >> 6);
    const int b = bh >> 2, hh = bh & 3; const size_t r0 = (size_t)b * LV + 64 * ch;
    const int k = tid & 127, sq = tid >> 7;
    float bl[16];
    { float s = 0.f;
#pragma unroll
      for (int i = 0; i < 16; ++i) { s += R.g[i]; bl[i] = s; }
      ((LAS float*)(lds + O_QT))[sq * 128 + k] = s; }
#pragma unroll
    for (int i = 0; i < 2; ++i) { const int id = tid + 512 * i, row = id >> 4, cc = id & 15; *(LAS u32x4*)(lds + O_VT + row * P + cc * 16) = R.vv[i]; }
    if (ch > 0) {
#pragma unroll
        for (int i = 0; i < 4; ++i) { const int id = tid + 512 * i, row = id >> 4, cc = id & 15; *(LAS u32x4*)(lds + O_ST + row * P + cc * 16) = R.st[i]; }
    }
    LBAR();
    { const LAS float* qt = (const LAS float*)(lds + O_QT); float pre = 0.f;
#pragma unroll
      for (int q = 0; q < 4; ++q) { const float t = qt[q * 128 + k]; if (q < sq) pre += t; }
      const float rr = qt[k] + qt[128 + k];
#pragma unroll
      for (int i = 0; i < 16; ++i) { const float bb = pre + bl[i]; const int off = (16 * sq + i) * P + 2 * k; const float qv = bf2f(R.q[i]);
          *(LAS bf16_t*)(lds + O_QE + off) = (bf16_t)f2bf(qv * __expf(bb));
          *(LAS bf16_t*)(lds + O_QS + off) = (bf16_t)f2bf(qv * __expf(fminf(bb - rr, 80.f)));
          *(LAS bf16_t*)(lds + O_KS + off) = (bf16_t)f2bf((1.f - __expf(R.g[i])) * __expf(fminf(rr - bb, 80.f))); } }
    LBAR();
    const int fr = lane & 15, g4 = lane >> 4, q = fr >> 2, p = lane & 3;
#pragma unroll
    for (int tl = 0; tl < 2; ++tl) { const int tile = 2 * w + tl, ti = tile >> 2, sj = tile & 3;
        f32x4 acc = (f32x4){0.f, 0.f, 0.f, 0.f};
        if (sj <= ti) {
#pragma unroll
            for (int ks = 0; ks < 4; ++ks) { const bf16x8 a = *(const LAS bf16x8*)(lds + O_QS + (16 * ti + fr) * P + (32 * ks + 8 * g4) * 2);
                const bf16x8 bb = *(const LAS bf16x8*)(lds + O_KS + (16 * sj + fr) * P + (32 * ks + 8 * g4) * 2); acc = mfma16(a, bb, acc); } }
#pragma unroll
        for (int j = 0; j < 4; ++j) { const int t = 16 * ti + 4 * g4 + j, s = 16 * sj + fr; const float v = (s <= t) ? acc[j] : 0.f; *(LAS bf16_t*)(lds + O_AM + t * PA + 2 * s) = (bf16_t)f2bf(v); } }
    LBAR();
    f32x4 acc[4];
#pragma unroll
    for (int tt = 0; tt < 4; ++tt) acc[tt] = (f32x4){0.f, 0.f, 0.f, 0.f};
    if (ch > 0) {
#pragma unroll
        for (int ks = 0; ks < 4; ++ks) { const bf16x8 bfr = *(const LAS bf16x8*)(lds + O_ST + (16 * w + fr) * P + (32 * ks + 8 * g4) * 2);
#pragma unroll
            for (int tt = 0; tt < 4; ++tt) { const bf16x8 a = *(const LAS bf16x8*)(lds + O_QE + (16 * tt + fr) * P + (32 * ks + 8 * g4) * 2); acc[tt] = mfma16(a, bfr, acc[tt]); } }
    }
#pragma unroll
    for (int ks = 0; ks < 2; ++ks) { const bf16x8 bfr = tr_frag(lds + O_VT + (32 * ks + 8 * g4 + q) * P + w * 32 + p * 8, P);
#pragma unroll
        for (int tt = 0; tt < 4; ++tt) { const bf16x8 a = *(const LAS bf16x8*)(lds + O_AM + (16 * tt + fr) * PA + (32 * ks + 8 * g4) * 2); acc[tt] = mfma16(a, bfr, acc[tt]); } }
    LAS float* rs = (LAS float*)(lds + O_RS);
#pragma unroll
    for (int tt = 0; tt < 4; ++tt)
#pragma unroll
        for (int j = 0; j < 4; ++j) { float s2 = acc[tt][j] * acc[tt][j]; s2 += __shfl_xor(s2, 1); s2 += __shfl_xor(s2, 2); s2 += __shfl_xor(s2, 4); s2 += __shfl_xor(s2, 8);
            if (fr == 0) rs[(16 * tt + 4 * g4 + j) * 8 + w] = s2; }
    LBAR();
    { const int v = 16 * w + fr; const float nw = c.hnw[layer * 128 + v];
#pragma unroll
      for (int tt = 0; tt < 4; ++tt)
#pragma unroll
        for (int j = 0; j < 4; ++j) { const int t = 16 * tt + 4 * g4 + j; const f32x4 s0 = *(const LAS f32x4*)(rs + t * 8), s1 = *(const LAS f32x4*)(rs + t * 8 + 4);
            const float ss = ((s0[0] + s0[1]) + (s0[2] + s0[3])) + ((s1[0] + s1[1]) + (s1[2] + s1[3])); const float rstd = 1.f / sqrtf(ss * (1.f / 128.f) + EPS);
            c.MIX[(r0 + t) * DM + 512 + hh * 128 + v] = (bf16_t)f2bf(acc[tt][j] * rstd * nw * bf2f(R.gt[tt * 4 + j])); } }
    LBAR();
}
__device__ __forceinline__ void hgrn_C_phase(const Ctx& c, LAS unsigned char* lds, int layer, const bf16_t* SD) {
    int tid_ = threadIdx.x; asm volatile("" : "+v"(tid_)); const int tid = tid_;
    CRegs R;
    int u = blockIdx.x;
    if (u < 16 * 65) hgrn_C_load(c, tid, u / 65, u % 65, SD, R);
    for (; u < 16 * 65; u += gridDim.x) {
        const CRegs Rc = R;
        const int un = u + gridDim.x;
        if (un < 16 * 65) hgrn_C_load(c, tid, un / 65, un % 65, SD, R);
        hgrn_C_compute(c, lds, tid, layer, u / 65, u % 65, Rc);
    }
    __syncthreads();
}

__device__ __forceinline__ void mix_queue(const Ctx& c, unsigned char* lds_generic, int layer, const bf16_t* SD, unsigned* qctr) {
    LAS volatile int* slot = (LAS volatile int*)((LAS unsigned char*)lds_generic + 131072);
    for (;;) {
        if (c.tid == 0) slot[0] = (int)atomicAdd(qctr, 1u);
        __syncthreads();
        const int n = slot[0];
        if (n >= 17 * 32) break;
        const int qb = 16 - (n >> 5), bh = n & 31;
        attn_body::attn_unit<8>(bh >> 3, bh & 7, qb, (const attn_body::bf16*)c.QB, (const attn_body::bf16*)c.KB, (const attn_body::bf16*)c.VB, (attn_body::bf16*)c.MIX,
                                c.kbias + (size_t)bh * KBL, c.ctl + 1024 + layer * 32 + bh, (char*)lds_generic);
    }
}

__device__ __forceinline__ void knorm_job(const Ctx& c, int layer, int job) {
    const int bh = job >> 3, sl = job & 7, b = bh >> 3, h = bh & 7;
    const int sub = c.tid & 7, rloc = c.tid >> 3;
    u32x4 kv[9];
#pragma unroll
    for (int i = 0; i < 9; ++i) { const int vp = sl * 520 + i * 64 + rloc; kv[i] = (i * 64 + rloc < 520) ? *(const u32x4*)(c.KB + (size_t)(b * LV + vp) * 512 + h * 64 + sub * 8) : (u32x4){0u, 0u, 0u, 0u}; }
    float m = 0.f;
#pragma unroll
    for (int i = 0; i < 9; ++i) { float s = 0.f;
#pragma unroll
        for (int e = 0; e < 4; ++e) { const float lo = __builtin_bit_cast(float, kv[i][e] << 16), hi = __builtin_bit_cast(float, kv[i][e] & 0xffff0000u); s += lo * lo + hi * hi; }
        s += __shfl_xor(s, 1); s += __shfl_xor(s, 2); s += __shfl_xor(s, 4); m = fmaxf(m, s); }
    m = wave_max(m);
    if (c.lane == 0) atomicMax(c.ctl + 1024 + layer * 32 + bh, __float_as_uint(m));
}

__device__ __forceinline__ void fox_simple(const Ctx& c, LAS unsigned char* lds, int first_block) {
    LAS float* sc = (LAS float*)(lds + c.wave * 16896);
    LAS float* qs = sc; LAS float* ps = sc + 64;
    const int nblk = gridDim.x - first_block; if ((int)blockIdx.x < first_block) return;
    const int gw = ((int)blockIdx.x - first_block) * NWAVES + c.wave, NGW = nblk * NWAVES;
    for (int it = gw; it < MROWS * FOXH; it += NGW) {
        const int r = it >> 3, h = it & 7, b = r / LV, vp = r - b * LV;
        bf16_t* op = c.MIX + (size_t)r * DM + h * 64;
        if (vp < PADF) { op[c.lane] = 0; continue; }
        qs[c.lane] = bf2f(c.QB[(size_t)r * 512 + h * 64 + c.lane]);
        asm volatile("s_waitcnt lgkmcnt(0)" ::: "memory");
        const float* kb = c.kbias + (size_t)(b * 8 + h) * KBL;
        float mx = -3.0e38f;
        for (int j = PADF + c.lane; j <= vp; j += 64) {
            const bf16_t* kr = c.KB + (size_t)(b * LV + j) * 512 + h * 64; float s = 0.f;
#pragma unroll
            for (int d8 = 0; d8 < 8; ++d8) { const bf16x8 kv = *(const bf16x8*)(kr + d8 * 8);
#pragma unroll
                for (int e = 0; e < 8; ++e) s += qs[d8 * 8 + e] * bf2f((unsigned short)kv[e]); }
            s += kb[j]; ps[j] = s; mx = fmaxf(mx, s);
        }
        mx = wave_max(mx);
        float l = 0.f;
        for (int j = PADF + c.lane; j <= vp; j += 64) { const float p = exp2f(ps[j] - mx); ps[j] = p; l += p; }
        l = wave_sum(l);
        asm volatile("s_waitcnt lgkmcnt(0)" ::: "memory");
        float o = 0.f;
        const bf16_t* vr = c.VB + (size_t)(b * LV) * 512 + h * 64 + c.lane;
        for (int j = PADF; j <= vp; ++j) o += ps[j] * bf2f(vr[(size_t)j * 512]);
        op[c.lane] = (bf16_t)f2bf(o / l);
        asm volatile("s_waitcnt lgkmcnt(0)" ::: "memory");
    }
}

__device__ __forceinline__ void hgrn_simple(const Ctx& c, LAS unsigned char* lds, int layer) {
    if (blockIdx.x >= NB * HGH) return;
    const int b = blockIdx.x >> 2, hh = blockIdx.x & 3;
    LAS float* fL = (LAS float*)lds;
    LAS float* kL = fL + 2048; LAS float* qL = kL + 2048; LAS float* vL = qL + 2048; LAS float* oP = vL + 2048;
    const int v = c.tid & 127, kg = c.tid >> 7;
    float S[32];
#pragma unroll
    for (int i = 0; i < 32; ++i) S[i] = 0.f;
    for (int i = c.tid; i < PADF * 128; i += NTHREADS) { const int vp = i >> 7; c.MIX[(size_t)(b * LV + vp) * DM + 512 + hh * 128 + (i & 127)] = 0; }
    for (int t0 = PADF; t0 < LV; t0 += 16) {
        for (int i = c.tid; i < 2048; i += NTHREADS) { const int t = i >> 7, k = i & 127; const size_t o = (size_t)(b * LV + t0 + t) * 512 + hh * 128 + k;
            const float f = __expf(c.LOGF[o]); fL[i] = f; kL[i] = 1.f - f; qL[i] = bf2f(c.HXQ[o]); vL[i] = bf2f(c.HV[o]); }
        __syncthreads();
        for (int t = 0; t < 16; ++t) { const float vv = vL[t * 128 + v]; float part = 0.f;
#pragma unroll
            for (int i = 0; i < 32; ++i) { const int k = kg * 32 + i; S[i] = fL[t * 128 + k] * S[i] + kL[t * 128 + k] * vv; part += S[i] * qL[t * 128 + k]; }
            oP[(kg * 16 + t) * 128 + v] = part; }
        __syncthreads();
        for (int tt = 0; tt < 2; ++tt) { const int t = c.wave * 2 + tt; float o0, o1;
            { const int v0 = c.lane, v1 = c.lane + 64; o0 = oP[t * 128 + v0] + oP[(16 + t) * 128 + v0] + oP[(32 + t) * 128 + v0] + oP[(48 + t) * 128 + v0];
              o1 = oP[t * 128 + v1] + oP[(16 + t) * 128 + v1] + oP[(32 + t) * 128 + v1] + oP[(48 + t) * 128 + v1]; }
            const float ss = wave_sum(o0 * o0 + o1 * o1); const float rstd = 1.f / sqrtf(ss * (1.f / 128.f) + EPS);
            const size_t ro = (size_t)(b * LV + t0 + t);
            const float g0 = bf2f(c.HG[ro * 512 + hh * 128 + c.lane]), g1 = bf2f(c.HG[ro * 512 + hh * 128 + c.lane + 64]);
            c.MIX[ro * DM + 512 + hh * 128 + c.lane] = (bf16_t)f2bf(o0 * rstd * c.hnw[layer * 128 + c.lane] * g0);
            c.MIX[ro * DM + 512 + hh * 128 + c.lane + 64] = (bf16_t)f2bf(o1 * rstd * c.hnw[layer * 128 + c.lane + 64] * g1); }
        __syncthreads();
    }
}

__device__ __forceinline__ void final_norm(const Ctx& c) {
    f32x4 w[4];
#pragma unroll
    for (int j = 0; j < 4; ++j) w[j] = *(const f32x4*)(c.nfinal + 4 * c.lane + 256 * j);
    for (int rb = c.gw; rb < NB * SEQ; rb += 4 * c.NGW) {
        f32x4 v[4][4];
#pragma unroll
        for (int q = 0; q < 4; ++q) { const int r = rb + q * c.NGW;
            if (r < NB * SEQ) {
#pragma unroll
                for (int j = 0; j < 4; ++j) v[q][j] = *(const f32x4*)(c.out + (size_t)r * DM + 4 * c.lane + 256 * j); } }
#pragma unroll
        for (int q = 0; q < 4; ++q) { const int r = rb + q * c.NGW;
            if (r < NB * SEQ) { float s = 0.f;
#pragma unroll
                for (int j = 0; j < 4; ++j) s += (v[q][j].x * v[q][j].x + v[q][j].y * v[q][j].y) + (v[q][j].z * v[q][j].z + v[q][j].w * v[q][j].w);
                s = wave_sum(s); const float rstd = 1.f / sqrtf(s * (1.f / DM) + EPS);
#pragma unroll
                for (int j = 0; j < 4; ++j) *(f32x4*)(c.out + (size_t)r * DM + 4 * c.lane + 256 * j) = v[q][j] * rstd * w[j]; } }
    }
}

__global__ void __launch_bounds__(NTHREADS, 2) fwd_kernel(Args a) {
    extern __shared__ __attribute__((aligned(16))) unsigned char lds_raw[];
    LAS unsigned char* lds = (LAS unsigned char*)lds_raw;
    cg::grid_group grid = cg::this_grid();
    Ctx c;
    c.x = a.in[0]; c.meta = a.in[1]; c.nmw = a.in[2]; c.win = a.in[3]; c.fbias = a.in[4]; c.lbraw = a.in[5]; c.hnw = a.in[6]; c.wout = a.in[7];
    c.nfw = a.in[8]; c.wg = a.in[9]; c.wu = a.in[10]; c.wd = a.in[11]; c.nfinal = a.in[12];
    c.out = a.out; c.ws = a.ws;
    c.ctl = (unsigned*)(a.ws + WS_CTL); c.sumsq = (float*)(a.ws + WS_SUMSQ); c.lbv = (float*)(a.ws + WS_LBV); c.logf8 = (float*)(a.ws + WS_LOGF8);
    c.kbias = (float*)(a.ws + WS_KBIAS); c.hs = (float*)(a.ws + WS_HS);
    c.HB = (bf16_t*)(a.ws + WS_HB); c.MIX = (bf16_t*)(a.ws + WS_MIX); c.QB = (bf16_t*)(a.ws + WS_QB); c.KB = (bf16_t*)(a.ws + WS_KB); c.VB = (bf16_t*)(a.ws + WS_VB);
    c.HXQ = (bf16_t*)(a.ws + WS_HXQ); c.LOGF = (float*)(a.ws + WS_LOGF); c.HV = (bf16_t*)(a.ws + WS_HV); c.HG = (bf16_t*)(a.ws + WS_HG); c.ACT = (bf16_t*)(a.ws + WS_ACT);
    c.tid = threadIdx.x; c.lane = c.tid & 63; c.wave = __builtin_amdgcn_readfirstlane(c.tid >> 6);
    c.gw = blockIdx.x * NWAVES + c.wave; c.NGW = gridDim.x * NWAVES;
    volatile LAS unsigned* bst = (volatile LAS unsigned*)(lds + 131072 + 64);
    if (c.tid == 0) { bst[0] = 0u; bst[1] = 0u; }
    __syncthreads();
    const XcdBarrier bar = xcd_barrier_post((unsigned*)(a.ws + WS_BAR), bst);
#define GSYNC() xcd_barrier(bar)
    bf16_t* SD = (bf16_t*)(a.ws + WS_HB);
    float* DV = (float*)(a.ws + WS_DV);

    { const int gt = blockIdx.x * NTHREADS + c.tid, NGT = gridDim.x * NTHREADS;
      for (int i = gt; i < 16384; i += NGT) c.ctl[i] = (i == 8) ? 1u : 0u;
      for (int i = gt; i < 3 * MALLOC; i += NGT) c.sumsq[MALLOC + i] = 0.f;
      for (int i = gt; i < HGW; i += NGT) c.lbv[i] = 1.f / (1.f + __expf(c.lbraw[i] - c.lbraw[HGW + i])); }
    p0_weights(c, lds, 0, 0, 1 << 30, c.gw, c.NGW);
    p0_weights(c, lds, 1, 0, 1 << 30, c.gw, c.NGW);
    p0_extra_rows(c, 0, blockIdx.x * NTHREADS + c.tid, gridDim.x * NTHREADS);
    p0_extra_rows(c, 1, blockIdx.x * NTHREADS + c.tid, gridDim.x * NTHREADS);
    __syncthreads();
    if constexpr (DUPMASK & 1) { LAUNDER0(); p0_weights(c, lds, 0, 0, 1 << 30, c.gw, c.NGW); __syncthreads(); }
    h_build(c);
    grid.sync();
#define LAUNDER() do { int t_ = threadIdx.x; asm volatile("" : "+v"(t_)); c.tid = t_; c.lane = t_ & 63; } while (0)
    for (int layer = 0; layer < 2; ++layer) {
        LAUNDER();
        if constexpr (FASTMASK & 1) gemm_fast<0>(c, lds, layer); else gemm_simple<0>(c, layer);
        if constexpr (DUPMASK & 2) { LAUNDER(); gemm_fast<0>(c, lds, layer); }
        GSYNC();
        LAUNDER();
        hgrn_A_phase(c, lds, SD, DV);
        if (blockIdx.x >= gridDim.x - 32) { LAUNDER(); kbias_job(c, lds, (int)(gridDim.x - 1 - blockIdx.x)); }
        LAUNDER();
        for (int job = blockIdx.x; job < 256; job += gridDim.x) knorm_job(c, layer, job);
        if constexpr (DUPMASK & 4) { LAUNDER(); hgrn_A_phase(c, lds, SD, DV); }
        GSYNC();
        LAUNDER();
        hgrn_B_scan(c, SD, DV);
        GSYNC();
        LAUNDER();
        hgrn_C_phase(c, lds, layer, SD);
        LAUNDER();
        mix_queue(c, lds_raw, layer, SD, c.ctl + 64 * (1 + layer));
        if constexpr (DUPMASK & 8) { LAUNDER(); mix_queue(c, lds_raw, layer, SD, c.ctl + 64 * (3 + layer)); }
        if constexpr (DUPMASK & 256) { LAUNDER(); hgrn_C_phase(c, lds, layer, SD); }
        if constexpr (DUPMASK & 128) { for (int i = 0; i < 8; ++i) GSYNC(); }
        GSYNC();
        LAUNDER();
        if constexpr (DUPMASK & 16) { gemm_fast<1>(c, lds, layer, c.ctl[8]); LAUNDER(); }
        if constexpr (FASTMASK & 2) gemm_fast<1>(c, lds, layer); else gemm_simple<1>(c, layer);
        GSYNC();
        if constexpr (FASTMASK & 4) gemm_fast<2>(c, lds, layer); else gemm_simple<2>(c, layer);
        if constexpr (DUPMASK & 32) { LAUNDER(); gemm_fast<2>(c, lds, layer); }
        GSYNC();
        if constexpr (DUPMASK & 64) { gemm_fast<3>(c, lds, layer, c.ctl[8]); LAUNDER(); }
        if constexpr (FASTMASK & 8) gemm_fast<3>(c, lds, layer); else gemm_simple<3>(c, layer);
        GSYNC();
    }
    LAUNDER();
    final_norm(c);
}

extern "C" void kernel_launch(void* const* d_in, const int* in_sizes, int n_in, void* d_out, int out_size, void* d_ws, size_t ws_size, hipStream_t stream) {
    static int grid = 0;
    if (grid == 0) {
        if (n_in != 13 || out_size != NB * SEQ * DM || ws_size < WS_END) { fprintf(stderr, "kernel_launch: unexpected shapes n_in %d out %d ws %zu\n", n_in, out_size, ws_size); grid = -1; return; }
        int dev = 0, cus = 0, per_cu = 0;
        (void)hipGetDevice(&dev); (void)hipDeviceGetAttribute(&cus, hipDeviceAttributeMultiprocessorCount, dev);
        (void)hipFuncSetAttribute((const void*)fwd_kernel, hipFuncAttributeMaxDynamicSharedMemorySize, LDS_BYTES);
        (void)hipOccupancyMaxActiveBlocksPerMultiprocessor(&per_cu, (const void*)fwd_kernel, NTHREADS, LDS_BYTES);
        if (per_cu < 1) per_cu = 1;
        grid = cus * per_cu;
        (void)hipGetLastError();
    }
    if (grid < 0) return;
    Args a{};
    for (int i = 0; i < 13; ++i) a.in[i] = (const float*)d_in[i];
    a.out = (float*)d_out; a.ws = (unsigned char*)d_ws;
    (void)hipMemsetAsync((unsigned char*)d_ws + WS_BAR, 0, 16384, stream);
    void* args[] = {&a};
    hipError_t e = hipLaunchCooperativeKernel((const void*)fwd_kernel, dim3(grid), dim3(NTHREADS), args, LDS_BYTES, stream);
    if (e != hipSuccess) fprintf(stderr, "cooperative launch failed: %s (grid %d)\n", hipGetErrorString(e), grid);
}
```

```cpp
#include <hip/hip_runtime.h>
#include <hip/hip_cooperative_groups.h>
#include <cstdint>
#include <cstdio>
namespace cg = cooperative_groups;

typedef unsigned short bf16_t;
typedef short bf16x8 __attribute__((ext_vector_type(8)));
typedef float f32x4 __attribute__((ext_vector_type(4)));
typedef unsigned u32x4 __attribute__((ext_vector_type(4)));
#define LAS __attribute__((address_space(3)))

constexpr int DM = 1024, NB = 4, SEQ = 4096, NMETA = 16, PADF = 48, LV = 4160, MROWS = NB * LV, MALLOC = MROWS + 256;
constexpr int FOXH = 8, FOXD = 64, FOXW = 512, HGH = 4, HGK = 128, HGV = 128, HGW = 512, DFF = 2816, INCOLS = 3592, NIN = 3584, NINP = 3840;
constexpr int KBL = 4352;
constexpr float EPS = 1e-6f, LOG2E = 1.4426950408889634f, C2 = 0.125f * LOG2E, HGQS = 0.08838834764831845f;
constexpr int NTHREADS = 512, NWAVES = 8;
constexpr int LDS_BYTES = 147456;
#ifndef FASTMASK
#define FASTMASK 15
#endif
#ifndef DUPMASK
#define DUPMASK 0
#endif

constexpr size_t MiB = 1u << 20;
constexpr size_t WS_CTL = 0;
constexpr size_t WS_SUMSQ = 64 * 1024;
constexpr size_t SUMSQ_STRIDE = (size_t)MALLOC * 4;
constexpr size_t WS_LBV = WS_SUMSQ + 4 * SUMSQ_STRIDE;
constexpr size_t WS_LOGF8 = WS_LBV + 4096;
constexpr size_t WS_KBIAS = WS_LOGF8 + (size_t)MALLOC * 32;
constexpr size_t WS_DV = WS_KBIAS + 32 * KBL * 4;
constexpr size_t WS_BAR = WS_DV + 16 * 64 * 128 * 4;
constexpr size_t WS_HS = 2 * MiB;
constexpr size_t WS_W = 3 * MiB;
constexpr size_t W_IN = 0, W_OUT = W_IN + (size_t)NINP * DM * 2, W_GU = W_OUT + (size_t)DM * DM * 2, W_DN = W_GU + (size_t)2 * DFF * DM * 2, W_LAYER = W_DN + (size_t)DM * DFF * 2;
constexpr size_t WS_HB = WS_W + 2 * W_LAYER + 65536;
constexpr size_t WS_MIX = WS_HB + (size_t)MALLOC * DM * 2;
constexpr size_t WS_QB = WS_MIX + (size_t)MALLOC * DM * 2;
constexpr size_t WS_KB = WS_QB + (size_t)MALLOC * 512 * 2, WS_VB = WS_KB + (size_t)MALLOC * 512 * 2;
constexpr size_t WS_HXQ = WS_VB + (size_t)MALLOC * 512 * 2;
constexpr size_t WS_LOGF = WS_HXQ + (size_t)MALLOC * 512 * 2;
constexpr size_t WS_HV = WS_LOGF + (size_t)MALLOC * 512 * 4, WS_HG = WS_HV + (size_t)MALLOC * 512 * 2;
constexpr size_t WS_END = WS_HG + (size_t)MALLOC * 512 * 2;
constexpr size_t WS_ACT = WS_QB;
static_assert(WS_BAR + 16384 <= WS_HS && 3456 * 4 <= 16384 && (size_t)16 * 64 * 16384 * 2 <= (size_t)MALLOC * DM * 2 && WS_HS + 4 * 64 * 1024 * 4 <= WS_W, "small map");
static_assert(WS_ACT + (size_t)MALLOC * DFF * 2 <= WS_END, "ACT overlay");
static_assert(WS_END <= 256 * MiB, "d_ws");

#define LAUNDER0() do { int t_ = threadIdx.x; asm volatile("" : "+v"(t_)); c.tid = t_; c.lane = t_ & 63; } while (0)
struct Args { const float* in[13]; float* out; unsigned char* ws; };

struct Ctx {
    const float *x, *meta, *nmw, *win, *fbias, *lbraw, *hnw, *wout, *nfw, *wg, *wu, *wd, *nfinal;
    float* out; unsigned char* ws;
    unsigned* ctl; float* sumsq; float* lbv; float* logf8; float* kbias; float* hs;
    bf16_t *HB, *MIX, *QB, *KB, *VB, *HXQ, *HV, *HG, *ACT; float* LOGF;
    int tid, lane, wave, gw, NGW;
};

__device__ __forceinline__ unsigned f2bf(float f) { unsigned u = __builtin_bit_cast(unsigned, f); return (u + 0x7fffu + ((u >> 16) & 1u)) >> 16; }
__device__ __forceinline__ unsigned pk2(float lo, float hi) { return f2bf(lo) | (f2bf(hi) << 16); }
__device__ __forceinline__ float bf2f(unsigned short b) { return __builtin_bit_cast(float, (unsigned)b << 16); }
__device__ __forceinline__ float wave_sum(float v) {
#pragma unroll
    for (int o = 1; o < 64; o <<= 1) v += __shfl_xor(v, o);
    return v;
}
__device__ __forceinline__ float wave_max(float v) {
#pragma unroll
    for (int o = 1; o < 64; o <<= 1) v = fmaxf(v, __shfl_xor(v, o));
    return v;
}
__device__ __forceinline__ float siluf(float x) { return x / (1.f + __expf(-x)); }
__device__ __forceinline__ float* hrow(const Ctx& c, int r) {
    const int b = r / LV, vp = r - b * LV;
    return vp >= 64 ? c.out + (size_t)(b * SEQ + vp - 64) * DM : c.hs + (size_t)(b * 64 + vp) * DM;
}
__device__ __forceinline__ bf16_t* wptr(const Ctx& c, int layer, size_t off) { return (bf16_t*)(c.ws + WS_W + (size_t)layer * W_LAYER + off); }

namespace pg8 {
#define PG8_LAS __attribute__((address_space(3)))
typedef unsigned short bf16_t;
typedef short bf16x8 __attribute__((ext_vector_type(8)));
typedef float f32x4 __attribute__((ext_vector_type(4)));
typedef unsigned u32x4 __attribute__((ext_vector_type(4)));
constexpr int BM = 256, BK = 64, HALF = 128, HTB = HALF * BK * 2  , STAGE_BYTES = 8 * HTB, NXCD = 8, WGM = 8;

__host__ __device__ __forceinline__ int lds_byte(int r, int c) { const int st = (r >> 4) * 2 + (c >> 5), rr = r & 15, cc = c & 31, ob = rr * 64 + cc * 2; return st * 1024 + (ob ^ (((ob >> 9) & 1) << 5)); }
__host__ __device__ __forceinline__ void stage_rc(int b, int& R, int& C) { const int st = b / 1024, sb = b % 1024, swz = sb ^ (((sb >> 9) & 1) << 5); R = (st >> 1) * 16 + swz / 64; C = (st & 1) * 32 + (swz % 64) / 2; }
__host__ __device__ __forceinline__ int perm32(int rho) { const int n = rho >> 4, i = rho & 15; return 8 * (i >> 2) + 4 * n + (i & 3); }

struct Unit { int pm, pn; };
struct Gemm { const bf16_t* A; const bf16_t* Bt; int M, N, K; };

struct StaticOrder {
    int nM, nN, nwg, G, c;
    __host__ __device__ void init(int M, int N, int G_, int c_) { nM = M / BM; nN = N / BM; nwg = nM * nN; G = G_; c = c_; }
    __host__ __device__ bool next(int i, Unit& u) const {
        const long L = (long)i * G + c; if (L >= nwg) return false;
        int wgid = (int)L; { const int q = nwg / NXCD, r = nwg % NXCD, xcd = wgid % NXCD, off = wgid / NXCD; wgid = (xcd < r ? xcd * (q + 1) : r * (q + 1) + (xcd - r) * q) + off; }
        const int nig = WGM * nN, gid = wgid / nig, fm = gid * WGM, gsz = (nM - fm) < WGM ? (nM - fm) : WGM;
        u.pm = fm + ((wgid % nig) % gsz); u.pn = (wgid % nig) / gsz; return true;
    }
    __device__ __forceinline__ void a_ready(const Unit&) const {}
    __device__ __forceinline__ void done(const Unit&) const {}
};

__device__ __forceinline__ unsigned cvt_pk_bf16(float lo, float hi) { unsigned r; asm volatile("v_cvt_pk_bf16_f32 %0, %1, %2" : "=v"(r) : "v"(lo), "v"(hi)); return r; }
typedef float f32x2 __attribute__((ext_vector_type(2)));
template <class Epi, class Sched, bool ALIGN_EPI = false, bool SP2 = false>
__device__ __forceinline__ void gemm_phase(PG8_LAS unsigned char* lds, const Gemm g, const Sched& S, const Epi& E) {
    int tid_ = threadIdx.x; asm volatile("" : "+v"(tid_));
    const int tid = tid_, wid = __builtin_amdgcn_readfirstlane(tid >> 6), lane = tid & 63, wr = wid >> 2, wc = wid & 3, fr = lane & 15, fq = lane >> 4;
    const int K = g.K, nt = K / BK;
    unsigned voffA[2], voffB[2];
#pragma unroll
    for (int i = 0; i < 2; ++i) { int R, C; stage_rc(tid * 16 + i * 8192, R, C); const int Rb = Epi::PERM ? ((R & ~31) + perm32(R & 31)) : R;
        voffA[i] = (unsigned)(R * K + C) * 2u; voffB[i] = (unsigned)(Rb * K + C) * 2u; }
    const size_t kstep = (size_t)(BK * 2);
    const size_t hstep = (size_t)HALF * K * 2;
    const size_t tstep = 2 * hstep;
    const unsigned ldsw = (unsigned)wid * 1024u;
    const int aoff = lds_byte(wr * 64 + fr, fq * 8), boff = lds_byte(wc * 32 + fr, fq * 8);
#define PG8_SA(b, h) (((b) * 2 + (h)) * HTB)
#define PG8_SB(b, h) ((4 + (b) * 2 + (h)) * HTB)
#define PG8_STAGE(bufoff, gbase, voff) do { _Pragma("unroll") for (int _i = 0; _i < 2; ++_i) \
        __builtin_amdgcn_global_load_lds((const unsigned*)((const char*)(gbase) + (voff)[_i]), (PG8_LAS unsigned*)(lds + (bufoff) + ldsw + _i * 8192), 16, 0, 0); } while (0)
#define PG8_LDA(dst, b, h) do { _Pragma("unroll") for (int m = 0; m < 4; ++m) _Pragma("unroll") for (int k = 0; k < 2; ++k) dst[m][k] = *(const PG8_LAS bf16x8*)(lds + PG8_SA(b, h) + aoff + m * 2048 + k * 1024); } while (0)
#define PG8_LDB(dst, b, h) do { _Pragma("unroll") for (int n = 0; n < 2; ++n) _Pragma("unroll") for (int k = 0; k < 2; ++k) dst[n][k] = *(const PG8_LAS bf16x8*)(lds + PG8_SB(b, h) + boff + n * 2048 + k * 1024); } while (0)
#define PG8_MMA(ai, bj, At, Bt) do { __builtin_amdgcn_s_setprio(1); _Pragma("unroll") for (int m = 0; m < 4; ++m) _Pragma("unroll") for (int n = 0; n < 2; ++n) _Pragma("unroll") for (int k = 0; k < 2; ++k) \
        acc[ai][bj][m][n] = __builtin_amdgcn_mfma_f32_16x16x32_bf16(Bt[n][k], At[m][k], acc[ai][bj][m][n], 0, 0, 0); __builtin_amdgcn_s_setprio(0); } while (0)
#define PG8_WAIT_V(n) asm volatile("s_waitcnt vmcnt(" #n ")" ::: "memory")
#define PG8_WAIT_L(n) asm volatile("s_waitcnt lgkmcnt(" #n ")" ::: "memory")
#define PG8_BAR __builtin_amdgcn_s_barrier()
#define PG8_SCHED __builtin_amdgcn_sched_barrier(0)
    Unit cur, nxt; int ui = 0;
    if (!S.next(0, cur)) return;
    f32x4 acc[2][2][4][2];
#pragma unroll
    for (int a = 0; a < 2; ++a)
#pragma unroll
        for (int b = 0; b < 2; ++b)
#pragma unroll
            for (int m = 0; m < 4; ++m)
#pragma unroll
                for (int n = 0; n < 2; ++n) acc[a][b][m][n] = (f32x4){0.f, 0.f, 0.f, 0.f};
    bf16x8 At[4][2], B0[2][2], B1[2][2];
    const char* cA = (const char*)g.A + (size_t)cur.pm * tstep; const char* cB = (const char*)g.Bt + (size_t)cur.pn * tstep;
    S.a_ready(cur);
    if constexpr (SP2) {
        PG8_STAGE(PG8_SB(0, 0), cB, voffB); PG8_STAGE(PG8_SB(0, 1), cB + hstep, voffB); PG8_STAGE(PG8_SA(0, 0), cA, voffA); PG8_STAGE(PG8_SA(0, 1), cA + hstep, voffA);
        if (wr == 1) PG8_BAR;
        PG8_WAIT_V(2); PG8_BAR;
        PG8_STAGE(PG8_SB(1, 0), cB + kstep, voffB); PG8_STAGE(PG8_SA(1, 0), cA + kstep, voffA); PG8_STAGE(PG8_SB(1, 1), cB + hstep + kstep, voffB);
        PG8_WAIT_V(6); PG8_BAR;
    } else {
        PG8_STAGE(PG8_SB(0, 0), cB, voffB); PG8_STAGE(PG8_SA(0, 0), cA, voffA); PG8_STAGE(PG8_SB(0, 1), cB + hstep, voffB); PG8_STAGE(PG8_SA(0, 1), cA + hstep, voffA);
        if (wr == 1) PG8_BAR;
        PG8_WAIT_V(4); PG8_BAR;
        PG8_STAGE(PG8_SB(1, 0), cB + kstep, voffB); PG8_STAGE(PG8_SA(1, 0), cA + kstep, voffA); PG8_STAGE(PG8_SB(1, 1), cB + hstep + kstep, voffB);
        PG8_WAIT_V(6); PG8_BAR;
    }
    for (;;) {
        const bool has_next = S.next(ui + 1, nxt);
        const char* nA = has_next ? (const char*)g.A + (size_t)nxt.pm * tstep : cA; const char* nB = has_next ? (const char*)g.Bt + (size_t)nxt.pn * tstep : cB;
        for (int t = 0; t < nt; t += 2) {
            const bool last = (t == nt - 2);
            const char* a1 = cA + (size_t)(t + 1) * kstep;
            const char* a2 = last ? nA : cA + (size_t)(t + 2) * kstep; const char* b2 = last ? nB : cB + (size_t)(t + 2) * kstep;
            const char* a3 = a2 + kstep; const char* b3 = b2 + kstep;
            if (last && has_next) S.a_ready(nxt);
            if constexpr (SP2) {
            PG8_LDB(B0, 0, 0); PG8_LDB(B1, 0, 1); PG8_SCHED; PG8_LDA(At, 0, 0); PG8_STAGE(PG8_SA(1, 1), a1 + hstep, voffA);
            PG8_WAIT_V(8); PG8_WAIT_L(0); PG8_BAR; PG8_MMA(0, 0, At, B0); PG8_MMA(0, 1, At, B1); PG8_BAR; PG8_SCHED;
            PG8_LDA(At, 0, 1); PG8_STAGE(PG8_SB(0, 0), b2, voffB); PG8_STAGE(PG8_SB(0, 1), b2 + hstep, voffB); PG8_STAGE(PG8_SA(0, 0), a2, voffA);
            PG8_WAIT_V(8); PG8_WAIT_L(0); PG8_BAR; PG8_MMA(1, 0, At, B0); PG8_MMA(1, 1, At, B1); PG8_BAR; PG8_SCHED;
            PG8_LDB(B0, 1, 0); PG8_LDB(B1, 1, 1); PG8_SCHED; PG8_LDA(At, 1, 0); PG8_STAGE(PG8_SA(0, 1), a2 + hstep, voffA);
            PG8_WAIT_V(8); PG8_WAIT_L(0); PG8_BAR; PG8_MMA(0, 0, At, B0); PG8_MMA(0, 1, At, B1); PG8_BAR; PG8_SCHED;
            PG8_LDA(At, 1, 1); PG8_STAGE(PG8_SB(1, 0), b3, voffB); PG8_STAGE(PG8_SB(1, 1), b3 + hstep, voffB); PG8_STAGE(PG8_SA(1, 0), a3, voffA);
            PG8_WAIT_V(8); PG8_WAIT_L(0); PG8_BAR; PG8_MMA(1, 0, At, B0); PG8_MMA(1, 1, At, B1); PG8_BAR; PG8_SCHED;
            } else {
            PG8_LDB(B0, 0, 0); PG8_SCHED; PG8_LDA(At, 0, 0); PG8_STAGE(PG8_SA(1, 1), a1 + hstep, voffA);
            PG8_WAIT_L(8); PG8_BAR; PG8_WAIT_L(0); PG8_MMA(0, 0, At, B0); PG8_BAR; PG8_SCHED;
            PG8_LDB(B1, 0, 1); PG8_STAGE(PG8_SB(0, 0), b2, voffB);
            PG8_BAR; PG8_WAIT_L(0); PG8_MMA(0, 1, At, B1); PG8_BAR;
            PG8_LDA(At, 0, 1); PG8_STAGE(PG8_SA(0, 0), a2, voffA);
            PG8_BAR; PG8_WAIT_L(0); PG8_MMA(1, 0, At, B0); PG8_BAR; PG8_SCHED;
            PG8_STAGE(PG8_SB(0, 1), b2 + hstep, voffB);
            PG8_WAIT_V(6); PG8_BAR; PG8_MMA(1, 1, At, B1); PG8_BAR;
            PG8_LDB(B0, 1, 0); PG8_SCHED; PG8_LDA(At, 1, 0); PG8_STAGE(PG8_SA(0, 1), a2 + hstep, voffA);
            PG8_WAIT_L(8); PG8_BAR; PG8_WAIT_L(0); PG8_MMA(0, 0, At, B0); PG8_BAR; PG8_SCHED;
            PG8_LDB(B1, 1, 1); PG8_STAGE(PG8_SB(1, 0), b3, voffB);
            PG8_BAR; PG8_WAIT_L(0); PG8_MMA(0, 1, At, B1); PG8_BAR;
            PG8_LDA(At, 1, 1); PG8_STAGE(PG8_SA(1, 0), a3, voffA);
            PG8_BAR; PG8_WAIT_L(0); PG8_MMA(1, 0, At, B0); PG8_BAR; PG8_SCHED;
            PG8_STAGE(PG8_SB(1, 1), b3 + hstep, voffB);
            PG8_WAIT_V(6); PG8_BAR; PG8_MMA(1, 1, At, B1); PG8_BAR;
            }
        }
        if constexpr (ALIGN_EPI) { if (wr == 0) PG8_BAR; }
        if constexpr (!Epi::AFTER_DRAIN) { E(acc, cur, wr, wc, fr, fq); S.done(cur); }
        if (!has_next) break;
#pragma unroll
        for (int a = 0; a < 2; ++a)
#pragma unroll
            for (int b = 0; b < 2; ++b)
#pragma unroll
                for (int m = 0; m < 4; ++m)
#pragma unroll
                    for (int n = 0; n < 2; ++n) acc[a][b][m][n] = (f32x4){0.f, 0.f, 0.f, 0.f};
        cur = nxt; cA = nA; cB = nB; ++ui;
        if constexpr (ALIGN_EPI) { if (wr == 1) PG8_BAR; }
    }
    PG8_WAIT_V(0);
    if constexpr (!ALIGN_EPI) { if (wr == 0) PG8_BAR; }
    PG8_BAR;
    if constexpr (Epi::AFTER_DRAIN) { E.fused(acc, cur, wr, wc, fr, fq, lds, wid, lane); S.done(cur); }
#undef PG8_SA
#undef PG8_SB
#undef PG8_STAGE
#undef PG8_LDA
#undef PG8_LDB
#undef PG8_MMA
#undef PG8_WAIT_V
#undef PG8_WAIT_L
#undef PG8_BAR
#undef PG8_SCHED
}
}

namespace pg8 {
__device__ __forceinline__ float silu_f(float x) { return x * __builtin_amdgcn_rcpf(1.f + __expf(-x)); }
struct EpiInProj {
    static constexpr bool PERM = true, AFTER_DRAIN = false;
    const float* ssq; const float* lbv; bf16_t *QB, *KB, *VB, *HXQ, *HV, *HG; float* LOGF; const float* fbias; float* logf8;
    __device__ __forceinline__ void operator()(const f32x4 (&acc)[2][2][4][2], const Unit& u, int wr, int wc, int fr, int fq) const {
        const int part = u.pn >> 1;
        const int cbase = (u.pn & 1) * 256 + wc * 32 + 8 * fq;
        if (part == 7) {
            if (wc == 0 && fq == 0) {
                const f32x4 b0 = *(const f32x4*)fbias, b1 = *(const f32x4*)(fbias + 4);
#pragma unroll
                for (int ai = 0; ai < 2; ++ai)
#pragma unroll
                    for (int m = 0; m < 4; ++m) {
                        const int r = u.pm * BM + ai * HALF + wr * 64 + m * 16 + fr;
                        const float rstd = 1.f / sqrtf(ssq[r] * (1.f / 1024.f) + 1e-6f);
                        f32x4 z0 = acc[ai][0][m][0] * rstd + b0, z1 = acc[ai][0][m][1] * rstd + b1;
#pragma unroll
                        for (int e = 0; e < 4; ++e) { z0[e] = fminf(z0[e], 0.f) - __logf(1.f + __expf(-fabsf(z0[e]))); z1[e] = fminf(z1[e], 0.f) - __logf(1.f + __expf(-fabsf(z1[e]))); }
                        *(f32x4*)(logf8 + (size_t)r * 8) = z0; *(f32x4*)(logf8 + (size_t)r * 8 + 4) = z1;
                    }
            }
        } else if (part == 4) {
#pragma unroll
            for (int bj = 0; bj < 2; ++bj)
#pragma unroll
                for (int n = 0; n < 2; ++n) {
                    const int cc = cbase + bj * HALF + 4 * n;
                    f32x4 lb1 = (f32x4){1.f, 1.f, 1.f, 1.f};
                    if (lbv) lb1 = lb1 - *(const f32x4*)(lbv + cc);
#pragma unroll
                    for (int ai = 0; ai < 2; ++ai)
#pragma unroll
                        for (int m = 0; m < 4; ++m) {
                            const int r = u.pm * BM + ai * HALF + wr * 64 + m * 16 + fr;
                            const float rstd = 1.f / sqrtf(ssq[r] * (1.f / 1024.f) + 1e-6f);
                            f32x4 a;
#pragma unroll
                            for (int e = 0; e < 4; ++e) { const float xv = acc[ai][bj][m][n][e] * rstd; const float omf = lb1[e] * __builtin_amdgcn_rcpf(1.f + __expf(xv)); a[e] = fmaxf(__logf(1.f - omf), -30.f); }
                            *(f32x4*)(LOGF + (size_t)r * 512 + cc) = a;
                        }
                }
        } else {
            bf16_t* dst = part == 0 ? QB : part == 1 ? KB : part == 2 ? VB : part == 3 ? HXQ : part == 5 ? HV : HG;
            const float sc = part == 0 ? 0.125f * 1.4426950408889634f : part == 3 ? 0.08838834764831845f : 1.f;
            const bool dosilu = (part == 3) || (part == 6);
#pragma unroll
            for (int ai = 0; ai < 2; ++ai)
#pragma unroll
                for (int m = 0; m < 4; ++m) {
                    const int r = u.pm * BM + ai * HALF + wr * 64 + m * 16 + fr;
                    const float rstd = sc / sqrtf(ssq[r] * (1.f / 1024.f) + 1e-6f);
#pragma unroll
                    for (int bj = 0; bj < 2; ++bj) {
                        f32x4 v0 = acc[ai][bj][m][0], v1 = acc[ai][bj][m][1];
                        if (dosilu) {
#pragma unroll
                            for (int e = 0; e < 4; ++e) { const float a0 = v0[e] * (rstd / sc), a1 = v1[e] * (rstd / sc); v0[e] = silu_f(a0) * sc; v1[e] = silu_f(a1) * sc; }
                        } else { v0 = v0 * rstd; v1 = v1 * rstd; }
                        u32x4 w; w.x = cvt_pk_bf16(v0[0], v0[1]); w.y = cvt_pk_bf16(v0[2], v0[3]); w.z = cvt_pk_bf16(v1[0], v1[1]); w.w = cvt_pk_bf16(v1[2], v1[3]);
                        *(u32x4*)(dst + (size_t)r * 512 + cbase + bj * HALF) = w;
                    }
                }
        }
    }
};
struct EpiResid {
    static constexpr bool PERM = false, AFTER_DRAIN = false;
    float* out; float* hs; bf16_t* HB; float* ssq; unsigned skip; const float* xsrc; const float* msrc;
    __device__ __forceinline__ void operator()(const f32x4 (&acc)[2][2][4][2], const Unit& u, int wr, int wc, int fr, int fq) const {
        if (skip) return;
        const int col0 = u.pn * BM + wc * 32 + 4 * fq;
#pragma unroll
        for (int ai = 0; ai < 2; ++ai)
#pragma unroll
            for (int m = 0; m < 4; ++m) {
                const int r = u.pm * BM + ai * HALF + wr * 64 + m * 16 + fr;
                const int b = r / 4160, vp = r - b * 4160;
                float* hp = vp >= 64 ? out + (size_t)(b * 4096 + vp - 64) * 1024 : hs + (size_t)(b * 64 + vp) * 1024;
                const float* rp = !xsrc ? hp : (vp >= 64 ? xsrc + (size_t)(b * 4096 + vp - 64) * 1024 : (vp >= 48 ? msrc + (size_t)(vp - 48) * 1024 : nullptr));
                float q = 0.f;
#pragma unroll
                for (int bj = 0; bj < 2; ++bj)
#pragma unroll
                    for (int n = 0; n < 2; ++n) { const int c = col0 + bj * HALF + n * 16; const f32x4 h = (rp ? *(const f32x4*)(rp + c) : (f32x4){0.f, 0.f, 0.f, 0.f}) + acc[ai][bj][m][n]; *(f32x4*)(hp + c) = h;
                        unsigned long long w = (unsigned long long)cvt_pk_bf16(h[0], h[1]) | ((unsigned long long)cvt_pk_bf16(h[2], h[3]) << 32);
                        *(unsigned long long*)(HB + (size_t)r * 1024 + c) = w; q += (h[0] * h[0] + h[1] * h[1]) + (h[2] * h[2] + h[3] * h[3]); }
                if (ssq) { q += __shfl_xor(q, 16); q += __shfl_xor(q, 32); if (fq == 0) atomicAdd(ssq + r, q); }
            }
    }
};
struct EpiSwiGLU {
    static constexpr bool PERM = true, AFTER_DRAIN = false;
    const float* ssq; bf16_t* ACT;
    __device__ __forceinline__ void operator()(const f32x4 (&acc)[2][2][4][2], const Unit& u, int wr, int wc, int fr, int fq) const {
        const int f0 = u.pn * HALF + wc * 32 + 8 * fq;
#pragma unroll
        for (int ai = 0; ai < 2; ++ai)
#pragma unroll
            for (int m = 0; m < 4; ++m) {
                const int r = u.pm * BM + ai * HALF + wr * 64 + m * 16 + fr;
                const float rstd = 1.f / sqrtf(ssq[r] * (1.f / 1024.f) + 1e-6f);
                float y[8];
#pragma unroll
                for (int n = 0; n < 2; ++n)
#pragma unroll
                    for (int e = 0; e < 4; ++e) { const float g = acc[ai][0][m][n][e] * rstd, uu = acc[ai][1][m][n][e] * rstd; y[4 * n + e] = silu_f(g) * uu; }
                u32x4 w; w.x = cvt_pk_bf16(y[0], y[1]); w.y = cvt_pk_bf16(y[2], y[3]); w.z = cvt_pk_bf16(y[4], y[5]); w.w = cvt_pk_bf16(y[6], y[7]);
                *(u32x4*)(ACT + (size_t)r * 2816 + f0) = w;
            }
    }
};
}

#define GAS __attribute__((address_space(1)))
typedef unsigned v4u __attribute__((ext_vector_type(4)));
typedef GAS unsigned gu32;
typedef GAS unsigned long long gu64;
#define RLX_AGENT __ATOMIC_RELAXED, __HIP_MEMORY_SCOPE_AGENT
#define LDS_WAIT() asm volatile("s_waitcnt lgkmcnt(0)" ::: "memory")
#define VM_WAIT() asm volatile("s_waitcnt vmcnt(0)" ::: "memory")
__device__ __forceinline__ unsigned long long rt() { return __builtin_amdgcn_s_memrealtime(); }
#define XB_TMO      128
#define XB_XCNT(j)  (256  + 64 * (j))
#define XB_XSUB(j)  (1280 + 64 * (j))
#define XB_XGEN(j)  (2304 + 64 * (j))
#define XB_TOP      3328
#define XB_TOPGEN   3392
#define XCD_BAR_WORDS 3456
#define XB_SPIN_CAP (1u << 18)

__device__ __forceinline__ unsigned xb_ld(unsigned* p)              { return __hip_atomic_load(p, __ATOMIC_RELAXED, __HIP_MEMORY_SCOPE_AGENT); }
__device__ __forceinline__ unsigned xb_add(unsigned* p, unsigned v) { return __hip_atomic_fetch_add(p, v, __ATOMIC_RELAXED, __HIP_MEMORY_SCOPE_AGENT); }
__device__ __forceinline__ unsigned xb_xcc_id() { return (unsigned)__builtin_amdgcn_s_getreg((3 << 11) | 20) & 0xFu; }
#define XB_SPIN(cond, bar) do { unsigned _sp = 0; while (cond) { __builtin_amdgcn_s_sleep(1); \
    if ((++_sp & 255u) == 0u) { if (xb_ld(&(bar)[XB_TMO])) break; if (_sp > XB_SPIN_CAP) { atomicAdd(&(bar)[XB_TMO], 1u); break; } } } } while (0)

struct XcdBarrier {
    unsigned* bar; unsigned x;
    volatile LAS unsigned* st;
};

__device__ __forceinline__ XcdBarrier xcd_barrier_post(unsigned* bar, volatile LAS unsigned* st) {
    XcdBarrier b; b.bar = bar; b.x = xb_xcc_id(); b.st = st;
    if (threadIdx.x == 0) (void)xb_add(&bar[XB_XCNT(b.x)], 1u);
    return b;
}
__device__ __forceinline__ void xcd_barrier_complete(unsigned* bar, unsigned x, unsigned& nloc, unsigned& nx) {
    const unsigned G = gridDim.x * gridDim.y * gridDim.z;
    unsigned sum, cnt, mine, sp = 0u;
    for (;;) {
        sum = 0u; cnt = 0u; mine = 0u;
#pragma unroll
        for (unsigned j = 0; j < 16; ++j) { const unsigned c = xb_ld(&bar[XB_XCNT(j)]); sum += c; cnt += (c > 0u) ? 1u : 0u; mine = (j == x) ? c : mine; }
        if (sum == G) break;
        __builtin_amdgcn_s_sleep(1);
        if ((++sp & 255u) == 0u) { if (xb_ld(&bar[XB_TMO])) break; if (sp > XB_SPIN_CAP) { atomicAdd(&bar[XB_TMO], 1u); break; } }
    }
    nloc = mine > 0u ? mine : 1u; nx = cnt > 0u ? cnt : 1u;
}

__device__ __forceinline__ void xcd_barrier(const XcdBarrier& b) {
    asm volatile("s_waitcnt vmcnt(0)" ::: "memory");
    __syncthreads();
    int t_ = threadIdx.x; asm volatile("" : "+v"(t_));
    if (t_ == 0) {
        unsigned* bar = b.bar;
        __builtin_amdgcn_s_waitcnt(0);
        unsigned nloc = b.st[0], nx = b.st[1];
        if (nloc == 0u) { xcd_barrier_complete(bar, b.x, nloc, nx); b.st[0] = nloc; b.st[1] = nx; }
        const unsigned old = xb_add(&bar[XB_XSUB(b.x)], 1u);
        const unsigned gen = old / nloc;
        if (old + 1u == (gen + 1u) * nloc) {
            __builtin_amdgcn_fence(__ATOMIC_RELEASE, "agent");
            asm volatile("s_waitcnt vmcnt(0)" ::: "memory");
            const unsigned og = xb_add(&bar[XB_TOP], 1u);
            const unsigned tg = og / nx;
            if (og + 1u == (tg + 1u) * nx) xb_add(&bar[XB_TOPGEN], 1u);
            else XB_SPIN(xb_ld(&bar[XB_TOPGEN]) == tg, bar);
            __builtin_amdgcn_fence(__ATOMIC_ACQUIRE, "agent");
            xb_add(&bar[XB_XGEN(b.x)], 1u);
            asm volatile("s_waitcnt vmcnt(0)" ::: "memory");
        } else {
            XB_SPIN(xb_ld(&bar[XB_XGEN(b.x)]) == gen, bar);
            __builtin_amdgcn_fence(__ATOMIC_ACQUIRE, "agent");
            asm volatile("s_waitcnt vmcnt(0)" ::: "memory");
        }
    }
    __syncthreads();
}

__device__ __forceinline__ void tr_item(const float* W, int K, int N, int k0, int nsrc0, bf16_t* WT, int dst_row0, const float* kscale, LAS float* scr, int lane) {
    float wv[32];
#pragma unroll
    for (int i = 0; i < 32; ++i) { const int kk = 2 * i + (lane >> 5); wv[i] = W[(size_t)(k0 + kk) * N + nsrc0 + (lane & 31)]; }
#pragma unroll
    for (int i = 0; i < 32; ++i) { const int kk = 2 * i + (lane >> 5); const float s = kscale ? kscale[k0 + kk] : 1.f; scr[kk * 33 + (lane & 31)] = wv[i] * s; }
    asm volatile("s_waitcnt lgkmcnt(0)" ::: "memory");
    const int ch = lane & 7;
#pragma unroll
    for (int j = 0; j < 4; ++j) { const int n = (lane >> 3) + 8 * j; const LAS float* s = scr + (8 * ch) * 33 + n;
        u32x4 o; o.x = pk2(s[0 * 33], s[1 * 33]); o.y = pk2(s[2 * 33], s[3 * 33]); o.z = pk2(s[4 * 33], s[5 * 33]); o.w = pk2(s[6 * 33], s[7 * 33]);
        *(u32x4*)(WT + (size_t)(dst_row0 + n) * K + k0 + 8 * ch) = o; }
    asm volatile("s_waitcnt lgkmcnt(0)" ::: "memory");
}

__device__ __forceinline__ void p0_weights(const Ctx& c, LAS unsigned char* lds, int l, int it0, int it1, int w0, int nw) {
    LAS float* scr = (LAS float*)(lds + c.wave * 16384);
    constexpr int I_IN = 16 * (NIN / 32), I_OUT = 16 * 32, I_G = 16 * (DFF / 32), I_D = (DFF / 64) * 32, I_L = I_IN + I_OUT + 2 * I_G + I_D;
    if (it1 > I_L) it1 = I_L;
#pragma nounroll
    for (int it = it0 + w0; it < it1; it += nw) {
        int r = it;
        if (r < I_IN) { const int kb = r / (NIN / 32), nb = r % (NIN / 32), n0 = nb * 32;
            tr_item(c.win + (size_t)l * DM * INCOLS, DM, INCOLS, kb * 64, n0 + (n0 >= 1536 ? 8 : 0), wptr(c, l, W_IN), n0, c.nmw + l * DM, scr, c.lane); continue; }
        r -= I_IN;
        if (r < I_OUT) { const int kb = r / 32, nb = r % 32; tr_item(c.wout + (size_t)l * DM * DM, DM, DM, kb * 64, nb * 32, wptr(c, l, W_OUT), nb * 32, nullptr, scr, c.lane); continue; }
        r -= I_OUT;
        if (r < 2 * I_G) { const int up = r >= I_G; if (up) r -= I_G; const int kb = r / (DFF / 32), nb = r % (DFF / 32), f0 = nb * 32;
            tr_item((up ? c.wu : c.wg) + (size_t)l * DM * DFF, DM, DFF, kb * 64, f0, wptr(c, l, W_GU), 256 * (f0 >> 7) + (f0 & 127) + (up ? 128 : 0), c.nfw + l * DM, scr, c.lane); continue; }
        r -= 2 * I_G;
        { const int kb = r / 32, nb = r % 32; tr_item(c.wd + (size_t)l * DFF * DM, DFF, DM, kb * 64, nb * 32, wptr(c, l, W_DN), nb * 32, nullptr, scr, c.lane); }
    }
}

__device__ __forceinline__ void p0_extra_rows(const Ctx& c, int l, int gt, int NGT) {
#pragma nounroll
    for (int i = gt; i < 8 * DM; i += NGT) { const int cc = i >> 10, k = i & 1023;
        wptr(c, l, W_IN)[(size_t)(NIN + cc) * DM + k] = (bf16_t)f2bf(c.win[(size_t)l * DM * INCOLS + (size_t)k * INCOLS + 1536 + cc] * c.nmw[l * DM + k]); }
#pragma nounroll
    for (int i = gt; i < 248 * 128; i += NGT) *(u32x4*)(wptr(c, l, W_IN) + (size_t)(NIN + 8) * DM + (size_t)i * 8) = (u32x4){0u, 0u, 0u, 0u};
}
__device__ __forceinline__ void h_build(const Ctx& c) {
    float* ssq = c.sumsq;
    for (int rb = c.gw; rb < MROWS; rb += 4 * c.NGW) {
        f32x4 v[4][4];
#pragma unroll
        for (int q = 0; q < 4; ++q) { const int r = rb + q * c.NGW;
            if (r < MROWS) { const int b = r / LV, vp = r - b * LV;
                const float* src = vp >= 64 ? c.x + (size_t)(b * SEQ + vp - 64) * DM : (vp >= PADF ? c.meta + (size_t)(vp - PADF) * DM : nullptr);
#pragma unroll
                for (int j = 0; j < 4; ++j) v[q][j] = src ? *(const f32x4*)(src + 4 * c.lane + 256 * j) : (f32x4){0.f, 0.f, 0.f, 0.f}; } }
#pragma unroll
        for (int q = 0; q < 4; ++q) { const int r = rb + q * c.NGW;
            if (r < MROWS) { float s = 0.f;
#pragma unroll
                for (int j = 0; j < 4; ++j) {
                    unsigned long long w = (unsigned long long)pk2(v[q][j].x, v[q][j].y) | ((unsigned long long)pk2(v[q][j].z, v[q][j].w) << 32);
                    *(unsigned long long*)(c.HB + (size_t)r * DM + 4 * c.lane + 256 * j) = w;
                    s += (v[q][j].x * v[q][j].x + v[q][j].y * v[q][j].y) + (v[q][j].z * v[q][j].z + v[q][j].w * v[q][j].w); }
                s = wave_sum(s);
                if (c.lane == 0) ssq[r] = s; } }
    }
}

__device__ __forceinline__ void kbias_job(const Ctx& c, LAS unsigned char* lds, int job) {
    const int b = job >> 3, h = job & 7;
    LAS float* wt = (LAS float*)lds;
    const int v0 = 9 * c.tid;
    float g[9]; float s = 0.f;
#pragma unroll
    for (int i = 0; i < 9; ++i) { const int vp = v0 + i; g[i] = (vp >= PADF && vp < LV) ? c.logf8[(size_t)(b * LV + vp) * 8 + h] : 0.f; s += g[i]; }
    float inc = s;
#pragma unroll
    for (int o = 1; o < 64; o <<= 1) { const float t = __shfl_up(inc, o); if (c.lane >= o) inc += t; }
    if (c.lane == 63) wt[c.wave] = inc;
    __syncthreads();
    float run = inc - s;
    for (int w = 0; w < c.wave; ++w) run += wt[w];
    float* kb = c.kbias + (size_t)job * KBL;
#pragma unroll
    for (int i = 0; i < 9; ++i) { const int vp = v0 + i; run += g[i]; if (vp < KBL) kb[vp] = vp < PADF ? -1e30f : (vp < LV ? -run * LOG2E : 0.f); }
    __syncthreads();
}

template <int MODE>
__device__ __forceinline__ void gemm_simple(const Ctx& c, int layer) {
    const int fr = c.lane & 15, g = c.lane >> 4;
    const bf16_t* A = MODE == 0 ? c.HB : MODE == 1 ? c.MIX : MODE == 2 ? c.HB : c.ACT;
    const bf16_t* Bt = wptr(c, layer, MODE == 0 ? W_IN : MODE == 1 ? W_OUT : MODE == 2 ? W_GU : W_DN);
    constexpr int K = MODE == 3 ? DFF : DM;
    constexpr int NCOL = MODE == 0 ? NIN : MODE == 2 ? DFF : DM;
    constexpr int ntn = NCOL / 64, ntm = MROWS / 16;
    for (int t = c.gw; t < ntm * ntn; t += c.NGW) {
        const int tm = t / ntn, tn = t - tm * ntn, row0 = tm * 16, col0 = tn * 64;
        f32x4 acc[4], acc2[4];
#pragma unroll
        for (int n = 0; n < 4; ++n) { acc[n] = (f32x4){0.f, 0.f, 0.f, 0.f}; acc2[n] = (f32x4){0.f, 0.f, 0.f, 0.f}; }
        const bf16_t* ap = A + (size_t)(row0 + fr) * K + 8 * g;
        const bf16_t* bp[4];
#pragma unroll
        for (int n = 0; n < 4; ++n) { const int cn = col0 + 16 * n + fr; const int br = MODE == 2 ? 256 * (cn >> 7) + (cn & 127) : cn; bp[n] = Bt + (size_t)br * K + 8 * g; }
        for (int k0 = 0; k0 < K; k0 += 32) {
            const bf16x8 a = *(const bf16x8*)(ap + k0);
#pragma unroll
            for (int n = 0; n < 4; ++n) { const bf16x8 b = *(const bf16x8*)(bp[n] + k0); acc[n] = __builtin_amdgcn_mfma_f32_16x16x32_bf16(a, b, acc[n], 0, 0, 0);
                if (MODE == 2) { const bf16x8 b2 = *(const bf16x8*)(bp[n] + (size_t)128 * K + k0); acc2[n] = __builtin_amdgcn_mfma_f32_16x16x32_bf16(a, b2, acc2[n], 0, 0, 0); } }
        }
        if (MODE == 0) {
            const float* ssq = c.sumsq + (size_t)layer * MALLOC;
#pragma unroll
            for (int j = 0; j < 4; ++j) { const int r = row0 + 4 * g + j; const float rstd = 1.f / sqrtf(ssq[r] * (1.f / DM) + EPS);
#pragma unroll
                for (int n = 0; n < 4; ++n) { const int cn = col0 + 16 * n + fr; const float xv = acc[n][j] * rstd; const int part = cn >> 9, cc = cn & 511; const size_t o = (size_t)r * 512 + cc;
                    if (part == 0) c.QB[o] = (bf16_t)f2bf(xv * C2);
                    else if (part == 1) c.KB[o] = (bf16_t)f2bf(xv);
                    else if (part == 2) c.VB[o] = (bf16_t)f2bf(xv);
                    else if (part == 3) c.HXQ[o] = (bf16_t)f2bf(siluf(xv) * HGQS);
                    else if (part == 4) { const float lb = layer ? c.lbv[cc] : 0.f; const float omf = (1.f - lb) / (1.f + __expf(xv)); c.LOGF[o] = fmaxf(log1pf(-omf), -30.f); }
                    else if (part == 5) c.HV[o] = (bf16_t)f2bf(xv);
                    else c.HG[o] = (bf16_t)f2bf(siluf(xv)); } }
        } else if (MODE == 1 || MODE == 3) {
            float* ssq = c.sumsq + (size_t)(2 + layer) * MALLOC;
#pragma unroll
            for (int j = 0; j < 4; ++j) { const int r = row0 + 4 * g + j; float* hp = hrow(c, r); float q = 0.f;
#pragma unroll
                for (int n = 0; n < 4; ++n) { const int cn = col0 + 16 * n + fr; const float hn = hp[cn] + acc[n][j]; hp[cn] = hn; c.HB[(size_t)r * DM + cn] = (bf16_t)f2bf(hn); q += hn * hn; }
                if (MODE == 1) { q += __shfl_xor(q, 1); q += __shfl_xor(q, 2); q += __shfl_xor(q, 4); q += __shfl_xor(q, 8); if (fr == 0) atomicAdd(ssq + r, q); } }
        } else {
            const float* ssq = c.sumsq + (size_t)(2 + layer) * MALLOC;
#pragma unroll
            for (int j = 0; j < 4; ++j) { const int r = row0 + 4 * g + j; const float rstd = 1.f / sqrtf(ssq[r] * (1.f / DM) + EPS);
#pragma unroll
                for (int n = 0; n < 4; ++n) { const int cn = col0 + 16 * n + fr; const float gv = acc[n][j] * rstd, uv = acc2[n][j] * rstd; c.ACT[(size_t)r * DFF + cn] = (bf16_t)f2bf(siluf(gv) * uv); } }
        }
    }
}

template <int MODE>
__device__ __forceinline__ void tail_job(const Ctx& c, LAS unsigned char* lds, int layer) {
    constexpr int K = MODE == 3 ? DFF : DM, KW = K / 8;
    const bf16_t* A = MODE == 1 ? c.MIX : c.ACT;
    const bf16_t* Bt = wptr(c, layer, MODE == 1 ? W_OUT : W_DN);
    float* ssq = MODE == 1 ? c.sumsq + (size_t)(2 + layer) * MALLOC : (layer == 0 ? c.sumsq + (size_t)MALLOC : nullptr);
    int tid_ = threadIdx.x; asm volatile("" : "+v"(tid_)); const int tid = tid_, lane = tid & 63, w = __builtin_amdgcn_readfirstlane(tid >> 6);
    const int fr = lane & 15, g = lane >> 4;
    LAS float* P = (LAS float*)lds;
    for (int job = blockIdx.x; job < 256; job += gridDim.x) {
        const int tm = job >> 4, tn = job & 15, row0 = 16384 + tm * 16, col0 = tn * 64;
        f32x4 acc[4];
#pragma unroll
        for (int n = 0; n < 4; ++n) acc[n] = (f32x4){0.f, 0.f, 0.f, 0.f};
        const bf16_t* ap = A + (size_t)(row0 + fr) * K + w * KW + 8 * g;
        const bf16_t* bp = Bt + (size_t)(col0 + fr) * K + w * KW + 8 * g;
#pragma unroll 4
        for (int k0 = 0; k0 < KW; k0 += 32) {
            const bf16x8 a = *(const bf16x8*)(ap + k0);
#pragma unroll
            for (int n = 0; n < 4; ++n) { const bf16x8 b = *(const bf16x8*)(bp + (size_t)n * 16 * K + k0); acc[n] = __builtin_amdgcn_mfma_f32_16x16x32_bf16(a, b, acc[n], 0, 0, 0); }
        }
#pragma unroll
        for (int n = 0; n < 4; ++n)
#pragma unroll
            for (int j = 0; j < 4; ++j) P[(w * 16 + 4 * g + j) * 64 + 16 * n + fr] = acc[n][j];
        __syncthreads();
        { const int row = tid >> 5, c2 = (tid & 31) * 2; float s0 = 0.f, s1 = 0.f;
#pragma unroll
          for (int ww = 0; ww < 8; ++ww) { s0 += P[(ww * 16 + row) * 64 + c2]; s1 += P[(ww * 16 + row) * 64 + c2 + 1]; }
          const int r = row0 + row; float* hp = hrow(c, r) + col0 + c2;
          const float* rp = hp;
          if (MODE == 1 && layer == 0) { const int b = r / LV, vp = r - b * LV; rp = vp >= 64 ? c.x + (size_t)(b * SEQ + vp - 64) * DM + col0 + c2 : (vp >= PADF ? c.meta + (size_t)(vp - PADF) * DM + col0 + c2 : nullptr); }
          const float h0 = (rp ? rp[0] : 0.f) + s0, h1 = (rp ? rp[1] : 0.f) + s1; hp[0] = h0; hp[1] = h1;
          *(unsigned*)(c.HB + (size_t)r * DM + col0 + c2) = pk2(h0, h1);
          if (ssq) { float q = h0 * h0 + h1 * h1; q += __shfl_xor(q, 1); q += __shfl_xor(q, 2); q += __shfl_xor(q, 4); q += __shfl_xor(q, 8); q += __shfl_xor(q, 16); if ((tid & 31) == 0) atomicAdd(ssq + r, q); } }
        __syncthreads();
    }
}

template <int MODE>
__device__ __forceinline__ void gemm_fast(const Ctx& c, LAS unsigned char* lds, int layer, unsigned skip = 0u) {
    const bf16_t* A = MODE == 0 ? c.HB : MODE == 1 ? c.MIX : MODE == 2 ? c.HB : c.ACT;
    const bf16_t* Bt = wptr(c, layer, MODE == 0 ? W_IN : MODE == 1 ? W_OUT : MODE == 2 ? W_GU : W_DN);
    constexpr int K = MODE == 3 ? DFF : DM;
    constexpr int N = MODE == 0 ? NINP : MODE == 2 ? 2 * DFF : DM;
    int bx_ = blockIdx.x; asm volatile("" : "+s"(bx_));
    constexpr int MG = (MODE == 1 || MODE == 3) ? 16384 : MROWS;
    pg8::Gemm g{A, Bt, MG, N, K}; pg8::StaticOrder S; S.init(MG, N, (int)gridDim.x, bx_);
    if constexpr (MODE == 0) {
        pg8::EpiInProj E{c.sumsq + (size_t)layer * MALLOC, layer ? c.lbv : nullptr, c.QB, c.KB, c.VB, c.HXQ, c.HV, c.HG, c.LOGF, c.fbias + layer * 8, c.logf8};
        pg8::gemm_phase<pg8::EpiInProj, pg8::StaticOrder, true, true>(lds, g, S, E);
    } else if constexpr (MODE == 2) {
        pg8::EpiSwiGLU E{c.sumsq + (size_t)(2 + layer) * MALLOC, c.ACT};
        pg8::gemm_phase<pg8::EpiSwiGLU, pg8::StaticOrder, true, true>(lds, g, S, E);
    } else {
        pg8::EpiResid E{c.out, c.hs, c.HB, MODE == 1 ? c.sumsq + (size_t)(2 + layer) * MALLOC : (layer == 0 ? c.sumsq + (size_t)MALLOC : nullptr), skip, (MODE == 1 && layer == 0) ? c.x : nullptr, c.meta};
        pg8::gemm_phase<pg8::EpiResid, pg8::StaticOrder, true, true>(lds, g, S, E);
        if (!skip) tail_job<MODE>(c, lds, layer);
    }
}

#include <hip/hip_bf16.h>
#include <cmath>
namespace attn_body {
using bf16=__hip_bfloat16;
using bf16x8=__attribute__((ext_vector_type(8)))short;
using s16x4=__attribute__((ext_vector_type(4)))short;
using f32x16=__attribute__((ext_vector_type(16)))float;
using u32x4=__attribute__((ext_vector_type(4)))unsigned;
constexpr int BATCH=4,NHEAD=8,SEQ=4160,D=64,DM=NHEAD*D,OP=1024;
constexpr int NW=8,QBLK=32,QB=QBLK*NW,KVBLK=64,NQB=17;
constexpr int ATTN_PITCH=DM, ATTN_UNIT_ROWS=QB;
__device__ __forceinline__ int crow(int r,int hi){return (r&3)+8*(r>>2)+4*hi;}
#define SBAR() __builtin_amdgcn_sched_barrier(0)
__device__ __forceinline__ void cmask(f32x16&p0,f32x16&p1,int jb,int qrel,int hi){
  const float NEG=-INFINITY; int kb=64*jb+4*hi;
  #pragma unroll
  for(int r=0;r<16;++r){int kv=kb+(r&3)+8*(r>>2); if(kv>qrel)p0[r]=NEG; if(kv+32>qrel)p1[r]=NEG;}
}

constexpr int NSLOT=3, SLOTB=8192;
constexpr int LDS_K=0, LDS_V=NSLOT*SLOTB, LDS_WS=2*NSLOT*SLOTB, LDS_OST=LDS_WS+NW*64*4, LDS_KB=LDS_OST+NW*4096, LDS_BYTES=LDS_KB+4352*4+256;
constexpr float C2=0.125f*1.4426950408889634f;
__device__ __forceinline__ void glds16(const void*gsrc,unsigned lds_dst){unsigned keep;
  asm volatile("s_mov_b32 %0, m0\n\ts_mov_b32 m0, %2\n\ts_nop 0\n\tglobal_load_lds_dwordx4 %1, off\n\ts_mov_b32 m0, %0":"=&s"(keep):"v"(gsrc),"s"(lds_dst):"memory");}
__device__ __forceinline__ float max3f(float a,float b,float c){float r;asm("v_max3_f32 %0, %1, %2, %3":"=v"(r):"v"(a),"v"(b),"v"(c));return r;}
__device__ __forceinline__ float max2f(float a,float b){float r;asm("v_max_f32_e32 %0, %1, %2":"=v"(r):"v"(a),"v"(b));return r;}
__device__ __forceinline__ float fadd_s(float a,float b){float r;asm("v_add_f32_e32 %0, %1, %2":"=v"(r):"v"(a),"v"(b));return r;}
__device__ __forceinline__ float fsub_s(float a,float b){float r;asm("v_sub_f32_e32 %0, %1, %2":"=v"(r):"v"(a),"v"(b));return r;}
typedef float f32x2_t __attribute__((ext_vector_type(2))); typedef __bf16 bf16x2_t __attribute__((ext_vector_type(2)));
__device__ __forceinline__ unsigned cvtpk_s(float lo,float hi){f32x2_t v={lo,hi};bf16x2_t b=__builtin_convertvector(v,bf16x2_t);return __builtin_bit_cast(unsigned,b);}
#define WAIT_BAR(N) asm volatile("s_waitcnt vmcnt(" #N ") lgkmcnt(0)\n\ts_barrier":::"memory")

__device__ __forceinline__ void qkt(f32x16&p0,f32x16&p1,const char*Kslot,const bf16x8*qr,int r32,int hi){
  const char*kb=Kslot+hi*1024+r32*16;
  #pragma unroll
  for(int d0=0;d0<4;++d0){
    const bf16x8 b0=*reinterpret_cast<const bf16x8*>(kb+d0*2048);
    const bf16x8 b1=*reinterpret_cast<const bf16x8*>(kb+d0*2048+512);
    p0=__builtin_amdgcn_mfma_f32_32x32x16_bf16(b0,qr[d0],p0,0,0,0);p1=__builtin_amdgcn_mfma_f32_32x32x16_bf16(b1,qr[d0],p1,0,0,0);}
}
typedef __attribute__((address_space(3))) const char* lds_cptr;
typedef short v4i16_t __attribute__((ext_vector_type(4)));
__device__ __forceinline__ void kload8(bf16x8*kf,lds_cptr kp){
  kf[0]=*(const __attribute__((address_space(3))) bf16x8*)(kp);      kf[1]=*(const __attribute__((address_space(3))) bf16x8*)(kp+512);
  kf[2]=*(const __attribute__((address_space(3))) bf16x8*)(kp+2048); kf[3]=*(const __attribute__((address_space(3))) bf16x8*)(kp+2560);
  kf[4]=*(const __attribute__((address_space(3))) bf16x8*)(kp+4096); kf[5]=*(const __attribute__((address_space(3))) bf16x8*)(kp+4608);
  kf[6]=*(const __attribute__((address_space(3))) bf16x8*)(kp+6144); kf[7]=*(const __attribute__((address_space(3))) bf16x8*)(kp+6656);
}
__device__ __forceinline__ void kload2(bf16x8*kf,lds_cptr kp,int j){ kf[2*j]=*(const __attribute__((address_space(3))) bf16x8*)(kp+j*2048); kf[2*j+1]=*(const __attribute__((address_space(3))) bf16x8*)(kp+j*2048+512); }
__device__ __forceinline__ s16x4 vtr(lds_cptr p){ return __builtin_bit_cast(s16x4,__builtin_amdgcn_ds_read_tr16_b64_v4i16((__attribute__((address_space(3))) v4i16_t*)p)); }
__device__ __forceinline__ float rowmax(const f32x16&p0,const f32x16&p1){
  float a=max3f(p0[0],p0[1],p1[0]),b=max3f(p0[2],p0[3],p1[1]);a=max3f(a,p1[2],p1[3]);
  #pragma unroll
  for(int r=4;r<16;r+=4){a=max3f(a,p0[r],p0[r+1]);b=max3f(b,p0[r+2],p0[r+3]);a=max3f(a,p1[r],p1[r+1]);b=max3f(b,p1[r+2],p1[r+3]);}
  const float m=max2f(a,b);
  auto rr=__builtin_amdgcn_permlane32_swap(__float_as_uint(m),__float_as_uint(m),false,false);
  return max2f(__uint_as_float(rr[0]),__uint_as_float(rr[1]));
}
__device__ __forceinline__ void pv(f32x16*o,int vb,bf16x8 pa0,bf16x8 pa1,bf16x8 pa2,bf16x8 pa3){
  #pragma unroll
  for(int d0=0;d0<2;++d0){s16x4 lo[4],hi[4];
    #pragma unroll
    for(int ks=0;ks<4;++ks){
      asm volatile("ds_read_b64_tr_b16 %0,%1 offset:%c2":"=&v"(lo[ks]):"v"(vb),"i"(d0*4096+ks*1024):"memory");
      asm volatile("ds_read_b64_tr_b16 %0,%1 offset:%c2":"=&v"(hi[ks]):"v"(vb),"i"(d0*4096+ks*1024+512):"memory");}
    asm volatile("s_waitcnt lgkmcnt(0)":::"memory");SBAR();
    #define PK(k) (bf16x8){lo[k][0],lo[k][1],lo[k][2],lo[k][3],hi[k][0],hi[k][1],hi[k][2],hi[k][3]}
    o[d0]=__builtin_amdgcn_mfma_f32_32x32x16_bf16(pa0,PK(0),o[d0],0,0,0);
    o[d0]=__builtin_amdgcn_mfma_f32_32x32x16_bf16(pa1,PK(1),o[d0],0,0,0);
    o[d0]=__builtin_amdgcn_mfma_f32_32x32x16_bf16(pa2,PK(2),o[d0],0,0,0);
    o[d0]=__builtin_amdgcn_mfma_f32_32x32x16_bf16(pa3,PK(3),o[d0],0,0,0);
    #undef PK
  }
}

#ifndef ATTN_STORE16
#define ATTN_STORE16(p,v) (*(u32x4*)(p)=(v))
#endif
template<int THRL> __device__ __forceinline__ void attn_unit(int b,int h,int qb,const bf16*Q,const bf16*__restrict__ K,const bf16*__restrict__ V,bf16*O,const float*__restrict__ kbg,const unsigned*__restrict__ kn2p,char*shm){
  int tid_=threadIdx.x; asm volatile("":"+v"(tid_)); const int tid=tid_,lane=tid&63,r32=lane&31,hi=lane>>5; const int wid=__builtin_amdgcn_readfirstlane(tid>>6);
  const long rowbase=(long)b*SEQ; const int q0=qb*QB;
  const bf16*Qw=Q+(rowbase+q0+wid*QBLK)*DM+h*D;
  const bf16*Kh=K+rowbase*DM+h*D,*Vh=V+rowbase*DM+h*D;
  const unsigned lds0=(unsigned)(uintptr_t)shm;
  float*wsf=(float*)(shm+LDS_WS)+wid*64;
  const bf16*ksrc=Kh+(long)lane*DM+wid*8;
  const bf16*vsrc=Vh+(long)(16*(wid&3)+(lane>>2))*DM+(wid>>2)*32+(lane&3)*8;
  const unsigned kdst=lds0+LDS_K+wid*1024, vdst=lds0+LDS_V+wid*1024;
  #define DMA_K(t,slot) glds16(ksrc+(long)(NT-1-(t))*KVBLK*DM,(unsigned)__builtin_amdgcn_readfirstlane(kdst+(slot)))
  #define DMA_V(t,slot) glds16(vsrc+(long)(NT-1-(t))*KVBLK*DM,(unsigned)__builtin_amdgcn_readfirstlane(vdst+(slot)))
  const int vb0=(int)(lds0+LDS_V)+((lane>>4)&1)*32+(lane&3)*8+(4*hi+((lane&15)>>2))*64;
  const char*Kbase=shm+LDS_K; bf16x8 kf[8];
  const lds_cptr shm3=(lds_cptr)shm; const lds_cptr kp0=shm3+LDS_K+hi*1024+r32*16; const lds_cptr vp0=shm3+LDS_V+((lane>>4)&1)*32+(lane&3)*8+(4*hi+((lane&15)>>2))*64;
  const int NT=(q0+QB)/KVBLK;
  typedef __attribute__((address_space(3))) float lds_f32; typedef float kb4_t __attribute__((ext_vector_type(4)));
  { lds_f32*kw=(lds_f32*)(shm3+LDS_KB); float kv_[9];
    _Pragma("unroll") for(int j=0;j<9;++j){const int i=tid+j*NW*64; kv_[j]=(i<NT*KVBLK)?kbg[i]:0.f;}
    _Pragma("unroll") for(int j=0;j<9;++j){const int i=tid+j*NW*64; if(i<NT*KVBLK)kw[i]=kv_[j];} }
  const __attribute__((address_space(3))) kb4_t*kbl=(const __attribute__((address_space(3))) kb4_t*)(shm3+LDS_KB)+hi;
  #define KBLOAD(P0,P1,t) do{ const __attribute__((address_space(3))) kb4_t*kb_=kbl+16*(NT-1-(t)); \
    _Pragma("unroll") for(int g_=0;g_<4;++g_){ const kb4_t a_=kb_[2*g_], b_=kb_[2*g_+8]; \
      P0[4*g_]=a_[0];P0[4*g_+1]=a_[1];P0[4*g_+2]=a_[2];P0[4*g_+3]=a_[3]; P1[4*g_]=b_[0];P1[4*g_+1]=b_[1];P1[4*g_+2]=b_[2];P1[4*g_+3]=b_[3]; } }while(0)
  DMA_K(0,0);DMA_V(0,0);DMA_K(1,SLOTB);
  bf16x8 qr[4];
  #pragma unroll
  for(int d0=0;d0<4;++d0)qr[d0]=*reinterpret_cast<const bf16x8*>(&Qw[(long)r32*DM+d0*16+hi*8]);
  float mhat=0.f,l_reg=0.f;f32x16 o[2];o[0]=f32x16{};o[1]=f32x16{};
  const int qrel=wid*QBLK+r32;
  #define CMASK(P0,P1,t) do{ if((t)<4)cmask(P0,P1,3-(t),qrel,hi); }while(0)
  bool resc=false;
  #define START(P0,P1) do{ const float rm=rowmax(P0,P1); resc=false; \
    { const float dl=(rm==-INFINITY)?-1.0e4f:rm; mhat=fadd_s(mhat,dl); \
      _Pragma("unroll") for(int r=0;r<16;++r){P0[r]=fsub_s(P0[r],dl);P1[r]=fsub_s(P1[r],dl);} } \
    _Pragma("unroll") for(int r=0;r<16;++r)P0[r]=__builtin_amdgcn_exp2f(P0[r]); }while(0)
  #define RESC() do{ if(resc){ asm volatile("s_waitcnt lgkmcnt(0)":::"memory"); \
      _Pragma("unroll") for(int d_=0;d_<2;++d_) _Pragma("unroll") for(int r=0;r<16;++r)o[d_][r]*=wsf[crow(r,hi)]; } }while(0)
  f32x16 pA0,pA1,pB0,pB1;
  int sl_prev=0,sl_cur=0,sl_next=SLOTB;
  #define ROT() do{sl_prev=sl_cur;sl_cur=sl_next;sl_next=(sl_next==(NSLOT-1)*SLOTB)?0:sl_next+SLOTB;}while(0)
  DMA_K(2,2*SLOTB);
  {
    float s_=0.f;
    _Pragma("unroll") for(int d0=0;d0<4;++d0) _Pragma("unroll") for(int e_=0;e_<8;++e_){ const float x_=__builtin_bit_cast(float,(unsigned)(unsigned short)qr[d0][e_]<<16); s_+=x_*x_; }
    { auto rr_=__builtin_amdgcn_permlane32_swap(__float_as_uint(s_),__float_as_uint(s_),false,false); s_=__uint_as_float(rr_[0])+__uint_as_float(rr_[1]); }
    _Pragma("unroll") for(int o_=1;o_<32;o_<<=1) s_=fmaxf(s_,__shfl_xor(s_,o_));
    if(lane==0)wsf[0]=s_; }
  WAIT_BAR(3);
  int NTe=NT;
  { const float*wl_=(const float*)(shm+LDS_WS); float q2_=0.f;
    _Pragma("unroll") for(int w_=0;w_<NW;++w_) q2_=fmaxf(q2_,wl_[w_*64]);
    const float qk_=sqrtf(q2_*__uint_as_float(*kn2p));
    const lds_f32*kbs_=(const lds_f32*)(shm3+LDS_KB);
    const float thr_=kbs_[q0]-(64.f+(float)THRL+8.f+2.f*qk_);
    const int T0_=lane, T1_=lane+64;
    const bool c0_=(T0_<NT-4)&&(kbs_[64*T0_+63]<thr_), c1_=(T1_<NT-4)&&(kbs_[64*T1_+63]<thr_);
    const int cut_=(__popcll(__ballot(c0_))+__popcll(__ballot(c1_)))&~1;
    NTe=NT-cut_; }
  KBLOAD(pA0,pA1,0);
  qkt(pA0,pA1,Kbase,qr,r32,hi);asm volatile("s_nop 15\n\ts_nop 7":"+v"(pA0),"+v"(pA1));CMASK(pA0,pA1,0);
  START(pA0,pA1);
  _Pragma("unroll") for(int r=0;r<16;++r)pA1[r]=__builtin_amdgcn_exp2f(pA1[r]);
  KBLOAD(pB0,pB1,1);
  _Pragma("unroll") for(int r=0;r<16;++r){pB0[r]-=mhat;pB1[r]-=mhat;}
  WAIT_BAR(0);
  DMA_K(3,0);DMA_V(1,SLOTB);
  ROT();
  kload8(kf,kp0+sl_cur);
  WAIT_BAR(2);
  s16x4 vlo[8],vhi[8]; u32x4 pw0,pw1,pw2,pw3;
  #define PKW(P,B) cvtpk_s(P[B],P[B+1])
  #define PAF(k) __builtin_bit_cast(bf16x8,pw##k)
  #define VFR(i) (bf16x8){vlo[i][0],vlo[i][1],vlo[i][2],vlo[i][3],vhi[i][0],vhi[i][1],vhi[i][2],vhi[i][3]}
  #define PIN(x) asm volatile("":"+v"(x))
  #define MX3(a,b,c) __builtin_fmaxf(__builtin_fmaxf((a),(b)),(c))
  #define GAPA(MF,A0,A1,A2,A3,W0,W1,PW) do{ MF; sacc+=A0; sacc+=A1; sacc+=A2; sacc+=A3; PIN(sacc); W0; W1; PIN(PW); SBAR(); }while(0)
  #define EX(v) __builtin_amdgcn_exp2f(v)
  #define GAPB(MF,X,B,Y) do{ MF; X[B]=EX(X[B]); X[B+1]=EX(X[B+1]); X[B+2]=EX(X[B+2]); X[B+3]=EX(X[B+3]); PIN(X); Y[B]-=mhat; Y[B+1]-=mhat; Y[B+2]-=mhat; Y[B+3]-=mhat; SBAR(); }while(0)
  #define VRD(i) do{ vlo[i]=vtr(vp_+(((i)>>2)*4096+((i)&3)*1024)); vhi[i]=vtr(vp_+(((i)>>2)*4096+((i)&3)*1024+512)); }while(0)
  #define KRD(G,j) do{ if(G){ kload2(kf,kp0+sl_next,j); SBAR(); } }while(0)
  #define STEP(C0,C1,P0,P1,t,GK,GV,GL) do{ SBAR(); \
    const lds_cptr vp_=vp0+sl_prev; \
    VRD(0); SBAR(); float sacc=(P0[0]+P0[1]); \
    GAPA(C0=__builtin_amdgcn_mfma_f32_32x32x16_bf16(kf[0],qr[0],C0,0,0,0), P0[2],P0[3],P0[4],P0[5],     pw0[0]=PKW(P0,0), pw0[1]=PKW(P0,2), pw0); \
    VRD(4); SBAR(); GAPA(C1=__builtin_amdgcn_mfma_f32_32x32x16_bf16(kf[1],qr[0],C1,0,0,0), P0[6],P0[7],P0[8],P0[9],     pw0[2]=PKW(P0,4), pw0[3]=PKW(P0,6), pw0); \
    VRD(1); SBAR(); GAPA(C0=__builtin_amdgcn_mfma_f32_32x32x16_bf16(kf[2],qr[1],C0,0,0,0),   P0[10],P0[11],P0[12],P0[13], pw1[0]=PKW(P0,8), pw1[1]=PKW(P0,10), pw1); \
    VRD(5); SBAR(); GAPA(C1=__builtin_amdgcn_mfma_f32_32x32x16_bf16(kf[3],qr[1],C1,0,0,0),   P0[14],P0[15],P1[0],P1[1],   pw1[2]=PKW(P0,12),pw1[3]=PKW(P0,14), pw1); \
    VRD(2); SBAR(); GAPA(C0=__builtin_amdgcn_mfma_f32_32x32x16_bf16(kf[4],qr[2],C0,0,0,0),   P1[2],P1[3],P1[4],P1[5],     pw2[0]=PKW(P1,0), pw2[1]=PKW(P1,2), pw2); \
    VRD(6); SBAR(); GAPA(C1=__builtin_amdgcn_mfma_f32_32x32x16_bf16(kf[5],qr[2],C1,0,0,0),   P1[6],P1[7],P1[8],P1[9],     pw2[2]=PKW(P1,4), pw2[3]=PKW(P1,6), pw2); \
    VRD(3); SBAR(); GAPA(C0=__builtin_amdgcn_mfma_f32_32x32x16_bf16(kf[6],qr[3],C0,0,0,0),   P1[10],P1[11],P1[12],P1[13], pw3[0]=PKW(P1,8), pw3[1]=PKW(P1,10), pw3); \
    VRD(7); SBAR(); GAPA(C1=__builtin_amdgcn_mfma_f32_32x32x16_bf16(kf[7],qr[3],C1,0,0,0),   P1[14],P1[15],0.f,0.f,       pw3[2]=PKW(P1,12),pw3[3]=PKW(P1,14), pw3); \
    l_reg+=sacc; \
    KBLOAD(P0,P1,(t)+1); \
    if(GK){DMA_K((t)+3,sl_cur);} if(GV){DMA_V((t)+1,sl_next);} \
    CMASK(C0,C1,t); \
    { float a=MX3(C0[0],C0[1],C1[0]),b=MX3(C0[2],C0[3],C1[1]); a=MX3(a,C1[2],C1[3]); \
      _Pragma("unroll") for(int r=4;r<16;r+=4){a=MX3(a,C0[r],C0[r+1]);b=MX3(b,C0[r+2],C0[r+3]);a=MX3(a,C1[r],C1[r+1]);b=MX3(b,C1[r+2],C1[r+3]);} \
      float rm=__builtin_fmaxf(a,b); { auto rr=__builtin_amdgcn_permlane32_swap(__float_as_uint(rm),__float_as_uint(rm),false,false); rm=__builtin_fmaxf(__uint_as_float(rr[0]),__uint_as_float(rr[1])); } \
      resc=false; \
      if(__builtin_expect(__any(rm>(float)THRL),0)){ const float dl=__builtin_fmaxf(rm,0.f); mhat+=dl; \
        _Pragma("unroll") for(int r=0;r<16;++r){C0[r]-=dl;C1[r]-=dl;} \
        const float f=__builtin_amdgcn_exp2f(-dl); l_reg*=f; if(hi==0)wsf[r32]=f; resc=true; } } \
    SBAR(); \
    GAPB(o[0]=__builtin_amdgcn_mfma_f32_32x32x16_bf16(PAF(0),VFR(0),o[0],0,0,0), C0,0,P0); \
    GAPB(o[1]=__builtin_amdgcn_mfma_f32_32x32x16_bf16(PAF(0),VFR(4),o[1],0,0,0), C0,4,P0); \
    KRD(GL,0); GAPB(o[0]=__builtin_amdgcn_mfma_f32_32x32x16_bf16(PAF(1),VFR(1),o[0],0,0,0), C0,8,P0); \
    KRD(GL,1); GAPB(o[1]=__builtin_amdgcn_mfma_f32_32x32x16_bf16(PAF(1),VFR(5),o[1],0,0,0), C0,12,P0); \
    KRD(GL,2); GAPB(o[0]=__builtin_amdgcn_mfma_f32_32x32x16_bf16(PAF(2),VFR(2),o[0],0,0,0), C1,0,P1); \
    KRD(GL,3); GAPB(o[1]=__builtin_amdgcn_mfma_f32_32x32x16_bf16(PAF(2),VFR(6),o[1],0,0,0), C1,4,P1); \
    GAPB(o[0]=__builtin_amdgcn_mfma_f32_32x32x16_bf16(PAF(3),VFR(3),o[0],0,0,0), C1,8,P1); \
    GAPB(o[1]=__builtin_amdgcn_mfma_f32_32x32x16_bf16(PAF(3),VFR(7),o[1],0,0,0), C1,12,P1); \
    }while(0)
  int t=1;
  #undef CMASK
  #define CMASK(P0,P1,t) do{ if((t)<4)cmask(P0,P1,3-(t),qrel,hi); }while(0)
  for(;t+5<NTe;t+=2){
    STEP(pB0,pB1,pA0,pA1,t,true,true,true);     WAIT_BAR(2); RESC(); ROT();
    STEP(pA0,pA1,pB0,pB1,t+1,true,true,true);   WAIT_BAR(2); RESC(); ROT();
  }
  #undef CMASK
  #define CMASK(P0,P1,t) do{ if((t)<4)cmask(P0,P1,3-(t),qrel,hi); }while(0)
  #define ENDW(tt) do{ if((tt)+3<NTe){WAIT_BAR(2);} else if((tt)+2<NTe){WAIT_BAR(1);} else {WAIT_BAR(0);} }while(0)
  for(;t+1<NTe;t+=2){
    STEP(pB0,pB1,pA0,pA1,t,(t+3<NTe),(t+1<NTe),(t+1<NTe));       ENDW(t);   RESC(); ROT();
    STEP(pA0,pA1,pB0,pB1,t+1,(t+4<NTe),(t+2<NTe),(t+2<NTe));     ENDW(t+1); RESC(); ROT();
  }
  STEP(pB0,pB1,pA0,pA1,NTe-1,false,false,false); RESC();
  { float sacc=pB0[0]+pB0[1]; _Pragma("unroll") for(int r=2;r<16;++r)sacc+=pB0[r]; _Pragma("unroll") for(int r=0;r<16;++r)sacc+=pB1[r]; l_reg+=sacc;
    pw0=(u32x4){PKW(pB0,0),PKW(pB0,2),PKW(pB0,4),PKW(pB0,6)};pw1=(u32x4){PKW(pB0,8),PKW(pB0,10),PKW(pB0,12),PKW(pB0,14)};pw2=(u32x4){PKW(pB1,0),PKW(pB1,2),PKW(pB1,4),PKW(pB1,6)};pw3=(u32x4){PKW(pB1,8),PKW(pB1,10),PKW(pB1,12),PKW(pB1,14)};
    SBAR(); pv(o,vb0+sl_cur,PAF(0),PAF(1),PAF(2),PAF(3)); }
  #undef PKW
  #undef PAF
  #undef VFR
  #undef PIN
  #undef MX3
  #undef GAPA
  #undef GAPB
  #undef EX
  #undef VRD
  #undef KRD
  #undef STEP
  #undef ENDW
  {auto rr=__builtin_amdgcn_permlane32_swap(__float_as_uint(l_reg),__float_as_uint(l_reg),false,false);l_reg=__uint_as_float(rr[0])+__uint_as_float(rr[1]);}
  if(hi==0)wsf[32+r32]=l_reg;asm volatile("s_waitcnt lgkmcnt(0)":::"memory");
  float rli[16];
  #pragma unroll
  for(int r=0;r<16;++r){const float l_=wsf[32+crow(r,hi)]; rli[r]=l_>0.f?__builtin_amdgcn_rcpf(l_):0.f;}
  bf16*Ow=O+(rowbase+q0+wid*QBLK)*OP+h*D;
  { bf16*stg=(bf16*)(shm+LDS_OST)+wid*2048;
    #pragma unroll
    for(int r=0;r<16;++r){const int orow=crow(r,hi);
      #pragma unroll
      for(int d0=0;d0<2;++d0)stg[orow*64+d0*32+r32]=__float2bfloat16(o[d0][r]*rli[r]);}
    asm volatile("s_waitcnt lgkmcnt(0)":::"memory");
    #pragma unroll
    for(int i=0;i<4;++i){const int row=i*8+(lane>>3),ch=lane&7; const u32x4 v=*(const u32x4*)(stg+row*64+ch*8); if(q0+wid*QBLK+row<SEQ)ATTN_STORE16(Ow+(long)row*OP+ch*8,v);} }
  asm volatile("s_waitcnt lgkmcnt(0)\n\ts_barrier":::"memory");
  #undef KBLOAD
  #undef DMA_K
  #undef DMA_V
  #undef CMASK
  #undef START
  #undef RESC
  #undef ROT
}
constexpr int ATTN_LDS_BYTES=LDS_BYTES;
#undef SBAR
#undef WAIT_BAR
}

__device__ __forceinline__ void mix_queue(const Ctx& c, unsigned char* lds_generic, int layer, const bf16_t* SD, unsigned* qctr);

namespace hg {
constexpr int P = 272, PA = 144;
constexpr int O_QE = 0, O_QS = 17408, O_KS = 34816, O_VT = 52224, O_ST = 69632, O_AM = 104448, O_QT = 113664, O_RS = 115712, O_END = 117760;
typedef short v4i16_t __attribute__((ext_vector_type(4)));
__device__ __forceinline__ f32x4 mfma16(bf16x8 a, bf16x8 b, f32x4 c) { return __builtin_amdgcn_mfma_f32_16x16x32_bf16(a, b, c, 0, 0, 0); }
__device__ __forceinline__ bf16x8 tr_frag(const LAS unsigned char* p, int pitch) {
    const v4i16_t lo = __builtin_amdgcn_ds_read_tr16_b64_v4i16((LAS v4i16_t*)p);
    const v4i16_t hi = __builtin_amdgcn_ds_read_tr16_b64_v4i16((LAS v4i16_t*)(p + 4 * pitch));
    return (bf16x8){lo[0], lo[1], lo[2], lo[3], hi[0], hi[1], hi[2], hi[3]};
}
}

struct ARegs { float g[16]; u32x4 vv[2]; };
__device__ __forceinline__ void hgrn_A_load(const Ctx& c, int tid, int bh, int ch, ARegs& R) {
    const int b = bh >> 2, hh = bh & 3; const size_t r0 = (size_t)b * LV + 64 * ch;
    const int k = tid & 127, sq = tid >> 7;
    const float* gp = c.LOGF + (r0 + 16 * sq) * 512 + hh * 128 + k;
#pragma unroll
    for (int i = 0; i < 16; ++i) R.g[i] = gp[(size_t)i * 512];
#pragma unroll
    for (int i = 0; i < 2; ++i) { const int id = tid + 512 * i, row = id >> 4, cc = id & 15; R.vv[i] = *(const u32x4*)(c.HV + (r0 + row) * 512 + hh * 128 + cc * 8); }
}
__device__ __forceinline__ void hgrn_A_compute(const Ctx& c, LAS unsigned char* lds, int tid, int bh, int ch, bf16_t* SD, float* DV, const ARegs& R) {
    using namespace hg;
    const int lane = tid & 63, w = __builtin_amdgcn_readfirstlane(tid >> 6);
    const int k = tid & 127, sq = tid >> 7;
    float bl[16];
    { float s = 0.f;
#pragma unroll
      for (int i = 0; i < 16; ++i) { s += R.g[i]; bl[i] = s; }
      ((LAS float*)(lds + O_QT))[sq * 128 + k] = s; }
#pragma unroll
    for (int i = 0; i < 2; ++i) { const int id = tid + 512 * i, row = id >> 4, cc = id & 15; *(LAS u32x4*)(lds + O_VT + row * P + cc * 16) = R.vv[i]; }
    asm volatile("s_waitcnt lgkmcnt(0)\n\ts_barrier" ::: "memory");
    { const LAS float* qt = (const LAS float*)(lds + O_QT); float pre = 0.f, tot = 0.f;
#pragma unroll
      for (int q = 0; q < 4; ++q) { const float t = qt[q * 128 + k]; tot += t; if (q < sq) pre += t; }
#pragma unroll
      for (int i = 0; i < 16; ++i) { const float kd = (1.f - __expf(R.g[i])) * __expf(tot - (pre + bl[i])); *(LAS bf16_t*)(lds + O_KS + (16 * sq + i) * P + 2 * k) = (bf16_t)f2bf(kd); }
      if (sq == 0) DV[((size_t)bh * 64 + ch) * 128 + k] = __expf(tot); }
    asm volatile("s_waitcnt lgkmcnt(0)\n\ts_barrier" ::: "memory");
    const int fr = lane & 15, g4 = lane >> 4, q = fr >> 2, p = lane & 3;
    const LAS unsigned char* abase = lds + O_VT + (8 * g4 + q) * P + w * 32 + p * 8;
    const LAS unsigned char* bbase = lds + O_KS + (8 * g4 + q) * P + p * 8;
    bf16x8 a[2]; a[0] = tr_frag(abase, P); a[1] = tr_frag(abase + 32 * P, P);
    bf16_t* od = SD + ((size_t)bh * 64 + ch) * 16384 + (size_t)(16 * w + 4 * g4) * 128 + fr;
#pragma unroll
    for (int ct = 0; ct < 8; ++ct) { f32x4 acc = (f32x4){0.f, 0.f, 0.f, 0.f};
        acc = mfma16(a[0], tr_frag(bbase + ct * 32, P), acc); acc = mfma16(a[1], tr_frag(bbase + 32 * P + ct * 32, P), acc);
#pragma unroll
        for (int j = 0; j < 4; ++j) od[j * 128 + 16 * ct] = (bf16_t)f2bf(acc[j]); }
    asm volatile("s_waitcnt lgkmcnt(0)\n\ts_barrier" ::: "memory");
}
__device__ __forceinline__ void hgrn_A_phase(const Ctx& c, LAS unsigned char* lds, bf16_t* SD, float* DV) {
    int tid_ = threadIdx.x; asm volatile("" : "+v"(tid_)); const int tid = tid_;
    ARegs R;
    int u = blockIdx.x;
    if (u < 16 * 64) hgrn_A_load(c, tid, u >> 6, u & 63, R);
    for (; u < 16 * 64; u += gridDim.x) {
        const ARegs Rc = R;
        const int un = u + gridDim.x;
        if (un < 16 * 64) hgrn_A_load(c, tid, un >> 6, un & 63, R);
        hgrn_A_compute(c, lds, tid, u >> 6, u & 63, SD, DV, Rc);
    }
    __syncthreads();
}

__device__ __forceinline__ void hgrn_B_scan(const Ctx& c, bf16_t* SD, const float* DV) {
    const int gt = blockIdx.x * NTHREADS + c.tid, NGT = gridDim.x * NTHREADS;
    for (int pidx = gt; pidx < 16 * 8192; pidx += NGT) {
        const int bh = pidx >> 13, e2 = pidx & 8191, k = (e2 & 63) * 2;
        unsigned* sp = (unsigned*)(SD + (size_t)bh * 64 * 16384 + 2 * e2);
        const float* dp = DV + (size_t)bh * 64 * 128 + k;
        float s0 = 0.f, s1 = 0.f;
        for (int c0 = 0; c0 < 64; c0 += 16) {
            unsigned d[16]; float dv0[16], dv1[16];
#pragma unroll
            for (int i = 0; i < 16; ++i) { d[i] = sp[(size_t)(c0 + i) * 8192]; const float* q = dp + (c0 + i) * 128; dv0[i] = q[0]; dv1[i] = q[1]; }
#pragma unroll
            for (int i = 0; i < 16; ++i) { s0 = dv0[i] * s0 + __builtin_bit_cast(float, d[i] << 16); s1 = dv1[i] * s1 + __builtin_bit_cast(float, d[i] & 0xffff0000u);
                sp[(size_t)(c0 + i) * 8192] = pk2(s0, s1); }
        }
    }
}

struct CRegs { float g[16]; unsigned short q[16]; unsigned short gt[16]; u32x4 vv[2]; u32x4 st[4]; };
#define LBAR() asm volatile("s_waitcnt lgkmcnt(0)\n\ts_barrier" ::: "memory")
__device__ __forceinline__ void hgrn_C_load(const Ctx& c, int tid, int bh, int ch, const bf16_t* SD, CRegs& R) {
    const int lane = tid & 63, w = __builtin_amdgcn_readfirstlane(tid >> 6);
    const int b = bh >> 2, hh = bh & 3; const size_t r0 = (size_t)b * LV + 64 * ch;
    const int k = tid & 127, sq = tid >> 7, fr = lane & 15, g4 = lane >> 4;
    const float* gp = c.LOGF + (r0 + 16 * sq) * 512 + hh * 128 + k; const bf16_t* qp = c.HXQ + (r0 + 16 * sq) * 512 + hh * 128 + k;
#pragma unroll
    for (int i = 0; i < 16; ++i) { R.g[i] = gp[(size_t)i * 512]; R.q[i] = qp[(size_t)i * 512]; }
#pragma unroll
    for (int i = 0; i < 2; ++i) { const int id = tid + 512 * i, row = id >> 4, cc = id & 15; R.vv[i] = *(const u32x4*)(c.HV + (r0 + row) * 512 + hh * 128 + cc * 8); }
    if (ch > 0) { const bf16_t* sp = SD + ((size_t)bh * 64 + ch - 1) * 16384;
#pragma unroll
        for (int i = 0; i < 4; ++i) { const int id = tid + 512 * i, row = id >> 4, cc = id & 15; R.st[i] = *(const u32x4*)(sp + row * 128 + cc * 8); } }
#pragma unroll
    for (int tt = 0; tt < 4; ++tt)
#pragma unroll
        for (int j = 0; j < 4; ++j) R.gt[tt * 4 + j] = c.HG[(r0 + 16 * tt + 4 * g4 + j) * 512 + hh * 128 + 16 * w + fr];
}
__device__ __forceinline__ void hgrn_C_compute(const Ctx& c, LAS unsigned char* lds, int tid, int layer, int bh, int ch, const CRegs& R) {
    using namespace hg;
    const int lane = tid & 63, w = __builtin_amdgcn_readfirstlane(tid >> 6);
    const int b = bh >> 2, hh = bh & 3; const size_t r0 = (size_t)b * LV + 64 * ch;
    const int k = tid & 127, sq = tid >> 7;
    float bl[16];
    { float s = 0.f;
#pragma unroll
      for (int i = 0; i < 16; ++i) { s += R.g[i]; bl[i] = s; }
      ((LAS float*)(lds + O_QT))[sq * 128 + k] = s; }
#pragma unroll
    for (int i = 0; i < 2; ++i) { const int id = tid + 512 * i, row = id >> 4, cc = id & 15; *(LAS u32x4*)(lds + O_VT + row * P + cc * 16) = R.vv[i]; }
    if (ch > 0) {
#pragma unroll
        for (int i = 0; i < 4; ++i) { const int id = tid + 512 * i, row = id >> 4, cc = id & 15; *(LAS u32x4*)(lds + O_ST + row * P + cc * 16) = R.st[i]; }
    }
    LBAR();
    { const LAS float* qt = (const LAS float*)(lds + O_QT); float pre = 0.f;
#pragma unroll
      for (int q = 0; q < 4; ++q) { const float t = qt[q * 128 + k]; if (q < sq) pre += t; }
      const float rr = qt[k] + qt[128 + k];
#pragma unroll
      for (int i = 0; i < 16; ++i) { const float bb = pre + bl[i]; const int off = (16 * sq + i) * P + 2 * k; const float qv = bf2f(R.q[i]);
          *(LAS bf16_t*)(lds + O_QE + off) = (bf16_t)f2bf(qv * __expf(bb));
          *(LAS bf16_t*)(lds + O_QS + off) = (bf16_t)f2bf(qv * __expf(fminf(bb - rr, 80.f)));
          *(LAS bf16_t*)(lds + O_KS + off) = (bf16_t)f2bf((1.f - __expf(R.g[i])) * __expf(fminf(rr - bb, 80.f))); } }
    LBAR();
    const int fr = lane & 15, g4 = lane >> 4, q = fr >> 2, p = lane & 3;
#pragma unroll
    for (int tl = 0; tl < 2; ++tl) { const int tile = 2 * w + tl, ti = tile >> 2, sj = tile & 3;
        f32x4 acc = (f32x4){0.f, 0.f, 0.f, 0.f};
        if (sj <= ti) {
#pragma unroll
            for (int ks = 0; ks < 4; ++ks) { const bf16x8 a = *(const LAS bf16x8*)(lds + O_QS + (16 * ti + fr) * P + (32 * ks + 8 * g4) * 2);
                const bf16x8 bb = *(const LAS bf16x8*)(lds + O_KS + (16 * sj + fr) * P + (32 * ks + 8 * g4) * 2); acc = mfma16(a, bb, acc); } }
#pragma unroll
        for (int j = 0; j < 4; ++j) { const int t = 16 * ti + 4 * g4 + j, s = 16 * sj + fr; const float v = (s <= t) ? acc[j] : 0.f; *(LAS bf16_t*)(lds + O_AM + t * PA + 2 * s) = (bf16_t)f2bf(v); } }
    LBAR();
    f32x4 acc[4];
#pragma unroll
    for (int tt = 0; tt < 4; ++tt) acc[tt] = (f32x4){0.f, 0.f, 0.f, 0.f};
    if (ch > 0) {
#pragma unroll
        for (int ks = 0; ks < 4; ++ks) { const bf16x8 bfr = *(const LAS bf16x8*)(lds + O_ST + (16 * w + fr) * P + (32 * ks + 8 * g4) * 2);
#pragma unroll
            for (int tt = 0; tt < 4; ++tt) { const bf16x8 a = *(const LAS bf16x8*)(lds + O_QE + (16 * tt + fr) * P + (32 * ks + 8 * g4) * 2); acc[tt] = mfma16(a, bfr, acc[tt]); } }
    }
#pragma unroll
    for (int ks = 0; ks < 2; ++ks) { const bf16x8 bfr = tr_frag(lds + O_VT + (32 * ks + 8 * g4 + q) * P + w * 32 + p * 8, P);
#pragma unroll
        for (int tt = 0; tt < 4; ++tt) { const bf16x8 a = *(const LAS bf16x8*)(lds + O_AM + (16 * tt + fr) * PA + (32 * ks + 8 * g4) * 2); acc[tt] = mfma16(a, bfr, acc[tt]); } }
    LAS float* rs = (LAS float*)(lds + O_RS);
#pragma unroll
    for (int tt = 0; tt < 4; ++tt)
#pragma unroll
        for (int j = 0; j < 4; ++j) { float s2 = acc[tt][j] * acc[tt][j]; s2 += __shfl_xor(s2, 1); s2 += __shfl_xor(s2, 2); s2 += __shfl_xor(s2, 4); s2 += __shfl_xor(s2, 8);
            if (fr == 0) rs[(16 * tt + 4 * g4 + j) * 8 + w] = s2; }
    LBAR();
    { const int v = 16 * w + fr; const float nw = c.hnw[layer * 128 + v];
#pragma unroll
      for (int tt = 0; tt < 4; ++tt)
#pragma unroll
        for (int j = 0; j < 4; ++j) { const int t = 16 * tt + 4 * g4 + j; const f32x4 s0 = *(const LAS f32x4*)(rs + t * 8), s1 = *(const LAS f32x4*)(rs + t * 8 + 4);
            const float ss = ((s0[0] + s0[1]) + (s0[2] + s0[3])) + ((s1[0] + s1[1]) + (s1[2] + s1[3])); const float rstd = 1.f / sqrtf(ss * (1.f / 128.f) + EPS);
            c.MIX[(r0 + t) * DM + 512 + hh * 128 + v] = (bf16_t)f2bf(acc[tt][j] * rstd * nw * bf2f(R.gt[tt * 4 + j])); } }
    LBAR();
}
__device__ __forceinline__ void hgrn_C_phase(const Ctx& c, LAS unsigned char* lds, int layer, const bf16_t* SD) {
    int tid_ = threadIdx.x; asm volatile("" : "+v"(tid_)); const int tid = tid_;
    CRegs R;
    int u = blockIdx.x;
    if (u < 16 * 65) hgrn_C_load(c, tid, u / 65, u % 65, SD, R);
    for (; u < 16 * 65; u += gridDim.x) {
        const CRegs Rc = R;
        const int un = u + gridDim.x;
        if (un < 16 * 65) hgrn_C_load(c, tid, un / 65, un % 65, SD, R);
        hgrn_C_compute(c, lds, tid, layer, u / 65, u % 65, Rc);
    }
    __syncthreads();
}

__device__ __forceinline__ void mix_queue(const Ctx& c, unsigned char* lds_generic, int layer, const bf16_t* SD, unsigned* qctr) {
    LAS volatile int* slot = (LAS volatile int*)((LAS unsigned char*)lds_generic + 131072);
    for (;;) {
        if (c.tid == 0) slot[0] = (int)atomicAdd(qctr, 1u);
        __syncthreads();
        const int n = slot[0];
        if (n >= 17 * 32) break;
        const int qb = 16 - (n >> 5), bh = n & 31;
        attn_body::attn_unit<8>(bh >> 3, bh & 7, qb, (const attn_body::bf16*)c.QB, (const attn_body::bf16*)c.KB, (const attn_body::bf16*)c.VB, (attn_body::bf16*)c.MIX,
                                c.kbias + (size_t)bh * KBL, c.ctl + 1024 + layer * 32 + bh, (char*)lds_generic);
    }
}

__device__ __forceinline__ void knorm_job(const Ctx& c, int layer, int job) {
    const int bh = job >> 3, sl = job & 7, b = bh >> 3, h = bh & 7;
    const int sub = c.tid & 7, rloc = c.tid >> 3;
    u32x4 kv[9];
#pragma unroll
    for (int i = 0; i < 9; ++i) { const int vp = sl * 520 + i * 64 + rloc; kv[i] = (i * 64 + rloc < 520) ? *(const u32x4*)(c.KB + (size_t)(b * LV + vp) * 512 + h * 64 + sub * 8) : (u32x4){0u, 0u, 0u, 0u}; }
    float m = 0.f;
#pragma unroll
    for (int i = 0; i < 9; ++i) { float s = 0.f;
#pragma unroll
        for (int e = 0; e < 4; ++e) { const float lo = __builtin_bit_cast(float, kv[i][e] << 16), hi = __builtin_bit_cast(float, kv[i][e] & 0xffff0000u); s += lo * lo + hi * hi; }
        s += __shfl_xor(s, 1); s += __shfl_xor(s, 2); s += __shfl_xor(s, 4); m = fmaxf(m, s); }
    m = wave_max(m);
    if (c.lane == 0) atomicMax(c.ctl + 1024 + layer * 32 + bh, __float_as_uint(m));
}

__device__ __forceinline__ void fox_simple(const Ctx& c, LAS unsigned char* lds, int first_block) {
    LAS float* sc = (LAS float*)(lds + c.wave * 16896);
    LAS float* qs = sc; LAS float* ps = sc + 64;
    const int nblk = gridDim.x - first_block; if ((int)blockIdx.x < first_block) return;
    const int gw = ((int)blockIdx.x - first_block) * NWAVES + c.wave, NGW = nblk * NWAVES;
    for (int it = gw; it < MROWS * FOXH; it += NGW) {
        const int r = it >> 3, h = it & 7, b = r / LV, vp = r - b * LV;
        bf16_t* op = c.MIX + (size_t)r * DM + h * 64;
        if (vp < PADF) { op[c.lane] = 0; continue; }
        qs[c.lane] = bf2f(c.QB[(size_t)r * 512 + h * 64 + c.lane]);
        asm volatile("s_waitcnt lgkmcnt(0)" ::: "memory");
        const float* kb = c.kbias + (size_t)(b * 8 + h) * KBL;
        float mx = -3.0e38f;
        for (int j = PADF + c.lane; j <= vp; j += 64) {
            const bf16_t* kr = c.KB + (size_t)(b * LV + j) * 512 + h * 64; float s = 0.f;
#pragma unroll
            for (int d8 = 0; d8 < 8; ++d8) { const bf16x8 kv = *(const bf16x8*)(kr + d8 * 8);
#pragma unroll
                for (int e = 0; e < 8; ++e) s += qs[d8 * 8 + e] * bf2f((unsigned short)kv[e]); }
            s += kb[j]; ps[j] = s; mx = fmaxf(mx, s);
        }
        mx = wave_max(mx);
        float l = 0.f;
        for (int j = PADF + c.lane; j <= vp; j += 64) { const float p = exp2f(ps[j] - mx); ps[j] = p; l += p; }
        l = wave_sum(l);
        asm volatile("s_waitcnt lgkmcnt(0)" ::: "memory");
        float o = 0.f;
        const bf16_t* vr = c.VB + (size_t)(b * LV) * 512 + h * 64 + c.lane;
        for (int j = PADF; j <= vp; ++j) o += ps[j] * bf2f(vr[(size_t)j * 512]);
        op[c.lane] = (bf16_t)f2bf(o / l);
        asm volatile("s_waitcnt lgkmcnt(0)" ::: "memory");
    }
}

__device__ __forceinline__ void hgrn_simple(const Ctx& c, LAS unsigned char* lds, int layer) {
    if (blockIdx.x >= NB * HGH) return;
    const int b = blockIdx.x >> 2, hh = blockIdx.x & 3;
    LAS float* fL = (LAS float*)lds;
    LAS float* kL = fL + 2048; LAS float* qL = kL + 2048; LAS float* vL = qL + 2048; LAS float* oP = vL + 2048;
    const int v = c.tid & 127, kg = c.tid >> 7;
    float S[32];
#pragma unroll
    for (int i = 0; i < 32; ++i) S[i] = 0.f;
    for (int i = c.tid; i < PADF * 128; i += NTHREADS) { const int vp = i >> 7; c.MIX[(size_t)(b * LV + vp) * DM + 512 + hh * 128 + (i & 127)] = 0; }
    for (int t0 = PADF; t0 < LV; t0 += 16) {
        for (int i = c.tid; i < 2048; i += NTHREADS) { const int t = i >> 7, k = i & 127; const size_t o = (size_t)(b * LV + t0 + t) * 512 + hh * 128 + k;
            const float f = __expf(c.LOGF[o]); fL[i] = f; kL[i] = 1.f - f; qL[i] = bf2f(c.HXQ[o]); vL[i] = bf2f(c.HV[o]); }
        __syncthreads();
        for (int t = 0; t < 16; ++t) { const float vv = vL[t * 128 + v]; float part = 0.f;
#pragma unroll
            for (int i = 0; i < 32; ++i) { const int k = kg * 32 + i; S[i] = fL[t * 128 + k] * S[i] + kL[t * 128 + k] * vv; part += S[i] * qL[t * 128 + k]; }
            oP[(kg * 16 + t) * 128 + v] = part; }
        __syncthreads();
        for (int tt = 0; tt < 2; ++tt) { const int t = c.wave * 2 + tt; float o0, o1;
            { const int v0 = c.lane, v1 = c.lane + 64; o0 = oP[t * 128 + v0] + oP[(16 + t) * 128 + v0] + oP[(32 + t) * 128 + v0] + oP[(48 + t) * 128 + v0];
              o1 = oP[t * 128 + v1] + oP[(16 + t) * 128 + v1] + oP[(32 + t) * 128 + v1] + oP[(48 + t) * 128 + v1]; }
            const float ss = wave_sum(o0 * o0 + o1 * o1); const float rstd = 1.f / sqrtf(ss * (1.f / 128.f) + EPS);
            const size_t ro = (size_t)(b * LV + t0 + t);
            const float g0 = bf2f(c.HG[ro * 512 + hh * 128 + c.lane]), g1 = bf2f(c.HG[ro * 512 + hh * 128 + c.lane + 64]);
            c.MIX[ro * DM + 512 + hh * 128 + c.lane] = (bf16_t)f2bf(o0 * rstd * c.hnw[layer * 128 + c.lane] * g0);
            c.MIX[ro * DM + 512 + hh * 128 + c.lane + 64] = (bf16_t)f2bf(o1 * rstd * c.hnw[layer * 128 + c.lane + 64] * g1); }
        __syncthreads();
    }
}

__device__ __forceinline__ void final_norm(const Ctx& c) {
    f32x4 w[4];
#pragma unroll
    for (int j = 0; j < 4; ++j) w[j] = *(const f32x4*)(c.nfinal + 4 * c.lane + 256 * j);
    for (int rb = c.gw; rb < NB * SEQ; rb += 4 * c.NGW) {
        f32x4 v[4][4];
#pragma unroll
        for (int q = 0; q < 4; ++q) { const int r = rb + q * c.NGW;
            if (r < NB * SEQ) {
#pragma unroll
                for (int j = 0; j < 4; ++j) v[q][j] = *(const f32x4*)(c.out + (size_t)r * DM + 4 * c.lane + 256 * j); } }
#pragma unroll
        for (int q = 0; q < 4; ++q) { const int r = rb + q * c.NGW;
            if (r < NB * SEQ) { float s = 0.f;
#pragma unroll
                for (int j = 0; j < 4; ++j) s += (v[q][j].x * v[q][j].x + v[q][j].y * v[q][j].y) + (v[q][j].z * v[q][j].z + v[q][j].w * v[q][j].w);
                s = wave_sum(s); const float rstd = 1.f / sqrtf(s * (1.f / DM) + EPS);
#pragma unroll
                for (int j = 0; j < 4; ++j) *(f32x4*)(c.out + (size_t)r * DM + 4 * c.lane + 256 * j) = v[q][j] * rstd * w[j]; } }
    }
}

__device__ __forceinline__ void idle_slot_weights(Ctx& c, LAS unsigned char* lds, int first, int nb, int it0, int it1, bool extra) {
    int t_ = threadIdx.x; asm volatile("" : "+v"(t_)); c.tid = t_; c.lane = t_ & 63;
    int bi = (int)blockIdx.x - first, nw = nb * NWAVES, nt = nb * NTHREADS, a0 = it0, a1 = it1;
    asm volatile("" : "+v"(bi), "+v"(nw), "+v"(nt), "+v"(a0), "+v"(a1));
    bi = __builtin_amdgcn_readfirstlane(bi); nw = __builtin_amdgcn_readfirstlane(nw); nt = __builtin_amdgcn_readfirstlane(nt); a0 = __builtin_amdgcn_readfirstlane(a0); a1 = __builtin_amdgcn_readfirstlane(a1);
    const int wv = __builtin_amdgcn_readfirstlane(t_ >> 6);
    p0_weights(c, lds, 1, a0, a1, bi * NWAVES + wv, nw);
    if (extra) p0_extra_rows(c, 1, bi * NTHREADS + t_, nt);
}

__global__ void __launch_bounds__(NTHREADS, 2) fwd_kernel(Args a) {
    extern __shared__ __attribute__((aligned(16))) unsigned char lds_raw[];
    LAS unsigned char* lds = (LAS unsigned char*)lds_raw;
    cg::grid_group grid = cg::this_grid();
    Ctx c;
    c.x = a.in[0]; c.meta = a.in[1]; c.nmw = a.in[2]; c.win = a.in[3]; c.fbias = a.in[4]; c.lbraw = a.in[5]; c.hnw = a.in[6]; c.wout = a.in[7];
    c.nfw = a.in[8]; c.wg = a.in[9]; c.wu = a.in[10]; c.wd = a.in[11]; c.nfinal = a.in[12];
    c.out = a.out; c.ws = a.ws;
    c.ctl = (unsigned*)(a.ws + WS_CTL); c.sumsq = (float*)(a.ws + WS_SUMSQ); c.lbv = (float*)(a.ws + WS_LBV); c.logf8 = (float*)(a.ws + WS_LOGF8);
    c.kbias = (float*)(a.ws + WS_KBIAS); c.hs = (float*)(a.ws + WS_HS);
    c.HB = (bf16_t*)(a.ws + WS_HB); c.MIX = (bf16_t*)(a.ws + WS_MIX); c.QB = (bf16_t*)(a.ws + WS_QB); c.KB = (bf16_t*)(a.ws + WS_KB); c.VB = (bf16_t*)(a.ws + WS_VB);
    c.HXQ = (bf16_t*)(a.ws + WS_HXQ); c.LOGF = (float*)(a.ws + WS_LOGF); c.HV = (bf16_t*)(a.ws + WS_HV); c.HG = (bf16_t*)(a.ws + WS_HG); c.ACT = (bf16_t*)(a.ws + WS_ACT);
    c.tid = threadIdx.x; c.lane = c.tid & 63; c.wave = __builtin_amdgcn_readfirstlane(c.tid >> 6);
    c.gw = blockIdx.x * NWAVES + c.wave; c.NGW = gridDim.x * NWAVES;
    volatile LAS unsigned* bst = (volatile LAS unsigned*)(lds + 131072 + 64);
    if (c.tid == 0) { bst[0] = 0u; bst[1] = 0u; }
    __syncthreads();
    const XcdBarrier bar = xcd_barrier_post((unsigned*)(a.ws + WS_BAR), bst);
#define GSYNC() xcd_barrier(bar)
    bf16_t* SD = (bf16_t*)(a.ws + WS_HB);
    float* DV = (float*)(a.ws + WS_DV);

    { const int gt = blockIdx.x * NTHREADS + c.tid, NGT = gridDim.x * NTHREADS;
      for (int i = gt; i < 16384; i += NGT) c.ctl[i] = (i == 8) ? 1u : 0u;
      for (int i = gt; i < 3 * MALLOC; i += NGT) c.sumsq[MALLOC + i] = 0.f;
      for (int i = gt; i < HGW; i += NGT) c.lbv[i] = 1.f / (1.f + __expf(c.lbraw[i] - c.lbraw[HGW + i])); }
    p0_weights(c, lds, 0, 0, 1 << 30, c.gw, c.NGW);
    p0_extra_rows(c, 0, blockIdx.x * NTHREADS + c.tid, gridDim.x * NTHREADS);
    if (gridDim.x != 256) { p0_weights(c, lds, 1, 0, 1 << 30, c.gw, c.NGW); p0_extra_rows(c, 1, blockIdx.x * NTHREADS + c.tid, gridDim.x * NTHREADS); }
    __syncthreads();
    if constexpr (DUPMASK & 1) { LAUNDER0(); p0_weights(c, lds, 0, 0, 1 << 30, c.gw, c.NGW); __syncthreads(); }
    h_build(c);
    grid.sync();
#define LAUNDER() do { int t_ = threadIdx.x; asm volatile("" : "+v"(t_)); c.tid = t_; c.lane = t_ & 63; } while (0)
    for (int layer = 0; layer < 2; ++layer) {
        LAUNDER();
        if constexpr (FASTMASK & 1) gemm_fast<0>(c, lds, layer); else gemm_simple<0>(c, layer);
        if constexpr (DUPMASK & 2) { LAUNDER(); gemm_fast<0>(c, lds, layer); }
        if (layer == 0 && gridDim.x == 256 && blockIdx.x >= 207) idle_slot_weights(c, lds, 207, 49, 0, 16 * (NIN / 32), true);
        GSYNC();
        LAUNDER();
        hgrn_A_phase(c, lds, SD, DV);
        if (blockIdx.x >= gridDim.x - 32) { LAUNDER(); kbias_job(c, lds, (int)(gridDim.x - 1 - blockIdx.x)); }
        LAUNDER();
        for (int job = blockIdx.x; job < 256; job += gridDim.x) knorm_job(c, layer, job);
        if constexpr (DUPMASK & 4) { LAUNDER(); hgrn_A_phase(c, lds, SD, DV); }
        GSYNC();
        LAUNDER();
        hgrn_B_scan(c, SD, DV);
        GSYNC();
        LAUNDER();
        hgrn_C_phase(c, lds, layer, SD);
        LAUNDER();
        mix_queue(c, lds_raw, layer, SD, c.ctl + 64 * (1 + layer));
        if constexpr (DUPMASK & 8) { LAUNDER(); mix_queue(c, lds_raw, layer, SD, c.ctl + 64 * (3 + layer)); }
        if constexpr (DUPMASK & 256) { LAUNDER(); hgrn_C_phase(c, lds, layer, SD); }
        if constexpr (DUPMASK & 128) { for (int i = 0; i < 8; ++i) GSYNC(); }
        GSYNC();
        LAUNDER();
        if constexpr (DUPMASK & 16) { gemm_fast<1>(c, lds, layer, c.ctl[8]); LAUNDER(); }
        if constexpr (FASTMASK & 2) gemm_fast<1>(c, lds, layer); else gemm_simple<1>(c, layer);
        GSYNC();
        if constexpr (FASTMASK & 4) gemm_fast<2>(c, lds, layer); else gemm_simple<2>(c, layer);
        if constexpr (DUPMASK & 32) { LAUNDER(); gemm_fast<2>(c, lds, layer); }
        if (layer == 0 && gridDim.x == 256 && blockIdx.x >= 150) idle_slot_weights(c, lds, 150, 106, 16 * (NIN / 32), 1 << 30, false);
        GSYNC();
        if constexpr (DUPMASK & 64) { gemm_fast<3>(c, lds, layer, c.ctl[8]); LAUNDER(); }
        if constexpr (FASTMASK & 8) gemm_fast<3>(c, lds, layer); else gemm_simple<3>(c, layer);
        GSYNC();
    }
    LAUNDER();
    final_norm(c);
}

extern "C" void kernel_launch(void* const* d_in, const int* in_sizes, int n_in, void* d_out, int out_size, void* d_ws, size_t ws_size, hipStream_t stream) {
    static int grid = 0;
    if (grid == 0) {
        if (n_in != 13 || out_size != NB * SEQ * DM || ws_size < WS_END) { fprintf(stderr, "kernel_launch: unexpected shapes n_in %d out %d ws %zu\n", n_in, out_size, ws_size); grid = -1; return; }
        int dev = 0, cus = 0, per_cu = 0;
        (void)hipGetDevice(&dev); (void)hipDeviceGetAttribute(&cus, hipDeviceAttributeMultiprocessorCount, dev);
        (void)hipFuncSetAttribute((const void*)fwd_kernel, hipFuncAttributeMaxDynamicSharedMemorySize, LDS_BYTES);
        (void)hipOccupancyMaxActiveBlocksPerMultiprocessor(&per_cu, (const void*)fwd_kernel, NTHREADS, LDS_BYTES);
        if (per_cu < 1) per_cu = 1;
        grid = cus * per_cu;
        (void)hipGetLastError();
    }
    if (grid < 0) return;
    Args a{};
    for (int i = 0; i < 13; ++i) a.in[i] = (const float*)d_in[i];
    a.out = (float*)d_out; a.ws = (unsigned char*)d_ws;
    (void)hipMemsetAsync((unsigned char*)d_ws + WS_BAR, 0, 16384, stream);
    void* args[] = {&a};
    hipError_t e = hipLaunchCooperativeKernel((const void*)fwd_kernel, dim3(grid), dim3(NTHREADS), args, LDS_BYTES, stream);
    if (e != hipSuccess) fprintf(stderr, "cooperative launch failed: %s (grid %d)\n", hipGetErrorString(e), grid);
}
```
